# Optimizing an MI355X kernel written in HIP

```python
import math
import jax, jax.numpy as jnp
from jax import lax
import numpy as np

D_MODEL = 1024
BATCH = 8
SEQ = 2048
DEPTH = 1

CHUNK = 64
Q_BLOCK = 128
SSM_WIDTH = D_MODEL // 2
SSM_GROUP = 16
SSM_GROUPS = SSM_WIDTH // SSM_GROUP
SSM_STATE = 64
ATT_HEADS = 4
ATT_SUB_DIM = 64
ATT_V_DIM = 2 * ATT_SUB_DIM
ATT_QK_WIDTH = ATT_HEADS * 2 * ATT_SUB_DIM
ATT_V_WIDTH = ATT_HEADS * ATT_V_DIM
IN_WIDTH = SSM_WIDTH + 2 * ATT_QK_WIDTH + ATT_V_WIDTH + 2 * D_MODEL
N_EXPERTS = 32
TOP_K = 4
D_EXPERT = D_MODEL
SWIGLU_ALPHA = 1.702
SWIGLU_LIMIT = 7.0
MOE_BLOCK = 256
RMS_EPS = 1e-6

kernel_name = "hybrid_s5_diffattn_moe_block"


def rms_norm(x, g):
    xf = x.astype(jnp.float32)
    y = xf * lax.rsqrt(jnp.mean(xf * xf, axis=-1, keepdims=True) + RMS_EPS)
    return (y * g.astype(jnp.float32)).astype(x.dtype)


def _complex_linear_combine(left, right):
    a1r, a1i, b1r, b1i = left
    a2r, a2i, b2r, b2i = right
    ar = a2r * a1r - a2i * a1i
    ai = a2r * a1i + a2i * a1r
    br = a2r * b1r - a2i * b1i + b2r
    bi = a2r * b1i + a2i * b1r + b2i
    return (ar, ai, br, bi)


def s5_branch(u, a_re, a_im, log_dt, b_re, b_im, c_re, c_im, d_skip, w_glu, b_glu):
    f32 = jnp.float32
    bsz, seq, _ = u.shape
    ug = u.astype(f32).reshape(bsz, seq, SSM_GROUPS, SSM_GROUP)
    dt = jnp.exp(log_dt.astype(f32))[:, None]
    lr = a_re.astype(f32)
    li = a_im.astype(f32)
    mag = jnp.exp(lr * dt)
    abar_r = mag * jnp.cos(li * dt)
    abar_i = mag * jnp.sin(li * dt)
    den = lr * lr + li * li
    nr = abar_r - 1.0
    ni = abar_i
    coef_r = (nr * lr + ni * li) / den
    coef_i = (ni * lr - nr * li) / den
    br_ = b_re.astype(f32)
    bi_ = b_im.astype(f32)
    bbar_r = coef_r[..., None] * br_ - coef_i[..., None] * bi_
    bbar_i = coef_r[..., None] * bi_ + coef_i[..., None] * br_
    inp_r = jnp.einsum('blgh,gph->blgp', ug, bbar_r)
    inp_i = jnp.einsum('blgh,gph->blgp', ug, bbar_i)
    a_r = jnp.broadcast_to(abar_r, inp_r.shape)
    a_i = jnp.broadcast_to(abar_i, inp_i.shape)
    _, _, st_r, st_i = lax.associative_scan(
        _complex_linear_combine, (a_r, a_i, inp_r, inp_i), axis=1)
    y = (jnp.einsum('blgp,ghp->blgh', st_r, c_re.astype(f32))
         - jnp.einsum('blgp,ghp->blgh', st_i, c_im.astype(f32))
         + d_skip.astype(f32).reshape(SSM_GROUPS, SSM_GROUP) * ug)
    y = jax.nn.gelu(y.reshape(bsz, seq, SSM_WIDTH))
    y = y * jax.nn.sigmoid(y @ w_glu.astype(f32) + b_glu.astype(f32))
    return y.astype(u.dtype)


def diff_attention(q, k, v, q_g, k_g, lq1, lk1, lq2, lk2, subln_g, lambda_init):
    f32 = jnp.float32
    bsz, seq, _ = q.shape
    q = rms_norm(q.reshape(bsz, seq, ATT_HEADS, 2, ATT_SUB_DIM), q_g)
    k = rms_norm(k.reshape(bsz, seq, ATT_HEADS, 2, ATT_SUB_DIM), k_g)
    v = v.reshape(bsz, seq, ATT_HEADS, ATT_V_DIM)
    lam = (jnp.exp(jnp.sum(lq1.astype(f32) * lk1.astype(f32)))
           - jnp.exp(jnp.sum(lq2.astype(f32) * lk2.astype(f32))) + lambda_init)
    n_blocks = seq // Q_BLOCK
    q_blocks = q.reshape(bsz, n_blocks, Q_BLOCK, ATT_HEADS, 2, ATT_SUB_DIM).transpose(1, 0, 2, 3, 4, 5)
    key_chunk = jnp.arange(seq) // CHUNK
    scale = ATT_SUB_DIM ** -0.5

    def one_block(args):
        qblk, bi = args
        qpos = bi * Q_BLOCK + jnp.arange(Q_BLOCK)
        allowed = key_chunk[None, :] <= (qpos // CHUNK)[:, None]
        s = jnp.einsum('bqhtd,bkhtd->bhtqk', qblk, k).astype(f32) * scale
        p = jax.nn.softmax(jnp.where(allowed, s, -jnp.inf), axis=-1)
        w = p[:, :, 0] - lam * p[:, :, 1]
        return jnp.einsum('bhqk,bkhe->bqhe', w.astype(v.dtype), v)

    o = lax.map(one_block, (q_blocks, jnp.arange(n_blocks)))
    o = o.transpose(1, 0, 2, 3, 4).reshape(bsz, seq, ATT_HEADS, ATT_V_DIM)
    o = rms_norm(o, subln_g) * (1.0 - lambda_init)
    return o.reshape(bsz, seq, ATT_V_WIDTH)


def moe_ffn(hn, w_router, b_router, w_up, b_up, w_down, b_down):
    bsz, seq, dm = hn.shape
    xf = hn.reshape(-1, dm)
    n_tok = xf.shape[0]
    logits = (xf @ w_router + b_router).astype(jnp.float32)
    top_v, top_i = lax.top_k(logits, TOP_K)
    top_w = jax.nn.softmax(top_v, axis=-1)
    m = n_tok * TOP_K
    flat_e = top_i.reshape(-1)
    flat_tok = jnp.repeat(jnp.arange(n_tok, dtype=jnp.int32), TOP_K)
    flat_w = top_w.reshape(-1)
    order = jnp.argsort(flat_e)
    sorted_e = flat_e[order]
    counts = jnp.bincount(flat_e, length=N_EXPERTS)
    padded = ((counts + MOE_BLOCK - 1) // MOE_BLOCK) * MOE_BLOCK
    pad_end = jnp.cumsum(padded)
    pad_start = pad_end - padded
    start = jnp.cumsum(counts) - counts
    dest = pad_start[sorted_e] + jnp.arange(m) - start[sorted_e]
    n_rows = ((m + MOE_BLOCK - 1) // MOE_BLOCK) * MOE_BLOCK + N_EXPERTS * MOE_BLOCK
    n_blocks = n_rows // MOE_BLOCK
    row_tok = jnp.zeros((n_rows,), jnp.int32).at[dest].set(flat_tok[order])
    row_w = jnp.zeros((n_rows,), jnp.float32).at[dest].set(flat_w[order])
    block_e = jnp.minimum(
        jnp.searchsorted(pad_end, jnp.arange(n_blocks) * MOE_BLOCK, side='right'), N_EXPERTS - 1)
    xs = xf[row_tok].reshape(n_blocks, MOE_BLOCK, dm)

    def expert_block(args):
        xb, e = args
        hup = xb @ w_up[e] + b_up[e]
        glu = jnp.minimum(hup[:, 0::2], SWIGLU_LIMIT)
        lin = jnp.clip(hup[:, 1::2], -SWIGLU_LIMIT, SWIGLU_LIMIT)
        act = glu * jax.nn.sigmoid(SWIGLU_ALPHA * glu) * (lin + 1.0)
        return act @ w_down[e] + b_down[e]

    ys = lax.map(expert_block, (xs, block_e)).reshape(n_rows, dm)
    out = jnp.zeros_like(xf).at[row_tok].add(ys * row_w[:, None].astype(ys.dtype))
    return out.reshape(bsz, seq, dm)


def setup_inputs(seed: int = 0) -> dict:
    key = jax.random.key(seed)
    ks = jax.random.split(key, 32)
    f32 = jnp.float32

    def nrm(k, shape, scale):
        return jax.random.normal(k, shape, f32) * scale

    G, P, H, S = SSM_GROUPS, SSM_STATE, SSM_GROUP, SSM_WIDTH
    a_im_init = jnp.pi * jnp.arange(P, dtype=f32)
    return {
        "x": nrm(ks[0], (BATCH, SEQ, D_MODEL), 1.0),
        "norm1_g": 1.0 + nrm(ks[1], (DEPTH, D_MODEL), 0.02),
        "w_in": nrm(ks[2], (DEPTH, D_MODEL, IN_WIDTH), D_MODEL ** -0.5),
        "b_gate": nrm(ks[3], (DEPTH, 2 * D_MODEL), 0.01),
        "ssm_a_re": -0.5 + nrm(ks[4], (DEPTH, G, P), 0.01),
        "ssm_a_im": a_im_init + nrm(ks[5], (DEPTH, G, P), 0.01),
        "ssm_log_dt": jax.random.uniform(ks[6], (DEPTH, G), f32, math.log(1e-3), math.log(1e-1)),
        "ssm_b_re": nrm(ks[7], (DEPTH, G, P, H), (2 * H) ** -0.5),
        "ssm_b_im": nrm(ks[8], (DEPTH, G, P, H), (2 * H) ** -0.5),
        "ssm_c_re": nrm(ks[9], (DEPTH, G, H, P), (2 * P) ** -0.5),
        "ssm_c_im": nrm(ks[10], (DEPTH, G, H, P), (2 * P) ** -0.5),
        "ssm_d": nrm(ks[11], (DEPTH, S), 1.0),
        "ssm_w_glu": nrm(ks[12], (DEPTH, S, S), S ** -0.5),
        "ssm_b_glu": nrm(ks[13], (DEPTH, S), 0.01),
        "q_norm_g": 1.0 + nrm(ks[14], (DEPTH, ATT_SUB_DIM), 0.02),
        "k_norm_g": 1.0 + nrm(ks[15], (DEPTH, ATT_SUB_DIM), 0.02),
        "lambda_q1": nrm(ks[16], (DEPTH, ATT_SUB_DIM), 0.1),
        "lambda_k1": nrm(ks[17], (DEPTH, ATT_SUB_DIM), 0.1),
        "lambda_q2": nrm(ks[18], (DEPTH, ATT_SUB_DIM), 0.1),
        "lambda_k2": nrm(ks[19], (DEPTH, ATT_SUB_DIM), 0.1),
        "subln_g": 1.0 + nrm(ks[20], (DEPTH, ATT_V_DIM), 0.02),
        "w_proj_ssm": nrm(ks[21], (DEPTH, S, D_MODEL), S ** -0.5),
        "w_proj_att": nrm(ks[22], (DEPTH, ATT_V_WIDTH, D_MODEL), ATT_V_WIDTH ** -0.5),
        "w_out": nrm(ks[23], (DEPTH, D_MODEL, D_MODEL), D_MODEL ** -0.5),
        "norm2_g": 1.0 + nrm(ks[24], (DEPTH, D_MODEL), 0.02),
        "w_router": nrm(ks[25], (DEPTH, D_MODEL, N_EXPERTS), D_MODEL ** -0.5),
        "b_router": nrm(ks[26], (DEPTH, N_EXPERTS), 0.01),
        "w_up": nrm(ks[27], (DEPTH, N_EXPERTS, D_MODEL, 2 * D_EXPERT), D_MODEL ** -0.5),
        "b_up": nrm(ks[28], (DEPTH, N_EXPERTS, 2 * D_EXPERT), 0.01),
        "w_down": nrm(ks[29], (DEPTH, N_EXPERTS, D_EXPERT, D_MODEL), D_EXPERT ** -0.5),
        "b_down": nrm(ks[30], (DEPTH, N_EXPERTS, D_MODEL), 0.01),
    }


def reference(x, norm1_g, w_in, b_gate, ssm_a_re, ssm_a_im, ssm_log_dt, ssm_b_re, ssm_b_im,
              ssm_c_re, ssm_c_im, ssm_d, ssm_w_glu, ssm_b_glu, q_norm_g, k_norm_g,
              lambda_q1, lambda_k1, lambda_q2, lambda_k2, subln_g, w_proj_ssm, w_proj_att,
              w_out, norm2_g, w_router, b_router, w_up, b_up, w_down, b_down):
    split_at = [SSM_WIDTH,
                SSM_WIDTH + ATT_QK_WIDTH,
                SSM_WIDTH + 2 * ATT_QK_WIDTH,
                SSM_WIDTH + 2 * ATT_QK_WIDTH + ATT_V_WIDTH,
                SSM_WIDTH + 2 * ATT_QK_WIDTH + ATT_V_WIDTH + D_MODEL]
    h = x
    for l in range(DEPTH):
        lambda_init = 0.8 - 0.6 * math.exp(-0.3 * l)
        xn = rms_norm(h, norm1_g[l])
        z = xn @ w_in[l]
        u, q, k, v, g_ssm, g_att = jnp.split(z, split_at, axis=-1)
        y_ssm = s5_branch(u, ssm_a_re[l], ssm_a_im[l], ssm_log_dt[l], ssm_b_re[l], ssm_b_im[l],
                          ssm_c_re[l], ssm_c_im[l], ssm_d[l], ssm_w_glu[l], ssm_b_glu[l])
        y_att = diff_attention(q, k, v, q_norm_g[l], k_norm_g[l], lambda_q1[l], lambda_k1[l],
                               lambda_q2[l], lambda_k2[l], subln_g[l], lambda_init)
        gate_ssm = jax.nn.sigmoid(g_ssm + b_gate[l, :D_MODEL])
        gate_att = jax.nn.sigmoid(g_att + b_gate[l, D_MODEL:])
        mixed = gate_ssm * (y_ssm @ w_proj_ssm[l]) + gate_att * (y_att @ w_proj_att[l])
        h = h + mixed @ w_out[l]
        hn = rms_norm(h, norm2_g[l])
        h = h + moe_ffn(hn, w_router[l], b_router[l], w_up[l], b_up[l], w_down[l], b_down[l])
    return h
```

```cpp
#include <hip/hip_runtime.h>
#include <cstdio>
#include <cstdint>

#ifndef MK_N_LAUNCHES
#define MK_N_LAUNCHES 1
#endif
#ifndef PROBE_REP
#define PROBE_REP -1
#endif
#define NREP(k) ((PROBE_REP == (k)) ? 2 : 1)

namespace pg8 {
#define PG8_LAS __attribute__((address_space(3)))
typedef unsigned short bf16_t;
typedef short bf16x8 __attribute__((ext_vector_type(8)));
typedef float f32x4 __attribute__((ext_vector_type(4)));
typedef unsigned u32x4 __attribute__((ext_vector_type(4)));
typedef unsigned u32x2 __attribute__((ext_vector_type(2)));
constexpr int BM = 256, BK = 64, HALF = 128, HTB = HALF * BK * 2  , STAGE_BYTES = 8 * HTB, NXCD = 8, WGM = 8;

__host__ __device__ __forceinline__ int lds_byte(int r, int c) { const int st = (r >> 4) * 2 + (c >> 5), rr = r & 15, cc = c & 31, ob = rr * 64 + cc * 2; return st * 1024 + (ob ^ (((ob >> 9) & 1) * 48)); }
__host__ __device__ __forceinline__ void stage_rc(int b, int& R, int& C) { const int st = b / 1024, sb = b % 1024, swz = sb ^ (((sb >> 9) & 1) * 48); R = (st >> 1) * 16 + swz / 64; C = (st & 1) * 32 + (swz % 64) / 2; }
__host__ __device__ __forceinline__ int perm32(int rho) { const int n = rho >> 4, i = rho & 15; return 8 * (i >> 2) + 4 * n + (i & 3); }

struct Unit { int pm, pn; };
struct Gemm { const bf16_t* A; const bf16_t* Bt; int M, N, K; };

struct StaticOrder {
    int nM, nN, nwg, G, c;
    __host__ __device__ void init(int M, int N, int G_, int c_) { nM = M / BM; nN = N / BM; nwg = nM * nN; G = G_; c = c_; }
    __host__ __device__ bool next(int i, Unit& u) const {
        const long L = (long)i * G + c; if (L >= nwg) return false;
        int wgid = (int)L; { const int q = nwg / NXCD, r = nwg % NXCD, xcd = wgid % NXCD, off = wgid / NXCD; wgid = (xcd < r ? xcd * (q + 1) : r * (q + 1) + (xcd - r) * q) + off; }
        const int nig = WGM * nN, gid = wgid / nig, fm = gid * WGM, gsz = (nM - fm) < WGM ? (nM - fm) : WGM;
        u.pm = fm + ((wgid % nig) % gsz); u.pn = (wgid % nig) / gsz; return true;
    }
    __device__ __forceinline__ int row_slot(const Unit&, int) const { return 0; }
    __device__ __forceinline__ int a_row(const Unit& u, int r, int) const { return u.pm * BM + r; }
};

__device__ __forceinline__ unsigned cvt_pk_bf16(float lo, float hi) { unsigned r; asm volatile("v_cvt_pk_bf16_f32 %0, %1, %2" : "=v"(r) : "v"(lo), "v"(hi)); return r; }

typedef int v8i __attribute__((ext_vector_type(8)));
typedef int v4i __attribute__((ext_vector_type(4)));
template <class Epi, class Sched, bool ALIGN_EPI = false, bool ROWTAB = false, bool GATHER = false, bool FP8 = false>
__device__ __forceinline__ void gemm_phase(PG8_LAS unsigned char* lds, const Gemm g, const Sched& S, const Epi& E, const int sA8 = 127, const int sB8 = 127) {
    static_assert(!GATHER || ROWTAB, "GATHER needs ROWTAB");
    const int tid = threadIdx.x, wid = __builtin_amdgcn_readfirstlane(tid >> 6), lane = tid & 63, wr = wid >> 2, wc = wid & 3, fr = lane & 15, fq = lane >> 4;
    const int K = g.K, RB = FP8 ? K : 2 * K  , nt = RB / (2 * BK);
    unsigned voffA[2], voffB[2];
#pragma unroll
    for (int i = 0; i < 2; ++i) { int R, C; stage_rc(tid * 16 + i * 8192, R, C); const int Rb = Epi::PERM ? ((R & ~31) + perm32(R & 31)) : R;
        voffA[i] = (unsigned)(R * RB + 2 * C); voffB[i] = (unsigned)(Rb * RB + 2 * C); }
    unsigned vA[2][2] = {{0u, 0u}, {0u, 0u}};
    const size_t kstep = (size_t)(BK * 2);
    const size_t hstep = (size_t)HALF * RB;
    const size_t tstep = 2 * hstep;
    const unsigned ldsw = (unsigned)wid * 1024u;
    const int aoff = FP8 ? lds_byte(wr * 64 + fr, fq * 16) : lds_byte(wr * 64 + fr, fq * 8), boff = FP8 ? lds_byte(wc * 32 + fr, fq * 16) : lds_byte(wc * 32 + fr, fq * 8);
    PG8_LAS int* tab = (PG8_LAS int*)(lds + STAGE_BYTES);
#define PG8_SA(b, h) (((b) * 2 + (h)) * HTB)
#define PG8_SB(b, h) ((4 + (b) * 2 + (h)) * HTB)
#define PG8_STAGE(bufoff, gbase, voff) do { _Pragma("unroll") for (int _i = 0; _i < 2; ++_i) \
        __builtin_amdgcn_global_load_lds((const unsigned*)((const char*)(gbase) + (voff)[_i]), (PG8_LAS unsigned*)(lds + (bufoff) + ldsw + _i * 8192), 16, 0, 0); } while (0)
#define PG8_STAGE_A(bufoff, kbase, h) do { if constexpr (GATHER) { PG8_STAGE(bufoff, kbase, vA[h]); } else { PG8_STAGE(bufoff, (kbase) + (h) * hstep, voffA); } } while (0)
#define PG8_LOAD_VA(sel, un) do { _Pragma("unroll") for (int _i = 0; _i < 2; ++_i) { int R_, C_; stage_rc(tid * 16 + _i * 8192, R_, C_); \
        _Pragma("unroll") for (int _h = 0; _h < 2; ++_h) { const int s_ = tab[(sel) * 256 + _h * HALF + R_]; vA[_h][_i] = (unsigned)(S.a_row(un, _h * HALF + R_, s_) * RB + 2 * C_); } } } while (0)
#define PG8_LDA(dst, b, h) do { _Pragma("unroll") for (int m = 0; m < 4; ++m) _Pragma("unroll") for (int k = 0; k < 2; ++k) dst[m][k] = *(const PG8_LAS bf16x8*)(lds + PG8_SA(b, h) + (FP8 ? (aoff ^ (16 * k)) : aoff + k * 1024) + m * 2048); } while (0)
#define PG8_LDB(dst, b, h) do { _Pragma("unroll") for (int n = 0; n < 2; ++n) _Pragma("unroll") for (int k = 0; k < 2; ++k) dst[n][k] = *(const PG8_LAS bf16x8*)(lds + PG8_SB(b, h) + (FP8 ? (boff ^ (16 * k)) : boff + k * 1024) + n * 2048); } while (0)
#define PG8_V8(x) __builtin_shufflevector(__builtin_bit_cast(v4i, (x)[0]), __builtin_bit_cast(v4i, (x)[1]), 0, 1, 2, 3, 4, 5, 6, 7)
#define PG8_MMA(ai, bj, At, Bt) do { __builtin_amdgcn_s_setprio(1); if constexpr (FP8) { _Pragma("unroll") for (int m = 0; m < 4; ++m) _Pragma("unroll") for (int n = 0; n < 2; ++n) \
        acc[ai][bj][m][n] = __builtin_amdgcn_mfma_scale_f32_16x16x128_f8f6f4(PG8_V8(Bt[n]), PG8_V8(At[m]), acc[ai][bj][m][n], 0, 0, 0, sB8, 0, sA8); } else { \
        _Pragma("unroll") for (int m = 0; m < 4; ++m) _Pragma("unroll") for (int n = 0; n < 2; ++n) _Pragma("unroll") for (int k = 0; k < 2; ++k) \
        acc[ai][bj][m][n] = __builtin_amdgcn_mfma_f32_16x16x32_bf16(Bt[n][k], At[m][k], acc[ai][bj][m][n], 0, 0, 0); } __builtin_amdgcn_s_setprio(0); } while (0)
#define PG8_WAIT_V(n) asm volatile("s_waitcnt vmcnt(" #n ")" ::: "memory")
#define PG8_WAIT_L(n) asm volatile("s_waitcnt lgkmcnt(" #n ")" ::: "memory")
#define PG8_BAR __builtin_amdgcn_s_barrier()
#define PG8_SCHED __builtin_amdgcn_sched_barrier(0)
    Unit cur, nxt; int ui = 0;
    if (!S.next(0, cur)) return;
    f32x4 acc[2][2][4][2];
#pragma unroll
    for (int a = 0; a < 2; ++a)
#pragma unroll
        for (int b = 0; b < 2; ++b)
#pragma unroll
            for (int m = 0; m < 4; ++m)
#pragma unroll
                for (int n = 0; n < 2; ++n) acc[a][b][m][n] = (f32x4){0.f, 0.f, 0.f, 0.f};
    bf16x8 At[4][2], B0[2][2], B1[2][2];
    if constexpr (ROWTAB) {
        if (tid < 256) tab[tid] = S.row_slot(cur, tid);
        PG8_WAIT_L(0); PG8_BAR; asm volatile("" ::: "memory");
        if constexpr (GATHER) { PG8_LOAD_VA(0, cur); }
    }
    const char* cA = GATHER ? (const char*)g.A : (const char*)g.A + (size_t)cur.pm * tstep; const char* cB = (const char*)g.Bt + (size_t)cur.pn * tstep;
    PG8_STAGE(PG8_SB(0, 0), cB, voffB); PG8_STAGE(PG8_SB(0, 1), cB + hstep, voffB); PG8_STAGE_A(PG8_SA(0, 0), cA, 0); PG8_STAGE_A(PG8_SA(0, 1), cA, 1);
    if (wr == 1) PG8_BAR;
    PG8_WAIT_V(2); PG8_BAR;
    PG8_STAGE(PG8_SB(1, 0), cB + kstep, voffB); PG8_STAGE_A(PG8_SA(1, 0), cA + kstep, 0); PG8_STAGE(PG8_SB(1, 1), cB + hstep + kstep, voffB);
    PG8_WAIT_V(6); PG8_BAR;
    for (;;) {
        const bool has_next = S.next(ui + 1, nxt);
        if constexpr (ROWTAB) { if (has_next && tid < 256) tab[((ui + 1) % 3) * 256 + tid] = S.row_slot(nxt, tid); }
        const char* nA = has_next ? (GATHER ? (const char*)g.A : (const char*)g.A + (size_t)nxt.pm * tstep) : cA; const char* nB = has_next ? (const char*)g.Bt + (size_t)nxt.pn * tstep : cB;
        for (int t = 0; t < nt; t += 2) {
            const bool last = (t == nt - 2);
            const char* a1 = cA + (size_t)(t + 1) * kstep;
            const char* a2 = last ? nA : cA + (size_t)(t + 2) * kstep; const char* b2 = last ? nB : cB + (size_t)(t + 2) * kstep;
            const char* a3 = a2 + kstep; const char* b3 = b2 + kstep;
            PG8_LDB(B0, 0, 0); PG8_LDB(B1, 0, 1); PG8_SCHED; PG8_LDA(At, 0, 0); PG8_STAGE_A(PG8_SA(1, 1), a1, 1);
            if constexpr (GATHER) { if (last && has_next) { PG8_LOAD_VA((ui + 1) % 3, nxt); } }
            PG8_WAIT_V(8); PG8_WAIT_L(0); PG8_BAR; PG8_MMA(0, 0, At, B0); PG8_MMA(0, 1, At, B1); PG8_BAR; PG8_SCHED;
            PG8_LDA(At, 0, 1); PG8_STAGE(PG8_SB(0, 0), b2, voffB); PG8_STAGE(PG8_SB(0, 1), b2 + hstep, voffB); PG8_STAGE_A(PG8_SA(0, 0), a2, 0);
            PG8_WAIT_V(8); PG8_WAIT_L(0); PG8_BAR; PG8_MMA(1, 0, At, B0); PG8_MMA(1, 1, At, B1); PG8_BAR; PG8_SCHED;
            PG8_LDB(B0, 1, 0); PG8_LDB(B1, 1, 1); PG8_SCHED; PG8_LDA(At, 1, 0); PG8_STAGE_A(PG8_SA(0, 1), a2, 1);
            PG8_WAIT_V(8); PG8_WAIT_L(0); PG8_BAR; PG8_MMA(0, 0, At, B0); PG8_MMA(0, 1, At, B1); PG8_BAR; PG8_SCHED;
            PG8_LDA(At, 1, 1); PG8_STAGE(PG8_SB(1, 0), b3, voffB); PG8_STAGE(PG8_SB(1, 1), b3 + hstep, voffB); PG8_STAGE_A(PG8_SA(1, 0), a3, 0);
            PG8_WAIT_V(8); PG8_WAIT_L(0); PG8_BAR; PG8_MMA(1, 0, At, B0); PG8_MMA(1, 1, At, B1); PG8_BAR; PG8_SCHED;
        }
        if constexpr (ALIGN_EPI) { if (wr == 0) PG8_BAR; }
        E(acc, cur, wr, wc, fr, fq, (const PG8_LAS int*)(tab + (ui % 3) * 256));
        if (!has_next) break;
#pragma unroll
        for (int a = 0; a < 2; ++a)
#pragma unroll
            for (int b = 0; b < 2; ++b)
#pragma unroll
                for (int m = 0; m < 4; ++m)
#pragma unroll
                    for (int n = 0; n < 2; ++n) acc[a][b][m][n] = (f32x4){0.f, 0.f, 0.f, 0.f};
        cur = nxt; cA = nA; cB = nB; ++ui;
        if constexpr (ALIGN_EPI) { if (wr == 1) PG8_BAR; }
    }
    PG8_WAIT_V(0);
    if constexpr (!ALIGN_EPI) { if (wr == 0) PG8_BAR; }
    PG8_BAR;
#undef PG8_SA
#undef PG8_SB
#undef PG8_STAGE
#undef PG8_STAGE_A
#undef PG8_LOAD_VA
#undef PG8_LDA
#undef PG8_LDB
#undef PG8_MMA
#undef PG8_V8
#undef PG8_WAIT_V
#undef PG8_WAIT_L
#undef PG8_BAR
#undef PG8_SCHED
}
}

constexpr int NWAVES = 8;
constexpr int N_LAUNCHES = MK_N_LAUNCHES;
constexpr int PER_PHASE = 10;
constexpr int BATCH = 8, SEQ = 2048, DM = 1024, M = BATCH * SEQ;
constexpr int SSM_W = 512, SSM_G = 32, SSM_H = 16, SSM_P = 64, SSM_T = 16, SSM_NC = SEQ / SSM_T;
constexpr int ATT_H = 4, ATT_D = 64, ATT_V = 128, QK_W = 512, V_W = 512;
constexpr int IN_W = 4096;
constexpr int NE = 32, TOPK = 4, DE = 1024, UPW = 2048;
constexpr float RMS_EPS = 1e-6f;
constexpr float LAMBDA_INIT = 0.2f;
constexpr float QSCALE = 0.125f * 1.4426950408889634f;
constexpr int MOE_ROWS_MAX = M * TOPK + NE * 256;
constexpr int MOE_MT_MAX = MOE_ROWS_MAX / 256;

constexpr size_t MiB = 1u << 20;
constexpr size_t WS_CTL = 0, CTL_ZERO_BYTES = 1 * MiB;
constexpr size_t WS_WIN = 2 * MiB;
constexpr size_t WS_WGLU = 10 * MiB;
constexpr size_t WS_WPS = 11 * MiB;
constexpr size_t WS_WPA = 12 * MiB;
constexpr size_t WS_WOUT = 13 * MiB;
constexpr size_t WS_WRT = 15 * MiB;
constexpr size_t WS_S5 = 16 * MiB;
constexpr size_t WS_A16 = 24 * MiB;
constexpr size_t WS_WUP = 32 * MiB;
constexpr size_t WS_WDN = 160 * MiB;
constexpr size_t WS_XN = 224 * MiB;
constexpr size_t WS_U = 256 * MiB;
constexpr size_t WS_Q = 272 * MiB, WS_K = 288 * MiB, WS_V = 304 * MiB;
constexpr size_t WS_G1 = 320 * MiB, WS_G2 = 352 * MiB;
constexpr size_t WS_YG = 384 * MiB, WS_YS = 400 * MiB, WS_OB = 416 * MiB;
constexpr size_t WS_TA = 432 * MiB, WS_MX = 464 * MiB;
constexpr size_t WS_HB = 496 * MiB;
constexpr size_t WS_RS2 = 528 * MiB;
constexpr size_t WS_WSLOT = 529 * MiB;
constexpr size_t WS_ELIST = 530 * MiB;
constexpr size_t WS_ACT = 544 * MiB;
constexpr size_t WS_YS2 = 688 * MiB;
constexpr size_t WS_END = 816 * MiB;
constexpr int CW_BAR = 4096;
constexpr int CW_Q = 20480;
constexpr int CW_CNT = 16384;

constexpr int RING_OFF = 0, RING_BYTES = 139264;
constexpr int LDSCTL_OFF = RING_BYTES, MISC_OFF = LDSCTL_OFF;
constexpr int MOE_LDS_OFF = LDSCTL_OFF + 256;
constexpr int LDS_BYTES = 147456;

#define GAS __attribute__((address_space(1)))
#define LAS __attribute__((address_space(3)))
typedef unsigned short bf16;
typedef unsigned v4u __attribute__((ext_vector_type(4)));
typedef unsigned v2u __attribute__((ext_vector_type(2)));
typedef float f32x4 __attribute__((ext_vector_type(4)));
typedef float f32x16 __attribute__((ext_vector_type(16)));
typedef short bf16x8 __attribute__((ext_vector_type(8)));
typedef short s16x4 __attribute__((ext_vector_type(4)));
typedef GAS unsigned gu32;
#define RLX_AGENT __ATOMIC_RELAXED, __HIP_MEMORY_SCOPE_AGENT
#define LDS_WAIT() asm volatile("s_waitcnt lgkmcnt(0)" ::: "memory")
#define VM_WAIT() asm volatile("s_waitcnt vmcnt(0)" ::: "memory")
using pg8::cvt_pk_bf16;
__device__ __forceinline__ unsigned f2bf(float f) { unsigned u = __builtin_bit_cast(unsigned, f); return (u + 0x7fffu + ((u >> 16) & 1u)) >> 16; }
__device__ __forceinline__ unsigned pk4_fp8(float a, float b, float c, float d) { unsigned w = 0; w = __builtin_amdgcn_cvt_pk_fp8_f32(a, b, w, false); w = __builtin_amdgcn_cvt_pk_fp8_f32(c, d, w, true); return w; }
__device__ __forceinline__ float bf2f(unsigned b) { return __builtin_bit_cast(float, b << 16); }
__device__ __forceinline__ float bflo(unsigned w) { return __builtin_bit_cast(float, w << 16); }
__device__ __forceinline__ float bfhi(unsigned w) { return __builtin_bit_cast(float, w & 0xffff0000u); }
__device__ __forceinline__ float fsigmoid(float x) { return 1.0f / (1.0f + __expf(-x)); }
__device__ __forceinline__ float gelu_tanh(float x) { const float z = 1.5957691216057308f * (x + 0.044715f * x * x * x); return x / (1.0f + __expf(-z)); }
__device__ __forceinline__ int crow(int r, int hi) { return (r & 3) + 8 * (r >> 2) + 4 * hi; }
__device__ __forceinline__ float wave_sum(float v) {
#pragma unroll
    for (int o = 1; o < 64; o <<= 1) v += __shfl_xor(v, o);
    return v;
}

#define XB_TMO      128
#define XB_XCNT(j)  (256  + 64 * (j))
#define XB_XSUB(j)  (1280 + 64 * (j))
#define XB_XGEN(j)  (2304 + 64 * (j))
#define XB_TOP      3328
#define XB_TOPGEN   3392
#define XCD_BAR_WORDS 3456
#define XB_SPIN_CAP (1u << 18)
__device__ __forceinline__ unsigned xb_ld(unsigned* p)              { return __hip_atomic_load(p, __ATOMIC_RELAXED, __HIP_MEMORY_SCOPE_AGENT); }
__device__ __forceinline__ unsigned xb_add(unsigned* p, unsigned v) { return __hip_atomic_fetch_add(p, v, __ATOMIC_RELAXED, __HIP_MEMORY_SCOPE_AGENT); }
__device__ __forceinline__ unsigned xb_xcc_id() { return (unsigned)__builtin_amdgcn_s_getreg((3 << 11) | 20) & 0xFu; }
#define XB_SPIN(cond, bar) do { unsigned _sp = 0; while (cond) { __builtin_amdgcn_s_sleep(1); \
    if ((++_sp & 255u) == 0u) { if (xb_ld(&(bar)[XB_TMO])) break; if (_sp > XB_SPIN_CAP) { atomicAdd(&(bar)[XB_TMO], 1u); break; } } } } while (0)
struct XcdBarrier { unsigned* bar; unsigned x; volatile LAS unsigned* st; };
__device__ __forceinline__ XcdBarrier xcd_barrier_post(unsigned* bar, volatile LAS unsigned* st) {
    XcdBarrier b; b.bar = bar; b.x = xb_xcc_id(); b.st = st;
    if (threadIdx.x == 0) (void)xb_add(&bar[XB_XCNT(b.x)], 1u);
    return b;
}
__device__ __forceinline__ void xcd_barrier_complete(unsigned* bar, unsigned x, unsigned& nloc, unsigned& nx) {
    const unsigned G = gridDim.x * gridDim.y * gridDim.z;
    unsigned sum, cnt, mine, sp = 0u;
    for (;;) {
        sum = 0u; cnt = 0u; mine = 0u;
#pragma unroll
        for (unsigned j = 0; j < 16; ++j) { const unsigned c = xb_ld(&bar[XB_XCNT(j)]); sum += c; cnt += (c > 0u) ? 1u : 0u; mine = (j == x) ? c : mine; }
        if (sum == G) break;
        __builtin_amdgcn_s_sleep(1);
        if ((++sp & 255u) == 0u) { if (xb_ld(&bar[XB_TMO])) break; if (sp > XB_SPIN_CAP) { atomicAdd(&bar[XB_TMO], 1u); break; } }
    }
    nloc = mine > 0u ? mine : 1u; nx = cnt > 0u ? cnt : 1u;
}
__device__ __forceinline__ void xcd_barrier(const XcdBarrier& b) {
    asm volatile("s_waitcnt vmcnt(0)" ::: "memory");
    __syncthreads();
    if (threadIdx.x == 0) {
        unsigned* bar = b.bar;
        __builtin_amdgcn_s_waitcnt(0);
        unsigned nloc = b.st[0], nx = b.st[1];
        if (nloc == 0u) { xcd_barrier_complete(bar, b.x, nloc, nx); b.st[0] = nloc; b.st[1] = nx; }
        const unsigned old = xb_add(&bar[XB_XSUB(b.x)], 1u);
        const unsigned gen = old / nloc;
        if (old + 1u == (gen + 1u) * nloc) {
            __builtin_amdgcn_fence(__ATOMIC_RELEASE, "agent");
            asm volatile("s_waitcnt vmcnt(0)" ::: "memory");
            const unsigned og = xb_add(&bar[XB_TOP], 1u);
            const unsigned tg = og / nx;
            if (og + 1u == (tg + 1u) * nx) xb_add(&bar[XB_TOPGEN], 1u);
            else XB_SPIN(xb_ld(&bar[XB_TOPGEN]) == tg, bar);
            __builtin_amdgcn_fence(__ATOMIC_ACQUIRE, "agent");
            xb_add(&bar[XB_XGEN(b.x)], 1u);
            asm volatile("s_waitcnt vmcnt(0)" ::: "memory");
        } else {
            XB_SPIN(xb_ld(&bar[XB_XGEN(b.x)]) == gen, bar);
            __builtin_amdgcn_fence(__ATOMIC_ACQUIRE, "agent");
            asm volatile("s_waitcnt vmcnt(0)" ::: "memory");
        }
    }
    __syncthreads();
}

struct Frame {
    LAS unsigned char* lds;
    volatile LAS unsigned* MISC;
    gu32* ctl;
    unsigned char* ws;
    int tid, lane, wave;
    int vcu, G;
    const float* in[31];
    float* out;
};
enum { I_X = 0, I_N1G, I_WIN, I_BGATE, I_ARE, I_AIM, I_LOGDT, I_BRE, I_BIM, I_CRE, I_CIM, I_SSMD, I_WGLU, I_BGLU, I_QG, I_KG, I_LQ1, I_LK1, I_LQ2, I_LK2, I_SUBLN,
       I_WPS, I_WPA, I_WOUT, I_N2G, I_WR, I_BR, I_WUP, I_BUP, I_WDN, I_BDN };

template <int MODE>
__device__ __forceinline__ int physrow(int c) {
    if (MODE == 1) { const int w = c & 63; return (c & ~255) + 128 * (w >> 5) + 32 * ((c >> 6) & 3) + (w & 31); }
    if (MODE == 2) { const int j = c >> 1; return 256 * (j >> 7) + 128 * (c & 1) + (j & 127); }
    return c;
}
struct P0Item { const float* src; void* dst; const float* kscale; int N, K, mode, out8, k0, c0; };
__device__ __forceinline__ int physrow_rt(int mode, int c) { return mode == 1 ? physrow<1>(c) : (mode == 2 ? physrow<2>(c) : c); }
__device__ __forceinline__ void p0_item_load(const P0Item& d, f32x4 (&v)[16], int lane) {
    const int lr = lane >> 4, lc = lane & 15;
#pragma unroll
    for (int i = 0; i < 16; ++i) v[i] = __builtin_nontemporal_load((const f32x4*)(d.src + (size_t)(d.k0 + lr + 4 * i) * d.N + d.c0 + 4 * lc));
}
__device__ __forceinline__ void p0_item_finish(const P0Item& d, const f32x4 (&v)[16], LAS float* scr, int lane) {
    const int lr = lane >> 4, lc = lane & 15;
#pragma unroll
    for (int i = 0; i < 16; ++i) { const int k = lr + 4 * i; *(LAS f32x4*)(scr + k * 64 + 4 * (lc ^ ((k >> 3) & 7))) = v[i]; }
    LDS_WAIT(); asm volatile("" ::: "memory");
    const int a = lane & 7, bq = lane >> 3;
    float ks[8];
#pragma unroll
    for (int i = 0; i < 8; ++i) ks[i] = (d.kscale ? d.kscale[d.k0 + 8 * a + i] : 1.0f) * (d.out8 ? 32.0f : 1.0f);
#pragma unroll
    for (int j = 0; j < 8; ++j) { const int cl = bq + 8 * j; float x[8];
#pragma unroll
        for (int i = 0; i < 8; ++i) x[i] = scr[(8 * a + i) * 64 + 4 * ((cl >> 2) ^ a) + (cl & 3)] * ks[i];
        const size_t ro = (size_t)physrow_rt(d.mode, d.c0 + cl) * d.K + d.k0 + 8 * a;
        if (d.out8) { v2u o; o.x = pk4_fp8(x[0], x[1], x[2], x[3]); o.y = pk4_fp8(x[4], x[5], x[6], x[7]); *(GAS v2u*)((unsigned char*)d.dst + ro) = o; }
        else { v4u o; o.x = cvt_pk_bf16(x[0], x[1]); o.y = cvt_pk_bf16(x[2], x[3]); o.z = cvt_pk_bf16(x[4], x[5]); o.w = cvt_pk_bf16(x[6], x[7]); *(GAS v4u*)((bf16*)d.dst + ro) = o; } }
    LDS_WAIT(); asm volatile("" ::: "memory");
}
__device__ __forceinline__ void rms_row_to_bf16(int lane, const float* xrow, const float* g, bf16* orow) {
    const GAS f32x4* xr = (const GAS f32x4*)xrow + lane; const GAS f32x4* gr = (const GAS f32x4*)g + lane;
    f32x4 v[4]; float s = 0.f;
#pragma unroll
    for (int j = 0; j < 4; ++j) { v[j] = xr[64 * j]; s += (v[j].x * v[j].x + v[j].y * v[j].y) + (v[j].z * v[j].z + v[j].w * v[j].w); }
    const float rs = 1.0f / sqrtf(wave_sum(s) * (1.f / DM) + RMS_EPS);
    GAS unsigned long long* o8 = (GAS unsigned long long*)orow + lane;
#pragma unroll
    for (int j = 0; j < 4; ++j) { const f32x4 gg = gr[64 * j];
        o8[64 * j] = (unsigned long long)cvt_pk_bf16(v[j].x * rs * gg.x, v[j].y * rs * gg.y) | ((unsigned long long)cvt_pk_bf16(v[j].z * rs * gg.z, v[j].w * rs * gg.w) << 32); }
}
__device__ __forceinline__ void p0_s5_group(Frame& F, int g) {
    LAS float* AP = (LAS float*)(F.lds + RING_OFF);
    LAS float* BB = AP + 17 * 64 * 2;
    LAS float* CC = BB + 64 * 16 * 2;
    LAS float* KM = CC + 16 * 64 * 2;
    const float* are = F.in[I_ARE] + g * SSM_P; const float* aim = F.in[I_AIM] + g * SSM_P;
    const double dt = exp((double)F.in[I_LOGDT][g]);
    for (int e = F.tid; e < 17 * 64; e += NWAVES * 64) { const int m = e >> 6, p = e & 63; const double lr = are[p], li = aim[p];
        const double mag = exp(lr * dt * m), ang = li * dt * m; AP[e * 2] = (float)(mag * cos(ang)); AP[e * 2 + 1] = (float)(mag * sin(ang)); }
    for (int e = F.tid; e < 64 * 16; e += NWAVES * 64) { const int p = e >> 4, h = e & 15; const double lr = are[p], li = aim[p];
        const double mag = exp(lr * dt), ar = mag * cos(li * dt), ai = mag * sin(li * dt), den = lr * lr + li * li, nr = ar - 1.0, ni = ai;
        const double cr = (nr * lr + ni * li) / den, ci = (ni * lr - nr * li) / den;
        const double br = F.in[I_BRE][(size_t)(g * SSM_P + p) * SSM_H + h], bi = F.in[I_BIM][(size_t)(g * SSM_P + p) * SSM_H + h];
        BB[e * 2] = (float)(cr * br - ci * bi); BB[e * 2 + 1] = (float)(cr * bi + ci * br); }
    for (int e = F.tid; e < 16 * 64; e += NWAVES * 64) { CC[e * 2] = F.in[I_CRE][(size_t)g * 1024 + e]; CC[e * 2 + 1] = F.in[I_CIM][(size_t)g * 1024 + e]; }
    __syncthreads();
    if (F.tid < 64) { float* a16 = (float*)(F.ws + WS_A16) + (g * 64 + F.tid) * 2; a16[0] = AP[(16 * 64 + F.tid) * 2]; a16[1] = AP[(16 * 64 + F.tid) * 2 + 1]; }
    for (int e = F.tid; e < 16 * 256; e += NWAVES * 64) { const int m = e >> 8, ho = (e >> 4) & 15, hi = e & 15; float s = 0.f;
        for (int p = 0; p < 64; ++p) { const float cr = CC[(ho * 64 + p) * 2], ci = CC[(ho * 64 + p) * 2 + 1], ar = AP[(m * 64 + p) * 2], ai = AP[(m * 64 + p) * 2 + 1];
            const float tr = cr * ar - ci * ai, ti = cr * ai + ci * ar; s += tr * BB[(p * 16 + hi) * 2] - ti * BB[(p * 16 + hi) * 2 + 1]; }
        KM[e] = s; }
    __syncthreads();
    bf16* W1T = (bf16*)(F.ws + WS_S5 + (size_t)g * 262144); bf16* M2T = W1T + 128 * 256; bf16* W3T = M2T + 256 * 256;
    for (int e = F.tid; e < 128 * 256; e += NWAVES * 64) { const int n = e >> 8, k = e & 255, p = n & 63, j = k >> 4, hi = k & 15;
        const float ar = AP[((15 - j) * 64 + p) * 2], ai = AP[((15 - j) * 64 + p) * 2 + 1], br = BB[(p * 16 + hi) * 2], bi = BB[(p * 16 + hi) * 2 + 1];
        W1T[e] = (bf16)f2bf(n < 64 ? ar * br - ai * bi : ar * bi + ai * br); }
    for (int e = F.tid; e < 256 * 128; e += NWAVES * 64) { const int n = e >> 7, k = e & 127, i = n >> 4, ho = n & 15, p = k & 63;
        const float cr = CC[(ho * 64 + p) * 2], ci = CC[(ho * 64 + p) * 2 + 1], ar = AP[((i + 1) * 64 + p) * 2], ai = AP[((i + 1) * 64 + p) * 2 + 1];
        W3T[e] = (bf16)f2bf(k < 64 ? cr * ar - ci * ai : -(cr * ai + ci * ar)); }
    const float* dsk = F.in[I_SSMD] + g * 16;
    for (int e = F.tid; e < 256 * 256; e += NWAVES * 64) { const int n = e >> 8, k = e & 255, i = n >> 4, ho = n & 15, j = k >> 4, hi = k & 15;
        float v = 0.f; if (j <= i) { v = KM[((i - j) * 16 + ho) * 16 + hi]; if (i == j && ho == hi) v += dsk[ho]; }
        M2T[e] = (bf16)f2bf(v); }
    __syncthreads();
}
__device__ __forceinline__ void p0_prologue(Frame& F) {
    if (F.vcu < SSM_G) p0_s5_group(F, F.vcu);
    LAS float* scr = (LAS float*)(F.lds + RING_OFF + F.wave * 16384);
    const int gw = F.vcu * NWAVES + F.wave, NGW = F.G * NWAVES;
    { float* wrT = (float*)(F.ws + WS_WRT); const float* wr = F.in[I_WR]; const float* g2 = F.in[I_N2G];
      for (int e = gw * 64 + F.lane; e < NE * DM; e += NGW * 64) { const int ex = e >> 10, k = e & 1023; wrT[e] = g2[k] * wr[k * NE + ex]; } }
    for (int m = gw; m < M; m += NGW) rms_row_to_bf16(F.lane, F.in[I_X] + (size_t)m * DM, F.in[I_N1G], (bf16*)(F.ws + WS_XN) + (size_t)m * DM);
    constexpr int IT_IN = (DM / 64) * (IN_W / 64), IT_GLU = (512 / 64) * (512 / 64), IT_PS = (512 / 64) * (DM / 64), IT_OUT = (DM / 64) * (DM / 64);
    constexpr int IT_UP1 = (DM / 64) * (UPW / 64), IT_DN1 = (DE / 64) * (DM / 64);
    constexpr int NITEMS = IT_IN + IT_GLU + 2 * IT_PS + IT_OUT + NE * IT_UP1 + NE * IT_DN1;
#define P0_DECODE(it, d) do { int r_ = (it); int nb_; \
        if (r_ < IT_IN) { d.src = F.in[I_WIN]; d.dst = F.ws + WS_WIN; d.kscale = nullptr; d.N = IN_W; d.K = DM; d.mode = 1; d.out8 = 0; } \
        else if ((r_ -= IT_IN) < IT_GLU) { d.src = F.in[I_WGLU]; d.dst = F.ws + WS_WGLU; d.kscale = nullptr; d.N = 512; d.K = 512; d.mode = 0; d.out8 = 0; } \
        else if ((r_ -= IT_GLU) < IT_PS) { d.src = F.in[I_WPS]; d.dst = F.ws + WS_WPS; d.kscale = nullptr; d.N = DM; d.K = 512; d.mode = 0; d.out8 = 0; } \
        else if ((r_ -= IT_PS) < IT_PS) { d.src = F.in[I_WPA]; d.dst = F.ws + WS_WPA; d.kscale = nullptr; d.N = DM; d.K = 512; d.mode = 0; d.out8 = 0; } \
        else if ((r_ -= IT_PS) < IT_OUT) { d.src = F.in[I_WOUT]; d.dst = F.ws + WS_WOUT; d.kscale = nullptr; d.N = DM; d.K = DM; d.mode = 0; d.out8 = 0; } \
        else if ((r_ -= IT_OUT) < NE * IT_UP1) { const int e_ = r_ / IT_UP1; r_ -= e_ * IT_UP1; d.src = F.in[I_WUP] + (size_t)e_ * DM * UPW; d.dst = F.ws + WS_WUP + (size_t)e_ * UPW * DM; d.kscale = F.in[I_N2G]; d.N = UPW; d.K = DM; d.mode = 2; d.out8 = 1; } \
        else { r_ -= NE * IT_UP1; const int e_ = r_ / IT_DN1; r_ -= e_ * IT_DN1; d.src = F.in[I_WDN] + (size_t)e_ * DE * DM; d.dst = F.ws + WS_WDN + (size_t)e_ * DM * DE; d.kscale = nullptr; d.N = DM; d.K = DE; d.mode = 0; d.out8 = 1; } \
        nb_ = d.N / 64; d.k0 = 64 * (r_ / nb_); d.c0 = 64 * (r_ % nb_); } while (0)
    int qcur = 0, qend = 0;
#define P0_DRAW(it) do { if (qcur == qend) { unsigned q_ = 0; if (F.lane == 0) q_ = atomicAdd((unsigned*)(F.ctl + CW_Q), 1u); qcur = 8 * (int)__builtin_amdgcn_readfirstlane(q_); qend = qcur + 8; } it = qcur++; } while (0)
    {
        P0Item dA, dB; f32x4 vA[16], vB[16]; int itA, itB;
        P0_DRAW(itA);
        if (itA < NITEMS) { P0_DECODE(itA, dA); p0_item_load(dA, vA, F.lane);
            for (;;) {
                P0_DRAW(itB); const bool hasB = itB < NITEMS;
                if (hasB) { P0_DECODE(itB, dB); p0_item_load(dB, vB, F.lane); }
                p0_item_finish(dA, vA, scr, F.lane);
                if (!hasB) break;
                P0_DRAW(itA); const bool hasA = itA < NITEMS;
                if (hasA) { P0_DECODE(itA, dA); p0_item_load(dA, vA, F.lane); }
                p0_item_finish(dB, vB, scr, F.lane);
                if (!hasA) break;
            } }
    }
#undef P0_DECODE
#undef P0_DRAW
}

typedef const pg8::f32x4 (&AccRef)[2][2][4][2];
__device__ __forceinline__ v4u pack8(const f32x4 a, const f32x4 b) { v4u w; w.x = cvt_pk_bf16(a[0], a[1]); w.y = cvt_pk_bf16(a[2], a[3]); w.z = cvt_pk_bf16(b[0], b[1]); w.w = cvt_pk_bf16(b[2], b[3]); return w; }
__device__ __forceinline__ void unpack8(const v4u w, f32x4& a, f32x4& b) { a = (f32x4){bflo(w.x), bfhi(w.x), bflo(w.y), bfhi(w.y)}; b = (f32x4){bflo(w.z), bfhi(w.z), bflo(w.w), bfhi(w.w)}; }

struct EpiInProj {
    static constexpr bool PERM = true;
    bf16 *U, *Q, *Kb, *V, *G1, *G2; const float *bgate, *qg, *kg;
    __device__ __forceinline__ void operator()(AccRef acc, const pg8::Unit& u, int wr, int wc, int fr, int fq, const LAS int*) const {
        const int pn = u.pn, row0 = u.pm * 256 + wr * 64 + fr;
        if (pn < 2) {
#pragma unroll
            for (int ai = 0; ai < 2; ++ai)
#pragma unroll
                for (int m = 0; m < 4; ++m) { const int row = row0 + ai * 128 + m * 16, b = row >> 11, t = row & 2047;
#pragma unroll
                    for (int bj = 0; bj < 2; ++bj) { const int lc = 256 * pn + 64 * wc + 32 * bj + 8 * fq, g = lc >> 4, ch = lc & 15;
                        *(v4u*)(U + ((size_t)(b * SSM_G + g) * SEQ + t) * 16 + ch) = pack8(acc[ai][bj][m][0], acc[ai][bj][m][1]); } }
        } else if (pn < 6) {
            const bool isq = pn < 4; const float* gv = isq ? qg : kg; const float sc = isq ? QSCALE : 1.0f;
            bf16* dst = (isq ? Q : Kb) + 256 * (pn - (isq ? 2 : 4)) + 64 * wc + 8 * fq;
            f32x4 gg[2][2];
#pragma unroll
            for (int bj = 0; bj < 2; ++bj)
#pragma unroll
                for (int n = 0; n < 2; ++n) gg[bj][n] = *(const f32x4*)(gv + 32 * bj + 8 * fq + 4 * n) * sc;
#pragma unroll
            for (int ai = 0; ai < 2; ++ai)
#pragma unroll
                for (int m = 0; m < 4; ++m) { const int row = row0 + ai * 128 + m * 16; float ss = 0.f;
#pragma unroll
                    for (int bj = 0; bj < 2; ++bj)
#pragma unroll
                        for (int n = 0; n < 2; ++n) { const f32x4 x = acc[ai][bj][m][n]; ss += (x[0] * x[0] + x[1] * x[1]) + (x[2] * x[2] + x[3] * x[3]); }
                    ss += __shfl_xor(ss, 16); ss += __shfl_xor(ss, 32);
                    const float rs = 1.0f / sqrtf(ss * (1.0f / 64.0f) + RMS_EPS);
#pragma unroll
                    for (int bj = 0; bj < 2; ++bj) *(v4u*)(dst + (size_t)row * 512 + 32 * bj) = pack8(acc[ai][bj][m][0] * rs * gg[bj][0], acc[ai][bj][m][1] * rs * gg[bj][1]); }
        } else if (pn < 8) {
            bf16* dst = V + 256 * (pn - 6) + 64 * wc + 8 * fq;
#pragma unroll
            for (int ai = 0; ai < 2; ++ai)
#pragma unroll
                for (int m = 0; m < 4; ++m) { const int row = row0 + ai * 128 + m * 16;
#pragma unroll
                    for (int bj = 0; bj < 2; ++bj) *(v4u*)(dst + (size_t)row * 512 + 32 * bj) = pack8(acc[ai][bj][m][0], acc[ai][bj][m][1]); }
        } else {
            const int gc = 256 * (pn - 8) + 64 * wc + 8 * fq;
            bf16* dst = (gc < 1024 ? G1 + gc : G2 + (gc - 1024));
            f32x4 bb[2][2];
#pragma unroll
            for (int bj = 0; bj < 2; ++bj)
#pragma unroll
                for (int n = 0; n < 2; ++n) bb[bj][n] = *(const f32x4*)(bgate + gc + 32 * bj + 4 * n);
#pragma unroll
            for (int ai = 0; ai < 2; ++ai)
#pragma unroll
                for (int m = 0; m < 4; ++m) { const int row = row0 + ai * 128 + m * 16;
#pragma unroll
                    for (int bj = 0; bj < 2; ++bj) { f32x4 a = acc[ai][bj][m][0] + bb[bj][0], b = acc[ai][bj][m][1] + bb[bj][1];
#pragma unroll
                        for (int e = 0; e < 4; ++e) { a[e] = fsigmoid(a[e]); b[e] = fsigmoid(b[e]); }
                        *(v4u*)(dst + (size_t)row * 1024 + 32 * bj) = pack8(a, b); } }
        }
    }
};
template <int MODE> struct EpiMix {
    static constexpr bool PERM = true;
    const bf16* P0; const bf16* P1; bf16* O; const float* bias; int ld;
    __device__ __forceinline__ void operator()(AccRef acc, const pg8::Unit& u, int wr, int wc, int fr, int fq, const LAS int*) const {
        const int row0 = u.pm * 256 + wr * 64 + fr, col0 = u.pn * 256 + wc * 32 + 8 * fq;
        f32x4 bb[2][2];
#pragma unroll
        for (int bj = 0; bj < 2; ++bj)
#pragma unroll
            for (int n = 0; n < 2; ++n) bb[bj][n] = (MODE == 0) ? *(const f32x4*)(bias + col0 + bj * 128 + 4 * n) : (f32x4){0.f, 0.f, 0.f, 0.f};
#pragma unroll
        for (int ai = 0; ai < 2; ++ai)
#pragma unroll
            for (int m = 0; m < 4; ++m) { const size_t off = (size_t)(row0 + ai * 128 + m * 16) * ld + col0;
#pragma unroll
                for (int bj = 0; bj < 2; ++bj) { f32x4 a = acc[ai][bj][m][0], b = acc[ai][bj][m][1], p0a, p0b;
                    unpack8(*(const v4u*)(P0 + off + bj * 128), p0a, p0b);
                    if (MODE == 0) { a += bb[bj][0]; b += bb[bj][1];
#pragma unroll
                        for (int e = 0; e < 4; ++e) { a[e] = p0a[e] * fsigmoid(a[e]); b[e] = p0b[e] * fsigmoid(b[e]); } }
                    else if (MODE == 1) { a *= p0a; b *= p0b; }
                    else { f32x4 p1a, p1b; unpack8(*(const v4u*)(P1 + off + bj * 128), p1a, p1b); a = p0a + p1a * a; b = p0b + p1b * b; }
                    *(v4u*)(O + off + bj * 128) = pack8(a, b); } }
    }
};
struct EpiOut {
    static constexpr bool PERM = false;
    const float* X; float* H; unsigned char* HB;
    __device__ __forceinline__ void operator()(AccRef acc, const pg8::Unit& u, int wr, int wc, int fr, int fq, const LAS int*) const {
        const int row0 = u.pm * 256 + wr * 64 + fr, col0 = u.pn * 256 + wc * 32 + 4 * fq;
#pragma unroll
        for (int ai = 0; ai < 2; ++ai)
#pragma unroll
            for (int m = 0; m < 4; ++m) { const size_t off = (size_t)(row0 + ai * 128 + m * 16) * DM + col0;
#pragma unroll
                for (int bj = 0; bj < 2; ++bj)
#pragma unroll
                    for (int n = 0; n < 2; ++n) { const f32x4 h = *(const f32x4*)(X + off + bj * 128 + n * 16) + acc[ai][bj][m][n];
                        *(f32x4*)(H + off + bj * 128 + n * 16) = h; *(unsigned*)(HB + off + bj * 128 + n * 16) = pk4_fp8(h[0], h[1], h[2], h[3]); } }
    }
};
template <int NN, bool TOKROWS> struct MoeOrder {
    int nunits, G, vcu; const LAS int* cnt; const LAS int* tstart; const LAS int* tile2e; const int* elist;
    __device__ __forceinline__ bool next(int i, pg8::Unit& u) const { const long L = (long)i * G + vcu; if (L >= nunits) return false; const int pm = (int)(L / NN), pnl = (int)(L % NN);
        u.pm = pm; u.pn = tile2e[pm] * NN + pnl; return true; }
    __device__ __forceinline__ int row_slot(const pg8::Unit& u, int r) const { const int e = u.pn / NN, pos = (u.pm - tstart[e]) * 256 + r; return pos < cnt[e] ? elist[e * M + pos] : -1; }
    __device__ __forceinline__ int a_row(const pg8::Unit& u, int r, int slot) const { return TOKROWS ? (slot < 0 ? 0 : (slot >> 2)) : u.pm * 256 + r; }
};
struct EpiUp {
    static constexpr bool PERM = true;
    unsigned char* ACT; const float* bup; const float* rs2;
    __device__ __forceinline__ void operator()(AccRef acc, const pg8::Unit& u, int wr, int wc, int fr, int fq, const LAS int* tab) const {
        const int e = u.pn >> 3, pnl = u.pn & 7, j0 = 128 * pnl + 32 * wc + 8 * fq;
        f32x4 bb[4];
#pragma unroll
        for (int q = 0; q < 4; ++q) bb[q] = *(const f32x4*)(bup + (size_t)e * UPW + 2 * j0 + 4 * q);
#pragma unroll
        for (int ai = 0; ai < 2; ++ai)
#pragma unroll
            for (int m = 0; m < 4; ++m) { const int r = ai * 128 + wr * 64 + m * 16 + fr, slot = tab[r];
                if (slot >= 0) { const float rs = rs2[slot >> 2]; f32x4 o[2];
#pragma unroll
                    for (int n = 0; n < 2; ++n)
#pragma unroll
                        for (int e4 = 0; e4 < 4; ++e4) { const int j = 4 * n + e4;
                            float gl = acc[ai][0][m][n][e4] * rs + bb[(2 * j) >> 2][(2 * j) & 3], li = acc[ai][1][m][n][e4] * rs + bb[(2 * j + 1) >> 2][(2 * j + 1) & 3];
                            gl = fminf(gl, 7.0f); li = fminf(fmaxf(li, -7.0f), 7.0f);
                            o[n][e4] = gl * fsigmoid(1.702f * gl) * (li + 1.0f) * 4.0f; }
                    v2u ov; ov.x = pk4_fp8(o[0][0], o[0][1], o[0][2], o[0][3]); ov.y = pk4_fp8(o[1][0], o[1][1], o[1][2], o[1][3]); *(v2u*)(ACT + (size_t)(u.pm * 256 + r) * DE + j0) = ov; } }
    }
};
struct EpiDown {
    static constexpr bool PERM = true;
    bf16* YS2; const float* bdn; const float* wslot;
    __device__ __forceinline__ void operator()(AccRef acc, const pg8::Unit& u, int wr, int wc, int fr, int fq, const LAS int* tab) const {
        const int e = u.pn >> 2, pnl = u.pn & 3, c0 = 256 * pnl + 32 * wc + 8 * fq;
        f32x4 bb[2][2];
#pragma unroll
        for (int bj = 0; bj < 2; ++bj)
#pragma unroll
            for (int n = 0; n < 2; ++n) bb[bj][n] = *(const f32x4*)(bdn + (size_t)e * DM + c0 + bj * 128 + 4 * n);
#pragma unroll
        for (int ai = 0; ai < 2; ++ai)
#pragma unroll
            for (int m = 0; m < 4; ++m) { const int r = ai * 128 + wr * 64 + m * 16 + fr, slot = tab[r];
                if (slot >= 0) { const float w = wslot[slot];
#pragma unroll
                    for (int bj = 0; bj < 2; ++bj) *(v4u*)(YS2 + (size_t)slot * DM + c0 + bj * 128) = pack8((acc[ai][bj][m][0] + bb[bj][0]) * w, (acc[ai][bj][m][1] + bb[bj][1]) * w); } }
    }
};

constexpr int S5_UPITCH = 528, S5_SX_OFF = 128 * S5_UPITCH, S5_XPITCH = 132;
__device__ __forceinline__ void s5_unit(Frame& F, int b, int g) {
    LAS unsigned char* Uimg = F.lds + RING_OFF; LAS float* SX = (LAS float*)(F.lds + RING_OFF + S5_SX_OFF);
    const int tid = F.tid, lane = F.lane, w = F.wave, r32 = lane & 31, hi = lane >> 5;
    const bf16* Ug = (const bf16*)(F.ws + WS_U) + (size_t)(b * SSM_G + g) * SEQ * 16;
    const bf16* W1T = (const bf16*)(F.ws + WS_S5 + (size_t)g * 262144); const bf16* M2T = W1T + 128 * 256; const bf16* W3T = M2T + 256 * 256;
#pragma unroll
    for (int j = 0; j < 8; ++j) { const int q = tid + 512 * j; *(LAS v4u*)(Uimg + (q >> 5) * S5_UPITCH + (q & 31) * 16) = *(const v4u*)(Ug + (size_t)q * 8); }
    __syncthreads();
    { const int nt = w & 3, mt0 = 2 * (w >> 2);
      f32x16 s0 = {0}, s1 = {0};
#pragma unroll 4
      for (int ks = 0; ks < 16; ++ks) {
          const bf16x8 bf = *(const bf16x8*)(W1T + (size_t)(32 * nt + r32) * 256 + 16 * ks + 8 * hi);
          const bf16x8 a0 = *(const LAS bf16x8*)(Uimg + (32 * mt0 + r32) * S5_UPITCH + (16 * ks + 8 * hi) * 2);
          const bf16x8 a1 = *(const LAS bf16x8*)(Uimg + (32 * (mt0 + 1) + r32) * S5_UPITCH + (16 * ks + 8 * hi) * 2);
          s0 = __builtin_amdgcn_mfma_f32_32x32x16_bf16(a0, bf, s0, 0, 0, 0); s1 = __builtin_amdgcn_mfma_f32_32x32x16_bf16(a1, bf, s1, 0, 0, 0); }
#pragma unroll
      for (int r = 0; r < 16; ++r) { SX[(32 * mt0 + crow(r, hi)) * S5_XPITCH + 32 * nt + r32] = s0[r]; SX[(32 * (mt0 + 1) + crow(r, hi)) * S5_XPITCH + 32 * nt + r32] = s1[r]; } }
    __syncthreads();
    if (tid < 64) {
        const float* a16 = (const float*)(F.ws + WS_A16) + (g * 64 + tid) * 2; const float ar = a16[0], ai = a16[1]; float xr = 0.f, xi = 0.f;
#pragma unroll 8
        for (int c = 0; c < SSM_NC; ++c) { const float sr = SX[c * S5_XPITCH + tid], si = SX[c * S5_XPITCH + 64 + tid];
            SX[c * S5_XPITCH + tid] = xr; SX[c * S5_XPITCH + 64 + tid] = xi;
            const float nr = ar * xr - ai * xi + sr, ni = ar * xi + ai * xr + si; xr = nr; xi = ni; }
    }
    __syncthreads();
    { f32x16 y[4] = {{0}, {0}, {0}, {0}};
      const int nks = 2 * w + 2;
      for (int ks = 0; ks < nks; ++ks) {
          const bf16x8 bf = *(const bf16x8*)(M2T + (size_t)(32 * w + r32) * 256 + 16 * ks + 8 * hi);
#pragma unroll
          for (int mt = 0; mt < 4; ++mt) { const bf16x8 a = *(const LAS bf16x8*)(Uimg + (32 * mt + r32) * S5_UPITCH + (16 * ks + 8 * hi) * 2); y[mt] = __builtin_amdgcn_mfma_f32_32x32x16_bf16(a, bf, y[mt], 0, 0, 0); } }
#pragma unroll 2
      for (int ks = 0; ks < 8; ++ks) {
          const bf16x8 bf = *(const bf16x8*)(W3T + (size_t)(32 * w + r32) * 128 + 16 * ks + 8 * hi);
#pragma unroll
          for (int mt = 0; mt < 4; ++mt) { const LAS f32x4* xp = (const LAS f32x4*)(SX + (32 * mt + r32) * S5_XPITCH + 16 * ks + 8 * hi); const f32x4 x0 = xp[0], x1 = xp[1];
              const v4u pk = pack8(x0, x1); y[mt] = __builtin_amdgcn_mfma_f32_32x32x16_bf16(__builtin_bit_cast(bf16x8, pk), bf, y[mt], 0, 0, 0); } }
      bf16* YG = (bf16*)(F.ws + WS_YG); const int i = 2 * w + (r32 >> 4), ho = r32 & 15;
#pragma unroll
      for (int mt = 0; mt < 4; ++mt)
#pragma unroll
          for (int r = 0; r < 16; ++r) { const int c = 32 * mt + crow(r, hi); YG[(size_t)(b * SEQ + 16 * c + i) * SSM_W + g * 16 + ho] = (bf16)f2bf(gelu_tanh(y[mt][r])); } }
    __syncthreads();
}

constexpr int AT_KP = 272, AT_VP = 320, AT_KB = 64 * AT_KP, AT_VB = 64 * AT_VP, AT_BUF = AT_KB + AT_VB;
__device__ __forceinline__ s16x4 vtr(const LAS unsigned char* p) { typedef short v4i16_t __attribute__((ext_vector_type(4))); return __builtin_bit_cast(s16x4, __builtin_amdgcn_ds_read_tr16_b64_v4i16((LAS v4i16_t*)p)); }
__device__ __forceinline__ void attn_unit(Frame& F, int b, int h, int qb, float lam) {
    const int tid = F.tid, lane = F.lane, w = F.wave, rg = w >> 1, t = w & 1, r32 = lane & 31, hi = lane >> 5;
    const bf16* Q = (const bf16*)(F.ws + WS_Q); const bf16* K = (const bf16*)(F.ws + WS_K); const bf16* V = (const bf16*)(F.ws + WS_V); bf16* OB = (bf16*)(F.ws + WS_OB);
    LAS unsigned char* L = F.lds + RING_OFF;
    const int qrow = b * SEQ + qb * 128 + rg * 32 + r32;
    bf16x8 qf[4];
#pragma unroll
    for (int ks = 0; ks < 4; ++ks) qf[ks] = *(const bf16x8*)(Q + (size_t)qrow * QK_W + h * 128 + t * 64 + 16 * ks + 8 * hi);
    const int ntile = 2 * qb + 2, mylim = 2 * qb + (rg >> 1);
    const int kr0 = tid >> 4, cc = tid & 15;
    const size_t gbase = (size_t)(b * SEQ) * 512 + h * 128 + cc * 8;
    v4u kreg[2], vreg[2];
#define AT_LOAD(j) do { _Pragma("unroll") for (int i_ = 0; i_ < 2; ++i_) { const size_t o_ = gbase + (size_t)(64 * (j) + kr0 + 32 * i_) * 512; kreg[i_] = *(const v4u*)(K + o_); vreg[i_] = *(const v4u*)(V + o_); } } while (0)
#define AT_STORE(buf) do { _Pragma("unroll") for (int i_ = 0; i_ < 2; ++i_) { *(LAS v4u*)(L + (buf) * AT_BUF + (kr0 + 32 * i_) * AT_KP + cc * 16) = kreg[i_]; \
        *(LAS v4u*)(L + (buf) * AT_BUF + AT_KB + (kr0 + 32 * i_) * AT_VP + cc * 16) = vreg[i_]; } } while (0)
    AT_LOAD(0); AT_STORE(0);
    __syncthreads();
    f32x16 o[4] = {{0}, {0}, {0}, {0}};
    float mrun = -1e30f, lrun = 0.f;
    const int g4 = lane >> 4, i16 = lane & 15;
    const int vlane = (4 * (g4 >> 1) + (i16 >> 2)) * AT_VP + (16 * (g4 & 1) + 4 * (i16 & 3)) * 2;
    for (int j = 0; j < ntile; ++j) {
        const int buf = j & 1;
        if (j + 1 < ntile) AT_LOAD(j + 1);
        if (j <= mylim) {
            const LAS unsigned char* Kb = L + buf * AT_BUF + t * 128 + hi * 16 + r32 * AT_KP;
            const LAS unsigned char* Vb = L + buf * AT_BUF + AT_KB + vlane;
            f32x16 s0 = {0}, s1 = {0};
#pragma unroll
            for (int ks = 0; ks < 4; ++ks) { const bf16x8 k0 = *(const LAS bf16x8*)(Kb + ks * 32), k1 = *(const LAS bf16x8*)(Kb + 32 * AT_KP + ks * 32);
                s0 = __builtin_amdgcn_mfma_f32_32x32x16_bf16(k0, qf[ks], s0, 0, 0, 0); s1 = __builtin_amdgcn_mfma_f32_32x32x16_bf16(k1, qf[ks], s1, 0, 0, 0); }
            float mx = s0[0];
#pragma unroll
            for (int r = 1; r < 16; ++r) mx = fmaxf(mx, s0[r]);
#pragma unroll
            for (int r = 0; r < 16; ++r) mx = fmaxf(mx, s1[r]);
            mx = fmaxf(mx, __shfl_xor(mx, 32));
            const float mnew = fmaxf(mrun, mx), alpha = __builtin_amdgcn_exp2f(mrun - mnew); mrun = mnew;
            float ps = 0.f;
#pragma unroll
            for (int r = 0; r < 16; ++r) { s0[r] = __builtin_amdgcn_exp2f(s0[r] - mnew); s1[r] = __builtin_amdgcn_exp2f(s1[r] - mnew); ps += s0[r] + s1[r]; }
            lrun = lrun * alpha + ps;
#pragma unroll
            for (int dt = 0; dt < 4; ++dt) o[dt] *= alpha;
#pragma unroll
            for (int s = 0; s < 4; ++s) {
                v4u pk; const int rb = 8 * (s & 1);
                if (s < 2) { pk.x = cvt_pk_bf16(s0[rb], s0[rb + 1]); pk.y = cvt_pk_bf16(s0[rb + 2], s0[rb + 3]); pk.z = cvt_pk_bf16(s0[rb + 4], s0[rb + 5]); pk.w = cvt_pk_bf16(s0[rb + 6], s0[rb + 7]); }
                else       { pk.x = cvt_pk_bf16(s1[rb], s1[rb + 1]); pk.y = cvt_pk_bf16(s1[rb + 2], s1[rb + 3]); pk.z = cvt_pk_bf16(s1[rb + 4], s1[rb + 5]); pk.w = cvt_pk_bf16(s1[rb + 6], s1[rb + 7]); }
                const bf16x8 pf = __builtin_bit_cast(bf16x8, pk);
#pragma unroll
                for (int dt = 0; dt < 4; ++dt) { const s16x4 lo = vtr(Vb + s * 16 * AT_VP + dt * 64), hh = vtr(Vb + s * 16 * AT_VP + dt * 64 + 8 * AT_VP);
                    const bf16x8 vf = (bf16x8){lo[0], lo[1], lo[2], lo[3], hh[0], hh[1], hh[2], hh[3]};
                    o[dt] = __builtin_amdgcn_mfma_f32_32x32x16_bf16(vf, pf, o[dt], 0, 0, 0); } }
        }
        if (j + 1 < ntile) AT_STORE(buf ^ 1);
        __syncthreads();
    }
#undef AT_LOAD
#undef AT_STORE
    const float ltot = lrun + __shfl_xor(lrun, 32), inv = 1.0f / ltot;
    LAS float* EX = (LAS float*)L + rg * 4096;
    if (t == 1) {
        const float sc = inv * lam;
#pragma unroll
        for (int dt = 0; dt < 4; ++dt)
#pragma unroll
            for (int r = 0; r < 16; ++r) EX[(dt * 16 + r) * 64 + lane] = o[dt][r] * sc;
    }
    __syncthreads();
    if (t == 0) {
        float ss = 0.f;
#pragma unroll
        for (int dt = 0; dt < 4; ++dt)
#pragma unroll
            for (int r = 0; r < 16; ++r) { const float y = o[dt][r] * inv - EX[(dt * 16 + r) * 64 + lane]; o[dt][r] = y; ss += y * y; }
        ss += __shfl_xor(ss, 32);
        const float rn = (1.0f - LAMBDA_INIT) / sqrtf(ss * (1.0f / 128.0f) + RMS_EPS);
        const float* sg = F.in[I_SUBLN];
#pragma unroll
        for (int dt = 0; dt < 4; ++dt)
#pragma unroll
            for (int rq = 0; rq < 4; ++rq) { const int d = 32 * dt + 8 * rq + 4 * hi; const f32x4 gg = *(const f32x4*)(sg + d);
                v2u wv; wv.x = cvt_pk_bf16(o[dt][4 * rq] * rn * gg[0], o[dt][4 * rq + 1] * rn * gg[1]); wv.y = cvt_pk_bf16(o[dt][4 * rq + 2] * rn * gg[2], o[dt][4 * rq + 3] * rn * gg[3]);
                *(v2u*)(OB + (size_t)qrow * V_W + h * 128 + d) = wv; }
    }
    __syncthreads();
}

constexpr int CW_CNT_STRIDE = 64;
__device__ __forceinline__ void router_phase(Frame& F, const bool dummy = false) {
    const int lane = F.lane, tid = F.tid, w = F.wave, tt = w >> 1, kh = w & 1;
    LAS float* LG = (LAS float*)(F.lds + RING_OFF);
    LAS float* SS = LG + 4 * 2 * 16 * 33;
    LAS int* LC = (LAS int*)(SS + 128);
    const float* Hf = F.out; const float* wrT = (const float*)(F.ws + WS_WRT); const float* br = F.in[I_BR];
    float* rs2 = (float*)(F.ws + (dummy ? WS_YS2 : WS_RS2)); float* wslot = (float*)(F.ws + (dummy ? WS_YS2 + MiB : WS_WSLOT)); int* elist = (int*)(F.ws + (dummy ? WS_YS2 + 2 * MiB : WS_ELIST));
    unsigned* cnt = (unsigned*)(F.ctl + CW_CNT + (dummy ? 32 : 0));
    const int i16 = lane & 15, kq = lane >> 4;
    for (int tg = F.vcu; tg < M / 64; tg += F.G) {
        if (tid < 64) LC[tid] = 0;
        const int tok0 = tg * 64 + tt * 16;
        f32x4 a0 = {0.f, 0.f, 0.f, 0.f}, a1 = {0.f, 0.f, 0.f, 0.f}; float ssq = 0.f;
        const float* hp = Hf + (size_t)(tok0 + i16) * DM + kh * 512 + 4 * kq; const float* w0 = wrT + (size_t)i16 * DM + kh * 512 + 4 * kq; const float* w1 = w0 + 16 * DM;
#pragma unroll 8
        for (int s = 0; s < 32; ++s) { const f32x4 a = *(const f32x4*)(hp + 16 * s), b0 = *(const f32x4*)(w0 + 16 * s), b1 = *(const f32x4*)(w1 + 16 * s);
            ssq += (a[0] * a[0] + a[1] * a[1]) + (a[2] * a[2] + a[3] * a[3]);
#pragma unroll
            for (int q = 0; q < 4; ++q) { a0 = __builtin_amdgcn_mfma_f32_16x16x4f32(a[q], b0[q], a0, 0, 0, 0); a1 = __builtin_amdgcn_mfma_f32_16x16x4f32(a[q], b1[q], a1, 0, 0, 0); } }
        ssq += __shfl_xor(ssq, 16); ssq += __shfl_xor(ssq, 32);
        LAS float* lg = LG + (tt * 2 + kh) * 16 * 33;
#pragma unroll
        for (int r = 0; r < 4; ++r) { lg[(4 * kq + r) * 33 + i16] = a0[r]; lg[(4 * kq + r) * 33 + 16 + i16] = a1[r]; }
        if (kq == 0) SS[(tt * 2 + kh) * 16 + i16] = ssq;
        __syncthreads();
        int ti[4]; float wv[4]; int lpos[4]; float rsv = 0.f;
        if (tid < 64) {
            const int t4 = tid >> 4, t16 = tid & 15;
            rsv = 1.0f / sqrtf((SS[(t4 * 2) * 16 + t16] + SS[(t4 * 2 + 1) * 16 + t16]) * (1.0f / DM) + RMS_EPS);
            float lgv[32];
#pragma unroll
            for (int e = 0; e < 32; ++e) lgv[e] = (LG[((t4 * 2) * 16 + t16) * 33 + e] + LG[((t4 * 2 + 1) * 16 + t16) * 33 + e]) * rsv + br[e];
            float tv[4];
#pragma unroll
            for (int k = 0; k < 4; ++k) { float best = -3.0e38f; int bi = 0;
#pragma unroll
                for (int e = 0; e < 32; ++e) { const bool tk = lgv[e] > best; best = tk ? lgv[e] : best; bi = tk ? e : bi; }
                tv[k] = best; ti[k] = bi;
#pragma unroll
                for (int e = 0; e < 32; ++e) lgv[e] = (e == bi) ? -3.0e38f : lgv[e]; }
            const float e1 = __expf(tv[1] - tv[0]), e2 = __expf(tv[2] - tv[0]), e3 = __expf(tv[3] - tv[0]), den = 1.0f / (1.0f + e1 + e2 + e3);
            wv[0] = den; wv[1] = e1 * den; wv[2] = e2 * den; wv[3] = e3 * den;
#pragma unroll
            for (int k = 0; k < 4; ++k) lpos[k] = __hip_atomic_fetch_add(LC + ti[k], 1, __ATOMIC_RELAXED, __HIP_MEMORY_SCOPE_WORKGROUP);
        }
        __syncthreads();
        if (tid < 32) { const int c = LC[tid]; LC[32 + tid] = c ? (int)atomicAdd(cnt + tid * CW_CNT_STRIDE, (unsigned)c) : 0; }
        __syncthreads();
        if (tid < 64) {
            const int tok = tg * 64 + tid;
            rs2[tok] = rsv;
#pragma unroll
            for (int k = 0; k < 4; ++k) { elist[ti[k] * M + LC[32 + ti[k]] + lpos[k]] = tok * 4 + k; wslot[tok * 4 + k] = wv[k]; }
        }
        __syncthreads();
    }
}
__device__ __forceinline__ int moe_tables(Frame& F) {
    LAS int* T = (LAS int*)(F.lds + MOE_LDS_OFF); LAS int* cnt = T, *tstart = T + 32, *tile2e = T + 72;
    if (F.tid < 32) cnt[F.tid] = (int)__hip_atomic_load((unsigned*)(F.ctl + CW_CNT) + F.tid * CW_CNT_STRIDE, RLX_AGENT);
    __syncthreads();
    if (F.tid == 0) { int s = 0; for (int e = 0; e < 32; ++e) { tstart[e] = s; s += (cnt[e] + 255) >> 8; } tstart[32] = s; }
    __syncthreads();
    if (F.tid < 32) { for (int p = tstart[F.tid]; p < tstart[F.tid + 1]; ++p) tile2e[p] = F.tid; }
    __syncthreads();
    return tstart[32];
}
__device__ __forceinline__ void combine_phase(Frame& F, float* dst) {
    const int lane = F.lane, gw = F.vcu * NWAVES + F.wave, NGW = F.G * NWAVES;
    const bf16* YS2 = (const bf16*)(F.ws + WS_YS2);
    for (int tk = gw; tk < M; tk += NGW) {
        GAS f32x4* orow = (GAS f32x4*)(F.out + (size_t)tk * DM) + lane; GAS f32x4* drow = (GAS f32x4*)(dst + (size_t)tk * DM) + lane;
#pragma unroll
        for (int j = 0; j < 4; ++j) { f32x4 v = orow[64 * j];
#pragma unroll
            for (int k = 0; k < 4; ++k) { const v2u y = *((const GAS v2u*)(YS2 + (size_t)(tk * 4 + k) * DM) + lane + 64 * j); v += (f32x4){bflo(y.x), bfhi(y.x), bflo(y.y), bfhi(y.y)}; }
            drow[64 * j] = v; }
    }
}

struct Args { const float* in[31]; float* out; unsigned char* ws; int ph_lo, ph_hi; };
__global__ void __launch_bounds__(NWAVES * 64, 2) mk_fwd(Args args) {
    extern __shared__ __attribute__((aligned(16))) unsigned char lds[];
    Frame F;
    F.lds = (LAS unsigned char*)lds;
    F.MISC = (volatile LAS unsigned*)(F.lds + MISC_OFF);
    F.tid = threadIdx.x; F.lane = F.tid & 63; F.wave = __builtin_amdgcn_readfirstlane(F.tid >> 6);
    F.G = gridDim.x; { const int bx = blockIdx.x; F.vcu = (F.G % 8 == 0) ? (bx % 8) * (F.G / 8) + bx / 8 : bx; }
    F.ws = args.ws; F.ctl = (gu32*)(args.ws + WS_CTL); F.out = args.out;
#pragma unroll
    for (int i = 0; i < 31; ++i) F.in[i] = args.in[i];
    for (int u = F.tid; u < 64; u += NWAVES * 64) F.MISC[u] = 0u;
    __syncthreads();
    XcdBarrier bar; bar.bar = (unsigned*)(F.ctl + CW_BAR); bar.x = 0; bar.st = nullptr;
    if (N_LAUNCHES != PER_PHASE) bar = xcd_barrier_post((unsigned*)(F.ctl + CW_BAR), F.MISC + 8);
#define GRID_BAR() do { if (N_LAUNCHES != PER_PHASE) xcd_barrier(bar); } while (0)
    const int lo = args.ph_lo, hi = args.ph_hi;
#define IN(k) (lo <= (k) && (k) < hi)
#define BOTH(k) (IN(k) && IN((k) + 1))
    unsigned char* ws = args.ws;

    if (IN(0)) { for (int rep = 0; rep < NREP(0); ++rep) { p0_prologue(F); if (BOTH(0)) GRID_BAR(); } }

    if (IN(1)) for (int rep = 0; rep < NREP(1); ++rep) {
        pg8::Gemm g{(const bf16*)(ws + WS_XN), (const bf16*)(ws + WS_WIN), M, IN_W, DM}; pg8::StaticOrder S; S.init(M, IN_W, F.G, (int)blockIdx.x);
        EpiInProj E{(bf16*)(ws + WS_U), (bf16*)(ws + WS_Q), (bf16*)(ws + WS_K), (bf16*)(ws + WS_V), (bf16*)(ws + WS_G1), (bf16*)(ws + WS_G2), F.in[I_BGATE], F.in[I_QG], F.in[I_KG]};
        pg8::gemm_phase<EpiInProj, pg8::StaticOrder, true>(F.lds + RING_OFF, g, S, E);
        if (BOTH(1)) GRID_BAR();
    }

    if (IN(2)) {
        for (int rep = 0; rep < NREP(20); ++rep) for (int u = F.vcu; u < BATCH * SSM_G; u += F.G) { const int g = (u >> 5) * 4 + ((u & 31) >> 3), b = u & 7; s5_unit(F, b, g); }
        float lam;
        { const float a = wave_sum(F.in[I_LQ1][F.lane] * F.in[I_LK1][F.lane]), c = wave_sum(F.in[I_LQ2][F.lane] * F.in[I_LK2][F.lane]); lam = __expf(a) - __expf(c) + LAMBDA_INIT; }
        for (int rep = 0; rep < NREP(21); ++rep) for (int u = F.vcu; u < BATCH * ATT_H * 8; u += F.G) { const int bh = u >> 3, qp = u & 7; attn_unit(F, bh >> 2, bh & 3, 15 - qp, lam); attn_unit(F, bh >> 2, bh & 3, qp, lam); }
        if (BOTH(2)) GRID_BAR();
    }

    if (IN(3)) for (int rep = 0; rep < NREP(3); ++rep) {
        { pg8::Gemm g{(const bf16*)(ws + WS_OB), (const bf16*)(ws + WS_WPA), M, DM, 512}; pg8::StaticOrder S; S.init(M, DM, F.G, (int)blockIdx.x);
          EpiMix<1> E{(const bf16*)(ws + WS_G2), nullptr, (bf16*)(ws + WS_TA), nullptr, DM};
          pg8::gemm_phase<EpiMix<1>, pg8::StaticOrder, true>(F.lds + RING_OFF, g, S, E); }
        { pg8::Gemm g{(const bf16*)(ws + WS_YG), (const bf16*)(ws + WS_WGLU), M, 512, 512}; pg8::StaticOrder S; S.init(M, 512, F.G, (int)blockIdx.x);
          EpiMix<0> E{(const bf16*)(ws + WS_YG), nullptr, (bf16*)(ws + WS_YS), F.in[I_BGLU], 512};
          pg8::gemm_phase<EpiMix<0>, pg8::StaticOrder, true>(F.lds + RING_OFF, g, S, E); }
        if (BOTH(3)) GRID_BAR();
    }

    if (IN(4)) for (int rep = 0; rep < NREP(4); ++rep) {
        pg8::Gemm g{(const bf16*)(ws + WS_YS), (const bf16*)(ws + WS_WPS), M, DM, 512}; pg8::StaticOrder S; S.init(M, DM, F.G, (int)blockIdx.x);
        EpiMix<2> E{(const bf16*)(ws + WS_TA), (const bf16*)(ws + WS_G1), (bf16*)(ws + WS_MX), nullptr, DM};
        pg8::gemm_phase<EpiMix<2>, pg8::StaticOrder, true>(F.lds + RING_OFF, g, S, E);
        if (BOTH(4)) GRID_BAR();
    }

    if (IN(5)) for (int rep = 0; rep < NREP(5); ++rep) {
        pg8::Gemm g{(const bf16*)(ws + WS_MX), (const bf16*)(ws + WS_WOUT), M, DM, DM}; pg8::StaticOrder S; S.init(M, DM, F.G, (int)blockIdx.x);
        EpiOut E{F.in[I_X], F.out, ws + WS_HB};
        pg8::gemm_phase<EpiOut, pg8::StaticOrder, true>(F.lds + RING_OFF, g, S, E);
        if (BOTH(5)) GRID_BAR();
    }

    if (IN(6)) { router_phase(F); if (BOTH(6)) GRID_BAR(); }

    if (IN(7)) for (int rep = 0; rep < NREP(7); ++rep) {
        const int nmt = moe_tables(F); LAS int* T = (LAS int*)(F.lds + MOE_LDS_OFF);
        pg8::Gemm g{(const bf16*)(ws + WS_HB), (const bf16*)(ws + WS_WUP), M, UPW, DM};
        MoeOrder<8, true> S{nmt * 8, F.G, F.vcu, T, T + 32, T + 72, (const int*)(ws + WS_ELIST)};
        EpiUp E{ws + WS_ACT, F.in[I_BUP], (const float*)(ws + WS_RS2)};
        pg8::gemm_phase<EpiUp, MoeOrder<8, true>, true, true, true, true>(F.lds + RING_OFF, g, S, E, 127, 122);
        if (BOTH(7)) GRID_BAR();
    }

    if (IN(8)) for (int rep = 0; rep < NREP(8); ++rep) {
        const int nmt = moe_tables(F); LAS int* T = (LAS int*)(F.lds + MOE_LDS_OFF);
        pg8::Gemm g{(const bf16*)(ws + WS_ACT), (const bf16*)(ws + WS_WDN), MOE_ROWS_MAX, DM, DE};
        MoeOrder<4, false> S{nmt * 4, F.G, F.vcu, T, T + 32, T + 72, (const int*)(ws + WS_ELIST)};
        EpiDown E{(bf16*)(ws + WS_YS2), F.in[I_BDN], (const float*)(ws + WS_WSLOT)};
        pg8::gemm_phase<EpiDown, MoeOrder<4, false>, true, true, true, true>(F.lds + RING_OFF, g, S, E, 125, 122);
        if (BOTH(8)) GRID_BAR();
    }

    if (IN(9)) { combine_phase(F, F.out); }
    if (IN(16)) router_phase(F, true);
    if (IN(19)) combine_phase(F, (float*)(ws + WS_TA));
#undef IN
#undef BOTH
#undef GRID_BAR
}

extern "C" void kernel_launch(void* const* d_in, const int* in_sizes, int n_in, void* d_out, int out_size, void* d_ws, size_t ws_size, hipStream_t stream) {
    static int grid = 0;
    if (grid == 0) {
        if (n_in != 31 || in_sizes[0] != M * DM || out_size != M * DM || ws_size < WS_END) {
            fprintf(stderr, "kernel_launch: unexpected shapes (n_in %d, in0 %d, out %d, ws %zu < %zu); nothing launched\n", n_in, n_in > 0 ? in_sizes[0] : -1, out_size, ws_size, (size_t)WS_END); grid = -1; return; }
        int dev = 0, cus = 0;
        if (hipGetDevice(&dev) != hipSuccess || hipDeviceGetAttribute(&cus, hipDeviceAttributeMultiprocessorCount, dev) != hipSuccess) { grid = -1; return; }
        if (hipFuncSetAttribute((const void*)mk_fwd, hipFuncAttributeMaxDynamicSharedMemorySize, LDS_BYTES) != hipSuccess) { fprintf(stderr, "kernel_launch: hipFuncSetAttribute failed\n"); grid = -1; return; }
        int per_cu = 0;
        if (hipOccupancyMaxActiveBlocksPerMultiprocessor(&per_cu, (const void*)mk_fwd, NWAVES * 64, LDS_BYTES) != hipSuccess || per_cu < 1) fprintf(stderr, "kernel_launch: occupancy query reports %d\n", per_cu);
        (void)hipGetLastError();
        grid = cus;
    }
    if (grid < 0) return;
    (void)hipMemsetAsync((char*)d_ws + WS_CTL, 0, CTL_ZERO_BYTES, stream);
    Args a{};
    for (int i = 0; i < 31; ++i) a.in[i] = (const float*)d_in[i];
    a.out = (float*)d_out; a.ws = (unsigned char*)d_ws;
    if (N_LAUNCHES == 1) { a.ph_lo = 0; a.ph_hi = PER_PHASE; hipLaunchKernelGGL(mk_fwd, dim3(grid), dim3(NWAVES * 64), LDS_BYTES, stream, a); }
    else for (int p = 0; p < PER_PHASE; ++p) { a.ph_lo = p; a.ph_hi = p + 1; if (PROBE_REP - 110 == p) { a.ph_lo = p + 10; a.ph_hi = p + 11; hipLaunchKernelGGL(mk_fwd, dim3(grid), dim3(NWAVES * 64), LDS_BYTES, stream, a); a.ph_lo = p; a.ph_hi = p + 1; }
        for (int rep = 0; rep < ((PROBE_REP - 100 == p) ? 2 : 1); ++rep) hipLaunchKernelGGL(mk_fwd, dim3(grid), dim3(NWAVES * 64), LDS_BYTES, stream, a); }
}
```

```cpp
#include <hip/hip_runtime.h>
#include <cstdio>
#include <cstdint>

#ifndef MK_N_LAUNCHES
#define MK_N_LAUNCHES 1
#endif
#ifndef PROBE_REP
#define PROBE_REP -1
#endif
#define NREP(k) ((PROBE_REP == (k)) ? 2 : 1)

namespace pg8 {
#define PG8_LAS __attribute__((address_space(3)))
typedef unsigned short bf16_t;
typedef short bf16x8 __attribute__((ext_vector_type(8)));
typedef float f32x4 __attribute__((ext_vector_type(4)));
typedef unsigned u32x4 __attribute__((ext_vector_type(4)));
typedef unsigned u32x2 __attribute__((ext_vector_type(2)));
constexpr int BM = 256, BK = 64, HALF = 128, HTB = HALF * BK * 2  , STAGE_BYTES = 8 * HTB, NXCD = 8, WGM = 8;

__host__ __device__ __forceinline__ int lds_byte(int r, int c) { const int st = (r >> 4) * 2 + (c >> 5), rr = r & 15, cc = c & 31, ob = rr * 64 + cc * 2; return st * 1024 + (ob ^ (((ob >> 9) & 1) * 48)); }
__host__ __device__ __forceinline__ void stage_rc(int b, int& R, int& C) { const int st = b / 1024, sb = b % 1024, swz = sb ^ (((sb >> 9) & 1) * 48); R = (st >> 1) * 16 + swz / 64; C = (st & 1) * 32 + (swz % 64) / 2; }
__host__ __device__ __forceinline__ int perm32(int rho) { const int n = rho >> 4, i = rho & 15; return 8 * (i >> 2) + 4 * n + (i & 3); }

struct Unit { int pm, pn; };
struct Gemm { const bf16_t* A; const bf16_t* Bt; int M, N, K; };

struct StaticOrder {
    int nM, nN, nwg, G, c;
    __host__ __device__ void init(int M, int N, int G_, int c_) { nM = M / BM; nN = N / BM; nwg = nM * nN; G = G_; c = c_; }
    __host__ __device__ bool next(int i, Unit& u) const {
        const long L = (long)i * G + c; if (L >= nwg) return false;
        int wgid = (int)L; { const int q = nwg / NXCD, r = nwg % NXCD, xcd = wgid % NXCD, off = wgid / NXCD; wgid = (xcd < r ? xcd * (q + 1) : r * (q + 1) + (xcd - r) * q) + off; }
        const int nig = WGM * nN, gid = wgid / nig, fm = gid * WGM, gsz = (nM - fm) < WGM ? (nM - fm) : WGM;
        u.pm = fm + ((wgid % nig) % gsz); u.pn = (wgid % nig) / gsz; return true;
    }
    __device__ __forceinline__ int row_slot(const Unit&, int) const { return 0; }
    __device__ __forceinline__ int a_row(const Unit& u, int r, int) const { return u.pm * BM + r; }
};

__device__ __forceinline__ unsigned cvt_pk_bf16(float lo, float hi) { unsigned r; asm volatile("v_cvt_pk_bf16_f32 %0, %1, %2" : "=v"(r) : "v"(lo), "v"(hi)); return r; }

typedef int v8i __attribute__((ext_vector_type(8)));
typedef int v4i __attribute__((ext_vector_type(4)));
template <class Epi, class Sched, bool ALIGN_EPI = false, bool ROWTAB = false, bool GATHER = false, bool FP8 = false>
__device__ __forceinline__ void gemm_phase(PG8_LAS unsigned char* lds, const Gemm g, const Sched& S, const Epi& E, const int sA8 = 127, const int sB8 = 127) {
    static_assert(!GATHER || ROWTAB, "GATHER needs ROWTAB");
    const int tid = threadIdx.x, wid = __builtin_amdgcn_readfirstlane(tid >> 6), lane = tid & 63, wr = wid >> 2, wc = wid & 3, fr = lane & 15, fq = lane >> 4;
    const int K = g.K, RB = FP8 ? K : 2 * K  , nt = RB / (2 * BK);
    unsigned voffA[2], voffB[2];
#pragma unroll
    for (int i = 0; i < 2; ++i) { int R, C; stage_rc(tid * 16 + i * 8192, R, C); const int Rb = Epi::PERM ? ((R & ~31) + perm32(R & 31)) : R;
        voffA[i] = (unsigned)(R * RB + 2 * C); voffB[i] = (unsigned)(Rb * RB + 2 * C); }
    unsigned vA[2][2] = {{0u, 0u}, {0u, 0u}};
    const size_t kstep = (size_t)(BK * 2);
    const size_t hstep = (size_t)HALF * RB;
    const size_t tstep = 2 * hstep;
    const unsigned ldsw = (unsigned)wid * 1024u;
    const int aoff = FP8 ? lds_byte(wr * 64 + fr, fq * 16) : lds_byte(wr * 64 + fr, fq * 8), boff = FP8 ? lds_byte(wc * 32 + fr, fq * 16) : lds_byte(wc * 32 + fr, fq * 8);
    PG8_LAS int* tab = (PG8_LAS int*)(lds + STAGE_BYTES);
#define PG8_SA(b, h) (((b) * 2 + (h)) * HTB)
#define PG8_SB(b, h) ((4 + (b) * 2 + (h)) * HTB)
#define PG8_STAGE(bufoff, gbase, voff) do { _Pragma("unroll") for (int _i = 0; _i < 2; ++_i) \
        __builtin_amdgcn_global_load_lds((const unsigned*)((const char*)(gbase) + (voff)[_i]), (PG8_LAS unsigned*)(lds + (bufoff) + ldsw + _i * 8192), 16, 0, 0); } while (0)
#define PG8_STAGE_A(bufoff, kbase, h) do { if constexpr (GATHER) { PG8_STAGE(bufoff, kbase, vA[h]); } else { PG8_STAGE(bufoff, (kbase) + (h) * hstep, voffA); } } while (0)
#define PG8_LOAD_VA(sel, un) do { _Pragma("unroll") for (int _i = 0; _i < 2; ++_i) { int R_, C_; stage_rc(tid * 16 + _i * 8192, R_, C_); \
        _Pragma("unroll") for (int _h = 0; _h < 2; ++_h) { const int s_ = tab[(sel) * 256 + _h * HALF + R_]; vA[_h][_i] = (unsigned)(S.a_row(un, _h * HALF + R_, s_) * RB + 2 * C_); } } } while (0)
#define PG8_LDA(dst, b, h) do { _Pragma("unroll") for (int m = 0; m < 4; ++m) _Pragma("unroll") for (int k = 0; k < 2; ++k) dst[m][k] = *(const PG8_LAS bf16x8*)(lds + PG8_SA(b, h) + (FP8 ? (aoff ^ (16 * k)) : aoff + k * 1024) + m * 2048); } while (0)
#define PG8_LDB(dst, b, h) do { _Pragma("unroll") for (int n = 0; n < 2; ++n) _Pragma("unroll") for (int k = 0; k < 2; ++k) dst[n][k] = *(const PG8_LAS bf16x8*)(lds + PG8_SB(b, h) + (FP8 ? (boff ^ (16 * k)) : boff + k * 1024) + n * 2048); } while (0)
#define PG8_V8(x) __builtin_shufflevector(__builtin_bit_cast(v4i, (x)[0]), __builtin_bit_cast(v4i, (x)[1]), 0, 1, 2, 3, 4, 5, 6, 7)
#define PG8_MMA(ai, bj, At, Bt) do { __builtin_amdgcn_s_setprio(1); if constexpr (FP8) { _Pragma("unroll") for (int m = 0; m < 4; ++m) _Pragma("unroll") for (int n = 0; n < 2; ++n) \
        acc[ai][bj][m][n] = __builtin_amdgcn_mfma_scale_f32_16x16x128_f8f6f4(PG8_V8(Bt[n]), PG8_V8(At[m]), acc[ai][bj][m][n], 0, 0, 0, sB8, 0, sA8); } else { \
        _Pragma("unroll") for (int m = 0; m < 4; ++m) _Pragma("unroll") for (int n = 0; n < 2; ++n) _Pragma("unroll") for (int k = 0; k < 2; ++k) \
        acc[ai][bj][m][n] = __builtin_amdgcn_mfma_f32_16x16x32_bf16(Bt[n][k], At[m][k], acc[ai][bj][m][n], 0, 0, 0); } __builtin_amdgcn_s_setprio(0); } while (0)
#define PG8_WAIT_V(n) asm volatile("s_waitcnt vmcnt(" #n ")" ::: "memory")
#define PG8_WAIT_L(n) asm volatile("s_waitcnt lgkmcnt(" #n ")" ::: "memory")
#define PG8_BAR __builtin_amdgcn_s_barrier()
#define PG8_SCHED __builtin_amdgcn_sched_barrier(0)
    Unit cur, nxt; int ui = 0;
    if (!S.next(0, cur)) return;
    f32x4 acc[2][2][4][2];
#pragma unroll
    for (int a = 0; a < 2; ++a)
#pragma unroll
        for (int b = 0; b < 2; ++b)
#pragma unroll
            for (int m = 0; m < 4; ++m)
#pragma unroll
                for (int n = 0; n < 2; ++n) acc[a][b][m][n] = (f32x4){0.f, 0.f, 0.f, 0.f};
    bf16x8 At[4][2], B0[2][2], B1[2][2];
    if constexpr (ROWTAB) {
        if (tid < 256) tab[tid] = S.row_slot(cur, tid);
        PG8_WAIT_L(0); PG8_BAR; asm volatile("" ::: "memory");
        if constexpr (GATHER) { PG8_LOAD_VA(0, cur); }
    }
    const char* cA = GATHER ? (const char*)g.A : (const char*)g.A + (size_t)cur.pm * tstep; const char* cB = (const char*)g.Bt + (size_t)cur.pn * tstep;
    PG8_STAGE(PG8_SB(0, 0), cB, voffB); PG8_STAGE(PG8_SB(0, 1), cB + hstep, voffB); PG8_STAGE_A(PG8_SA(0, 0), cA, 0); PG8_STAGE_A(PG8_SA(0, 1), cA, 1);
    if (wr == 1) PG8_BAR;
    PG8_WAIT_V(2); PG8_BAR;
    PG8_STAGE(PG8_SB(1, 0), cB + kstep, voffB); PG8_STAGE_A(PG8_SA(1, 0), cA + kstep, 0); PG8_STAGE(PG8_SB(1, 1), cB + hstep + kstep, voffB);
    PG8_WAIT_V(6); PG8_BAR;
    for (;;) {
        const bool has_next = S.next(ui + 1, nxt);
        if constexpr (ROWTAB) { if (has_next && tid < 256) tab[((ui + 1) % 3) * 256 + tid] = S.row_slot(nxt, tid); }
        const char* nA = has_next ? (GATHER ? (const char*)g.A : (const char*)g.A + (size_t)nxt.pm * tstep) : cA; const char* nB = has_next ? (const char*)g.Bt + (size_t)nxt.pn * tstep : cB;
        for (int t = 0; t < nt; t += 2) {
            const bool last = (t == nt - 2);
            const char* a1 = cA + (size_t)(t + 1) * kstep;
            const char* a2 = last ? nA : cA + (size_t)(t + 2) * kstep; const char* b2 = last ? nB : cB + (size_t)(t + 2) * kstep;
            const char* a3 = a2 + kstep; const char* b3 = b2 + kstep;
            PG8_LDB(B0, 0, 0); PG8_LDB(B1, 0, 1); PG8_SCHED; PG8_LDA(At, 0, 0); PG8_STAGE_A(PG8_SA(1, 1), a1, 1);
            if constexpr (GATHER) { if (last && has_next) { PG8_LOAD_VA((ui + 1) % 3, nxt); } }
            PG8_WAIT_V(8); PG8_WAIT_L(0); PG8_BAR; PG8_MMA(0, 0, At, B0); PG8_MMA(0, 1, At, B1); PG8_BAR; PG8_SCHED;
            PG8_LDA(At, 0, 1); PG8_STAGE(PG8_SB(0, 0), b2, voffB); PG8_STAGE(PG8_SB(0, 1), b2 + hstep, voffB); PG8_STAGE_A(PG8_SA(0, 0), a2, 0);
            PG8_WAIT_V(8); PG8_WAIT_L(0); PG8_BAR; PG8_MMA(1, 0, At, B0); PG8_MMA(1, 1, At, B1); PG8_BAR; PG8_SCHED;
            PG8_LDB(B0, 1, 0); PG8_LDB(B1, 1, 1); PG8_SCHED; PG8_LDA(At, 1, 0); PG8_STAGE_A(PG8_SA(0, 1), a2, 1);
            PG8_WAIT_V(8); PG8_WAIT_L(0); PG8_BAR; PG8_MMA(0, 0, At, B0); PG8_MMA(0, 1, At, B1); PG8_BAR; PG8_SCHED;
            PG8_LDA(At, 1, 1); PG8_STAGE(PG8_SB(1, 0), b3, voffB); PG8_STAGE(PG8_SB(1, 1), b3 + hstep, voffB); PG8_STAGE_A(PG8_SA(1, 0), a3, 0);
            PG8_WAIT_V(8); PG8_WAIT_L(0); PG8_BAR; PG8_MMA(1, 0, At, B0); PG8_MMA(1, 1, At, B1); PG8_BAR; PG8_SCHED;
        }
        if constexpr (ALIGN_EPI) { if (wr == 0) PG8_BAR; }
        E(acc, cur, wr, wc, fr, fq, (const PG8_LAS int*)(tab + (ui % 3) * 256));
        if (!has_next) break;
#pragma unroll
        for (int a = 0; a < 2; ++a)
#pragma unroll
            for (int b = 0; b < 2; ++b)
#pragma unroll
                for (int m = 0; m < 4; ++m)
#pragma unroll
                    for (int n = 0; n < 2; ++n) acc[a][b][m][n] = (f32x4){0.f, 0.f, 0.f, 0.f};
        cur = nxt; cA = nA; cB = nB; ++ui;
        if constexpr (ALIGN_EPI) { if (wr == 1) PG8_BAR; }
    }
    PG8_WAIT_V(0);
    if constexpr (!ALIGN_EPI) { if (wr == 0) PG8_BAR; }
    PG8_BAR;
#undef PG8_SA
#undef PG8_SB
#undef PG8_STAGE
#undef PG8_STAGE_A
#undef PG8_LOAD_VA
#undef PG8_LDA
#undef PG8_LDB
#undef PG8_MMA
#undef PG8_V8
#undef PG8_WAIT_V
#undef PG8_WAIT_L
#undef PG8_BAR
#undef PG8_SCHED
}
}

constexpr int NWAVES = 8;
constexpr int N_LAUNCHES = MK_N_LAUNCHES;
constexpr int PER_PHASE = 10;
constexpr int BATCH = 8, SEQ = 2048, DM = 1024, M = BATCH * SEQ;
constexpr int SSM_W = 512, SSM_G = 32, SSM_H = 16, SSM_P = 64, SSM_T = 16, SSM_NC = SEQ / SSM_T;
constexpr int ATT_H = 4, ATT_D = 64, ATT_V = 128, QK_W = 512, V_W = 512;
constexpr int IN_W = 4096;
constexpr int NE = 32, TOPK = 4, DE = 1024, UPW = 2048;
constexpr float RMS_EPS = 1e-6f;
constexpr float LAMBDA_INIT = 0.2f;
constexpr float QSCALE = 0.125f * 1.4426950408889634f;
constexpr int MOE_ROWS_MAX = M * TOPK + NE * 256;
constexpr int MOE_MT_MAX = MOE_ROWS_MAX / 256;

constexpr size_t MiB = 1u << 20;
constexpr size_t WS_CTL = 0, CTL_ZERO_BYTES = 1 * MiB;
constexpr size_t WS_WIN = 2 * MiB;
constexpr size_t WS_WGLU = 10 * MiB;
constexpr size_t WS_WPS = 11 * MiB;
constexpr size_t WS_WPA = 12 * MiB;
constexpr size_t WS_WOUT = 13 * MiB;
constexpr size_t WS_WRT = 15 * MiB;
constexpr size_t WS_S5 = 16 * MiB;
constexpr size_t WS_A16 = 24 * MiB;
constexpr size_t WS_WUP = 32 * MiB;
constexpr size_t WS_WDN = 160 * MiB;
constexpr size_t WS_XN = 224 * MiB;
constexpr size_t WS_U = 256 * MiB;
constexpr size_t WS_Q = 272 * MiB, WS_K = 288 * MiB, WS_V = 304 * MiB;
constexpr size_t WS_G1 = 320 * MiB, WS_G2 = 352 * MiB;
constexpr size_t WS_YG = 384 * MiB, WS_YS = 400 * MiB, WS_OB = 416 * MiB;
constexpr size_t WS_TA = 432 * MiB, WS_MX = 464 * MiB;
constexpr size_t WS_HB = 496 * MiB;
constexpr size_t WS_RS2 = 528 * MiB;
constexpr size_t WS_WSLOT = 529 * MiB;
constexpr size_t WS_ELIST = 530 * MiB;
constexpr size_t WS_ACT = 544 * MiB;
constexpr size_t WS_YS2 = 688 * MiB;
constexpr size_t WS_END = 816 * MiB;
constexpr int CW_BAR = 4096;
constexpr int CW_Q = 20480;
constexpr int CW_CNT = 16384;

constexpr int RING_OFF = 0, RING_BYTES = 139264;
constexpr int LDSCTL_OFF = RING_BYTES, MISC_OFF = LDSCTL_OFF;
constexpr int MOE_LDS_OFF = LDSCTL_OFF + 256;
constexpr int LDS_BYTES = 147456;

#define GAS __attribute__((address_space(1)))
#define LAS __attribute__((address_space(3)))
typedef unsigned short bf16;
typedef unsigned v4u __attribute__((ext_vector_type(4)));
typedef unsigned v2u __attribute__((ext_vector_type(2)));
typedef float f32x4 __attribute__((ext_vector_type(4)));
typedef float f32x16 __attribute__((ext_vector_type(16)));
typedef short bf16x8 __attribute__((ext_vector_type(8)));
typedef short s16x4 __attribute__((ext_vector_type(4)));
typedef GAS unsigned gu32;
#define RLX_AGENT __ATOMIC_RELAXED, __HIP_MEMORY_SCOPE_AGENT
#define LDS_WAIT() asm volatile("s_waitcnt lgkmcnt(0)" ::: "memory")
#define VM_WAIT() asm volatile("s_waitcnt vmcnt(0)" ::: "memory")
using pg8::cvt_pk_bf16;
__device__ __forceinline__ unsigned f2bf(float f) { unsigned u = __builtin_bit_cast(unsigned, f); return (u + 0x7fffu + ((u >> 16) & 1u)) >> 16; }
__device__ __forceinline__ unsigned pk4_fp8(float a, float b, float c, float d) { unsigned w = 0; w = __builtin_amdgcn_cvt_pk_fp8_f32(a, b, w, false); w = __builtin_amdgcn_cvt_pk_fp8_f32(c, d, w, true); return w; }
__device__ __forceinline__ float bf2f(unsigned b) { return __builtin_bit_cast(float, b << 16); }
__device__ __forceinline__ float bflo(unsigned w) { return __builtin_bit_cast(float, w << 16); }
__device__ __forceinline__ float bfhi(unsigned w) { return __builtin_bit_cast(float, w & 0xffff0000u); }
__device__ __forceinline__ float fsigmoid(float x) { return 1.0f / (1.0f + __expf(-x)); }
__device__ __forceinline__ float gelu_tanh(float x) { const float z = 1.5957691216057308f * (x + 0.044715f * x * x * x); return x / (1.0f + __expf(-z)); }
__device__ __forceinline__ int crow(int r, int hi) { return (r & 3) + 8 * (r >> 2) + 4 * hi; }
__device__ __forceinline__ float wave_sum(float v) {
#pragma unroll
    for (int o = 1; o < 64; o <<= 1) v += __shfl_xor(v, o);
    return v;
}

#define XB_TMO      128
#define XB_XCNT(j)  (256  + 64 * (j))
#define XB_XSUB(j)  (1280 + 64 * (j))
#define XB_XGEN(j)  (2304 + 64 * (j))
#define XB_TOP      3328
#define XB_TOPGEN   3392
#define XCD_BAR_WORDS 3456
#define XB_SPIN_CAP (1u << 18)
__device__ __forceinline__ unsigned xb_ld(unsigned* p)              { return __hip_atomic_load(p, __ATOMIC_RELAXED, __HIP_MEMORY_SCOPE_AGENT); }
__device__ __forceinline__ unsigned xb_add(unsigned* p, unsigned v) { return __hip_atomic_fetch_add(p, v, __ATOMIC_RELAXED, __HIP_MEMORY_SCOPE_AGENT); }
__device__ __forceinline__ unsigned xb_xcc_id() { return (unsigned)__builtin_amdgcn_s_getreg((3 << 11) | 20) & 0xFu; }
#define XB_SPIN(cond, bar) do { unsigned _sp = 0; while (cond) { __builtin_amdgcn_s_sleep(1); \
    if ((++_sp & 255u) == 0u) { if (xb_ld(&(bar)[XB_TMO])) break; if (_sp > XB_SPIN_CAP) { atomicAdd(&(bar)[XB_TMO], 1u); break; } } } } while (0)
struct XcdBarrier { unsigned* bar; unsigned x; volatile LAS unsigned* st; };
__device__ __forceinline__ XcdBarrier xcd_barrier_post(unsigned* bar, volatile LAS unsigned* st) {
    XcdBarrier b; b.bar = bar; b.x = xb_xcc_id(); b.st = st;
    if (threadIdx.x == 0) (void)xb_add(&bar[XB_XCNT(b.x)], 1u);
    return b;
}
__device__ __forceinline__ void xcd_barrier_complete(unsigned* bar, unsigned x, unsigned& nloc, unsigned& nx) {
    const unsigned G = gridDim.x * gridDim.y * gridDim.z;
    unsigned sum, cnt, mine, sp = 0u;
    for (;;) {
        sum = 0u; cnt = 0u; mine = 0u;
#pragma unroll
        for (unsigned j = 0; j < 16; ++j) { const unsigned c = xb_ld(&bar[XB_XCNT(j)]); sum += c; cnt += (c > 0u) ? 1u : 0u; mine = (j == x) ? c : mine; }
        if (sum == G) break;
        __builtin_amdgcn_s_sleep(1);
        if ((++sp & 255u) == 0u) { if (xb_ld(&bar[XB_TMO])) break; if (sp > XB_SPIN_CAP) { atomicAdd(&bar[XB_TMO], 1u); break; } }
    }
    nloc = mine > 0u ? mine : 1u; nx = cnt > 0u ? cnt : 1u;
}
__device__ __forceinline__ void xcd_barrier(const XcdBarrier& b) {
    asm volatile("s_waitcnt vmcnt(0)" ::: "memory");
    __syncthreads();
    if (threadIdx.x == 0) {
        unsigned* bar = b.bar;
        __builtin_amdgcn_s_waitcnt(0);
        unsigned nloc = b.st[0], nx = b.st[1];
        if (nloc == 0u) { xcd_barrier_complete(bar, b.x, nloc, nx); b.st[0] = nloc; b.st[1] = nx; }
        const unsigned old = xb_add(&bar[XB_XSUB(b.x)], 1u);
        const unsigned gen = old / nloc;
        if (old + 1u == (gen + 1u) * nloc) {
            __builtin_amdgcn_fence(__ATOMIC_RELEASE, "agent");
            asm volatile("s_waitcnt vmcnt(0)" ::: "memory");
            const unsigned og = xb_add(&bar[XB_TOP], 1u);
            const unsigned tg = og / nx;
            if (og + 1u == (tg + 1u) * nx) xb_add(&bar[XB_TOPGEN], 1u);
            else XB_SPIN(xb_ld(&bar[XB_TOPGEN]) == tg, bar);
            __builtin_amdgcn_fence(__ATOMIC_ACQUIRE, "agent");
            xb_add(&bar[XB_XGEN(b.x)], 1u);
            asm volatile("s_waitcnt vmcnt(0)" ::: "memory");
        } else {
            XB_SPIN(xb_ld(&bar[XB_XGEN(b.x)]) == gen, bar);
            __builtin_amdgcn_fence(__ATOMIC_ACQUIRE, "agent");
            asm volatile("s_waitcnt vmcnt(0)" ::: "memory");
        }
    }
    __syncthreads();
}

struct Frame {
    LAS unsigned char* lds;
    volatile LAS unsigned* MISC;
    gu32* ctl;
    unsigned char* ws;
    int tid, lane, wave;
    int vcu, G;
    const float* in[31];
    float* out;
};
enum { I_X = 0, I_N1G, I_WIN, I_BGATE, I_ARE, I_AIM, I_LOGDT, I_BRE, I_BIM, I_CRE, I_CIM, I_SSMD, I_WGLU, I_BGLU, I_QG, I_KG, I_LQ1, I_LK1, I_LQ2, I_LK2, I_SUBLN,
       I_WPS, I_WPA, I_WOUT, I_N2G, I_WR, I_BR, I_WUP, I_BUP, I_WDN, I_BDN };

template <int MODE>
__device__ __forceinline__ int physrow(int c) {
    if (MODE == 1) { const int w = c & 63; return (c & ~255) + 128 * (w >> 5) + 32 * ((c >> 6) & 3) + (w & 31); }
    if (MODE == 2) { const int j = c >> 1; return 256 * (j >> 7) + 128 * (c & 1) + (j & 127); }
    return c;
}
struct P0Item { const float* src; void* dst; const float* kscale; int N, K, mode, out8, k0, c0; };
__device__ __forceinline__ int physrow_rt(int mode, int c) { return mode == 1 ? physrow<1>(c) : (mode == 2 ? physrow<2>(c) : c); }
__device__ __forceinline__ void p0_item_load(const P0Item& d, f32x4 (&v)[16], int lane) {
    const int lr = lane >> 4, lc = lane & 15;
#pragma unroll
    for (int i = 0; i < 16; ++i) v[i] = __builtin_nontemporal_load((const f32x4*)(d.src + (size_t)(d.k0 + lr + 4 * i) * d.N + d.c0 + 4 * lc));
}
__device__ __forceinline__ void p0_item_finish(const P0Item& d, const f32x4 (&v)[16], LAS float* scr, int lane) {
    const int lr = lane >> 4, lc = lane & 15;
#pragma unroll
    for (int i = 0; i < 16; ++i) { const int k = lr + 4 * i; *(LAS f32x4*)(scr + k * 64 + 4 * (lc ^ ((k >> 3) & 7))) = v[i]; }
    LDS_WAIT(); asm volatile("" ::: "memory");
    const int a = lane & 7, bq = lane >> 3;
    float ks[8];
#pragma unroll
    for (int i = 0; i < 8; ++i) ks[i] = (d.kscale ? d.kscale[d.k0 + 8 * a + i] : 1.0f) * (d.out8 ? 32.0f : 1.0f);
#pragma unroll
    for (int j = 0; j < 8; ++j) { const int cl = bq + 8 * j; float x[8];
#pragma unroll
        for (int i = 0; i < 8; ++i) x[i] = scr[(8 * a + i) * 64 + 4 * ((cl >> 2) ^ a) + (cl & 3)] * ks[i];
        const size_t ro = (size_t)physrow_rt(d.mode, d.c0 + cl) * d.K + d.k0 + 8 * a;
        if (d.out8) { v2u o; o.x = pk4_fp8(x[0], x[1], x[2], x[3]); o.y = pk4_fp8(x[4], x[5], x[6], x[7]); __builtin_nontemporal_store(o, (GAS v2u*)((unsigned char*)d.dst + ro)); }
        else { v4u o; o.x = cvt_pk_bf16(x[0], x[1]); o.y = cvt_pk_bf16(x[2], x[3]); o.z = cvt_pk_bf16(x[4], x[5]); o.w = cvt_pk_bf16(x[6], x[7]); *(GAS v4u*)((bf16*)d.dst + ro) = o; } }
    LDS_WAIT(); asm volatile("" ::: "memory");
}
__device__ __forceinline__ void rms_row_to_bf16(int lane, const float* xrow, const float* g, bf16* orow) {
    const GAS f32x4* xr = (const GAS f32x4*)xrow + lane; const GAS f32x4* gr = (const GAS f32x4*)g + lane;
    f32x4 v[4]; float s = 0.f;
#pragma unroll
    for (int j = 0; j < 4; ++j) { v[j] = xr[64 * j]; s += (v[j].x * v[j].x + v[j].y * v[j].y) + (v[j].z * v[j].z + v[j].w * v[j].w); }
    const float rs = 1.0f / sqrtf(wave_sum(s) * (1.f / DM) + RMS_EPS);
    GAS unsigned long long* o8 = (GAS unsigned long long*)orow + lane;
#pragma unroll
    for (int j = 0; j < 4; ++j) { const f32x4 gg = gr[64 * j];
        o8[64 * j] = (unsigned long long)cvt_pk_bf16(v[j].x * rs * gg.x, v[j].y * rs * gg.y) | ((unsigned long long)cvt_pk_bf16(v[j].z * rs * gg.z, v[j].w * rs * gg.w) << 32); }
}
__device__ __forceinline__ void p0_s5_group(Frame& F, int g) {
    LAS float* AP = (LAS float*)(F.lds + RING_OFF);
    LAS float* BB = AP + 17 * 64 * 2;
    LAS float* CC = BB + 64 * 16 * 2;
    LAS float* KM = CC + 16 * 64 * 2;
    const float* are = F.in[I_ARE] + g * SSM_P; const float* aim = F.in[I_AIM] + g * SSM_P;
    const double dt = exp((double)F.in[I_LOGDT][g]);
    for (int e = F.tid; e < 17 * 64; e += NWAVES * 64) { const int m = e >> 6, p = e & 63; const double lr = are[p], li = aim[p];
        const double mag = exp(lr * dt * m), ang = li * dt * m; AP[e * 2] = (float)(mag * cos(ang)); AP[e * 2 + 1] = (float)(mag * sin(ang)); }
    for (int e = F.tid; e < 64 * 16; e += NWAVES * 64) { const int p = e >> 4, h = e & 15; const double lr = are[p], li = aim[p];
        const double mag = exp(lr * dt), ar = mag * cos(li * dt), ai = mag * sin(li * dt), den = lr * lr + li * li, nr = ar - 1.0, ni = ai;
        const double cr = (nr * lr + ni * li) / den, ci = (ni * lr - nr * li) / den;
        const double br = F.in[I_BRE][(size_t)(g * SSM_P + p) * SSM_H + h], bi = F.in[I_BIM][(size_t)(g * SSM_P + p) * SSM_H + h];
        BB[e * 2] = (float)(cr * br - ci * bi); BB[e * 2 + 1] = (float)(cr * bi + ci * br); }
    for (int e = F.tid; e < 16 * 64; e += NWAVES * 64) { CC[e * 2] = F.in[I_CRE][(size_t)g * 1024 + e]; CC[e * 2 + 1] = F.in[I_CIM][(size_t)g * 1024 + e]; }
    __syncthreads();
    if (F.tid < 64) { float* a16 = (float*)(F.ws + WS_A16) + (g * 64 + F.tid) * 2; a16[0] = AP[(16 * 64 + F.tid) * 2]; a16[1] = AP[(16 * 64 + F.tid) * 2 + 1]; }
    for (int e = F.tid; e < 16 * 256; e += NWAVES * 64) { const int m = e >> 8, ho = (e >> 4) & 15, hi = e & 15; float s = 0.f;
        for (int p = 0; p < 64; ++p) { const float cr = CC[(ho * 64 + p) * 2], ci = CC[(ho * 64 + p) * 2 + 1], ar = AP[(m * 64 + p) * 2], ai = AP[(m * 64 + p) * 2 + 1];
            const float tr = cr * ar - ci * ai, ti = cr * ai + ci * ar; s += tr * BB[(p * 16 + hi) * 2] - ti * BB[(p * 16 + hi) * 2 + 1]; }
        KM[e] = s; }
    __syncthreads();
    bf16* W1T = (bf16*)(F.ws + WS_S5 + (size_t)g * 262144); bf16* M2T = W1T + 128 * 256; bf16* W3T = M2T + 256 * 256;
    for (int e = F.tid; e < 128 * 256; e += NWAVES * 64) { const int n = e >> 8, k = e & 255, p = n & 63, j = k >> 4, hi = k & 15;
        const float ar = AP[((15 - j) * 64 + p) * 2], ai = AP[((15 - j) * 64 + p) * 2 + 1], br = BB[(p * 16 + hi) * 2], bi = BB[(p * 16 + hi) * 2 + 1];
        W1T[e] = (bf16)f2bf(n < 64 ? ar * br - ai * bi : ar * bi + ai * br); }
    for (int e = F.tid; e < 256 * 128; e += NWAVES * 64) { const int n = e >> 7, k = e & 127, i = n >> 4, ho = n & 15, p = k & 63;
        const float cr = CC[(ho * 64 + p) * 2], ci = CC[(ho * 64 + p) * 2 + 1], ar = AP[((i + 1) * 64 + p) * 2], ai = AP[((i + 1) * 64 + p) * 2 + 1];
        W3T[e] = (bf16)f2bf(k < 64 ? cr * ar - ci * ai : -(cr * ai + ci * ar)); }
    const float* dsk = F.in[I_SSMD] + g * 16;
    for (int e = F.tid; e < 256 * 256; e += NWAVES * 64) { const int n = e >> 8, k = e & 255, i = n >> 4, ho = n & 15, j = k >> 4, hi = k & 15;
        float v = 0.f; if (j <= i) { v = KM[((i - j) * 16 + ho) * 16 + hi]; if (i == j && ho == hi) v += dsk[ho]; }
        M2T[e] = (bf16)f2bf(v); }
    __syncthreads();
}
__device__ __forceinline__ void p0_prologue(Frame& F) {
    if (F.vcu < SSM_G) p0_s5_group(F, F.vcu);
    LAS float* scr = (LAS float*)(F.lds + RING_OFF + F.wave * 16384);
    const int gw = F.vcu * NWAVES + F.wave, NGW = F.G * NWAVES;
    { float* wrT = (float*)(F.ws + WS_WRT); const float* wr = F.in[I_WR]; const float* g2 = F.in[I_N2G];
      for (int e = gw * 64 + F.lane; e < NE * DM; e += NGW * 64) { const int ex = e >> 10, k = e & 1023; wrT[e] = g2[k] * wr[k * NE + ex]; } }
    for (int m = gw; m < M; m += NGW) rms_row_to_bf16(F.lane, F.in[I_X] + (size_t)m * DM, F.in[I_N1G], (bf16*)(F.ws + WS_XN) + (size_t)m * DM);
    constexpr int IT_IN = (DM / 64) * (IN_W / 64), IT_GLU = (512 / 64) * (512 / 64), IT_PS = (512 / 64) * (DM / 64), IT_OUT = (DM / 64) * (DM / 64);
    constexpr int IT_UP1 = (DM / 64) * (UPW / 64), IT_DN1 = (DE / 64) * (DM / 64);
    constexpr int NITEMS = IT_IN + IT_GLU + 2 * IT_PS + IT_OUT + NE * IT_UP1 + NE * IT_DN1;
#define P0_DECODE(it, d) do { int r_ = (it); int nb_; \
        if (r_ < IT_IN) { d.src = F.in[I_WIN]; d.dst = F.ws + WS_WIN; d.kscale = nullptr; d.N = IN_W; d.K = DM; d.mode = 1; d.out8 = 0; } \
        else if ((r_ -= IT_IN) < IT_GLU) { d.src = F.in[I_WGLU]; d.dst = F.ws + WS_WGLU; d.kscale = nullptr; d.N = 512; d.K = 512; d.mode = 0; d.out8 = 0; } \
        else if ((r_ -= IT_GLU) < IT_PS) { d.src = F.in[I_WPS]; d.dst = F.ws + WS_WPS; d.kscale = nullptr; d.N = DM; d.K = 512; d.mode = 0; d.out8 = 0; } \
        else if ((r_ -= IT_PS) < IT_PS) { d.src = F.in[I_WPA]; d.dst = F.ws + WS_WPA; d.kscale = nullptr; d.N = DM; d.K = 512; d.mode = 0; d.out8 = 0; } \
        else if ((r_ -= IT_PS) < IT_OUT) { d.src = F.in[I_WOUT]; d.dst = F.ws + WS_WOUT; d.kscale = nullptr; d.N = DM; d.K = DM; d.mode = 0; d.out8 = 0; } \
        else if ((r_ -= IT_OUT) < NE * IT_UP1) { const int e_ = r_ / IT_UP1; r_ -= e_ * IT_UP1; d.src = F.in[I_WUP] + (size_t)e_ * DM * UPW; d.dst = F.ws + WS_WUP + (size_t)e_ * UPW * DM; d.kscale = F.in[I_N2G]; d.N = UPW; d.K = DM; d.mode = 2; d.out8 = 1; } \
        else { r_ -= NE * IT_UP1; const int e_ = r_ / IT_DN1; r_ -= e_ * IT_DN1; d.src = F.in[I_WDN] + (size_t)e_ * DE * DM; d.dst = F.ws + WS_WDN + (size_t)e_ * DM * DE; d.kscale = nullptr; d.N = DM; d.K = DE; d.mode = 0; d.out8 = 1; } \
        nb_ = d.N / 64; d.k0 = 64 * (r_ / nb_); d.c0 = 64 * (r_ % nb_); } while (0)
    int qcur = 0, qend = 0;
#define P0_DRAW(it) do { if (qcur == qend) { unsigned q_ = 0; if (F.lane == 0) q_ = atomicAdd((unsigned*)(F.ctl + CW_Q), 1u); qcur = 8 * (int)__builtin_amdgcn_readfirstlane(q_); qend = qcur + 8; } it = qcur++; } while (0)
    {
        P0Item dA, dB; f32x4 vA[16], vB[16]; int itA, itB;
        P0_DRAW(itA);
        if (itA < NITEMS) { P0_DECODE(itA, dA); p0_item_load(dA, vA, F.lane);
            for (;;) {
                P0_DRAW(itB); const bool hasB = itB < NITEMS;
                if (hasB) { P0_DECODE(itB, dB); p0_item_load(dB, vB, F.lane); }
                p0_item_finish(dA, vA, scr, F.lane);
                if (!hasB) break;
                P0_DRAW(itA); const bool hasA = itA < NITEMS;
                if (hasA) { P0_DECODE(itA, dA); p0_item_load(dA, vA, F.lane); }
                p0_item_finish(dB, vB, scr, F.lane);
                if (!hasA) break;
            } }
    }
#undef P0_DECODE
#undef P0_DRAW
}

typedef const pg8::f32x4 (&AccRef)[2][2][4][2];
__device__ __forceinline__ v4u pack8(const f32x4 a, const f32x4 b) { v4u w; w.x = cvt_pk_bf16(a[0], a[1]); w.y = cvt_pk_bf16(a[2], a[3]); w.z = cvt_pk_bf16(b[0], b[1]); w.w = cvt_pk_bf16(b[2], b[3]); return w; }
__device__ __forceinline__ void unpack8(const v4u w, f32x4& a, f32x4& b) { a = (f32x4){bflo(w.x), bfhi(w.x), bflo(w.y), bfhi(w.y)}; b = (f32x4){bflo(w.z), bfhi(w.z), bflo(w.w), bfhi(w.w)}; }

struct EpiInProj {
    static constexpr bool PERM = true;
    bf16 *U, *Q, *Kb, *V, *G1, *G2; const float *bgate, *qg, *kg;
    __device__ __forceinline__ void operator()(AccRef acc, const pg8::Unit& u, int wr, int wc, int fr, int fq, const LAS int*) const {
        const int pn = u.pn, row0 = u.pm * 256 + wr * 64 + fr;
        if (pn < 2) {
#pragma unroll
            for (int ai = 0; ai < 2; ++ai)
#pragma unroll
                for (int m = 0; m < 4; ++m) { const int row = row0 + ai * 128 + m * 16, b = row >> 11, t = row & 2047;
#pragma unroll
                    for (int bj = 0; bj < 2; ++bj) { const int lc = 256 * pn + 64 * wc + 32 * bj + 8 * fq, g = lc >> 4, ch = lc & 15;
                        *(v4u*)(U + ((size_t)(b * SSM_G + g) * SEQ + t) * 16 + ch) = pack8(acc[ai][bj][m][0], acc[ai][bj][m][1]); } }
        } else if (pn < 6) {
            const bool isq = pn < 4; const float* gv = isq ? qg : kg; const float sc = isq ? QSCALE : 1.0f;
            bf16* dst = (isq ? Q : Kb) + 256 * (pn - (isq ? 2 : 4)) + 64 * wc + 8 * fq;
            f32x4 gg[2][2];
#pragma unroll
            for (int bj = 0; bj < 2; ++bj)
#pragma unroll
                for (int n = 0; n < 2; ++n) gg[bj][n] = *(const f32x4*)(gv + 32 * bj + 8 * fq + 4 * n) * sc;
#pragma unroll
            for (int ai = 0; ai < 2; ++ai)
#pragma unroll
                for (int m = 0; m < 4; ++m) { const int row = row0 + ai * 128 + m * 16; float ss = 0.f;
#pragma unroll
                    for (int bj = 0; bj < 2; ++bj)
#pragma unroll
                        for (int n = 0; n < 2; ++n) { const f32x4 x = acc[ai][bj][m][n]; ss += (x[0] * x[0] + x[1] * x[1]) + (x[2] * x[2] + x[3] * x[3]); }
                    ss += __shfl_xor(ss, 16); ss += __shfl_xor(ss, 32);
                    const float rs = 1.0f / sqrtf(ss * (1.0f / 64.0f) + RMS_EPS);
#pragma unroll
                    for (int bj = 0; bj < 2; ++bj) *(v4u*)(dst + (size_t)row * 512 + 32 * bj) = pack8(acc[ai][bj][m][0] * rs * gg[bj][0], acc[ai][bj][m][1] * rs * gg[bj][1]); }
        } else if (pn < 8) {
            bf16* dst = V + 256 * (pn - 6) + 64 * wc + 8 * fq;
#pragma unroll
            for (int ai = 0; ai < 2; ++ai)
#pragma unroll
                for (int m = 0; m < 4; ++m) { const int row = row0 + ai * 128 + m * 16;
#pragma unroll
                    for (int bj = 0; bj < 2; ++bj) *(v4u*)(dst + (size_t)row * 512 + 32 * bj) = pack8(acc[ai][bj][m][0], acc[ai][bj][m][1]); }
        } else {
            const int gc = 256 * (pn - 8) + 64 * wc + 8 * fq;
            bf16* dst = (gc < 1024 ? G1 + gc : G2 + (gc - 1024));
            f32x4 bb[2][2];
#pragma unroll
            for (int bj = 0; bj < 2; ++bj)
#pragma unroll
                for (int n = 0; n < 2; ++n) bb[bj][n] = *(const f32x4*)(bgate + gc + 32 * bj + 4 * n);
#pragma unroll
            for (int ai = 0; ai < 2; ++ai)
#pragma unroll
                for (int m = 0; m < 4; ++m) { const int row = row0 + ai * 128 + m * 16;
#pragma unroll
                    for (int bj = 0; bj < 2; ++bj) { f32x4 a = acc[ai][bj][m][0] + bb[bj][0], b = acc[ai][bj][m][1] + bb[bj][1];
#pragma unroll
                        for (int e = 0; e < 4; ++e) { a[e] = fsigmoid(a[e]); b[e] = fsigmoid(b[e]); }
                        *(v4u*)(dst + (size_t)row * 1024 + 32 * bj) = pack8(a, b); } }
        }
    }
};
template <int MODE> struct EpiMix {
    static constexpr bool PERM = true;
    const bf16* P0; const bf16* P1; bf16* O; const float* bias; int ld;
    __device__ __forceinline__ void operator()(AccRef acc, const pg8::Unit& u, int wr, int wc, int fr, int fq, const LAS int*) const {
        const int row0 = u.pm * 256 + wr * 64 + fr, col0 = u.pn * 256 + wc * 32 + 8 * fq;
        f32x4 bb[2][2];
#pragma unroll
        for (int bj = 0; bj < 2; ++bj)
#pragma unroll
            for (int n = 0; n < 2; ++n) bb[bj][n] = (MODE == 0) ? *(const f32x4*)(bias + col0 + bj * 128 + 4 * n) : (f32x4){0.f, 0.f, 0.f, 0.f};
#pragma unroll
        for (int ai = 0; ai < 2; ++ai)
#pragma unroll
            for (int m = 0; m < 4; ++m) { const size_t off = (size_t)(row0 + ai * 128 + m * 16) * ld + col0;
#pragma unroll
                for (int bj = 0; bj < 2; ++bj) { f32x4 a = acc[ai][bj][m][0], b = acc[ai][bj][m][1], p0a, p0b;
                    unpack8(*(const v4u*)(P0 + off + bj * 128), p0a, p0b);
                    if (MODE == 0) { a += bb[bj][0]; b += bb[bj][1];
#pragma unroll
                        for (int e = 0; e < 4; ++e) { a[e] = p0a[e] * fsigmoid(a[e]); b[e] = p0b[e] * fsigmoid(b[e]); } }
                    else if (MODE == 1) { a *= p0a; b *= p0b; }
                    else { f32x4 p1a, p1b; unpack8(*(const v4u*)(P1 + off + bj * 128), p1a, p1b); a = p0a + p1a * a; b = p0b + p1b * b; }
                    *(v4u*)(O + off + bj * 128) = pack8(a, b); } }
    }
};
struct EpiOut {
    static constexpr bool PERM = false;
    const float* X; float* H; unsigned char* HB;
    __device__ __forceinline__ void operator()(AccRef acc, const pg8::Unit& u, int wr, int wc, int fr, int fq, const LAS int*) const {
        const int row0 = u.pm * 256 + wr * 64 + fr, col0 = u.pn * 256 + wc * 32 + 4 * fq;
#pragma unroll
        for (int ai = 0; ai < 2; ++ai)
#pragma unroll
            for (int m = 0; m < 4; ++m) { const size_t off = (size_t)(row0 + ai * 128 + m * 16) * DM + col0;
#pragma unroll
                for (int bj = 0; bj < 2; ++bj)
#pragma unroll
                    for (int n = 0; n < 2; ++n) { const f32x4 h = *(const f32x4*)(X + off + bj * 128 + n * 16) + acc[ai][bj][m][n];
                        *(f32x4*)(H + off + bj * 128 + n * 16) = h; *(unsigned*)(HB + off + bj * 128 + n * 16) = pk4_fp8(h[0], h[1], h[2], h[3]); } }
    }
};
template <int NN, bool TOKROWS> struct MoeOrder {
    int nunits, G, vcu; const LAS int* cnt; const LAS int* tstart; const LAS int* tile2e; const int* elist;
    __device__ __forceinline__ bool next(int i, pg8::Unit& u) const { const long L = (long)i * G + vcu; if (L >= nunits) return false; const int pm = (int)(L / NN), pnl = (int)(L % NN);
        u.pm = pm; u.pn = tile2e[pm] * NN + pnl; return true; }
    __device__ __forceinline__ int row_slot(const pg8::Unit& u, int r) const { const int e = u.pn / NN, pos = (u.pm - tstart[e]) * 256 + r; return pos < cnt[e] ? elist[e * M + pos] : -1; }
    __device__ __forceinline__ int a_row(const pg8::Unit& u, int r, int slot) const { return TOKROWS ? (slot < 0 ? 0 : (slot >> 2)) : u.pm * 256 + r; }
};
struct EpiUp {
    static constexpr bool PERM = true;
    unsigned char* ACT; const float* bup; const float* rs2;
    __device__ __forceinline__ void operator()(AccRef acc, const pg8::Unit& u, int wr, int wc, int fr, int fq, const LAS int* tab) const {
        const int e = u.pn >> 3, pnl = u.pn & 7, j0 = 128 * pnl + 32 * wc + 8 * fq;
        f32x4 bb[4];
#pragma unroll
        for (int q = 0; q < 4; ++q) bb[q] = *(const f32x4*)(bup + (size_t)e * UPW + 2 * j0 + 4 * q);
#pragma unroll
        for (int ai = 0; ai < 2; ++ai)
#pragma unroll
            for (int m = 0; m < 4; ++m) { const int r = ai * 128 + wr * 64 + m * 16 + fr, slot = tab[r];
                if (slot >= 0) { const float rs = rs2[slot >> 2]; f32x4 o[2];
#pragma unroll
                    for (int n = 0; n < 2; ++n)
#pragma unroll
                        for (int e4 = 0; e4 < 4; ++e4) { const int j = 4 * n + e4;
                            float gl = acc[ai][0][m][n][e4] * rs + bb[(2 * j) >> 2][(2 * j) & 3], li = acc[ai][1][m][n][e4] * rs + bb[(2 * j + 1) >> 2][(2 * j + 1) & 3];
                            gl = fminf(gl, 7.0f); li = fminf(fmaxf(li, -7.0f), 7.0f);
                            o[n][e4] = gl * fsigmoid(1.702f * gl) * (li + 1.0f) * 4.0f; }
                    v2u ov; ov.x = pk4_fp8(o[0][0], o[0][1], o[0][2], o[0][3]); ov.y = pk4_fp8(o[1][0], o[1][1], o[1][2], o[1][3]); *(v2u*)(ACT + (size_t)(u.pm * 256 + r) * DE + j0) = ov; } }
    }
};
struct EpiDown {
    static constexpr bool PERM = true;
    bf16* YS2; const float* bdn; const float* wslot;
    __device__ __forceinline__ void operator()(AccRef acc, const pg8::Unit& u, int wr, int wc, int fr, int fq, const LAS int* tab) const {
        const int e = u.pn >> 2, pnl = u.pn & 3, c0 = 256 * pnl + 32 * wc + 8 * fq;
        f32x4 bb[2][2];
#pragma unroll
        for (int bj = 0; bj < 2; ++bj)
#pragma unroll
            for (int n = 0; n < 2; ++n) bb[bj][n] = *(const f32x4*)(bdn + (size_t)e * DM + c0 + bj * 128 + 4 * n);
#pragma unroll
        for (int ai = 0; ai < 2; ++ai)
#pragma unroll
            for (int m = 0; m < 4; ++m) { const int r = ai * 128 + wr * 64 + m * 16 + fr, slot = tab[r];
                if (slot >= 0) { const float w = wslot[slot];
#pragma unroll
                    for (int bj = 0; bj < 2; ++bj) *(v4u*)(YS2 + (size_t)slot * DM + c0 + bj * 128) = pack8((acc[ai][bj][m][0] + bb[bj][0]) * w, (acc[ai][bj][m][1] + bb[bj][1]) * w); } }
    }
};

constexpr int S5_UPITCH = 528, S5_SX_OFF = 128 * S5_UPITCH, S5_XPITCH = 132;
__device__ __forceinline__ void s5_unit(Frame& F, int b, int g) {
    LAS unsigned char* Uimg = F.lds + RING_OFF; LAS float* SX = (LAS float*)(F.lds + RING_OFF + S5_SX_OFF);
    const int tid = F.tid, lane = F.lane, w = F.wave, r32 = lane & 31, hi = lane >> 5;
    const bf16* Ug = (const bf16*)(F.ws + WS_U) + (size_t)(b * SSM_G + g) * SEQ * 16;
    const bf16* W1T = (const bf16*)(F.ws + WS_S5 + (size_t)g * 262144); const bf16* M2T = W1T + 128 * 256; const bf16* W3T = M2T + 256 * 256;
#pragma unroll
    for (int j = 0; j < 8; ++j) { const int q = tid + 512 * j; *(LAS v4u*)(Uimg + (q >> 5) * S5_UPITCH + (q & 31) * 16) = *(const v4u*)(Ug + (size_t)q * 8); }
    __syncthreads();
    { const int nt = w & 3, mt0 = 2 * (w >> 2);
      f32x16 s0 = {0}, s1 = {0};
#pragma unroll 4
      for (int ks = 0; ks < 16; ++ks) {
          const bf16x8 bf = *(const bf16x8*)(W1T + (size_t)(32 * nt + r32) * 256 + 16 * ks + 8 * hi);
          const bf16x8 a0 = *(const LAS bf16x8*)(Uimg + (32 * mt0 + r32) * S5_UPITCH + (16 * ks + 8 * hi) * 2);
          const bf16x8 a1 = *(const LAS bf16x8*)(Uimg + (32 * (mt0 + 1) + r32) * S5_UPITCH + (16 * ks + 8 * hi) * 2);
          s0 = __builtin_amdgcn_mfma_f32_32x32x16_bf16(a0, bf, s0, 0, 0, 0); s1 = __builtin_amdgcn_mfma_f32_32x32x16_bf16(a1, bf, s1, 0, 0, 0); }
#pragma unroll
      for (int r = 0; r < 16; ++r) { SX[(32 * mt0 + crow(r, hi)) * S5_XPITCH + 32 * nt + r32] = s0[r]; SX[(32 * (mt0 + 1) + crow(r, hi)) * S5_XPITCH + 32 * nt + r32] = s1[r]; } }
    __syncthreads();
    if (tid < 64) {
        const float* a16 = (const float*)(F.ws + WS_A16) + (g * 64 + tid) * 2; const float ar = a16[0], ai = a16[1]; float xr = 0.f, xi = 0.f;
#pragma unroll 8
        for (int c = 0; c < SSM_NC; ++c) { const float sr = SX[c * S5_XPITCH + tid], si = SX[c * S5_XPITCH + 64 + tid];
            SX[c * S5_XPITCH + tid] = xr; SX[c * S5_XPITCH + 64 + tid] = xi;
            const float nr = ar * xr - ai * xi + sr, ni = ar * xi + ai * xr + si; xr = nr; xi = ni; }
    }
    __syncthreads();
    { f32x16 y[4] = {{0}, {0}, {0}, {0}};
      const int nks = 2 * w + 2;
      for (int ks = 0; ks < nks; ++ks) {
          const bf16x8 bf = *(const bf16x8*)(M2T + (size_t)(32 * w + r32) * 256 + 16 * ks + 8 * hi);
#pragma unroll
          for (int mt = 0; mt < 4; ++mt) { const bf16x8 a = *(const LAS bf16x8*)(Uimg + (32 * mt + r32) * S5_UPITCH + (16 * ks + 8 * hi) * 2); y[mt] = __builtin_amdgcn_mfma_f32_32x32x16_bf16(a, bf, y[mt], 0, 0, 0); } }
#pragma unroll 2
      for (int ks = 0; ks < 8; ++ks) {
          const bf16x8 bf = *(const bf16x8*)(W3T + (size_t)(32 * w + r32) * 128 + 16 * ks + 8 * hi);
#pragma unroll
          for (int mt = 0; mt < 4; ++mt) { const LAS f32x4* xp = (const LAS f32x4*)(SX + (32 * mt + r32) * S5_XPITCH + 16 * ks + 8 * hi); const f32x4 x0 = xp[0], x1 = xp[1];
              const v4u pk = pack8(x0, x1); y[mt] = __builtin_amdgcn_mfma_f32_32x32x16_bf16(__builtin_bit_cast(bf16x8, pk), bf, y[mt], 0, 0, 0); } }
      bf16* YG = (bf16*)(F.ws + WS_YG); const int i = 2 * w + (r32 >> 4), ho = r32 & 15;
#pragma unroll
      for (int mt = 0; mt < 4; ++mt)
#pragma unroll
          for (int r = 0; r < 16; ++r) { const int c = 32 * mt + crow(r, hi); YG[(size_t)(b * SEQ + 16 * c + i) * SSM_W + g * 16 + ho] = (bf16)f2bf(gelu_tanh(y[mt][r])); } }
    __syncthreads();
}

constexpr int AT_KP = 272, AT_VP = 320, AT_KB = 64 * AT_KP, AT_VB = 64 * AT_VP, AT_BUF = AT_KB + AT_VB;
__device__ __forceinline__ s16x4 vtr(const LAS unsigned char* p) { typedef short v4i16_t __attribute__((ext_vector_type(4))); return __builtin_bit_cast(s16x4, __builtin_amdgcn_ds_read_tr16_b64_v4i16((LAS v4i16_t*)p)); }
__device__ __forceinline__ void attn_unit(Frame& F, int b, int h, int qb, float lam) {
    const int tid = F.tid, lane = F.lane, w = F.wave, rg = w >> 1, t = w & 1, r32 = lane & 31, hi = lane >> 5;
    const bf16* Q = (const bf16*)(F.ws + WS_Q); const bf16* K = (const bf16*)(F.ws + WS_K); const bf16* V = (const bf16*)(F.ws + WS_V); bf16* OB = (bf16*)(F.ws + WS_OB);
    LAS unsigned char* L = F.lds + RING_OFF;
    const int qrow = b * SEQ + qb * 128 + rg * 32 + r32;
    bf16x8 qf[4];
#pragma unroll
    for (int ks = 0; ks < 4; ++ks) qf[ks] = *(const bf16x8*)(Q + (size_t)qrow * QK_W + h * 128 + t * 64 + 16 * ks + 8 * hi);
    const int ntile = 2 * qb + 2, mylim = 2 * qb + (rg >> 1);
    const int kr0 = tid >> 4, cc = tid & 15;
    const size_t gbase = (size_t)(b * SEQ) * 512 + h * 128 + cc * 8;
    v4u kreg[2], vreg[2];
#define AT_LOAD(j) do { _Pragma("unroll") for (int i_ = 0; i_ < 2; ++i_) { const size_t o_ = gbase + (size_t)(64 * (j) + kr0 + 32 * i_) * 512; kreg[i_] = *(const v4u*)(K + o_); vreg[i_] = *(const v4u*)(V + o_); } } while (0)
#define AT_STORE(buf) do { _Pragma("unroll") for (int i_ = 0; i_ < 2; ++i_) { *(LAS v4u*)(L + (buf) * AT_BUF + (kr0 + 32 * i_) * AT_KP + cc * 16) = kreg[i_]; \
        *(LAS v4u*)(L + (buf) * AT_BUF + AT_KB + (kr0 + 32 * i_) * AT_VP + cc * 16) = vreg[i_]; } } while (0)
    AT_LOAD(0); AT_STORE(0);
    __syncthreads();
    f32x16 o[4] = {{0}, {0}, {0}, {0}};
    float mrun = -1e30f, lrun = 0.f;
    const int g4 = lane >> 4, i16 = lane & 15;
    const int vlane = (4 * (g4 >> 1) + (i16 >> 2)) * AT_VP + (16 * (g4 & 1) + 4 * (i16 & 3)) * 2;
    for (int j = 0; j < ntile; ++j) {
        const int buf = j & 1;
        if (j + 1 < ntile) AT_LOAD(j + 1);
        if (j <= mylim) {
            const LAS unsigned char* Kb = L + buf * AT_BUF + t * 128 + hi * 16 + r32 * AT_KP;
            const LAS unsigned char* Vb = L + buf * AT_BUF + AT_KB + vlane;
            f32x16 s0 = {0}, s1 = {0};
#pragma unroll
            for (int ks = 0; ks < 4; ++ks) { const bf16x8 k0 = *(const LAS bf16x8*)(Kb + ks * 32), k1 = *(const LAS bf16x8*)(Kb + 32 * AT_KP + ks * 32);
                s0 = __builtin_amdgcn_mfma_f32_32x32x16_bf16(k0, qf[ks], s0, 0, 0, 0); s1 = __builtin_amdgcn_mfma_f32_32x32x16_bf16(k1, qf[ks], s1, 0, 0, 0); }
            float mx = s0[0];
#pragma unroll
            for (int r = 1; r < 16; ++r) mx = fmaxf(mx, s0[r]);
#pragma unroll
            for (int r = 0; r < 16; ++r) mx = fmaxf(mx, s1[r]);
            mx = fmaxf(mx, __shfl_xor(mx, 32));
            const float mnew = fmaxf(mrun, mx), alpha = __builtin_amdgcn_exp2f(mrun - mnew); mrun = mnew;
            float ps = 0.f;
#pragma unroll
            for (int r = 0; r < 16; ++r) { s0[r] = __builtin_amdgcn_exp2f(s0[r] - mnew); s1[r] = __builtin_amdgcn_exp2f(s1[r] - mnew); ps += s0[r] + s1[r]; }
            lrun = lrun * alpha + ps;
#pragma unroll
            for (int dt = 0; dt < 4; ++dt) o[dt] *= alpha;
#pragma unroll
            for (int s = 0; s < 4; ++s) {
                v4u pk; const int rb = 8 * (s & 1);
                if (s < 2) { pk.x = cvt_pk_bf16(s0[rb], s0[rb + 1]); pk.y = cvt_pk_bf16(s0[rb + 2], s0[rb + 3]); pk.z = cvt_pk_bf16(s0[rb + 4], s0[rb + 5]); pk.w = cvt_pk_bf16(s0[rb + 6], s0[rb + 7]); }
                else       { pk.x = cvt_pk_bf16(s1[rb], s1[rb + 1]); pk.y = cvt_pk_bf16(s1[rb + 2], s1[rb + 3]); pk.z = cvt_pk_bf16(s1[rb + 4], s1[rb + 5]); pk.w = cvt_pk_bf16(s1[rb + 6], s1[rb + 7]); }
                const bf16x8 pf = __builtin_bit_cast(bf16x8, pk);
#pragma unroll
                for (int dt = 0; dt < 4; ++dt) { const s16x4 lo = vtr(Vb + s * 16 * AT_VP + dt * 64), hh = vtr(Vb + s * 16 * AT_VP + dt * 64 + 8 * AT_VP);
                    const bf16x8 vf = (bf16x8){lo[0], lo[1], lo[2], lo[3], hh[0], hh[1], hh[2], hh[3]};
                    o[dt] = __builtin_amdgcn_mfma_f32_32x32x16_bf16(vf, pf, o[dt], 0, 0, 0); } }
        }
        if (j + 1 < ntile) AT_STORE(buf ^ 1);
        __syncthreads();
    }
#undef AT_LOAD
#undef AT_STORE
    const float ltot = lrun + __shfl_xor(lrun, 32), inv = 1.0f / ltot;
    LAS float* EX = (LAS float*)L + rg * 4096;
    if (t == 1) {
        const float sc = inv * lam;
#pragma unroll
        for (int dt = 0; dt < 4; ++dt)
#pragma unroll
            for (int r = 0; r < 16; ++r) EX[(dt * 16 + r) * 64 + lane] = o[dt][r] * sc;
    }
    __syncthreads();
    if (t == 0) {
        float ss = 0.f;
#pragma unroll
        for (int dt = 0; dt < 4; ++dt)
#pragma unroll
            for (int r = 0; r < 16; ++r) { const float y = o[dt][r] * inv - EX[(dt * 16 + r) * 64 + lane]; o[dt][r] = y; ss += y * y; }
        ss += __shfl_xor(ss, 32);
        const float rn = (1.0f - LAMBDA_INIT) / sqrtf(ss * (1.0f / 128.0f) + RMS_EPS);
        const float* sg = F.in[I_SUBLN];
#pragma unroll
        for (int dt = 0; dt < 4; ++dt)
#pragma unroll
            for (int rq = 0; rq < 4; ++rq) { const int d = 32 * dt + 8 * rq + 4 * hi; const f32x4 gg = *(const f32x4*)(sg + d);
                v2u wv; wv.x = cvt_pk_bf16(o[dt][4 * rq] * rn * gg[0], o[dt][4 * rq + 1] * rn * gg[1]); wv.y = cvt_pk_bf16(o[dt][4 * rq + 2] * rn * gg[2], o[dt][4 * rq + 3] * rn * gg[3]);
                *(v2u*)(OB + (size_t)qrow * V_W + h * 128 + d) = wv; }
    }
    __syncthreads();
}

constexpr int CW_CNT_STRIDE = 64;
__device__ __forceinline__ void router_phase(Frame& F, const bool dummy = false) {
    const int lane = F.lane, tid = F.tid, w = F.wave, tt = w >> 1, kh = w & 1;
    LAS float* LG = (LAS float*)(F.lds + RING_OFF);
    LAS float* SS = LG + 4 * 2 * 16 * 33;
    LAS int* LC = (LAS int*)(SS + 128);
    const float* Hf = F.out; const float* wrT = (const float*)(F.ws + WS_WRT); const float* br = F.in[I_BR];
    float* rs2 = (float*)(F.ws + (dummy ? WS_YS2 : WS_RS2)); float* wslot = (float*)(F.ws + (dummy ? WS_YS2 + MiB : WS_WSLOT)); int* elist = (int*)(F.ws + (dummy ? WS_YS2 + 2 * MiB : WS_ELIST));
    unsigned* cnt = (unsigned*)(F.ctl + CW_CNT + (dummy ? 32 : 0));
    const int i16 = lane & 15, kq = lane >> 4;
    for (int tg = F.vcu; tg < M / 64; tg += F.G) {
        if (tid < 64) LC[tid] = 0;
        const int tok0 = tg * 64 + tt * 16;
        f32x4 a0 = {0.f, 0.f, 0.f, 0.f}, a1 = {0.f, 0.f, 0.f, 0.f}; float ssq = 0.f;
        const float* hp = Hf + (size_t)(tok0 + i16) * DM + kh * 512 + 4 * kq; const float* w0 = wrT + (size_t)i16 * DM + kh * 512 + 4 * kq; const float* w1 = w0 + 16 * DM;
#pragma unroll 8
        for (int s = 0; s < 32; ++s) { const f32x4 a = *(const f32x4*)(hp + 16 * s), b0 = *(const f32x4*)(w0 + 16 * s), b1 = *(const f32x4*)(w1 + 16 * s);
            ssq += (a[0] * a[0] + a[1] * a[1]) + (a[2] * a[2] + a[3] * a[3]);
#pragma unroll
            for (int q = 0; q < 4; ++q) { a0 = __builtin_amdgcn_mfma_f32_16x16x4f32(a[q], b0[q], a0, 0, 0, 0); a1 = __builtin_amdgcn_mfma_f32_16x16x4f32(a[q], b1[q], a1, 0, 0, 0); } }
        ssq += __shfl_xor(ssq, 16); ssq += __shfl_xor(ssq, 32);
        LAS float* lg = LG + (tt * 2 + kh) * 16 * 33;
#pragma unroll
        for (int r = 0; r < 4; ++r) { lg[(4 * kq + r) * 33 + i16] = a0[r]; lg[(4 * kq + r) * 33 + 16 + i16] = a1[r]; }
        if (kq == 0) SS[(tt * 2 + kh) * 16 + i16] = ssq;
        __syncthreads();
        int ti[4]; float wv[4]; int lpos[4]; float rsv = 0.f;
        if (tid < 64) {
            const int t4 = tid >> 4, t16 = tid & 15;
            rsv = 1.0f / sqrtf((SS[(t4 * 2) * 16 + t16] + SS[(t4 * 2 + 1) * 16 + t16]) * (1.0f / DM) + RMS_EPS);
            float lgv[32];
#pragma unroll
            for (int e = 0; e < 32; ++e) lgv[e] = (LG[((t4 * 2) * 16 + t16) * 33 + e] + LG[((t4 * 2 + 1) * 16 + t16) * 33 + e]) * rsv + br[e];
            float tv[4];
#pragma unroll
            for (int k = 0; k < 4; ++k) { float best = -3.0e38f; int bi = 0;
#pragma unroll
                for (int e = 0; e < 32; ++e) { const bool tk = lgv[e] > best; best = tk ? lgv[e] : best; bi = tk ? e : bi; }
                tv[k] = best; ti[k] = bi;
#pragma unroll
                for (int e = 0; e < 32; ++e) lgv[e] = (e == bi) ? -3.0e38f : lgv[e]; }
            const float e1 = __expf(tv[1] - tv[0]), e2 = __expf(tv[2] - tv[0]), e3 = __expf(tv[3] - tv[0]), den = 1.0f / (1.0f + e1 + e2 + e3);
            wv[0] = den; wv[1] = e1 * den; wv[2] = e2 * den; wv[3] = e3 * den;
#pragma unroll
            for (int k = 0; k < 4; ++k) lpos[k] = __hip_atomic_fetch_add(LC + ti[k], 1, __ATOMIC_RELAXED, __HIP_MEMORY_SCOPE_WORKGROUP);
        }
        __syncthreads();
        if (tid < 32) { const int c = LC[tid]; LC[32 + tid] = c ? (int)atomicAdd(cnt + tid * CW_CNT_STRIDE, (unsigned)c) : 0; }
        __syncthreads();
        if (tid < 64) {
            const int tok = tg * 64 + tid;
            rs2[tok] = rsv;
#pragma unroll
            for (int k = 0; k < 4; ++k) { elist[ti[k] * M + LC[32 + ti[k]] + lpos[k]] = tok * 4 + k; wslot[tok * 4 + k] = wv[k]; }
        }
        __syncthreads();
    }
}
__device__ __forceinline__ int moe_tables(Frame& F) {
    LAS int* T = (LAS int*)(F.lds + MOE_LDS_OFF); LAS int* cnt = T, *tstart = T + 32, *tile2e = T + 72;
    if (F.tid < 32) cnt[F.tid] = (int)__hip_atomic_load((unsigned*)(F.ctl + CW_CNT) + F.tid * CW_CNT_STRIDE, RLX_AGENT);
    __syncthreads();
    if (F.tid == 0) { int s = 0; for (int e = 0; e < 32; ++e) { tstart[e] = s; s += (cnt[e] + 255) >> 8; } tstart[32] = s; }
    __syncthreads();
    if (F.tid < 32) { for (int p = tstart[F.tid]; p < tstart[F.tid + 1]; ++p) tile2e[p] = F.tid; }
    __syncthreads();
    return tstart[32];
}
__device__ __forceinline__ void combine_phase(Frame& F, float* dst) {
    const int lane = F.lane, gw = F.vcu * NWAVES + F.wave, NGW = F.G * NWAVES;
    const bf16* YS2 = (const bf16*)(F.ws + WS_YS2);
    for (int tk = gw; tk < M; tk += NGW) {
        GAS f32x4* orow = (GAS f32x4*)(F.out + (size_t)tk * DM) + lane; GAS f32x4* drow = (GAS f32x4*)(dst + (size_t)tk * DM) + lane;
#pragma unroll
        for (int j = 0; j < 4; ++j) { f32x4 v = orow[64 * j];
#pragma unroll
            for (int k = 0; k < 4; ++k) { const v2u y = *((const GAS v2u*)(YS2 + (size_t)(tk * 4 + k) * DM) + lane + 64 * j); v += (f32x4){bflo(y.x), bfhi(y.x), bflo(y.y), bfhi(y.y)}; }
            drow[64 * j] = v; }
    }
}

struct Args { const float* in[31]; float* out; unsigned char* ws; int ph_lo, ph_hi; };
__global__ void __launch_bounds__(NWAVES * 64, 2) mk_fwd(Args args) {
    extern __shared__ __attribute__((aligned(16))) unsigned char lds[];
    Frame F;
    F.lds = (LAS unsigned char*)lds;
    F.MISC = (volatile LAS unsigned*)(F.lds + MISC_OFF);
    F.tid = threadIdx.x; F.lane = F.tid & 63; F.wave = __builtin_amdgcn_readfirstlane(F.tid >> 6);
    F.G = gridDim.x; { const int bx = blockIdx.x; F.vcu = (F.G % 8 == 0) ? (bx % 8) * (F.G / 8) + bx / 8 : bx; }
    F.ws = args.ws; F.ctl = (gu32*)(args.ws + WS_CTL); F.out = args.out;
#pragma unroll
    for (int i = 0; i < 31; ++i) F.in[i] = args.in[i];
    for (int u = F.tid; u < 64; u += NWAVES * 64) F.MISC[u] = 0u;
    __syncthreads();
    XcdBarrier bar; bar.bar = (unsigned*)(F.ctl + CW_BAR); bar.x = 0; bar.st = nullptr;
    if (N_LAUNCHES != PER_PHASE) bar = xcd_barrier_post((unsigned*)(F.ctl + CW_BAR), F.MISC + 8);
#define GRID_BAR() do { if (N_LAUNCHES != PER_PHASE) xcd_barrier(bar); } while (0)
    const int lo = args.ph_lo, hi = args.ph_hi;
#define IN(k) (lo <= (k) && (k) < hi)
#define BOTH(k) (IN(k) && IN((k) + 1))
    unsigned char* ws = args.ws;

    if (IN(0)) { for (int rep = 0; rep < NREP(0); ++rep) { p0_prologue(F); if (BOTH(0)) GRID_BAR(); } }

    if (IN(1)) for (int rep = 0; rep < NREP(1); ++rep) {
        pg8::Gemm g{(const bf16*)(ws + WS_XN), (const bf16*)(ws + WS_WIN), M, IN_W, DM}; pg8::StaticOrder S; S.init(M, IN_W, F.G, (int)blockIdx.x);
        EpiInProj E{(bf16*)(ws + WS_U), (bf16*)(ws + WS_Q), (bf16*)(ws + WS_K), (bf16*)(ws + WS_V), (bf16*)(ws + WS_G1), (bf16*)(ws + WS_G2), F.in[I_BGATE], F.in[I_QG], F.in[I_KG]};
        pg8::gemm_phase<EpiInProj, pg8::StaticOrder, true>(F.lds + RING_OFF, g, S, E);
        if (BOTH(1)) GRID_BAR();
    }

    if (IN(2)) {
        for (int rep = 0; rep < NREP(20); ++rep) for (int u = F.vcu; u < BATCH * SSM_G; u += F.G) { const int g = (u >> 5) * 4 + ((u & 31) >> 3), b = u & 7; s5_unit(F, b, g); }
        float lam;
        { const float a = wave_sum(F.in[I_LQ1][F.lane] * F.in[I_LK1][F.lane]), c = wave_sum(F.in[I_LQ2][F.lane] * F.in[I_LK2][F.lane]); lam = __expf(a) - __expf(c) + LAMBDA_INIT; }
        for (int rep = 0; rep < NREP(21); ++rep) for (int u = F.vcu; u < BATCH * ATT_H * 8; u += F.G) { const int bh = u >> 3, qp = u & 7; attn_unit(F, bh >> 2, bh & 3, 15 - qp, lam); attn_unit(F, bh >> 2, bh & 3, qp, lam); }
        if (BOTH(2)) GRID_BAR();
    }

    if (IN(3)) for (int rep = 0; rep < NREP(3); ++rep) {
        { pg8::Gemm g{(const bf16*)(ws + WS_OB), (const bf16*)(ws + WS_WPA), M, DM, 512}; pg8::StaticOrder S; S.init(M, DM, F.G, (int)blockIdx.x);
          EpiMix<1> E{(const bf16*)(ws + WS_G2), nullptr, (bf16*)(ws + WS_TA), nullptr, DM};
          pg8::gemm_phase<EpiMix<1>, pg8::StaticOrder, true>(F.lds + RING_OFF, g, S, E); }
        { pg8::Gemm g{(const bf16*)(ws + WS_YG), (const bf16*)(ws + WS_WGLU), M, 512, 512}; pg8::StaticOrder S; S.init(M, 512, F.G, (int)blockIdx.x);
          EpiMix<0> E{(const bf16*)(ws + WS_YG), nullptr, (bf16*)(ws + WS_YS), F.in[I_BGLU], 512};
          pg8::gemm_phase<EpiMix<0>, pg8::StaticOrder, true>(F.lds + RING_OFF, g, S, E); }
        if (BOTH(3)) GRID_BAR();
    }

    if (IN(4)) for (int rep = 0; rep < NREP(4); ++rep) {
        pg8::Gemm g{(const bf16*)(ws + WS_YS), (const bf16*)(ws + WS_WPS), M, DM, 512}; pg8::StaticOrder S; S.init(M, DM, F.G, (int)blockIdx.x);
        EpiMix<2> E{(const bf16*)(ws + WS_TA), (const bf16*)(ws + WS_G1), (bf16*)(ws + WS_MX), nullptr, DM};
        pg8::gemm_phase<EpiMix<2>, pg8::StaticOrder, true>(F.lds + RING_OFF, g, S, E);
        if (BOTH(4)) GRID_BAR();
    }

    if (IN(5)) for (int rep = 0; rep < NREP(5); ++rep) {
        pg8::Gemm g{(const bf16*)(ws + WS_MX), (const bf16*)(ws + WS_WOUT), M, DM, DM}; pg8::StaticOrder S; S.init(M, DM, F.G, (int)blockIdx.x);
        EpiOut E{F.in[I_X], F.out, ws + WS_HB};
        pg8::gemm_phase<EpiOut, pg8::StaticOrder, true>(F.lds + RING_OFF, g, S, E);
        if (BOTH(5)) GRID_BAR();
    }

    if (IN(6)) { router_phase(F); if (BOTH(6)) GRID_BAR(); }

    if (IN(7)) for (int rep = 0; rep < NREP(7); ++rep) {
        const int nmt = moe_tables(F); LAS int* T = (LAS int*)(F.lds + MOE_LDS_OFF);
        pg8::Gemm g{(const bf16*)(ws + WS_HB), (const bf16*)(ws + WS_WUP), M, UPW, DM};
        MoeOrder<8, true> S{nmt * 8, F.G, F.vcu, T, T + 32, T + 72, (const int*)(ws + WS_ELIST)};
        EpiUp E{ws + WS_ACT, F.in[I_BUP], (const float*)(ws + WS_RS2)};
        pg8::gemm_phase<EpiUp, MoeOrder<8, true>, true, true, true, true>(F.lds + RING_OFF, g, S, E, 127, 122);
        if (BOTH(7)) GRID_BAR();
    }

    if (IN(8)) for (int rep = 0; rep < NREP(8); ++rep) {
        const int nmt = moe_tables(F); LAS int* T = (LAS int*)(F.lds + MOE_LDS_OFF);
        pg8::Gemm g{(const bf16*)(ws + WS_ACT), (const bf16*)(ws + WS_WDN), MOE_ROWS_MAX, DM, DE};
        MoeOrder<4, false> S{nmt * 4, F.G, F.vcu, T, T + 32, T + 72, (const int*)(ws + WS_ELIST)};
        EpiDown E{(bf16*)(ws + WS_YS2), F.in[I_BDN], (const float*)(ws + WS_WSLOT)};
        pg8::gemm_phase<EpiDown, MoeOrder<4, false>, true, true, true, true>(F.lds + RING_OFF, g, S, E, 125, 122);
        if (BOTH(8)) GRID_BAR();
    }

    if (IN(9)) { combine_phase(F, F.out); }
    if (IN(16)) router_phase(F, true);
    if (IN(19)) combine_phase(F, (float*)(ws + WS_TA));
#undef IN
#undef BOTH
#undef GRID_BAR
}

extern "C" void kernel_launch(void* const* d_in, const int* in_sizes, int n_in, void* d_out, int out_size, void* d_ws, size_t ws_size, hipStream_t stream) {
    static int grid = 0;
    if (grid == 0) {
        if (n_in != 31 || in_sizes[0] != M * DM || out_size != M * DM || ws_size < WS_END) {
            fprintf(stderr, "kernel_launch: unexpected shapes (n_in %d, in0 %d, out %d, ws %zu < %zu); nothing launched\n", n_in, n_in > 0 ? in_sizes[0] : -1, out_size, ws_size, (size_t)WS_END); grid = -1; return; }
        int dev = 0, cus = 0;
        if (hipGetDevice(&dev) != hipSuccess || hipDeviceGetAttribute(&cus, hipDeviceAttributeMultiprocessorCount, dev) != hipSuccess) { grid = -1; return; }
        if (hipFuncSetAttribute((const void*)mk_fwd, hipFuncAttributeMaxDynamicSharedMemorySize, LDS_BYTES) != hipSuccess) { fprintf(stderr, "kernel_launch: hipFuncSetAttribute failed\n"); grid = -1; return; }
        int per_cu = 0;
        if (hipOccupancyMaxActiveBlocksPerMultiprocessor(&per_cu, (const void*)mk_fwd, NWAVES * 64, LDS_BYTES) != hipSuccess || per_cu < 1) fprintf(stderr, "kernel_launch: occupancy query reports %d\n", per_cu);
        (void)hipGetLastError();
        grid = cus;
    }
    if (grid < 0) return;
    (void)hipMemsetAsync((char*)d_ws + WS_CTL, 0, CTL_ZERO_BYTES, stream);
    Args a{};
    for (int i = 0; i < 31; ++i) a.in[i] = (const float*)d_in[i];
    a.out = (float*)d_out; a.ws = (unsigned char*)d_ws;
    if (N_LAUNCHES == 1) { a.ph_lo = 0; a.ph_hi = PER_PHASE; hipLaunchKernelGGL(mk_fwd, dim3(grid), dim3(NWAVES * 64), LDS_BYTES, stream, a); }
    else for (int p = 0; p < PER_PHASE; ++p) { a.ph_lo = p; a.ph_hi = p + 1; if (PROBE_REP - 110 == p) { a.ph_lo = p + 10; a.ph_hi = p + 11; hipLaunchKernelGGL(mk_fwd, dim3(grid), dim3(NWAVES * 64), LDS_BYTES, stream, a); a.ph_lo = p; a.ph_hi = p + 1; }
        for (int rep = 0; rep < ((PROBE_REP - 100 == p) ? 2 : 1); ++rep) hipLaunchKernelGGL(mk_fwd, dim3(grid), dim3(NWAVES * 64), LDS_BYTES, stream, a); }
}
```

```cpp
#include <hip/hip_runtime.h>
#include <cstdio>
#include <cstdint>

#ifndef MK_N_LAUNCHES
#define MK_N_LAUNCHES 1
#endif
#ifndef PROBE_REP
#define PROBE_REP -1
#endif
#define NREP(k) ((PROBE_REP == (k)) ? 2 : 1)

namespace pg8 {
#define PG8_LAS __attribute__((address_space(3)))
typedef unsigned short bf16_t;
typedef short bf16x8 __attribute__((ext_vector_type(8)));
typedef float f32x4 __attribute__((ext_vector_type(4)));
typedef unsigned u32x4 __attribute__((ext_vector_type(4)));
typedef unsigned u32x2 __attribute__((ext_vector_type(2)));
constexpr int BM = 256, BK = 64, HALF = 128, HTB = HALF * BK * 2  , STAGE_BYTES = 8 * HTB, NXCD = 8, WGM = 8;

__host__ __device__ __forceinline__ int lds_byte(int r, int c) { const int st = (r >> 4) * 2 + (c >> 5), rr = r & 15, cc = c & 31, ob = rr * 64 + cc * 2; return st * 1024 + (ob ^ (((ob >> 9) & 1) * 48)); }
__host__ __device__ __forceinline__ void stage_rc(int b, int& R, int& C) { const int st = b / 1024, sb = b % 1024, swz = sb ^ (((sb >> 9) & 1) * 48); R = (st >> 1) * 16 + swz / 64; C = (st & 1) * 32 + (swz % 64) / 2; }
__host__ __device__ __forceinline__ int perm32(int rho) { const int n = rho >> 4, i = rho & 15; return 8 * (i >> 2) + 4 * n + (i & 3); }

struct Unit { int pm, pn; };
struct Gemm { const bf16_t* A; const bf16_t* Bt; int M, N, K; };

struct StaticOrder {
    int nM, nN, nwg, G, c;
    __host__ __device__ void init(int M, int N, int G_, int c_) { nM = M / BM; nN = N / BM; nwg = nM * nN; G = G_; c = c_; }
    __host__ __device__ bool next(int i, Unit& u) const {
        const long L = (long)i * G + c; if (L >= nwg) return false;
        int wgid = (int)L; { const int q = nwg / NXCD, r = nwg % NXCD, xcd = wgid % NXCD, off = wgid / NXCD; wgid = (xcd < r ? xcd * (q + 1) : r * (q + 1) + (xcd - r) * q) + off; }
        const int nig = WGM * nN, gid = wgid / nig, fm = gid * WGM, gsz = (nM - fm) < WGM ? (nM - fm) : WGM;
        u.pm = fm + ((wgid % nig) % gsz); u.pn = (wgid % nig) / gsz; return true;
    }
    __device__ __forceinline__ int row_slot(const Unit&, int) const { return 0; }
    __device__ __forceinline__ int a_row(const Unit& u, int r, int) const { return u.pm * BM + r; }
};

__device__ __forceinline__ unsigned cvt_pk_bf16(float lo, float hi) { unsigned r; asm volatile("v_cvt_pk_bf16_f32 %0, %1, %2" : "=v"(r) : "v"(lo), "v"(hi)); return r; }

typedef int v8i __attribute__((ext_vector_type(8)));
typedef int v4i __attribute__((ext_vector_type(4)));
template <class Epi, class Sched, bool ALIGN_EPI = false, bool ROWTAB = false, bool GATHER = false, bool FP8 = false>
__device__ __forceinline__ void gemm_phase(PG8_LAS unsigned char* lds, const Gemm g, const Sched& S, const Epi& E, const int sA8 = 127, const int sB8 = 127) {
    static_assert(!GATHER || ROWTAB, "GATHER needs ROWTAB");
    const int tid = threadIdx.x, wid = __builtin_amdgcn_readfirstlane(tid >> 6), lane = tid & 63, wr = wid >> 2, wc = wid & 3, fr = lane & 15, fq = lane >> 4;
    const int K = g.K, RB = FP8 ? K : 2 * K  , nt = RB / (2 * BK);
    unsigned voffA[2], voffB[2];
#pragma unroll
    for (int i = 0; i < 2; ++i) { int R, C; stage_rc(tid * 16 + i * 8192, R, C); const int Rb = Epi::PERM ? ((R & ~31) + perm32(R & 31)) : R;
        voffA[i] = (unsigned)(R * RB + 2 * C); voffB[i] = (unsigned)(Rb * RB + 2 * C); }
    unsigned vA[2][2] = {{0u, 0u}, {0u, 0u}};
    const size_t kstep = (size_t)(BK * 2);
    const size_t hstep = (size_t)HALF * RB;
    const size_t tstep = 2 * hstep;
    const unsigned ldsw = (unsigned)wid * 1024u;
    const int aoff = FP8 ? lds_byte(wr * 64 + fr, fq * 16) : lds_byte(wr * 64 + fr, fq * 8), boff = FP8 ? lds_byte(wc * 32 + fr, fq * 16) : lds_byte(wc * 32 + fr, fq * 8);
    PG8_LAS int* tab = (PG8_LAS int*)(lds + STAGE_BYTES);
#define PG8_SA(b, h) (((b) * 2 + (h)) * HTB)
#define PG8_SB(b, h) ((4 + (b) * 2 + (h)) * HTB)
#define PG8_STAGE(bufoff, gbase, voff) do { _Pragma("unroll") for (int _i = 0; _i < 2; ++_i) \
        __builtin_amdgcn_global_load_lds((const unsigned*)((const char*)(gbase) + (voff)[_i]), (PG8_LAS unsigned*)(lds + (bufoff) + ldsw + _i * 8192), 16, 0, 0); } while (0)
#define PG8_STAGE_A(bufoff, kbase, h) do { if constexpr (GATHER) { PG8_STAGE(bufoff, kbase, vA[h]); } else { PG8_STAGE(bufoff, (kbase) + (h) * hstep, voffA); } } while (0)
#define PG8_LOAD_VA(sel, un) do { _Pragma("unroll") for (int _i = 0; _i < 2; ++_i) { int R_, C_; stage_rc(tid * 16 + _i * 8192, R_, C_); \
        _Pragma("unroll") for (int _h = 0; _h < 2; ++_h) { const int s_ = tab[(sel) * 256 + _h * HALF + R_]; vA[_h][_i] = (unsigned)(S.a_row(un, _h * HALF + R_, s_) * RB + 2 * C_); } } } while (0)
#define PG8_LDA(dst, b, h) do { _Pragma("unroll") for (int m = 0; m < 4; ++m) _Pragma("unroll") for (int k = 0; k < 2; ++k) dst[m][k] = *(const PG8_LAS bf16x8*)(lds + PG8_SA(b, h) + (FP8 ? (aoff ^ (16 * k)) : aoff + k * 1024) + m * 2048); } while (0)
#define PG8_LDB(dst, b, h) do { _Pragma("unroll") for (int n = 0; n < 2; ++n) _Pragma("unroll") for (int k = 0; k < 2; ++k) dst[n][k] = *(const PG8_LAS bf16x8*)(lds + PG8_SB(b, h) + (FP8 ? (boff ^ (16 * k)) : boff + k * 1024) + n * 2048); } while (0)
#define PG8_V8(x) __builtin_shufflevector(__builtin_bit_cast(v4i, (x)[0]), __builtin_bit_cast(v4i, (x)[1]), 0, 1, 2, 3, 4, 5, 6, 7)
#define PG8_MMA(ai, bj, At, Bt) do { __builtin_amdgcn_s_setprio(1); if constexpr (FP8) { _Pragma("unroll") for (int m = 0; m < 4; ++m) _Pragma("unroll") for (int n = 0; n < 2; ++n) \
        acc[ai][bj][m][n] = __builtin_amdgcn_mfma_scale_f32_16x16x128_f8f6f4(PG8_V8(Bt[n]), PG8_V8(At[m]), acc[ai][bj][m][n], 0, 0, 0, sB8, 0, sA8); } else { \
        _Pragma("unroll") for (int m = 0; m < 4; ++m) _Pragma("unroll") for (int n = 0; n < 2; ++n) _Pragma("unroll") for (int k = 0; k < 2; ++k) \
        acc[ai][bj][m][n] = __builtin_amdgcn_mfma_f32_16x16x32_bf16(Bt[n][k], At[m][k], acc[ai][bj][m][n], 0, 0, 0); } __builtin_amdgcn_s_setprio(0); } while (0)
#define PG8_WAIT_V(n) asm volatile("s_waitcnt vmcnt(" #n ")" ::: "memory")
#define PG8_WAIT_L(n) asm volatile("s_waitcnt lgkmcnt(" #n ")" ::: "memory")
#define PG8_BAR __builtin_amdgcn_s_barrier()
#define PG8_SCHED __builtin_amdgcn_sched_barrier(0)
    Unit cur, nxt; int ui = 0;
    if (!S.next(0, cur)) return;
    f32x4 acc[2][2][4][2];
#pragma unroll
    for (int a = 0; a < 2; ++a)
#pragma unroll
        for (int b = 0; b < 2; ++b)
#pragma unroll
            for (int m = 0; m < 4; ++m)
#pragma unroll
                for (int n = 0; n < 2; ++n) acc[a][b][m][n] = (f32x4){0.f, 0.f, 0.f, 0.f};
    bf16x8 At[4][2], B0[2][2], B1[2][2];
    if constexpr (ROWTAB) {
        if (tid < 256) tab[tid] = S.row_slot(cur, tid);
        PG8_WAIT_L(0); PG8_BAR; asm volatile("" ::: "memory");
        if constexpr (GATHER) { PG8_LOAD_VA(0, cur); }
    }
    const char* cA = GATHER ? (const char*)g.A : (const char*)g.A + (size_t)cur.pm * tstep; const char* cB = (const char*)g.Bt + (size_t)cur.pn * tstep;
    PG8_STAGE(PG8_SB(0, 0), cB, voffB); PG8_STAGE(PG8_SB(0, 1), cB + hstep, voffB); PG8_STAGE_A(PG8_SA(0, 0), cA, 0); PG8_STAGE_A(PG8_SA(0, 1), cA, 1);
    if (wr == 1) PG8_BAR;
    PG8_WAIT_V(2); PG8_BAR;
    PG8_STAGE(PG8_SB(1, 0), cB + kstep, voffB); PG8_STAGE_A(PG8_SA(1, 0), cA + kstep, 0); PG8_STAGE(PG8_SB(1, 1), cB + hstep + kstep, voffB);
    PG8_WAIT_V(6); PG8_BAR;
    for (;;) {
        const bool has_next = S.next(ui + 1, nxt);
        if constexpr (ROWTAB) { if (has_next && tid < 256) tab[((ui + 1) % 3) * 256 + tid] = S.row_slot(nxt, tid); }
        const char* nA = has_next ? (GATHER ? (const char*)g.A : (const char*)g.A + (size_t)nxt.pm * tstep) : cA; const char* nB = has_next ? (const char*)g.Bt + (size_t)nxt.pn * tstep : cB;
        for (int t = 0; t < nt; t += 2) {
            const bool last = (t == nt - 2);
            const char* a1 = cA + (size_t)(t + 1) * kstep;
            const char* a2 = last ? nA : cA + (size_t)(t + 2) * kstep; const char* b2 = last ? nB : cB + (size_t)(t + 2) * kstep;
            const char* a3 = a2 + kstep; const char* b3 = b2 + kstep;
            PG8_LDB(B0, 0, 0); PG8_LDB(B1, 0, 1); PG8_SCHED; PG8_LDA(At, 0, 0); PG8_STAGE_A(PG8_SA(1, 1), a1, 1);
            if constexpr (GATHER) { if (last && has_next) { PG8_LOAD_VA((ui + 1) % 3, nxt); } }
            PG8_WAIT_V(8); PG8_WAIT_L(0); PG8_BAR; PG8_MMA(0, 0, At, B0); PG8_MMA(0, 1, At, B1); PG8_BAR; PG8_SCHED;
            PG8_LDA(At, 0, 1); PG8_STAGE(PG8_SB(0, 0), b2, voffB); PG8_STAGE(PG8_SB(0, 1), b2 + hstep, voffB); PG8_STAGE_A(PG8_SA(0, 0), a2, 0);
            PG8_WAIT_V(8); PG8_WAIT_L(0); PG8_BAR; PG8_MMA(1, 0, At, B0); PG8_MMA(1, 1, At, B1); PG8_BAR; PG8_SCHED;
            PG8_LDB(B0, 1, 0); PG8_LDB(B1, 1, 1); PG8_SCHED; PG8_LDA(At, 1, 0); PG8_STAGE_A(PG8_SA(0, 1), a2, 1);
            PG8_WAIT_V(8); PG8_WAIT_L(0); PG8_BAR; PG8_MMA(0, 0, At, B0); PG8_MMA(0, 1, At, B1); PG8_BAR; PG8_SCHED;
            PG8_LDA(At, 1, 1); PG8_STAGE(PG8_SB(1, 0), b3, voffB); PG8_STAGE(PG8_SB(1, 1), b3 + hstep, voffB); PG8_STAGE_A(PG8_SA(1, 0), a3, 0);
            PG8_WAIT_V(8); PG8_WAIT_L(0); PG8_BAR; PG8_MMA(1, 0, At, B0); PG8_MMA(1, 1, At, B1); PG8_BAR; PG8_SCHED;
        }
        if constexpr (ALIGN_EPI) { if (wr == 0) PG8_BAR; }
        E(acc, cur, wr, wc, fr, fq, (const PG8_LAS int*)(tab + (ui % 3) * 256));
        if (!has_next) break;
#pragma unroll
        for (int a = 0; a < 2; ++a)
#pragma unroll
            for (int b = 0; b < 2; ++b)
#pragma unroll
                for (int m = 0; m < 4; ++m)
#pragma unroll
                    for (int n = 0; n < 2; ++n) acc[a][b][m][n] = (f32x4){0.f, 0.f, 0.f, 0.f};
        cur = nxt; cA = nA; cB = nB; ++ui;
        if constexpr (ALIGN_EPI) { if (wr == 1) PG8_BAR; }
    }
    PG8_WAIT_V(0);
    if constexpr (!ALIGN_EPI) { if (wr == 0) PG8_BAR; }
    PG8_BAR;
#undef PG8_SA
#undef PG8_SB
#undef PG8_STAGE
#undef PG8_STAGE_A
#undef PG8_LOAD_VA
#undef PG8_LDA
#undef PG8_LDB
#undef PG8_MMA
#undef PG8_V8
#undef PG8_WAIT_V
#undef PG8_WAIT_L
#undef PG8_BAR
#undef PG8_SCHED
}
}

constexpr int NWAVES = 8;
constexpr int N_LAUNCHES = MK_N_LAUNCHES;
constexpr int PER_PHASE = 10;
constexpr int BATCH = 8, SEQ = 2048, DM = 1024, M = BATCH * SEQ;
constexpr int SSM_W = 512, SSM_G = 32, SSM_H = 16, SSM_P = 64, SSM_T = 16, SSM_NC = SEQ / SSM_T;
constexpr int ATT_H = 4, ATT_D = 64, ATT_V = 128, QK_W = 512, V_W = 512;
constexpr int IN_W = 4096;
constexpr int NE = 32, TOPK = 4, DE = 1024, UPW = 2048;
constexpr float RMS_EPS = 1e-6f;
constexpr float LAMBDA_INIT = 0.2f;
constexpr float QSCALE = 0.125f * 1.4426950408889634f;
constexpr int MOE_ROWS_MAX = M * TOPK + NE * 256;
constexpr int MOE_MT_MAX = MOE_ROWS_MAX / 256;

constexpr size_t MiB = 1u << 20;
constexpr size_t WS_CTL = 0, CTL_ZERO_BYTES = 1 * MiB;
constexpr size_t WS_WIN = 2 * MiB;
constexpr size_t WS_WGLU = 10 * MiB;
constexpr size_t WS_WPS = 11 * MiB;
constexpr size_t WS_WPA = 12 * MiB;
constexpr size_t WS_WOUT = 13 * MiB;
constexpr size_t WS_WRT = 15 * MiB;
constexpr size_t WS_S5 = 16 * MiB;
constexpr size_t WS_A16 = 24 * MiB;
constexpr size_t WS_WUP = 32 * MiB;
constexpr size_t WS_WDN = 160 * MiB;
constexpr size_t WS_XN = 224 * MiB;
constexpr size_t WS_U = 256 * MiB;
constexpr size_t WS_Q = 272 * MiB, WS_K = 288 * MiB, WS_V = 304 * MiB;
constexpr size_t WS_G1 = 320 * MiB, WS_G2 = 352 * MiB;
constexpr size_t WS_YG = 384 * MiB, WS_YS = 400 * MiB, WS_OB = 416 * MiB;
constexpr size_t WS_TA = 432 * MiB, WS_MX = 464 * MiB;
constexpr size_t WS_HB = 496 * MiB;
constexpr size_t WS_RS2 = 528 * MiB;
constexpr size_t WS_WSLOT = 529 * MiB;
constexpr size_t WS_ELIST = 530 * MiB;
constexpr size_t WS_ACT = 544 * MiB;
constexpr size_t WS_YS2 = 688 * MiB;
constexpr size_t WS_END = 816 * MiB;
constexpr int CW_BAR = 4096;
constexpr int CW_Q = 20480;
constexpr int CW_CNT = 16384;

constexpr int RING_OFF = 0, RING_BYTES = 139264;
constexpr int LDSCTL_OFF = RING_BYTES, MISC_OFF = LDSCTL_OFF;
constexpr int MOE_LDS_OFF = LDSCTL_OFF + 256;
constexpr int LDS_BYTES = 147456;

#define GAS __attribute__((address_space(1)))
#define LAS __attribute__((address_space(3)))
typedef unsigned short bf16;
typedef unsigned v4u __attribute__((ext_vector_type(4)));
typedef unsigned v2u __attribute__((ext_vector_type(2)));
typedef float f32x4 __attribute__((ext_vector_type(4)));
typedef float f32x16 __attribute__((ext_vector_type(16)));
typedef short bf16x8 __attribute__((ext_vector_type(8)));
typedef short s16x4 __attribute__((ext_vector_type(4)));
typedef GAS unsigned gu32;
#define RLX_AGENT __ATOMIC_RELAXED, __HIP_MEMORY_SCOPE_AGENT
#define LDS_WAIT() asm volatile("s_waitcnt lgkmcnt(0)" ::: "memory")
#define VM_WAIT() asm volatile("s_waitcnt vmcnt(0)" ::: "memory")
using pg8::cvt_pk_bf16;
__device__ __forceinline__ unsigned f2bf(float f) { unsigned u = __builtin_bit_cast(unsigned, f); return (u + 0x7fffu + ((u >> 16) & 1u)) >> 16; }
__device__ __forceinline__ unsigned pk4_fp8(float a, float b, float c, float d) { unsigned w = 0; w = __builtin_amdgcn_cvt_pk_fp8_f32(a, b, w, false); w = __builtin_amdgcn_cvt_pk_fp8_f32(c, d, w, true); return w; }
__device__ __forceinline__ float bf2f(unsigned b) { return __builtin_bit_cast(float, b << 16); }
__device__ __forceinline__ float bflo(unsigned w) { return __builtin_bit_cast(float, w << 16); }
__device__ __forceinline__ float bfhi(unsigned w) { return __builtin_bit_cast(float, w & 0xffff0000u); }
__device__ __forceinline__ float fsigmoid(float x) { return 1.0f / (1.0f + __expf(-x)); }
__device__ __forceinline__ float gelu_tanh(float x) { const float z = 1.5957691216057308f * (x + 0.044715f * x * x * x); return x / (1.0f + __expf(-z)); }
__device__ __forceinline__ int crow(int r, int hi) { return (r & 3) + 8 * (r >> 2) + 4 * hi; }
__device__ __forceinline__ float wave_sum(float v) {
#pragma unroll
    for (int o = 1; o < 64; o <<= 1) v += __shfl_xor(v, o);
    return v;
}

#define XB_TMO      128
#define XB_XCNT(j)  (256  + 64 * (j))
#define XB_XSUB(j)  (1280 + 64 * (j))
#define XB_XGEN(j)  (2304 + 64 * (j))
#define XB_TOP      3328
#define XB_TOPGEN   3392
#define XCD_BAR_WORDS 3456
#define XB_SPIN_CAP (1u << 18)
__device__ __forceinline__ unsigned xb_ld(unsigned* p)              { return __hip_atomic_load(p, __ATOMIC_RELAXED, __HIP_MEMORY_SCOPE_AGENT); }
__device__ __forceinline__ unsigned xb_add(unsigned* p, unsigned v) { return __hip_atomic_fetch_add(p, v, __ATOMIC_RELAXED, __HIP_MEMORY_SCOPE_AGENT); }
__device__ __forceinline__ unsigned xb_xcc_id() { return (unsigned)__builtin_amdgcn_s_getreg((3 << 11) | 20) & 0xFu; }
#define XB_SPIN(cond, bar) do { unsigned _sp = 0; while (cond) { __builtin_amdgcn_s_sleep(1); \
    if ((++_sp & 255u) == 0u) { if (xb_ld(&(bar)[XB_TMO])) break; if (_sp > XB_SPIN_CAP) { atomicAdd(&(bar)[XB_TMO], 1u); break; } } } } while (0)
struct XcdBarrier { unsigned* bar; unsigned x; volatile LAS unsigned* st; };
__device__ __forceinline__ XcdBarrier xcd_barrier_post(unsigned* bar, volatile LAS unsigned* st) {
    XcdBarrier b; b.bar = bar; b.x = xb_xcc_id(); b.st = st;
    if (threadIdx.x == 0) (void)xb_add(&bar[XB_XCNT(b.x)], 1u);
    return b;
}
__device__ __forceinline__ void xcd_barrier_complete(unsigned* bar, unsigned x, unsigned& nloc, unsigned& nx) {
    const unsigned G = gridDim.x * gridDim.y * gridDim.z;
    unsigned sum, cnt, mine, sp = 0u;
    for (;;) {
        sum = 0u; cnt = 0u; mine = 0u;
#pragma unroll
        for (unsigned j = 0; j < 16; ++j) { const unsigned c = xb_ld(&bar[XB_XCNT(j)]); sum += c; cnt += (c > 0u) ? 1u : 0u; mine = (j == x) ? c : mine; }
        if (sum == G) break;
        __builtin_amdgcn_s_sleep(1);
        if ((++sp & 255u) == 0u) { if (xb_ld(&bar[XB_TMO])) break; if (sp > XB_SPIN_CAP) { atomicAdd(&bar[XB_TMO], 1u); break; } }
    }
    nloc = mine > 0u ? mine : 1u; nx = cnt > 0u ? cnt : 1u;
}
__device__ __forceinline__ void xcd_barrier(const XcdBarrier& b) {
    asm volatile("s_waitcnt vmcnt(0)" ::: "memory");
    __syncthreads();
    if (threadIdx.x == 0) {
        unsigned* bar = b.bar;
        __builtin_amdgcn_s_waitcnt(0);
        unsigned nloc = b.st[0], nx = b.st[1];
        if (nloc == 0u) { xcd_barrier_complete(bar, b.x, nloc, nx); b.st[0] = nloc; b.st[1] = nx; }
        const unsigned old = xb_add(&bar[XB_XSUB(b.x)], 1u);
        const unsigned gen = old / nloc;
        if (old + 1u == (gen + 1u) * nloc) {
            __builtin_amdgcn_fence(__ATOMIC_RELEASE, "agent");
            asm volatile("s_waitcnt vmcnt(0)" ::: "memory");
            const unsigned og = xb_add(&bar[XB_TOP], 1u);
            const unsigned tg = og / nx;
            if (og + 1u == (tg + 1u) * nx) xb_add(&bar[XB_TOPGEN], 1u);
            else XB_SPIN(xb_ld(&bar[XB_TOPGEN]) == tg, bar);
            __builtin_amdgcn_fence(__ATOMIC_ACQUIRE, "agent");
            xb_add(&bar[XB_XGEN(b.x)], 1u);
            asm volatile("s_waitcnt vmcnt(0)" ::: "memory");
        } else {
            XB_SPIN(xb_ld(&bar[XB_XGEN(b.x)]) == gen, bar);
            __builtin_amdgcn_fence(__ATOMIC_ACQUIRE, "agent");
            asm volatile("s_waitcnt vmcnt(0)" ::: "memory");
        }
    }
    __syncthreads();
}

struct Frame {
    LAS unsigned char* lds;
    volatile LAS unsigned* MISC;
    gu32* ctl;
    unsigned char* ws;
    int tid, lane, wave;
    int vcu, G;
    const float* in[31];
    float* out;
};
enum { I_X = 0, I_N1G, I_WIN, I_BGATE, I_ARE, I_AIM, I_LOGDT, I_BRE, I_BIM, I_CRE, I_CIM, I_SSMD, I_WGLU, I_BGLU, I_QG, I_KG, I_LQ1, I_LK1, I_LQ2, I_LK2, I_SUBLN,
       I_WPS, I_WPA, I_WOUT, I_N2G, I_WR, I_BR, I_WUP, I_BUP, I_WDN, I_BDN };

template <int MODE>
__device__ __forceinline__ int physrow(int c) {
    if (MODE == 1) { const int w = c & 63; return (c & ~255) + 128 * (w >> 5) + 32 * ((c >> 6) & 3) + (w & 31); }
    if (MODE == 2) { const int j = c >> 1; return 256 * (j >> 7) + 128 * (c & 1) + (j & 127); }
    return c;
}
struct P0Item { const float* src; void* dst; const float* kscale; int N, K, mode, out8, k0, c0; };
__device__ __forceinline__ int physrow_rt(int mode, int c) { return mode == 1 ? physrow<1>(c) : (mode == 2 ? physrow<2>(c) : c); }
__device__ __forceinline__ void p0_item_load(const P0Item& d, f32x4 (&v)[16], int lane) {
    const int lr = lane >> 4, lc = lane & 15;
#pragma unroll
    for (int i = 0; i < 16; ++i) v[i] = __builtin_nontemporal_load((const f32x4*)(d.src + (size_t)(d.k0 + lr + 4 * i) * d.N + d.c0 + 4 * lc));
}
__device__ __forceinline__ void p0_item_finish(const P0Item& d, const f32x4 (&v)[16], LAS float* scr, int lane) {
    const int lr = lane >> 4, lc = lane & 15;
#pragma unroll
    for (int i = 0; i < 16; ++i) { const int k = lr + 4 * i; *(LAS f32x4*)(scr + k * 64 + 4 * (lc ^ ((k >> 3) & 7))) = v[i]; }
    LDS_WAIT(); asm volatile("" ::: "memory");
    const int a = lane & 7, bq = lane >> 3;
    float ks[8];
#pragma unroll
    for (int i = 0; i < 8; ++i) ks[i] = (d.kscale ? d.kscale[d.k0 + 8 * a + i] : 1.0f) * (d.out8 ? 32.0f : 1.0f);
#pragma unroll
    for (int j = 0; j < 8; ++j) { const int cl = bq + 8 * j; float x[8];
#pragma unroll
        for (int i = 0; i < 8; ++i) x[i] = scr[(8 * a + i) * 64 + 4 * ((cl >> 2) ^ a) + (cl & 3)] * ks[i];
        const size_t ro = (size_t)physrow_rt(d.mode, d.c0 + cl) * d.K + d.k0 + 8 * a;
        if (d.out8) { v2u o; o.x = pk4_fp8(x[0], x[1], x[2], x[3]); o.y = pk4_fp8(x[4], x[5], x[6], x[7]); __builtin_nontemporal_store(o, (GAS v2u*)((unsigned char*)d.dst + ro)); }
        else { v4u o; o.x = cvt_pk_bf16(x[0], x[1]); o.y = cvt_pk_bf16(x[2], x[3]); o.z = cvt_pk_bf16(x[4], x[5]); o.w = cvt_pk_bf16(x[6], x[7]); *(GAS v4u*)((bf16*)d.dst + ro) = o; } }
    LDS_WAIT(); asm volatile("" ::: "memory");
}
__device__ __forceinline__ void rms_row_to_bf16(int lane, const float* xrow, const float* g, bf16* orow) {
    const GAS f32x4* xr = (const GAS f32x4*)xrow + lane; const GAS f32x4* gr = (const GAS f32x4*)g + lane;
    f32x4 v[4]; float s = 0.f;
#pragma unroll
    for (int j = 0; j < 4; ++j) { v[j] = xr[64 * j]; s += (v[j].x * v[j].x + v[j].y * v[j].y) + (v[j].z * v[j].z + v[j].w * v[j].w); }
    const float rs = 1.0f / sqrtf(wave_sum(s) * (1.f / DM) + RMS_EPS);
    GAS unsigned long long* o8 = (GAS unsigned long long*)orow + lane;
#pragma unroll
    for (int j = 0; j < 4; ++j) { const f32x4 gg = gr[64 * j];
        o8[64 * j] = (unsigned long long)cvt_pk_bf16(v[j].x * rs * gg.x, v[j].y * rs * gg.y) | ((unsigned long long)cvt_pk_bf16(v[j].z * rs * gg.z, v[j].w * rs * gg.w) << 32); }
}
__device__ __forceinline__ void p0_s5_group(Frame& F, int g) {
    LAS float* AP = (LAS float*)(F.lds + RING_OFF);
    LAS float* BB = AP + 17 * 64 * 2;
    LAS float* CC = BB + 64 * 16 * 2;
    LAS float* KM = CC + 16 * 64 * 2;
    const float* are = F.in[I_ARE] + g * SSM_P; const float* aim = F.in[I_AIM] + g * SSM_P;
    const double dt = exp((double)F.in[I_LOGDT][g]);
    for (int e = F.tid; e < 17 * 64; e += NWAVES * 64) { const int m = e >> 6, p = e & 63; const double lr = are[p], li = aim[p];
        const double mag = exp(lr * dt * m), ang = li * dt * m; AP[e * 2] = (float)(mag * cos(ang)); AP[e * 2 + 1] = (float)(mag * sin(ang)); }
    for (int e = F.tid; e < 64 * 16; e += NWAVES * 64) { const int p = e >> 4, h = e & 15; const double lr = are[p], li = aim[p];
        const double mag = exp(lr * dt), ar = mag * cos(li * dt), ai = mag * sin(li * dt), den = lr * lr + li * li, nr = ar - 1.0, ni = ai;
        const double cr = (nr * lr + ni * li) / den, ci = (ni * lr - nr * li) / den;
        const double br = F.in[I_BRE][(size_t)(g * SSM_P + p) * SSM_H + h], bi = F.in[I_BIM][(size_t)(g * SSM_P + p) * SSM_H + h];
        BB[e * 2] = (float)(cr * br - ci * bi); BB[e * 2 + 1] = (float)(cr * bi + ci * br); }
    for (int e = F.tid; e < 16 * 64; e += NWAVES * 64) { CC[e * 2] = F.in[I_CRE][(size_t)g * 1024 + e]; CC[e * 2 + 1] = F.in[I_CIM][(size_t)g * 1024 + e]; }
    __syncthreads();
    if (F.tid < 64) { float* a16 = (float*)(F.ws + WS_A16) + (g * 64 + F.tid) * 2; a16[0] = AP[(16 * 64 + F.tid) * 2]; a16[1] = AP[(16 * 64 + F.tid) * 2 + 1]; }
    for (int e = F.tid; e < 16 * 256; e += NWAVES * 64) { const int m = e >> 8, ho = (e >> 4) & 15, hi = e & 15; float s = 0.f;
        for (int p = 0; p < 64; ++p) { const float cr = CC[(ho * 64 + p) * 2], ci = CC[(ho * 64 + p) * 2 + 1], ar = AP[(m * 64 + p) * 2], ai = AP[(m * 64 + p) * 2 + 1];
            const float tr = cr * ar - ci * ai, ti = cr * ai + ci * ar; s += tr * BB[(p * 16 + hi) * 2] - ti * BB[(p * 16 + hi) * 2 + 1]; }
        KM[e] = s; }
    __syncthreads();
    bf16* W1T = (bf16*)(F.ws + WS_S5 + (size_t)g * 262144); bf16* M2T = W1T + 128 * 256; bf16* W3T = M2T + 256 * 256;
    for (int e = F.tid; e < 128 * 256; e += NWAVES * 64) { const int n = e >> 8, k = e & 255, p = n & 63, j = k >> 4, hi = k & 15;
        const float ar = AP[((15 - j) * 64 + p) * 2], ai = AP[((15 - j) * 64 + p) * 2 + 1], br = BB[(p * 16 + hi) * 2], bi = BB[(p * 16 + hi) * 2 + 1];
        W1T[e] = (bf16)f2bf(n < 64 ? ar * br - ai * bi : ar * bi + ai * br); }
    for (int e = F.tid; e < 256 * 128; e += NWAVES * 64) { const int n = e >> 7, k = e & 127, i = n >> 4, ho = n & 15, p = k & 63;
        const float cr = CC[(ho * 64 + p) * 2], ci = CC[(ho * 64 + p) * 2 + 1], ar = AP[((i + 1) * 64 + p) * 2], ai = AP[((i + 1) * 64 + p) * 2 + 1];
        W3T[e] = (bf16)f2bf(k < 64 ? cr * ar - ci * ai : -(cr * ai + ci * ar)); }
    const float* dsk = F.in[I_SSMD] + g * 16;
    for (int e = F.tid; e < 256 * 256; e += NWAVES * 64) { const int n = e >> 8, k = e & 255, i = n >> 4, ho = n & 15, j = k >> 4, hi = k & 15;
        float v = 0.f; if (j <= i) { v = KM[((i - j) * 16 + ho) * 16 + hi]; if (i == j && ho == hi) v += dsk[ho]; }
        M2T[e] = (bf16)f2bf(v); }
    __syncthreads();
}
__device__ __forceinline__ void p0_prologue(Frame& F) {
    if (F.vcu < SSM_G) p0_s5_group(F, F.vcu);
    LAS float* scr = (LAS float*)(F.lds + RING_OFF + F.wave * 16384);
    const int gw = F.vcu * NWAVES + F.wave, NGW = F.G * NWAVES;
    { float* wrT = (float*)(F.ws + WS_WRT); const float* wr = F.in[I_WR]; const float* g2 = F.in[I_N2G];
      for (int e = gw * 64 + F.lane; e < NE * DM; e += NGW * 64) { const int ex = e >> 10, k = e & 1023; wrT[e] = g2[k] * wr[k * NE + ex]; } }
    for (int m = gw; m < M; m += NGW) rms_row_to_bf16(F.lane, F.in[I_X] + (size_t)m * DM, F.in[I_N1G], (bf16*)(F.ws + WS_XN) + (size_t)m * DM);
    constexpr int IT_IN = (DM / 64) * (IN_W / 64), IT_GLU = (512 / 64) * (512 / 64), IT_PS = (512 / 64) * (DM / 64), IT_OUT = (DM / 64) * (DM / 64);
    constexpr int IT_UP1 = (DM / 64) * (UPW / 64), IT_DN1 = (DE / 64) * (DM / 64);
    constexpr int NITEMS = IT_IN + IT_GLU + 2 * IT_PS + IT_OUT + NE * IT_UP1 + NE * IT_DN1;
#define P0_DECODE(it, d) do { int r_ = (it); int nb_; \
        if (r_ < IT_IN) { d.src = F.in[I_WIN]; d.dst = F.ws + WS_WIN; d.kscale = nullptr; d.N = IN_W; d.K = DM; d.mode = 1; d.out8 = 0; } \
        else if ((r_ -= IT_IN) < IT_GLU) { d.src = F.in[I_WGLU]; d.dst = F.ws + WS_WGLU; d.kscale = nullptr; d.N = 512; d.K = 512; d.mode = 0; d.out8 = 0; } \
        else if ((r_ -= IT_GLU) < IT_PS) { d.src = F.in[I_WPS]; d.dst = F.ws + WS_WPS; d.kscale = nullptr; d.N = DM; d.K = 512; d.mode = 0; d.out8 = 0; } \
        else if ((r_ -= IT_PS) < IT_PS) { d.src = F.in[I_WPA]; d.dst = F.ws + WS_WPA; d.kscale = nullptr; d.N = DM; d.K = 512; d.mode = 0; d.out8 = 0; } \
        else if ((r_ -= IT_PS) < IT_OUT) { d.src = F.in[I_WOUT]; d.dst = F.ws + WS_WOUT; d.kscale = nullptr; d.N = DM; d.K = DM; d.mode = 0; d.out8 = 0; } \
        else if ((r_ -= IT_OUT) < NE * IT_UP1) { const int e_ = r_ / IT_UP1; r_ -= e_ * IT_UP1; d.src = F.in[I_WUP] + (size_t)e_ * DM * UPW; d.dst = F.ws + WS_WUP + (size_t)e_ * UPW * DM; d.kscale = F.in[I_N2G]; d.N = UPW; d.K = DM; d.mode = 2; d.out8 = 1; } \
        else { r_ -= NE * IT_UP1; const int e_ = r_ / IT_DN1; r_ -= e_ * IT_DN1; d.src = F.in[I_WDN] + (size_t)e_ * DE * DM; d.dst = F.ws + WS_WDN + (size_t)e_ * DM * DE; d.kscale = nullptr; d.N = DM; d.K = DE; d.mode = 0; d.out8 = 1; } \
        nb_ = d.N / 64; d.k0 = 64 * (r_ / nb_); d.c0 = 64 * (r_ % nb_); } while (0)
    int qcur = 0, qend = 0;
#define P0_DRAW(it) do { if (qcur == qend) { unsigned q_ = 0; if (F.lane == 0) q_ = atomicAdd((unsigned*)(F.ctl + CW_Q), 1u); qcur = 8 * (int)__builtin_amdgcn_readfirstlane(q_); qend = qcur + 8; } it = qcur++; } while (0)
    {
        P0Item dA, dB; f32x4 vA[16], vB[16]; int itA, itB;
        P0_DRAW(itA);
        if (itA < NITEMS) { P0_DECODE(itA, dA); p0_item_load(dA, vA, F.lane);
            for (;;) {
                P0_DRAW(itB); const bool hasB = itB < NITEMS;
                if (hasB) { P0_DECODE(itB, dB); p0_item_load(dB, vB, F.lane); }
                p0_item_finish(dA, vA, scr, F.lane);
                if (!hasB) break;
                P0_DRAW(itA); const bool hasA = itA < NITEMS;
                if (hasA) { P0_DECODE(itA, dA); p0_item_load(dA, vA, F.lane); }
                p0_item_finish(dB, vB, scr, F.lane);
                if (!hasA) break;
            } }
    }
#undef P0_DECODE
#undef P0_DRAW
}

typedef const pg8::f32x4 (&AccRef)[2][2][4][2];
__device__ __forceinline__ v4u pack8(const f32x4 a, const f32x4 b) { v4u w; w.x = cvt_pk_bf16(a[0], a[1]); w.y = cvt_pk_bf16(a[2], a[3]); w.z = cvt_pk_bf16(b[0], b[1]); w.w = cvt_pk_bf16(b[2], b[3]); return w; }
__device__ __forceinline__ void unpack8(const v4u w, f32x4& a, f32x4& b) { a = (f32x4){bflo(w.x), bfhi(w.x), bflo(w.y), bfhi(w.y)}; b = (f32x4){bflo(w.z), bfhi(w.z), bflo(w.w), bfhi(w.w)}; }

struct EpiInProj {
    static constexpr bool PERM = true;
    bf16 *U, *Q, *Kb, *V, *G1, *G2; const float *bgate, *qg, *kg;
    __device__ __forceinline__ void operator()(AccRef acc, const pg8::Unit& u, int wr, int wc, int fr, int fq, const LAS int*) const {
        const int pn = u.pn, row0 = u.pm * 256 + wr * 64 + fr;
        if (pn < 2) {
#pragma unroll
            for (int ai = 0; ai < 2; ++ai)
#pragma unroll
                for (int m = 0; m < 4; ++m) { const int row = row0 + ai * 128 + m * 16, b = row >> 11, t = row & 2047;
#pragma unroll
                    for (int bj = 0; bj < 2; ++bj) { const int lc = 256 * pn + 64 * wc + 32 * bj + 8 * fq, g = lc >> 4, ch = lc & 15;
                        *(v4u*)(U + ((size_t)(b * SSM_G + g) * SEQ + t) * 16 + ch) = pack8(acc[ai][bj][m][0], acc[ai][bj][m][1]); } }
        } else if (pn < 6) {
            const bool isq = pn < 4; const float* gv = isq ? qg : kg; const float sc = isq ? QSCALE : 1.0f;
            bf16* dst = (isq ? Q : Kb) + 256 * (pn - (isq ? 2 : 4)) + 64 * wc + 8 * fq;
            f32x4 gg[2][2];
#pragma unroll
            for (int bj = 0; bj < 2; ++bj)
#pragma unroll
                for (int n = 0; n < 2; ++n) gg[bj][n] = *(const f32x4*)(gv + 32 * bj + 8 * fq + 4 * n) * sc;
#pragma unroll
            for (int ai = 0; ai < 2; ++ai)
#pragma unroll
                for (int m = 0; m < 4; ++m) { const int row = row0 + ai * 128 + m * 16; float ss = 0.f;
#pragma unroll
                    for (int bj = 0; bj < 2; ++bj)
#pragma unroll
                        for (int n = 0; n < 2; ++n) { const f32x4 x = acc[ai][bj][m][n]; ss += (x[0] * x[0] + x[1] * x[1]) + (x[2] * x[2] + x[3] * x[3]); }
                    ss += __shfl_xor(ss, 16); ss += __shfl_xor(ss, 32);
                    const float rs = 1.0f / sqrtf(ss * (1.0f / 64.0f) + RMS_EPS);
#pragma unroll
                    for (int bj = 0; bj < 2; ++bj) *(v4u*)(dst + (size_t)row * 512 + 32 * bj) = pack8(acc[ai][bj][m][0] * rs * gg[bj][0], acc[ai][bj][m][1] * rs * gg[bj][1]); }
        } else if (pn < 8) {
            bf16* dst = V + 256 * (pn - 6) + 64 * wc + 8 * fq;
#pragma unroll
            for (int ai = 0; ai < 2; ++ai)
#pragma unroll
                for (int m = 0; m < 4; ++m) { const int row = row0 + ai * 128 + m * 16;
#pragma unroll
                    for (int bj = 0; bj < 2; ++bj) *(v4u*)(dst + (size_t)row * 512 + 32 * bj) = pack8(acc[ai][bj][m][0], acc[ai][bj][m][1]); }
        } else {
            const int gc = 256 * (pn - 8) + 64 * wc + 8 * fq;
            bf16* dst = (gc < 1024 ? G1 + gc : G2 + (gc - 1024));
            f32x4 bb[2][2];
#pragma unroll
            for (int bj = 0; bj < 2; ++bj)
#pragma unroll
                for (int n = 0; n < 2; ++n) bb[bj][n] = *(const f32x4*)(bgate + gc + 32 * bj + 4 * n);
#pragma unroll
            for (int ai = 0; ai < 2; ++ai)
#pragma unroll
                for (int m = 0; m < 4; ++m) { const int row = row0 + ai * 128 + m * 16;
#pragma unroll
                    for (int bj = 0; bj < 2; ++bj) { f32x4 a = acc[ai][bj][m][0] + bb[bj][0], b = acc[ai][bj][m][1] + bb[bj][1];
#pragma unroll
                        for (int e = 0; e < 4; ++e) { a[e] = fsigmoid(a[e]); b[e] = fsigmoid(b[e]); }
                        *(v4u*)(dst + (size_t)row * 1024 + 32 * bj) = pack8(a, b); } }
        }
    }
};
template <int MODE> struct EpiMix {
    static constexpr bool PERM = true;
    const bf16* P0; const bf16* P1; bf16* O; const float* bias; int ld;
    __device__ __forceinline__ void operator()(AccRef acc, const pg8::Unit& u, int wr, int wc, int fr, int fq, const LAS int*) const {
        const int row0 = u.pm * 256 + wr * 64 + fr, col0 = u.pn * 256 + wc * 32 + 8 * fq;
        f32x4 bb[2][2];
#pragma unroll
        for (int bj = 0; bj < 2; ++bj)
#pragma unroll
            for (int n = 0; n < 2; ++n) bb[bj][n] = (MODE == 0) ? *(const f32x4*)(bias + col0 + bj * 128 + 4 * n) : (f32x4){0.f, 0.f, 0.f, 0.f};
#pragma unroll
        for (int ai = 0; ai < 2; ++ai) {
            v4u q0[4][2], q1[4][2];
#pragma unroll
            for (int m = 0; m < 4; ++m)
#pragma unroll
                for (int bj = 0; bj < 2; ++bj) { const size_t off = (size_t)(row0 + ai * 128 + m * 16) * ld + col0 + bj * 128; q0[m][bj] = *(const v4u*)(P0 + off); if (MODE == 2) q1[m][bj] = *(const v4u*)(P1 + off); }
#pragma unroll
            for (int m = 0; m < 4; ++m) { const size_t off = (size_t)(row0 + ai * 128 + m * 16) * ld + col0;
#pragma unroll
                for (int bj = 0; bj < 2; ++bj) { f32x4 a = acc[ai][bj][m][0], b = acc[ai][bj][m][1], p0a, p0b;
                    unpack8(q0[m][bj], p0a, p0b);
                    if (MODE == 0) { a += bb[bj][0]; b += bb[bj][1];
#pragma unroll
                        for (int e = 0; e < 4; ++e) { a[e] = p0a[e] * fsigmoid(a[e]); b[e] = p0b[e] * fsigmoid(b[e]); } }
                    else if (MODE == 1) { a *= p0a; b *= p0b; }
                    else { f32x4 p1a, p1b; unpack8(q1[m][bj], p1a, p1b); a = p0a + p1a * a; b = p0b + p1b * b; }
                    *(v4u*)(O + off + bj * 128) = pack8(a, b); } } }
    }
};
struct EpiOut {
    static constexpr bool PERM = false;
    const float* X; float* H; unsigned char* HB;
    __device__ __forceinline__ void operator()(AccRef acc, const pg8::Unit& u, int wr, int wc, int fr, int fq, const LAS int*) const {
        const int row0 = u.pm * 256 + wr * 64 + fr, col0 = u.pn * 256 + wc * 32 + 4 * fq;
#pragma unroll
        for (int ai = 0; ai < 2; ++ai) {
            f32x4 xv[4][2][2];
#pragma unroll
            for (int m = 0; m < 4; ++m)
#pragma unroll
                for (int bj = 0; bj < 2; ++bj)
#pragma unroll
                    for (int n = 0; n < 2; ++n) xv[m][bj][n] = *(const f32x4*)(X + (size_t)(row0 + ai * 128 + m * 16) * DM + col0 + bj * 128 + n * 16);
#pragma unroll
            for (int m = 0; m < 4; ++m) { const size_t off = (size_t)(row0 + ai * 128 + m * 16) * DM + col0;
#pragma unroll
                for (int bj = 0; bj < 2; ++bj)
#pragma unroll
                    for (int n = 0; n < 2; ++n) { const f32x4 h = xv[m][bj][n] + acc[ai][bj][m][n];
                        *(f32x4*)(H + off + bj * 128 + n * 16) = h; *(unsigned*)(HB + off + bj * 128 + n * 16) = pk4_fp8(h[0], h[1], h[2], h[3]); } } }
    }
};
template <int NN, bool TOKROWS> struct MoeOrder {
    int nunits, G, vcu; const LAS int* cnt; const LAS int* tstart; const LAS int* tile2e; const int* elist;
    __device__ __forceinline__ bool next(int i, pg8::Unit& u) const { const long L = (long)i * G + vcu; if (L >= nunits) return false; const int pm = (int)(L / NN), pnl = (int)(L % NN);
        u.pm = pm; u.pn = tile2e[pm] * NN + pnl; return true; }
    __device__ __forceinline__ int row_slot(const pg8::Unit& u, int r) const { const int e = u.pn / NN, pos = (u.pm - tstart[e]) * 256 + r; return pos < cnt[e] ? elist[e * M + pos] : -1; }
    __device__ __forceinline__ int a_row(const pg8::Unit& u, int r, int slot) const { return TOKROWS ? (slot < 0 ? 0 : (slot >> 2)) : u.pm * 256 + r; }
};
struct EpiUp {
    static constexpr bool PERM = true;
    unsigned char* ACT; const float* bup; const float* rs2;
    __device__ __forceinline__ void operator()(AccRef acc, const pg8::Unit& u, int wr, int wc, int fr, int fq, const LAS int* tab) const {
        const int e = u.pn >> 3, pnl = u.pn & 7, j0 = 128 * pnl + 32 * wc + 8 * fq;
        f32x4 bb[4];
#pragma unroll
        for (int q = 0; q < 4; ++q) bb[q] = *(const f32x4*)(bup + (size_t)e * UPW + 2 * j0 + 4 * q);
        int sl[2][4]; float rsv[2][4];
#pragma unroll
        for (int ai = 0; ai < 2; ++ai)
#pragma unroll
            for (int m = 0; m < 4; ++m) { sl[ai][m] = tab[ai * 128 + wr * 64 + m * 16 + fr]; rsv[ai][m] = rs2[sl[ai][m] < 0 ? 0 : (sl[ai][m] >> 2)]; }
#pragma unroll
        for (int ai = 0; ai < 2; ++ai)
#pragma unroll
            for (int m = 0; m < 4; ++m) { const int r = ai * 128 + wr * 64 + m * 16 + fr, slot = sl[ai][m];
                if (slot >= 0) { const float rs = rsv[ai][m]; f32x4 o[2];
#pragma unroll
                    for (int n = 0; n < 2; ++n)
#pragma unroll
                        for (int e4 = 0; e4 < 4; ++e4) { const int j = 4 * n + e4;
                            float gl = acc[ai][0][m][n][e4] * rs + bb[(2 * j) >> 2][(2 * j) & 3], li = acc[ai][1][m][n][e4] * rs + bb[(2 * j + 1) >> 2][(2 * j + 1) & 3];
                            gl = fminf(gl, 7.0f); li = fminf(fmaxf(li, -7.0f), 7.0f);
                            o[n][e4] = gl * fsigmoid(1.702f * gl) * (li + 1.0f) * 4.0f; }
                    v2u ov; ov.x = pk4_fp8(o[0][0], o[0][1], o[0][2], o[0][3]); ov.y = pk4_fp8(o[1][0], o[1][1], o[1][2], o[1][3]); *(v2u*)(ACT + (size_t)(u.pm * 256 + r) * DE + j0) = ov; } }
    }
};
struct EpiDown {
    static constexpr bool PERM = true;
    bf16* YS2; const float* bdn; const float* wslot;
    __device__ __forceinline__ void operator()(AccRef acc, const pg8::Unit& u, int wr, int wc, int fr, int fq, const LAS int* tab) const {
        const int e = u.pn >> 2, pnl = u.pn & 3, c0 = 256 * pnl + 32 * wc + 8 * fq;
        f32x4 bb[2][2];
#pragma unroll
        for (int bj = 0; bj < 2; ++bj)
#pragma unroll
            for (int n = 0; n < 2; ++n) bb[bj][n] = *(const f32x4*)(bdn + (size_t)e * DM + c0 + bj * 128 + 4 * n);
        int sl[2][4]; float wv[2][4];
#pragma unroll
        for (int ai = 0; ai < 2; ++ai)
#pragma unroll
            for (int m = 0; m < 4; ++m) { sl[ai][m] = tab[ai * 128 + wr * 64 + m * 16 + fr]; wv[ai][m] = wslot[sl[ai][m] < 0 ? 0 : sl[ai][m]]; }
#pragma unroll
        for (int ai = 0; ai < 2; ++ai)
#pragma unroll
            for (int m = 0; m < 4; ++m) { const int slot = sl[ai][m];
                if (slot >= 0) { const float w = wv[ai][m];
#pragma unroll
                    for (int bj = 0; bj < 2; ++bj) *(v4u*)(YS2 + (size_t)slot * DM + c0 + bj * 128) = pack8((acc[ai][bj][m][0] + bb[bj][0]) * w, (acc[ai][bj][m][1] + bb[bj][1]) * w); } }
    }
};

constexpr int S5_UPITCH = 528, S5_SX_OFF = 128 * S5_UPITCH, S5_XPITCH = 132;
__device__ __forceinline__ void s5_unit(Frame& F, int b, int g) {
    LAS unsigned char* Uimg = F.lds + RING_OFF; LAS float* SX = (LAS float*)(F.lds + RING_OFF + S5_SX_OFF);
    const int tid = F.tid, lane = F.lane, w = F.wave, r32 = lane & 31, hi = lane >> 5;
    const bf16* Ug = (const bf16*)(F.ws + WS_U) + (size_t)(b * SSM_G + g) * SEQ * 16;
    const bf16* W1T = (const bf16*)(F.ws + WS_S5 + (size_t)g * 262144); const bf16* M2T = W1T + 128 * 256; const bf16* W3T = M2T + 256 * 256;
#pragma unroll
    for (int j = 0; j < 8; ++j) { const int q = tid + 512 * j; *(LAS v4u*)(Uimg + (q >> 5) * S5_UPITCH + (q & 31) * 16) = *(const v4u*)(Ug + (size_t)q * 8); }
    __syncthreads();
    { const int nt = w & 3, mt0 = 2 * (w >> 2);
      f32x16 s0 = {0}, s1 = {0};
#pragma unroll 4
      for (int ks = 0; ks < 16; ++ks) {
          const bf16x8 bf = *(const bf16x8*)(W1T + (size_t)(32 * nt + r32) * 256 + 16 * ks + 8 * hi);
          const bf16x8 a0 = *(const LAS bf16x8*)(Uimg + (32 * mt0 + r32) * S5_UPITCH + (16 * ks + 8 * hi) * 2);
          const bf16x8 a1 = *(const LAS bf16x8*)(Uimg + (32 * (mt0 + 1) + r32) * S5_UPITCH + (16 * ks + 8 * hi) * 2);
          s0 = __builtin_amdgcn_mfma_f32_32x32x16_bf16(a0, bf, s0, 0, 0, 0); s1 = __builtin_amdgcn_mfma_f32_32x32x16_bf16(a1, bf, s1, 0, 0, 0); }
#pragma unroll
      for (int r = 0; r < 16; ++r) { SX[(32 * mt0 + crow(r, hi)) * S5_XPITCH + 32 * nt + r32] = s0[r]; SX[(32 * (mt0 + 1) + crow(r, hi)) * S5_XPITCH + 32 * nt + r32] = s1[r]; } }
    __syncthreads();
    if (tid < 64) {
        const float* a16 = (const float*)(F.ws + WS_A16) + (g * 64 + tid) * 2; const float ar = a16[0], ai = a16[1]; float xr = 0.f, xi = 0.f;
#pragma unroll 8
        for (int c = 0; c < SSM_NC; ++c) { const float sr = SX[c * S5_XPITCH + tid], si = SX[c * S5_XPITCH + 64 + tid];
            SX[c * S5_XPITCH + tid] = xr; SX[c * S5_XPITCH + 64 + tid] = xi;
            const float nr = ar * xr - ai * xi + sr, ni = ar * xi + ai * xr + si; xr = nr; xi = ni; }
    }
    __syncthreads();
    { f32x16 y[4] = {{0}, {0}, {0}, {0}};
      const int nks = 2 * w + 2;
      for (int ks = 0; ks < nks; ++ks) {
          const bf16x8 bf = *(const bf16x8*)(M2T + (size_t)(32 * w + r32) * 256 + 16 * ks + 8 * hi);
#pragma unroll
          for (int mt = 0; mt < 4; ++mt) { const bf16x8 a = *(const LAS bf16x8*)(Uimg + (32 * mt + r32) * S5_UPITCH + (16 * ks + 8 * hi) * 2); y[mt] = __builtin_amdgcn_mfma_f32_32x32x16_bf16(a, bf, y[mt], 0, 0, 0); } }
#pragma unroll 2
      for (int ks = 0; ks < 8; ++ks) {
          const bf16x8 bf = *(const bf16x8*)(W3T + (size_t)(32 * w + r32) * 128 + 16 * ks + 8 * hi);
#pragma unroll
          for (int mt = 0; mt < 4; ++mt) { const LAS f32x4* xp = (const LAS f32x4*)(SX + (32 * mt + r32) * S5_XPITCH + 16 * ks + 8 * hi); const f32x4 x0 = xp[0], x1 = xp[1];
              const v4u pk = pack8(x0, x1); y[mt] = __builtin_amdgcn_mfma_f32_32x32x16_bf16(__builtin_bit_cast(bf16x8, pk), bf, y[mt], 0, 0, 0); } }
      bf16* YG = (bf16*)(F.ws + WS_YG); const int i = 2 * w + (r32 >> 4), ho = r32 & 15;
#pragma unroll
      for (int mt = 0; mt < 4; ++mt)
#pragma unroll
          for (int r = 0; r < 16; ++r) { const int c = 32 * mt + crow(r, hi); YG[(size_t)(b * SEQ + 16 * c + i) * SSM_W + g * 16 + ho] = (bf16)f2bf(gelu_tanh(y[mt][r])); } }
    __syncthreads();
}

constexpr int AT_KP = 272, AT_VP = 320, AT_KB = 64 * AT_KP, AT_VB = 64 * AT_VP, AT_BUF = AT_KB + AT_VB;
__device__ __forceinline__ s16x4 vtr(const LAS unsigned char* p) { typedef short v4i16_t __attribute__((ext_vector_type(4))); return __builtin_bit_cast(s16x4, __builtin_amdgcn_ds_read_tr16_b64_v4i16((LAS v4i16_t*)p)); }
__device__ __forceinline__ void attn_unit(Frame& F, int b, int h, int qb, float lam) {
    const int tid = F.tid, lane = F.lane, w = F.wave, rg = w >> 1, t = w & 1, r32 = lane & 31, hi = lane >> 5;
    const bf16* Q = (const bf16*)(F.ws + WS_Q); const bf16* K = (const bf16*)(F.ws + WS_K); const bf16* V = (const bf16*)(F.ws + WS_V); bf16* OB = (bf16*)(F.ws + WS_OB);
    LAS unsigned char* L = F.lds + RING_OFF;
    const int qrow = b * SEQ + qb * 128 + rg * 32 + r32;
    bf16x8 qf[4];
#pragma unroll
    for (int ks = 0; ks < 4; ++ks) qf[ks] = *(const bf16x8*)(Q + (size_t)qrow * QK_W + h * 128 + t * 64 + 16 * ks + 8 * hi);
    const int ntile = 2 * qb + 2, mylim = 2 * qb + (rg >> 1);
    const int kr0 = tid >> 4, cc = tid & 15;
    const size_t gbase = (size_t)(b * SEQ) * 512 + h * 128 + cc * 8;
    v4u kregA[2], vregA[2], kregB[2], vregB[2];
#define AT_LOAD(j, kreg, vreg) do { _Pragma("unroll") for (int i_ = 0; i_ < 2; ++i_) { const size_t o_ = gbase + (size_t)(64 * (j) + kr0 + 32 * i_) * 512; kreg[i_] = *(const v4u*)(K + o_); vreg[i_] = *(const v4u*)(V + o_); } } while (0)
#define AT_STORE(buf, kreg, vreg) do { _Pragma("unroll") for (int i_ = 0; i_ < 2; ++i_) { *(LAS v4u*)(L + (buf) * AT_BUF + (kr0 + 32 * i_) * AT_KP + cc * 16) = kreg[i_]; \
        *(LAS v4u*)(L + (buf) * AT_BUF + AT_KB + (kr0 + 32 * i_) * AT_VP + cc * 16) = vreg[i_]; } } while (0)
    AT_LOAD(0, kregB, vregB); AT_LOAD(1, kregA, vregA); AT_STORE(0, kregB, vregB);
    __syncthreads();
    f32x16 o[4] = {{0}, {0}, {0}, {0}};
    float mrun = -60.0f, lrun = 0.f;
    f32x16 negm;
#pragma unroll
    for (int r = 0; r < 16; ++r) negm[r] = 60.0f;
    const int g4 = lane >> 4, i16 = lane & 15;
    const int vlane = (4 * (g4 >> 1) + (i16 >> 2)) * AT_VP + (16 * (g4 & 1) + 4 * (i16 & 3)) * 2;
#define AT_COMPUTE(j, buf) do { \
        if (j <= mylim) { \
            const LAS unsigned char* Kb = L + buf * AT_BUF + t * 128 + hi * 16 + r32 * AT_KP; \
            const LAS unsigned char* Vb = L + buf * AT_BUF + AT_KB + vlane; \
            f32x16 s0, s1; \
        _Pragma("unroll") \
            for (int ks = 0; ks < 4; ++ks) { const bf16x8 k0 = *(const LAS bf16x8*)(Kb + ks * 32), k1 = *(const LAS bf16x8*)(Kb + 32 * AT_KP + ks * 32); \
                if (ks == 0) { s0 = __builtin_amdgcn_mfma_f32_32x32x16_bf16(k0, qf[0], negm, 0, 0, 0); s1 = __builtin_amdgcn_mfma_f32_32x32x16_bf16(k1, qf[0], negm, 0, 0, 0); } \
                else { s0 = __builtin_amdgcn_mfma_f32_32x32x16_bf16(k0, qf[ks], s0, 0, 0, 0); s1 = __builtin_amdgcn_mfma_f32_32x32x16_bf16(k1, qf[ks], s1, 0, 0, 0); } } \
            float mx = fmaxf(fmaxf(s0[0], s0[1]), s0[2]); \
        _Pragma("unroll") \
            for (int r = 3; r < 15; r += 2) mx = fmaxf(fmaxf(mx, s0[r]), s0[r + 1]); \
            mx = fmaxf(mx, s0[15]); \
        _Pragma("unroll") \
            for (int r = 0; r < 16; r += 2) mx = fmaxf(fmaxf(mx, s1[r]), s1[r + 1]); \
            mx = fmaxf(mx, __shfl_xor(mx, 32)); \
            if (__builtin_amdgcn_ballot_w64(mx > 8.0f) != 0ull) { \
                const float dm = (mx > 8.0f) ? mx : 0.0f, alpha = __builtin_amdgcn_exp2f(-dm); lrun *= alpha; mrun += dm; \
        _Pragma("unroll") \
                for (int dt = 0; dt < 4; ++dt) o[dt] *= alpha; \
        _Pragma("unroll") \
                for (int r = 0; r < 16; ++r) { s0[r] -= dm; s1[r] -= dm; negm[r] = -mrun; } } \
            float ps = 0.f; \
        _Pragma("unroll") \
            for (int r = 0; r < 16; ++r) { s0[r] = __builtin_amdgcn_exp2f(s0[r]); s1[r] = __builtin_amdgcn_exp2f(s1[r]); ps += s0[r] + s1[r]; } \
            lrun += ps; \
        _Pragma("unroll") \
            for (int s = 0; s < 4; ++s) { \
                v4u pk; const int rb = 8 * (s & 1); \
                if (s < 2) { pk.x = cvt_pk_bf16(s0[rb], s0[rb + 1]); pk.y = cvt_pk_bf16(s0[rb + 2], s0[rb + 3]); pk.z = cvt_pk_bf16(s0[rb + 4], s0[rb + 5]); pk.w = cvt_pk_bf16(s0[rb + 6], s0[rb + 7]); } \
                else       { pk.x = cvt_pk_bf16(s1[rb], s1[rb + 1]); pk.y = cvt_pk_bf16(s1[rb + 2], s1[rb + 3]); pk.z = cvt_pk_bf16(s1[rb + 4], s1[rb + 5]); pk.w = cvt_pk_bf16(s1[rb + 6], s1[rb + 7]); } \
                const bf16x8 pf = __builtin_bit_cast(bf16x8, pk); \
        _Pragma("unroll") \
                for (int dt = 0; dt < 4; ++dt) { const s16x4 lo = vtr(Vb + s * 16 * AT_VP + dt * 64), hh = vtr(Vb + s * 16 * AT_VP + dt * 64 + 8 * AT_VP); \
                    const bf16x8 vf = (bf16x8){lo[0], lo[1], lo[2], lo[3], hh[0], hh[1], hh[2], hh[3]}; \
                    o[dt] = __builtin_amdgcn_mfma_f32_32x32x16_bf16(vf, pf, o[dt], 0, 0, 0); } } \
        } \
    } while (0)
    for (int j = 0; j < ntile; j += 2) {
        { const int jn = (j + 2 < ntile) ? j + 2 : ntile - 1; AT_LOAD(jn, kregB, vregB); }
        AT_COMPUTE(j, 0);
        AT_STORE(1, kregA, vregA);
        __syncthreads();
        { const int jn = (j + 3 < ntile) ? j + 3 : ntile - 1; AT_LOAD(jn, kregA, vregA); }
        AT_COMPUTE(j + 1, 1);
        AT_STORE(0, kregB, vregB);
        __syncthreads();
    }
#undef AT_COMPUTE
#undef AT_LOAD
#undef AT_STORE
    const float ltot = lrun + __shfl_xor(lrun, 32), inv = 1.0f / ltot;
    LAS float* EX = (LAS float*)L + rg * 4096;
    if (t == 1) {
        const float sc = inv * lam;
#pragma unroll
        for (int dt = 0; dt < 4; ++dt)
#pragma unroll
            for (int r = 0; r < 16; ++r) EX[(dt * 16 + r) * 64 + lane] = o[dt][r] * sc;
    }
    __syncthreads();
    if (t == 0) {
        float ss = 0.f;
#pragma unroll
        for (int dt = 0; dt < 4; ++dt)
#pragma unroll
            for (int r = 0; r < 16; ++r) { const float y = o[dt][r] * inv - EX[(dt * 16 + r) * 64 + lane]; o[dt][r] = y; ss += y * y; }
        ss += __shfl_xor(ss, 32);
        const float rn = (1.0f - LAMBDA_INIT) / sqrtf(ss * (1.0f / 128.0f) + RMS_EPS);
        const float* sg = F.in[I_SUBLN];
        f32x4 ggv[4][4];
#pragma unroll
        for (int dt = 0; dt < 4; ++dt)
#pragma unroll
            for (int rq = 0; rq < 4; ++rq) ggv[dt][rq] = *(const f32x4*)(sg + 32 * dt + 8 * rq + 4 * hi);
#pragma unroll
        for (int dt = 0; dt < 4; ++dt)
#pragma unroll
            for (int rq = 0; rq < 4; ++rq) { const int d = 32 * dt + 8 * rq + 4 * hi; const f32x4 gg = ggv[dt][rq];
                v2u wv; wv.x = cvt_pk_bf16(o[dt][4 * rq] * rn * gg[0], o[dt][4 * rq + 1] * rn * gg[1]); wv.y = cvt_pk_bf16(o[dt][4 * rq + 2] * rn * gg[2], o[dt][4 * rq + 3] * rn * gg[3]);
                *(v2u*)(OB + (size_t)qrow * V_W + h * 128 + d) = wv; }
    }
    __syncthreads();
}

constexpr int CW_CNT_STRIDE = 64;
__device__ __forceinline__ void router_phase(Frame& F, const bool dummy = false) {
    const int lane = F.lane, tid = F.tid, w = F.wave, tt = w >> 1, kh = w & 1;
    LAS float* LG = (LAS float*)(F.lds + RING_OFF);
    LAS float* SS = LG + 4 * 2 * 16 * 33;
    LAS int* LC = (LAS int*)(SS + 128);
    const float* Hf = F.out; const float* wrT = (const float*)(F.ws + WS_WRT); const float* br = F.in[I_BR];
    float* rs2 = (float*)(F.ws + (dummy ? WS_YS2 : WS_RS2)); float* wslot = (float*)(F.ws + (dummy ? WS_YS2 + MiB : WS_WSLOT)); int* elist = (int*)(F.ws + (dummy ? WS_YS2 + 2 * MiB : WS_ELIST));
    unsigned* cnt = (unsigned*)(F.ctl + CW_CNT + (dummy ? 32 : 0));
    const int i16 = lane & 15, kq = lane >> 4;
    for (int tg = F.vcu; tg < M / 64; tg += F.G) {
        if (tid < 64) LC[tid] = 0;
        const int tok0 = tg * 64 + tt * 16;
        f32x4 a0 = {0.f, 0.f, 0.f, 0.f}, a1 = {0.f, 0.f, 0.f, 0.f}; float ssq = 0.f;
        const float* hp = Hf + (size_t)(tok0 + i16) * DM + kh * 512 + 4 * kq; const float* w0 = wrT + (size_t)i16 * DM + kh * 512 + 4 * kq; const float* w1 = w0 + 16 * DM;
#pragma unroll 8
        for (int s = 0; s < 32; ++s) { const f32x4 a = *(const f32x4*)(hp + 16 * s), b0 = *(const f32x4*)(w0 + 16 * s), b1 = *(const f32x4*)(w1 + 16 * s);
            ssq += (a[0] * a[0] + a[1] * a[1]) + (a[2] * a[2] + a[3] * a[3]);
#pragma unroll
            for (int q = 0; q < 4; ++q) { a0 = __builtin_amdgcn_mfma_f32_16x16x4f32(a[q], b0[q], a0, 0, 0, 0); a1 = __builtin_amdgcn_mfma_f32_16x16x4f32(a[q], b1[q], a1, 0, 0, 0); } }
        ssq += __shfl_xor(ssq, 16); ssq += __shfl_xor(ssq, 32);
        LAS float* lg = LG + (tt * 2 + kh) * 16 * 33;
#pragma unroll
        for (int r = 0; r < 4; ++r) { lg[(4 * kq + r) * 33 + i16] = a0[r]; lg[(4 * kq + r) * 33 + 16 + i16] = a1[r]; }
        if (kq == 0) SS[(tt * 2 + kh) * 16 + i16] = ssq;
        __syncthreads();
        int ti[4]; float wv[4]; int lpos[4]; float rsv = 0.f;
        if (tid < 64) {
            const int t4 = tid >> 4, t16 = tid & 15;
            rsv = 1.0f / sqrtf((SS[(t4 * 2) * 16 + t16] + SS[(t4 * 2 + 1) * 16 + t16]) * (1.0f / DM) + RMS_EPS);
            float lgv[32];
#pragma unroll
            for (int e = 0; e < 32; ++e) lgv[e] = (LG[((t4 * 2) * 16 + t16) * 33 + e] + LG[((t4 * 2 + 1) * 16 + t16) * 33 + e]) * rsv + br[e];
            float tv[4];
#pragma unroll
            for (int k = 0; k < 4; ++k) { float best = -3.0e38f; int bi = 0;
#pragma unroll
                for (int e = 0; e < 32; ++e) { const bool tk = lgv[e] > best; best = tk ? lgv[e] : best; bi = tk ? e : bi; }
                tv[k] = best; ti[k] = bi;
#pragma unroll
                for (int e = 0; e < 32; ++e) lgv[e] = (e == bi) ? -3.0e38f : lgv[e]; }
            const float e1 = __expf(tv[1] - tv[0]), e2 = __expf(tv[2] - tv[0]), e3 = __expf(tv[3] - tv[0]), den = 1.0f / (1.0f + e1 + e2 + e3);
            wv[0] = den; wv[1] = e1 * den; wv[2] = e2 * den; wv[3] = e3 * den;
#pragma unroll
            for (int k = 0; k < 4; ++k) lpos[k] = __hip_atomic_fetch_add(LC + ti[k], 1, __ATOMIC_RELAXED, __HIP_MEMORY_SCOPE_WORKGROUP);
        }
        __syncthreads();
        if (tid < 32) { const int c = LC[tid]; LC[32 + tid] = c ? (int)atomicAdd(cnt + tid * CW_CNT_STRIDE, (unsigned)c) : 0; }
        __syncthreads();
        if (tid < 64) {
            const int tok = tg * 64 + tid;
            rs2[tok] = rsv;
#pragma unroll
            for (int k = 0; k < 4; ++k) { elist[ti[k] * M + LC[32 + ti[k]] + lpos[k]] = tok * 4 + k; wslot[tok * 4 + k] = wv[k]; }
        }
        __syncthreads();
    }
}
__device__ __forceinline__ int moe_tables(Frame& F) {
    LAS int* T = (LAS int*)(F.lds + MOE_LDS_OFF); LAS int* cnt = T, *tstart = T + 32, *tile2e = T + 72;
    if (F.tid < 32) cnt[F.tid] = (int)__hip_atomic_load((unsigned*)(F.ctl + CW_CNT) + F.tid * CW_CNT_STRIDE, RLX_AGENT);
    __syncthreads();
    if (F.tid == 0) { int s = 0; for (int e = 0; e < 32; ++e) { tstart[e] = s; s += (cnt[e] + 255) >> 8; } tstart[32] = s; }
    __syncthreads();
    if (F.tid < 32) { for (int p = tstart[F.tid]; p < tstart[F.tid + 1]; ++p) tile2e[p] = F.tid; }
    __syncthreads();
    return tstart[32];
}
__device__ __forceinline__ void combine_phase(Frame& F, float* dst) {
    const int lane = F.lane, gw = F.vcu * NWAVES + F.wave, NGW = F.G * NWAVES;
    const bf16* YS2 = (const bf16*)(F.ws + WS_YS2);
    for (int tk = gw; tk < M; tk += NGW) {
        GAS f32x4* orow = (GAS f32x4*)(F.out + (size_t)tk * DM) + lane; GAS f32x4* drow = (GAS f32x4*)(dst + (size_t)tk * DM) + lane;
#pragma unroll
        for (int j = 0; j < 4; ++j) { f32x4 v = orow[64 * j];
#pragma unroll
            for (int k = 0; k < 4; ++k) { const v2u y = *((const GAS v2u*)(YS2 + (size_t)(tk * 4 + k) * DM) + lane + 64 * j); v += (f32x4){bflo(y.x), bfhi(y.x), bflo(y.y), bfhi(y.y)}; }
            drow[64 * j] = v; }
    }
}

struct Args { const float* in[31]; float* out; unsigned char* ws; int ph_lo, ph_hi; };
__global__ void __launch_bounds__(NWAVES * 64, 2) mk_fwd(Args args) {
    extern __shared__ __attribute__((aligned(16))) unsigned char lds[];
    Frame F;
    F.lds = (LAS unsigned char*)lds;
    F.MISC = (volatile LAS unsigned*)(F.lds + MISC_OFF);
    F.tid = threadIdx.x; F.lane = F.tid & 63; F.wave = __builtin_amdgcn_readfirstlane(F.tid >> 6);
    F.G = gridDim.x; { const int bx = blockIdx.x; F.vcu = (F.G % 8 == 0) ? (bx % 8) * (F.G / 8) + bx / 8 : bx; }
    F.ws = args.ws; F.ctl = (gu32*)(args.ws + WS_CTL); F.out = args.out;
#pragma unroll
    for (int i = 0; i < 31; ++i) F.in[i] = args.in[i];
    for (int u = F.tid; u < 64; u += NWAVES * 64) F.MISC[u] = 0u;
    __syncthreads();
    XcdBarrier bar; bar.bar = (unsigned*)(F.ctl + CW_BAR); bar.x = 0; bar.st = nullptr;
    if (N_LAUNCHES != PER_PHASE) bar = xcd_barrier_post((unsigned*)(F.ctl + CW_BAR), F.MISC + 8);
#define GRID_BAR() do { if (N_LAUNCHES != PER_PHASE) xcd_barrier(bar); } while (0)
    const int lo = args.ph_lo, hi = args.ph_hi;
#define IN(k) (lo <= (k) && (k) < hi)
#define BOTH(k) (IN(k) && IN((k) + 1))
    unsigned char* ws = args.ws;

    if (IN(0)) { for (int rep = 0; rep < NREP(0); ++rep) { p0_prologue(F); if (BOTH(0)) GRID_BAR(); } }

    if (IN(1)) for (int rep = 0; rep < NREP(1); ++rep) {
        pg8::Gemm g{(const bf16*)(ws + WS_XN), (const bf16*)(ws + WS_WIN), M, IN_W, DM}; pg8::StaticOrder S; S.init(M, IN_W, F.G, (int)blockIdx.x);
        EpiInProj E{(bf16*)(ws + WS_U), (bf16*)(ws + WS_Q), (bf16*)(ws + WS_K), (bf16*)(ws + WS_V), (bf16*)(ws + WS_G1), (bf16*)(ws + WS_G2), F.in[I_BGATE], F.in[I_QG], F.in[I_KG]};
        pg8::gemm_phase<EpiInProj, pg8::StaticOrder, true>(F.lds + RING_OFF, g, S, E);
        if (BOTH(1)) GRID_BAR();
    }

    if (PROBE_REP == 30 && IN(1) && IN(2)) { GRID_BAR(); GRID_BAR(); GRID_BAR(); GRID_BAR(); }
    if (IN(2)) {
        for (int rep = 0; rep < NREP(20); ++rep) for (int u = F.vcu; u < BATCH * SSM_G; u += F.G) { const int g = (u >> 5) * 4 + ((u & 31) >> 3), b = u & 7; s5_unit(F, b, g); }
        float lam;
        { const float a = wave_sum(F.in[I_LQ1][F.lane] * F.in[I_LK1][F.lane]), c = wave_sum(F.in[I_LQ2][F.lane] * F.in[I_LK2][F.lane]); lam = __expf(a) - __expf(c) + LAMBDA_INIT; }
        for (int rep = 0; rep < NREP(21); ++rep) for (int u = F.vcu; u < BATCH * ATT_H * 8; u += F.G) { const int bh = u >> 3, qp = u & 7; attn_unit(F, bh >> 2, bh & 3, 15 - qp, lam); attn_unit(F, bh >> 2, bh & 3, qp, lam); }
        if (BOTH(2)) GRID_BAR();
    }

    if (IN(3)) for (int rep = 0; rep < NREP(3); ++rep) {
        { pg8::Gemm g{(const bf16*)(ws + WS_OB), (const bf16*)(ws + WS_WPA), M, DM, 512}; pg8::StaticOrder S; S.init(M, DM, F.G, (int)blockIdx.x);
          EpiMix<1> E{(const bf16*)(ws + WS_G2), nullptr, (bf16*)(ws + WS_TA), nullptr, DM};
          pg8::gemm_phase<EpiMix<1>, pg8::StaticOrder, true>(F.lds + RING_OFF, g, S, E); }
        { pg8::Gemm g{(const bf16*)(ws + WS_YG), (const bf16*)(ws + WS_WGLU), M, 512, 512}; pg8::StaticOrder S; S.init(M, 512, F.G, (int)blockIdx.x);
          EpiMix<0> E{(const bf16*)(ws + WS_YG), nullptr, (bf16*)(ws + WS_YS), F.in[I_BGLU], 512};
          pg8::gemm_phase<EpiMix<0>, pg8::StaticOrder, true>(F.lds + RING_OFF, g, S, E); }
        if (BOTH(3)) GRID_BAR();
    }

    if (IN(4)) for (int rep = 0; rep < NREP(4); ++rep) {
        pg8::Gemm g{(const bf16*)(ws + WS_YS), (const bf16*)(ws + WS_WPS), M, DM, 512}; pg8::StaticOrder S; S.init(M, DM, F.G, (int)blockIdx.x);
        EpiMix<2> E{(const bf16*)(ws + WS_TA), (const bf16*)(ws + WS_G1), (bf16*)(ws + WS_MX), nullptr, DM};
        pg8::gemm_phase<EpiMix<2>, pg8::StaticOrder, true>(F.lds + RING_OFF, g, S, E);
        if (BOTH(4)) GRID_BAR();
    }

    if (IN(5)) for (int rep = 0; rep < NREP(5); ++rep) {
        pg8::Gemm g{(const bf16*)(ws + WS_MX), (const bf16*)(ws + WS_WOUT), M, DM, DM}; pg8::StaticOrder S; S.init(M, DM, F.G, (int)blockIdx.x);
        EpiOut E{F.in[I_X], F.out, ws + WS_HB};
        pg8::gemm_phase<EpiOut, pg8::StaticOrder, true>(F.lds + RING_OFF, g, S, E);
        if (BOTH(5)) GRID_BAR();
    }

    if (IN(6)) { router_phase(F); if (BOTH(6)) GRID_BAR(); }

    if (IN(7)) for (int rep = 0; rep < NREP(7); ++rep) {
        const int nmt = moe_tables(F); LAS int* T = (LAS int*)(F.lds + MOE_LDS_OFF);
        pg8::Gemm g{(const bf16*)(ws + WS_HB), (const bf16*)(ws + WS_WUP), M, UPW, DM};
        MoeOrder<8, true> S{nmt * 8, F.G, F.vcu, T, T + 32, T + 72, (const int*)(ws + WS_ELIST)};
        EpiUp E{ws + WS_ACT, F.in[I_BUP], (const float*)(ws + WS_RS2)};
        pg8::gemm_phase<EpiUp, MoeOrder<8, true>, true, true, true, true>(F.lds + RING_OFF, g, S, E, 127, 122);
        if (BOTH(7)) GRID_BAR();
    }

    if (IN(8)) for (int rep = 0; rep < NREP(8); ++rep) {
        const int nmt = moe_tables(F); LAS int* T = (LAS int*)(F.lds + MOE_LDS_OFF);
        pg8::Gemm g{(const bf16*)(ws + WS_ACT), (const bf16*)(ws + WS_WDN), MOE_ROWS_MAX, DM, DE};
        MoeOrder<4, false> S{nmt * 4, F.G, F.vcu, T, T + 32, T + 72, (const int*)(ws + WS_ELIST)};
        EpiDown E{(bf16*)(ws + WS_YS2), F.in[I_BDN], (const float*)(ws + WS_WSLOT)};
        pg8::gemm_phase<EpiDown, MoeOrder<4, false>, true, true, true, true>(F.lds + RING_OFF, g, S, E, 125, 122);
        if (BOTH(8)) GRID_BAR();
    }

    if (IN(9)) { combine_phase(F, F.out); }
    if (IN(16)) router_phase(F, true);
    if (IN(19)) combine_phase(F, (float*)(ws + WS_TA));
#undef IN
#undef BOTH
#undef GRID_BAR
}

extern "C" void kernel_launch(void* const* d_in, const int* in_sizes, int n_in, void* d_out, int out_size, void* d_ws, size_t ws_size, hipStream_t stream) {
    static int grid = 0;
    if (grid == 0) {
        if (n_in != 31 || in_sizes[0] != M * DM || out_size != M * DM || ws_size < WS_END) {
            fprintf(stderr, "kernel_launch: unexpected shapes (n_in %d, in0 %d, out %d, ws %zu < %zu); nothing launched\n", n_in, n_in > 0 ? in_sizes[0] : -1, out_size, ws_size, (size_t)WS_END); grid = -1; return; }
        int dev = 0, cus = 0;
        if (hipGetDevice(&dev) != hipSuccess || hipDeviceGetAttribute(&cus, hipDeviceAttributeMultiprocessorCount, dev) != hipSuccess) { grid = -1; return; }
        if (hipFuncSetAttribute((const void*)mk_fwd, hipFuncAttributeMaxDynamicSharedMemorySize, LDS_BYTES) != hipSuccess) { fprintf(stderr, "kernel_launch: hipFuncSetAttribute failed\n"); grid = -1; return; }
        int per_cu = 0;
        if (hipOccupancyMaxActiveBlocksPerMultiprocessor(&per_cu, (const void*)mk_fwd, NWAVES * 64, LDS_BYTES) != hipSuccess || per_cu < 1) fprintf(stderr, "kernel_launch: occupancy query reports %d\n", per_cu);
        (void)hipGetLastError();
        grid = cus;
    }
    if (grid < 0) return;
    (void)hipMemsetAsync((char*)d_ws + WS_CTL, 0, CTL_ZERO_BYTES, stream);
    Args a{};
    for (int i = 0; i < 31; ++i) a.in[i] = (const float*)d_in[i];
    a.out = (float*)d_out; a.ws = (unsigned char*)d_ws;
    if (N_LAUNCHES == 1) { a.ph_lo = 0; a.ph_hi = PER_PHASE; hipLaunchKernelGGL(mk_fwd, dim3(grid), dim3(NWAVES * 64), LDS_BYTES, stream, a); }
    else for (int p = 0; p < PER_PHASE; ++p) { a.ph_lo = p; a.ph_hi = p + 1; if (PROBE_REP - 110 == p) { a.ph_lo = p + 10; a.ph_hi = p + 11; hipLaunchKernelGGL(mk_fwd, dim3(grid), dim3(NWAVES * 64), LDS_BYTES, stream, a); a.ph_lo = p; a.ph_hi = p + 1; }
        for (int rep = 0; rep < ((PROBE_REP - 100 == p) ? 2 : 1); ++rep) hipLaunchKernelGGL(mk_fwd, dim3(grid), dim3(NWAVES * 64), LDS_BYTES, stream, a); }
}
```

```cpp
#include <hip/hip_runtime.h>
#include <cstdio>
#include <cstdint>

#ifndef MK_N_LAUNCHES
#define MK_N_LAUNCHES 1
#endif
#ifndef PROBE_REP
#define PROBE_REP -1
#endif
#define NREP(k) ((PROBE_REP == (k)) ? 2 : 1)

namespace pg8 {
#define PG8_LAS __attribute__((address_space(3)))
typedef unsigned short bf16_t;
typedef short bf16x8 __attribute__((ext_vector_type(8)));
typedef float f32x4 __attribute__((ext_vector_type(4)));
typedef unsigned u32x4 __attribute__((ext_vector_type(4)));
typedef unsigned u32x2 __attribute__((ext_vector_type(2)));
constexpr int BM = 256, BK = 64, HALF = 128, HTB = HALF * BK * 2  , STAGE_BYTES = 8 * HTB, NXCD = 8, WGM = 8;

__host__ __device__ __forceinline__ int lds_byte(int r, int c) { const int st = (r >> 4) * 2 + (c >> 5), rr = r & 15, cc = c & 31, ob = rr * 64 + cc * 2; return st * 1024 + (ob ^ (((ob >> 9) & 1) * 48)); }
__host__ __device__ __forceinline__ void stage_rc(int b, int& R, int& C) { const int st = b / 1024, sb = b % 1024, swz = sb ^ (((sb >> 9) & 1) * 48); R = (st >> 1) * 16 + swz / 64; C = (st & 1) * 32 + (swz % 64) / 2; }
__host__ __device__ __forceinline__ int perm32(int rho) { const int n = rho >> 4, i = rho & 15; return 8 * (i >> 2) + 4 * n + (i & 3); }

struct Unit { int pm, pn; };
struct Gemm { const bf16_t* A; const bf16_t* Bt; int M, N, K; };

struct StaticOrder {
    int nM, nN, nwg, G, c;
    __host__ __device__ void init(int M, int N, int G_, int c_) { nM = M / BM; nN = N / BM; nwg = nM * nN; G = G_; c = c_; }
    __host__ __device__ bool next(int i, Unit& u) const {
        const long L = (long)i * G + c; if (L >= nwg) return false;
        int wgid = (int)L; { const int q = nwg / NXCD, r = nwg % NXCD, xcd = wgid % NXCD, off = wgid / NXCD; wgid = (xcd < r ? xcd * (q + 1) : r * (q + 1) + (xcd - r) * q) + off; }
        const int nig = WGM * nN, gid = wgid / nig, fm = gid * WGM, gsz = (nM - fm) < WGM ? (nM - fm) : WGM;
        u.pm = fm + ((wgid % nig) % gsz); u.pn = (wgid % nig) / gsz; return true;
    }
    __device__ __forceinline__ int row_slot(const Unit&, int) const { return 0; }
    __device__ __forceinline__ int a_row(const Unit& u, int r, int) const { return u.pm * BM + r; }
    __device__ __forceinline__ const char* a_base(const Gemm& g, const Unit& u, size_t tstep) const { return (const char*)g.A + (size_t)u.pm * tstep; }
};

__device__ __forceinline__ unsigned cvt_pk_bf16(float lo, float hi) { unsigned r; asm volatile("v_cvt_pk_bf16_f32 %0, %1, %2" : "=v"(r) : "v"(lo), "v"(hi)); return r; }

typedef int v8i __attribute__((ext_vector_type(8)));
typedef int v4i __attribute__((ext_vector_type(4)));
template <class Epi, class Sched, bool ALIGN_EPI = false, bool ROWTAB = false, bool GATHER = false, bool FP8 = false>
__device__ __forceinline__ void gemm_phase(PG8_LAS unsigned char* lds, const Gemm g, const Sched& S, const Epi& E, const int sA8 = 127, const int sB8 = 127) {
    static_assert(!GATHER || ROWTAB, "GATHER needs ROWTAB");
    const int tid = threadIdx.x, wid = __builtin_amdgcn_readfirstlane(tid >> 6), lane = tid & 63, wr = wid >> 2, wc = wid & 3, fr = lane & 15, fq = lane >> 4;
    const int K = g.K, RB = FP8 ? K : 2 * K  , nt = RB / (2 * BK);
    unsigned voffA[2], voffB[2];
#pragma unroll
    for (int i = 0; i < 2; ++i) { int R, C; stage_rc(tid * 16 + i * 8192, R, C); const int Rb = Epi::PERM ? ((R & ~31) + perm32(R & 31)) : R;
        voffA[i] = (unsigned)(R * RB + 2 * C); voffB[i] = (unsigned)(Rb * RB + 2 * C); }
    unsigned vA[2][2] = {{0u, 0u}, {0u, 0u}};
    const size_t kstep = (size_t)(BK * 2);
    const size_t hstep = (size_t)HALF * RB;
    const size_t tstep = 2 * hstep;
    const unsigned ldsw = (unsigned)wid * 1024u;
    const int aoff = FP8 ? lds_byte(wr * 64 + fr, fq * 16) : lds_byte(wr * 64 + fr, fq * 8), boff = FP8 ? lds_byte(wc * 32 + fr, fq * 16) : lds_byte(wc * 32 + fr, fq * 8);
    PG8_LAS int* tab = (PG8_LAS int*)(lds + STAGE_BYTES);
#define PG8_SA(b, h) (((b) * 2 + (h)) * HTB)
#define PG8_SB(b, h) ((4 + (b) * 2 + (h)) * HTB)
#define PG8_STAGE(bufoff, gbase, voff) do { _Pragma("unroll") for (int _i = 0; _i < 2; ++_i) \
        __builtin_amdgcn_global_load_lds((const unsigned*)((const char*)(gbase) + (voff)[_i]), (PG8_LAS unsigned*)(lds + (bufoff) + ldsw + _i * 8192), 16, 0, 0); } while (0)
#define PG8_STAGE_A(bufoff, kbase, h) do { if constexpr (GATHER) { PG8_STAGE(bufoff, kbase, vA[h]); } else { PG8_STAGE(bufoff, (kbase) + (h) * hstep, voffA); } } while (0)
#define PG8_LOAD_VA(sel, un) do { _Pragma("unroll") for (int _i = 0; _i < 2; ++_i) { int R_, C_; stage_rc(tid * 16 + _i * 8192, R_, C_); \
        _Pragma("unroll") for (int _h = 0; _h < 2; ++_h) { const int s_ = tab[(sel) * 256 + _h * HALF + R_]; vA[_h][_i] = (unsigned)(S.a_row(un, _h * HALF + R_, s_) * RB + 2 * C_); } } } while (0)
#define PG8_LDA(dst, b, h) do { _Pragma("unroll") for (int m = 0; m < 4; ++m) _Pragma("unroll") for (int k = 0; k < 2; ++k) dst[m][k] = *(const PG8_LAS bf16x8*)(lds + PG8_SA(b, h) + (FP8 ? (aoff ^ (16 * k)) : aoff + k * 1024) + m * 2048); } while (0)
#define PG8_LDB(dst, b, h) do { _Pragma("unroll") for (int n = 0; n < 2; ++n) _Pragma("unroll") for (int k = 0; k < 2; ++k) dst[n][k] = *(const PG8_LAS bf16x8*)(lds + PG8_SB(b, h) + (FP8 ? (boff ^ (16 * k)) : boff + k * 1024) + n * 2048); } while (0)
#define PG8_V8(x) __builtin_shufflevector(__builtin_bit_cast(v4i, (x)[0]), __builtin_bit_cast(v4i, (x)[1]), 0, 1, 2, 3, 4, 5, 6, 7)
#define PG8_MMA(ai, bj, At, Bt) do { __builtin_amdgcn_s_setprio(1); if constexpr (FP8) { _Pragma("unroll") for (int m = 0; m < 4; ++m) _Pragma("unroll") for (int n = 0; n < 2; ++n) \
        acc[ai][bj][m][n] = __builtin_amdgcn_mfma_scale_f32_16x16x128_f8f6f4(PG8_V8(Bt[n]), PG8_V8(At[m]), acc[ai][bj][m][n], 0, 0, 0, sB8, 0, sA8); } else { \
        _Pragma("unroll") for (int m = 0; m < 4; ++m) _Pragma("unroll") for (int n = 0; n < 2; ++n) _Pragma("unroll") for (int k = 0; k < 2; ++k) \
        acc[ai][bj][m][n] = __builtin_amdgcn_mfma_f32_16x16x32_bf16(Bt[n][k], At[m][k], acc[ai][bj][m][n], 0, 0, 0); } __builtin_amdgcn_s_setprio(0); } while (0)
#define PG8_WAIT_V(n) asm volatile("s_waitcnt vmcnt(" #n ")" ::: "memory")
#define PG8_WAIT_L(n) asm volatile("s_waitcnt lgkmcnt(" #n ")" ::: "memory")
#define PG8_BAR __builtin_amdgcn_s_barrier()
#define PG8_SCHED __builtin_amdgcn_sched_barrier(0)
    Unit cur, nxt; int ui = 0;
    if (!S.next(0, cur)) return;
    f32x4 acc[2][2][4][2];
#pragma unroll
    for (int a = 0; a < 2; ++a)
#pragma unroll
        for (int b = 0; b < 2; ++b)
#pragma unroll
            for (int m = 0; m < 4; ++m)
#pragma unroll
                for (int n = 0; n < 2; ++n) acc[a][b][m][n] = (f32x4){0.f, 0.f, 0.f, 0.f};
    bf16x8 At[4][2], B0[2][2], B1[2][2];
    if constexpr (ROWTAB) {
        if (tid < 256) tab[tid] = S.row_slot(cur, tid);
        PG8_WAIT_L(0); PG8_BAR; asm volatile("" ::: "memory");
        if constexpr (GATHER) { PG8_LOAD_VA(0, cur); }
    }
    const char* cA = GATHER ? (const char*)g.A : S.a_base(g, cur, tstep); const char* cB = (const char*)g.Bt + (size_t)cur.pn * tstep;
    PG8_STAGE(PG8_SB(0, 0), cB, voffB); PG8_STAGE(PG8_SB(0, 1), cB + hstep, voffB); PG8_STAGE_A(PG8_SA(0, 0), cA, 0); PG8_STAGE_A(PG8_SA(0, 1), cA, 1);
    if (wr == 1) PG8_BAR;
    PG8_WAIT_V(2); PG8_BAR;
    PG8_STAGE(PG8_SB(1, 0), cB + kstep, voffB); PG8_STAGE_A(PG8_SA(1, 0), cA + kstep, 0); PG8_STAGE(PG8_SB(1, 1), cB + hstep + kstep, voffB);
    PG8_WAIT_V(6); PG8_BAR;
    for (;;) {
        const bool has_next = S.next(ui + 1, nxt);
        if constexpr (ROWTAB) { if (has_next && tid < 256) tab[((ui + 1) % 3) * 256 + tid] = S.row_slot(nxt, tid); }
        const char* nA = has_next ? (GATHER ? (const char*)g.A : S.a_base(g, nxt, tstep)) : cA; const char* nB = has_next ? (const char*)g.Bt + (size_t)nxt.pn * tstep : cB;
        for (int t = 0; t < nt; t += 2) {
            const bool last = (t == nt - 2);
            const char* a1 = cA + (size_t)(t + 1) * kstep;
            const char* a2 = last ? nA : cA + (size_t)(t + 2) * kstep; const char* b2 = last ? nB : cB + (size_t)(t + 2) * kstep;
            const char* a3 = a2 + kstep; const char* b3 = b2 + kstep;
            PG8_LDB(B0, 0, 0); PG8_LDB(B1, 0, 1); PG8_SCHED; PG8_LDA(At, 0, 0); PG8_STAGE_A(PG8_SA(1, 1), a1, 1);
            if constexpr (GATHER) { if (last && has_next) { PG8_LOAD_VA((ui + 1) % 3, nxt); } }
            PG8_WAIT_V(8); PG8_WAIT_L(0); PG8_BAR; PG8_MMA(0, 0, At, B0); PG8_MMA(0, 1, At, B1); PG8_BAR; PG8_SCHED;
            PG8_LDA(At, 0, 1); PG8_STAGE(PG8_SB(0, 0), b2, voffB); PG8_STAGE(PG8_SB(0, 1), b2 + hstep, voffB); PG8_STAGE_A(PG8_SA(0, 0), a2, 0);
            PG8_WAIT_V(8); PG8_WAIT_L(0); PG8_BAR; PG8_MMA(1, 0, At, B0); PG8_MMA(1, 1, At, B1); PG8_BAR; PG8_SCHED;
            PG8_LDB(B0, 1, 0); PG8_LDB(B1, 1, 1); PG8_SCHED; PG8_LDA(At, 1, 0); PG8_STAGE_A(PG8_SA(0, 1), a2, 1);
            PG8_WAIT_V(8); PG8_WAIT_L(0); PG8_BAR; PG8_MMA(0, 0, At, B0); PG8_MMA(0, 1, At, B1); PG8_BAR; PG8_SCHED;
            PG8_LDA(At, 1, 1); PG8_STAGE(PG8_SB(1, 0), b3, voffB); PG8_STAGE(PG8_SB(1, 1), b3 + hstep, voffB); PG8_STAGE_A(PG8_SA(1, 0), a3, 0);
            PG8_WAIT_V(8); PG8_WAIT_L(0); PG8_BAR; PG8_MMA(1, 0, At, B0); PG8_MMA(1, 1, At, B1); PG8_BAR; PG8_SCHED;
        }
        if constexpr (ALIGN_EPI) { if (wr == 0) PG8_BAR; }
        E(acc, cur, wr, wc, fr, fq, (const PG8_LAS int*)(tab + (ui % 3) * 256));
        if (!has_next) break;
        if (!E.keep(cur)) {
#pragma unroll
        for (int a = 0; a < 2; ++a)
#pragma unroll
            for (int b = 0; b < 2; ++b)
#pragma unroll
                for (int m = 0; m < 4; ++m)
#pragma unroll
                    for (int n = 0; n < 2; ++n) acc[a][b][m][n] = (f32x4){0.f, 0.f, 0.f, 0.f}; }
        cur = nxt; cA = nA; cB = nB; ++ui;
        if constexpr (ALIGN_EPI) { if (wr == 1) PG8_BAR; }
    }
    PG8_WAIT_V(0);
    if constexpr (!ALIGN_EPI) { if (wr == 0) PG8_BAR; }
    PG8_BAR;
#undef PG8_SA
#undef PG8_SB
#undef PG8_STAGE
#undef PG8_STAGE_A
#undef PG8_LOAD_VA
#undef PG8_LDA
#undef PG8_LDB
#undef PG8_MMA
#undef PG8_V8
#undef PG8_WAIT_V
#undef PG8_WAIT_L
#undef PG8_BAR
#undef PG8_SCHED
}
}

constexpr int NWAVES = 8;
constexpr int N_LAUNCHES = MK_N_LAUNCHES;
constexpr int PER_PHASE = 10;
constexpr int BATCH = 8, SEQ = 2048, DM = 1024, M = BATCH * SEQ;
constexpr int SSM_W = 512, SSM_G = 32, SSM_H = 16, SSM_P = 64, SSM_T = 16, SSM_NC = SEQ / SSM_T;
constexpr int ATT_H = 4, ATT_D = 64, ATT_V = 128, QK_W = 512, V_W = 512;
constexpr int IN_W = 4096;
constexpr int NE = 32, TOPK = 4, DE = 1024, UPW = 2048;
constexpr float RMS_EPS = 1e-6f;
constexpr float LAMBDA_INIT = 0.2f;
constexpr float QSCALE = 0.125f * 1.4426950408889634f;
constexpr int MOE_ROWS_MAX = M * TOPK + NE * 256;
constexpr int MOE_MT_MAX = MOE_ROWS_MAX / 256;

constexpr size_t MiB = 1u << 20;
constexpr size_t WS_CTL = 0, CTL_ZERO_BYTES = 1 * MiB;
constexpr size_t WS_WIN = 2 * MiB;
constexpr size_t WS_WGLU = 10 * MiB;
constexpr size_t WS_WPS = 11 * MiB;
constexpr size_t WS_WPA = 12 * MiB;
constexpr size_t WS_WOUT = 13 * MiB;
constexpr size_t WS_WRT = 15 * MiB;
constexpr size_t WS_S5 = 16 * MiB;
constexpr size_t WS_A16 = 24 * MiB;
constexpr size_t WS_WUP = 32 * MiB;
constexpr size_t WS_WDN = 160 * MiB;
constexpr size_t WS_XN = 224 * MiB;
constexpr size_t WS_U = 256 * MiB;
constexpr size_t WS_Q = 272 * MiB, WS_K = 288 * MiB, WS_V = 304 * MiB;
constexpr size_t WS_G1 = 320 * MiB, WS_G2 = 352 * MiB;
constexpr size_t WS_YG = 384 * MiB, WS_YS = 400 * MiB, WS_OB = 416 * MiB;
constexpr size_t WS_TA = 432 * MiB, WS_MX = 464 * MiB;
constexpr size_t WS_HB = 496 * MiB;
constexpr size_t WS_RS2 = 528 * MiB;
constexpr size_t WS_WSLOT = 529 * MiB;
constexpr size_t WS_ELIST = 530 * MiB;
constexpr size_t WS_ACT = 544 * MiB;
constexpr size_t WS_YS2 = 688 * MiB;
constexpr size_t WS_END = 816 * MiB;
constexpr int CW_BAR = 4096;
constexpr int CW_Q = 20480;
constexpr int CW_CNT = 16384;

constexpr int RING_OFF = 0, RING_BYTES = 139264;
constexpr int LDSCTL_OFF = RING_BYTES, MISC_OFF = LDSCTL_OFF;
constexpr int MOE_LDS_OFF = LDSCTL_OFF + 256;
constexpr int LDS_BYTES = 147456;

#define GAS __attribute__((address_space(1)))
#define LAS __attribute__((address_space(3)))
typedef unsigned short bf16;
typedef unsigned v4u __attribute__((ext_vector_type(4)));
typedef unsigned v2u __attribute__((ext_vector_type(2)));
typedef float f32x4 __attribute__((ext_vector_type(4)));
typedef float f32x16 __attribute__((ext_vector_type(16)));
typedef short bf16x8 __attribute__((ext_vector_type(8)));
typedef short s16x4 __attribute__((ext_vector_type(4)));
typedef GAS unsigned gu32;
#define RLX_AGENT __ATOMIC_RELAXED, __HIP_MEMORY_SCOPE_AGENT
#define LDS_WAIT() asm volatile("s_waitcnt lgkmcnt(0)" ::: "memory")
#define VM_WAIT() asm volatile("s_waitcnt vmcnt(0)" ::: "memory")
using pg8::cvt_pk_bf16;
__device__ __forceinline__ unsigned f2bf(float f) { unsigned u = __builtin_bit_cast(unsigned, f); return (u + 0x7fffu + ((u >> 16) & 1u)) >> 16; }
__device__ __forceinline__ unsigned pk4_fp8(float a, float b, float c, float d) { unsigned w = 0; w = __builtin_amdgcn_cvt_pk_fp8_f32(a, b, w, false); w = __builtin_amdgcn_cvt_pk_fp8_f32(c, d, w, true); return w; }
__device__ __forceinline__ float bf2f(unsigned b) { return __builtin_bit_cast(float, b << 16); }
__device__ __forceinline__ float bflo(unsigned w) { return __builtin_bit_cast(float, w << 16); }
__device__ __forceinline__ float bfhi(unsigned w) { return __builtin_bit_cast(float, w & 0xffff0000u); }
__device__ __forceinline__ float fsigmoid(float x) { return 1.0f / (1.0f + __expf(-x)); }
__device__ __forceinline__ float gelu_tanh(float x) { const float z = 1.5957691216057308f * (x + 0.044715f * x * x * x); return x / (1.0f + __expf(-z)); }
__device__ __forceinline__ int crow(int r, int hi) { return (r & 3) + 8 * (r >> 2) + 4 * hi; }
__device__ __forceinline__ float wave_sum(float v) {
#pragma unroll
    for (int o = 1; o < 64; o <<= 1) v += __shfl_xor(v, o);
    return v;
}

#define XB_TMO      128
#define XB_XCNT(j)  (256  + 64 * (j))
#define XB_XSUB(j)  (1280 + 64 * (j))
#define XB_XGEN(j)  (2304 + 64 * (j))
#define XB_TOP      3328
#define XB_TOPGEN   3392
#define XCD_BAR_WORDS 3456
#define XB_SPIN_CAP (1u << 18)
__device__ __forceinline__ unsigned xb_ld(unsigned* p)              { return __hip_atomic_load(p, __ATOMIC_RELAXED, __HIP_MEMORY_SCOPE_AGENT); }
__device__ __forceinline__ unsigned xb_add(unsigned* p, unsigned v) { return __hip_atomic_fetch_add(p, v, __ATOMIC_RELAXED, __HIP_MEMORY_SCOPE_AGENT); }
__device__ __forceinline__ unsigned xb_xcc_id() { return (unsigned)__builtin_amdgcn_s_getreg((3 << 11) | 20) & 0xFu; }
#define XB_SPIN(cond, bar) do { unsigned _sp = 0; while (cond) { __builtin_amdgcn_s_sleep(1); \
    if ((++_sp & 255u) == 0u) { if (xb_ld(&(bar)[XB_TMO])) break; if (_sp > XB_SPIN_CAP) { atomicAdd(&(bar)[XB_TMO], 1u); break; } } } } while (0)
struct XcdBarrier { unsigned* bar; unsigned x; volatile LAS unsigned* st; };
__device__ __forceinline__ XcdBarrier xcd_barrier_post(unsigned* bar, volatile LAS unsigned* st) {
    XcdBarrier b; b.bar = bar; b.x = xb_xcc_id(); b.st = st;
    if (threadIdx.x == 0) (void)xb_add(&bar[XB_XCNT(b.x)], 1u);
    return b;
}
__device__ __forceinline__ void xcd_barrier_complete(unsigned* bar, unsigned x, unsigned& nloc, unsigned& nx) {
    const unsigned G = gridDim.x * gridDim.y * gridDim.z;
    unsigned sum, cnt, mine, sp = 0u;
    for (;;) {
        sum = 0u; cnt = 0u; mine = 0u;
#pragma unroll
        for (unsigned j = 0; j < 16; ++j) { const unsigned c = xb_ld(&bar[XB_XCNT(j)]); sum += c; cnt += (c > 0u) ? 1u : 0u; mine = (j == x) ? c : mine; }
        if (sum == G) break;
        __builtin_amdgcn_s_sleep(1);
        if ((++sp & 255u) == 0u) { if (xb_ld(&bar[XB_TMO])) break; if (sp > XB_SPIN_CAP) { atomicAdd(&bar[XB_TMO], 1u); break; } }
    }
    nloc = mine > 0u ? mine : 1u; nx = cnt > 0u ? cnt : 1u;
}
__device__ __forceinline__ void xcd_barrier(const XcdBarrier& b) {
    asm volatile("s_waitcnt vmcnt(0)" ::: "memory");
    __syncthreads();
    if (threadIdx.x == 0) {
        unsigned* bar = b.bar;
        __builtin_amdgcn_s_waitcnt(0);
        unsigned nloc = b.st[0], nx = b.st[1];
        if (nloc == 0u) { xcd_barrier_complete(bar, b.x, nloc, nx); b.st[0] = nloc; b.st[1] = nx; }
        const unsigned old = xb_add(&bar[XB_XSUB(b.x)], 1u);
        const unsigned gen = old / nloc;
        if (old + 1u == (gen + 1u) * nloc) {
            __builtin_amdgcn_fence(__ATOMIC_RELEASE, "agent");
            asm volatile("s_waitcnt vmcnt(0)" ::: "memory");
            const unsigned og = xb_add(&bar[XB_TOP], 1u);
            const unsigned tg = og / nx;
            if (og + 1u == (tg + 1u) * nx) xb_add(&bar[XB_TOPGEN], 1u);
            else XB_SPIN(xb_ld(&bar[XB_TOPGEN]) == tg, bar);
            __builtin_amdgcn_fence(__ATOMIC_ACQUIRE, "agent");
            xb_add(&bar[XB_XGEN(b.x)], 1u);
            asm volatile("s_waitcnt vmcnt(0)" ::: "memory");
        } else {
            XB_SPIN(xb_ld(&bar[XB_XGEN(b.x)]) == gen, bar);
            __builtin_amdgcn_fence(__ATOMIC_ACQUIRE, "agent");
            asm volatile("s_waitcnt vmcnt(0)" ::: "memory");
        }
    }
    __syncthreads();
}

struct Frame {
    LAS unsigned char* lds;
    volatile LAS unsigned* MISC;
    gu32* ctl;
    unsigned char* ws;
    int tid, lane, wave;
    int vcu, G;
    const float* in[31];
    float* out;
};
enum { I_X = 0, I_N1G, I_WIN, I_BGATE, I_ARE, I_AIM, I_LOGDT, I_BRE, I_BIM, I_CRE, I_CIM, I_SSMD, I_WGLU, I_BGLU, I_QG, I_KG, I_LQ1, I_LK1, I_LQ2, I_LK2, I_SUBLN,
       I_WPS, I_WPA, I_WOUT, I_N2G, I_WR, I_BR, I_WUP, I_BUP, I_WDN, I_BDN };

template <int MODE>
__device__ __forceinline__ int physrow(int c) {
    if (MODE == 1) { const int w = c & 63; return (c & ~255) + 128 * (w >> 5) + 32 * ((c >> 6) & 3) + (w & 31); }
    if (MODE == 2) { const int j = c >> 1; return 256 * (j >> 7) + 128 * (c & 1) + (j & 127); }
    return c;
}
struct P0Item { const float* src; void* dst; const float* kscale; int N, K, mode, out8, k0, c0; };
__device__ __forceinline__ int physrow_rt(int mode, int c) { return mode == 1 ? physrow<1>(c) : (mode == 2 ? physrow<2>(c) : c); }
__device__ __forceinline__ void p0_item_load(const P0Item& d, f32x4 (&v)[16], int lane) {
    const int lr = lane >> 4, lc = lane & 15;
#pragma unroll
    for (int i = 0; i < 16; ++i) v[i] = __builtin_nontemporal_load((const f32x4*)(d.src + (size_t)(d.k0 + lr + 4 * i) * d.N + d.c0 + 4 * lc));
}
__device__ __forceinline__ void p0_item_finish(const P0Item& d, const f32x4 (&v)[16], LAS float* scr, int lane) {
    const int lr = lane >> 4, lc = lane & 15;
#pragma unroll
    for (int i = 0; i < 16; ++i) { const int k = lr + 4 * i; *(LAS f32x4*)(scr + k * 64 + 4 * (lc ^ ((k >> 3) & 7))) = v[i]; }
    LDS_WAIT(); asm volatile("" ::: "memory");
    const int a = lane & 7, bq = lane >> 3;
    float ks[8];
#pragma unroll
    for (int i = 0; i < 8; ++i) ks[i] = (d.kscale ? d.kscale[d.k0 + 8 * a + i] : 1.0f) * (d.out8 ? 32.0f : 1.0f);
#pragma unroll
    for (int j = 0; j < 8; ++j) { const int cl = bq + 8 * j; float x[8];
#pragma unroll
        for (int i = 0; i < 8; ++i) x[i] = scr[(8 * a + i) * 64 + 4 * ((cl >> 2) ^ a) + (cl & 3)] * ks[i];
        const size_t ro = (size_t)physrow_rt(d.mode, d.c0 + cl) * d.K + d.k0 + 8 * a;
        if (d.out8) { v2u o; o.x = pk4_fp8(x[0], x[1], x[2], x[3]); o.y = pk4_fp8(x[4], x[5], x[6], x[7]); __builtin_nontemporal_store(o, (GAS v2u*)((unsigned char*)d.dst + ro)); }
        else { v4u o; o.x = cvt_pk_bf16(x[0], x[1]); o.y = cvt_pk_bf16(x[2], x[3]); o.z = cvt_pk_bf16(x[4], x[5]); o.w = cvt_pk_bf16(x[6], x[7]); *(GAS v4u*)((bf16*)d.dst + ro) = o; } }
    LDS_WAIT(); asm volatile("" ::: "memory");
}
__device__ __forceinline__ void rms_row_to_bf16(int lane, const float* xrow, const float* g, bf16* orow) {
    const GAS f32x4* xr = (const GAS f32x4*)xrow + lane; const GAS f32x4* gr = (const GAS f32x4*)g + lane;
    f32x4 v[4]; float s = 0.f;
#pragma unroll
    for (int j = 0; j < 4; ++j) { v[j] = xr[64 * j]; s += (v[j].x * v[j].x + v[j].y * v[j].y) + (v[j].z * v[j].z + v[j].w * v[j].w); }
    const float rs = 1.0f / sqrtf(wave_sum(s) * (1.f / DM) + RMS_EPS);
    GAS unsigned long long* o8 = (GAS unsigned long long*)orow + lane;
#pragma unroll
    for (int j = 0; j < 4; ++j) { const f32x4 gg = gr[64 * j];
        o8[64 * j] = (unsigned long long)cvt_pk_bf16(v[j].x * rs * gg.x, v[j].y * rs * gg.y) | ((unsigned long long)cvt_pk_bf16(v[j].z * rs * gg.z, v[j].w * rs * gg.w) << 32); }
}
__device__ __forceinline__ void p0_s5_group(Frame& F, int g) {
    LAS float* AP = (LAS float*)(F.lds + RING_OFF);
    LAS float* BB = AP + 17 * 64 * 2;
    LAS float* CC = BB + 64 * 16 * 2;
    LAS float* KM = CC + 16 * 64 * 2;
    const float* are = F.in[I_ARE] + g * SSM_P; const float* aim = F.in[I_AIM] + g * SSM_P;
    const double dt = exp((double)F.in[I_LOGDT][g]);
    for (int e = F.tid; e < 17 * 64; e += NWAVES * 64) { const int m = e >> 6, p = e & 63; const double lr = are[p], li = aim[p];
        const double mag = exp(lr * dt * m), ang = li * dt * m; AP[e * 2] = (float)(mag * cos(ang)); AP[e * 2 + 1] = (float)(mag * sin(ang)); }
    for (int e = F.tid; e < 64 * 16; e += NWAVES * 64) { const int p = e >> 4, h = e & 15; const double lr = are[p], li = aim[p];
        const double mag = exp(lr * dt), ar = mag * cos(li * dt), ai = mag * sin(li * dt), den = lr * lr + li * li, nr = ar - 1.0, ni = ai;
        const double cr = (nr * lr + ni * li) / den, ci = (ni * lr - nr * li) / den;
        const double br = F.in[I_BRE][(size_t)(g * SSM_P + p) * SSM_H + h], bi = F.in[I_BIM][(size_t)(g * SSM_P + p) * SSM_H + h];
        BB[e * 2] = (float)(cr * br - ci * bi); BB[e * 2 + 1] = (float)(cr * bi + ci * br); }
    for (int e = F.tid; e < 16 * 64; e += NWAVES * 64) { CC[e * 2] = F.in[I_CRE][(size_t)g * 1024 + e]; CC[e * 2 + 1] = F.in[I_CIM][(size_t)g * 1024 + e]; }
    __syncthreads();
    if (F.tid < 64) { float* a16 = (float*)(F.ws + WS_A16) + (g * 64 + F.tid) * 2; a16[0] = AP[(16 * 64 + F.tid) * 2]; a16[1] = AP[(16 * 64 + F.tid) * 2 + 1]; }
    for (int e = F.tid; e < 16 * 256; e += NWAVES * 64) { const int m = e >> 8, ho = (e >> 4) & 15, hi = e & 15; float s = 0.f;
        for (int p = 0; p < 64; ++p) { const float cr = CC[(ho * 64 + p) * 2], ci = CC[(ho * 64 + p) * 2 + 1], ar = AP[(m * 64 + p) * 2], ai = AP[(m * 64 + p) * 2 + 1];
            const float tr = cr * ar - ci * ai, ti = cr * ai + ci * ar; s += tr * BB[(p * 16 + hi) * 2] - ti * BB[(p * 16 + hi) * 2 + 1]; }
        KM[e] = s; }
    __syncthreads();
    bf16* W1T = (bf16*)(F.ws + WS_S5 + (size_t)g * 262144); bf16* M2T = W1T + 128 * 256; bf16* W3T = M2T + 256 * 256;
    for (int e = F.tid; e < 128 * 256; e += NWAVES * 64) { const int n = e >> 8, k = e & 255, p = n & 63, j = k >> 4, hi = k & 15;
        const float ar = AP[((15 - j) * 64 + p) * 2], ai = AP[((15 - j) * 64 + p) * 2 + 1], br = BB[(p * 16 + hi) * 2], bi = BB[(p * 16 + hi) * 2 + 1];
        W1T[e] = (bf16)f2bf(n < 64 ? ar * br - ai * bi : ar * bi + ai * br); }
    for (int e = F.tid; e < 256 * 128; e += NWAVES * 64) { const int n = e >> 7, k = e & 127, i = n >> 4, ho = n & 15, p = k & 63;
        const float cr = CC[(ho * 64 + p) * 2], ci = CC[(ho * 64 + p) * 2 + 1], ar = AP[((i + 1) * 64 + p) * 2], ai = AP[((i + 1) * 64 + p) * 2 + 1];
        W3T[e] = (bf16)f2bf(k < 64 ? cr * ar - ci * ai : -(cr * ai + ci * ar)); }
    const float* dsk = F.in[I_SSMD] + g * 16;
    for (int e = F.tid; e < 256 * 256; e += NWAVES * 64) { const int n = e >> 8, k = e & 255, i = n >> 4, ho = n & 15, j = k >> 4, hi = k & 15;
        float v = 0.f; if (j <= i) { v = KM[((i - j) * 16 + ho) * 16 + hi]; if (i == j && ho == hi) v += dsk[ho]; }
        M2T[e] = (bf16)f2bf(v); }
    __syncthreads();
}
__device__ __forceinline__ void p0_prologue(Frame& F) {
    if (F.vcu < SSM_G) p0_s5_group(F, F.vcu);
    LAS float* scr = (LAS float*)(F.lds + RING_OFF + F.wave * 16384);
    const int gw = F.vcu * NWAVES + F.wave, NGW = F.G * NWAVES;
    { float* wrT = (float*)(F.ws + WS_WRT); const float* wr = F.in[I_WR]; const float* g2 = F.in[I_N2G];
      for (int e = gw * 64 + F.lane; e < NE * DM; e += NGW * 64) { const int ex = e >> 10, k = e & 1023; wrT[e] = g2[k] * wr[k * NE + ex]; } }
    for (int m = gw; m < M; m += NGW) rms_row_to_bf16(F.lane, F.in[I_X] + (size_t)m * DM, F.in[I_N1G], (bf16*)(F.ws + WS_XN) + (size_t)m * DM);
    constexpr int IT_IN = (DM / 64) * (IN_W / 64), IT_GLU = (512 / 64) * (512 / 64), IT_PS = (512 / 64) * (DM / 64), IT_OUT = (DM / 64) * (DM / 64);
    constexpr int IT_UP1 = (DM / 64) * (UPW / 64), IT_DN1 = (DE / 64) * (DM / 64);
    constexpr int NITEMS = IT_IN + IT_GLU + 2 * IT_PS + IT_OUT + NE * IT_UP1 + NE * IT_DN1;
#define P0_DECODE(it, d) do { int r_ = (it); int nb_; \
        if (r_ < IT_IN) { d.src = F.in[I_WIN]; d.dst = F.ws + WS_WIN; d.kscale = nullptr; d.N = IN_W; d.K = DM; d.mode = 1; d.out8 = 0; } \
        else if ((r_ -= IT_IN) < IT_GLU) { d.src = F.in[I_WGLU]; d.dst = F.ws + WS_WGLU; d.kscale = nullptr; d.N = 512; d.K = 512; d.mode = 0; d.out8 = 0; } \
        else if ((r_ -= IT_GLU) < IT_PS) { d.src = F.in[I_WPS]; d.dst = F.ws + WS_WPS; d.kscale = nullptr; d.N = DM; d.K = 512; d.mode = 0; d.out8 = 0; } \
        else if ((r_ -= IT_PS) < IT_PS) { d.src = F.in[I_WPA]; d.dst = F.ws + WS_WPA; d.kscale = nullptr; d.N = DM; d.K = 512; d.mode = 0; d.out8 = 0; } \
        else if ((r_ -= IT_PS) < IT_OUT) { d.src = F.in[I_WOUT]; d.dst = F.ws + WS_WOUT; d.kscale = nullptr; d.N = DM; d.K = DM; d.mode = 0; d.out8 = 0; } \
        else if ((r_ -= IT_OUT) < NE * IT_UP1) { const int e_ = r_ / IT_UP1; r_ -= e_ * IT_UP1; d.src = F.in[I_WUP] + (size_t)e_ * DM * UPW; d.dst = F.ws + WS_WUP + (size_t)e_ * UPW * DM; d.kscale = F.in[I_N2G]; d.N = UPW; d.K = DM; d.mode = 2; d.out8 = 1; } \
        else { r_ -= NE * IT_UP1; const int e_ = r_ / IT_DN1; r_ -= e_ * IT_DN1; d.src = F.in[I_WDN] + (size_t)e_ * DE * DM; d.dst = F.ws + WS_WDN + (size_t)e_ * DM * DE; d.kscale = nullptr; d.N = DM; d.K = DE; d.mode = 0; d.out8 = 1; } \
        nb_ = d.N / 64; d.k0 = 64 * (r_ / nb_); d.c0 = 64 * (r_ % nb_); } while (0)
    int qcur = 0, qend = 0;
#define P0_DRAW(it) do { if (qcur == qend) { unsigned q_ = 0; if (F.lane == 0) q_ = atomicAdd((unsigned*)(F.ctl + CW_Q), 1u); qcur = 8 * (int)__builtin_amdgcn_readfirstlane(q_); qend = qcur + 8; } it = qcur++; } while (0)
    {
        P0Item dA, dB; f32x4 vA[16], vB[16]; int itA, itB;
        P0_DRAW(itA);
        if (itA < NITEMS) { P0_DECODE(itA, dA); p0_item_load(dA, vA, F.lane);
            for (;;) {
                P0_DRAW(itB); const bool hasB = itB < NITEMS;
                if (hasB) { P0_DECODE(itB, dB); p0_item_load(dB, vB, F.lane); }
                p0_item_finish(dA, vA, scr, F.lane);
                if (!hasB) break;
                P0_DRAW(itA); const bool hasA = itA < NITEMS;
                if (hasA) { P0_DECODE(itA, dA); p0_item_load(dA, vA, F.lane); }
                p0_item_finish(dB, vB, scr, F.lane);
                if (!hasA) break;
            } }
    }
#undef P0_DECODE
#undef P0_DRAW
}

typedef const pg8::f32x4 (&AccRef)[2][2][4][2];
__device__ __forceinline__ v4u pack8(const f32x4 a, const f32x4 b) { v4u w; w.x = cvt_pk_bf16(a[0], a[1]); w.y = cvt_pk_bf16(a[2], a[3]); w.z = cvt_pk_bf16(b[0], b[1]); w.w = cvt_pk_bf16(b[2], b[3]); return w; }
__device__ __forceinline__ void unpack8(const v4u w, f32x4& a, f32x4& b) { a = (f32x4){bflo(w.x), bfhi(w.x), bflo(w.y), bfhi(w.y)}; b = (f32x4){bflo(w.z), bfhi(w.z), bflo(w.w), bfhi(w.w)}; }

struct EpiInProj {
    static constexpr bool PERM = true;
    __device__ __forceinline__ bool keep(const pg8::Unit&) const { return false; }
    bf16 *U, *Q, *Kb, *V, *G1, *G2; const float *bgate, *qg, *kg;
    __device__ __forceinline__ void operator()(AccRef acc, const pg8::Unit& u, int wr, int wc, int fr, int fq, const LAS int*) const {
        const int pn = u.pn, row0 = u.pm * 256 + wr * 64 + fr;
        if (pn < 2) {
#pragma unroll
            for (int ai = 0; ai < 2; ++ai)
#pragma unroll
                for (int m = 0; m < 4; ++m) { const int row = row0 + ai * 128 + m * 16, b = row >> 11, t = row & 2047;
#pragma unroll
                    for (int bj = 0; bj < 2; ++bj) { const int lc = 256 * pn + 64 * wc + 32 * bj + 8 * fq, g = lc >> 4, ch = lc & 15;
                        *(v4u*)(U + ((size_t)(b * SSM_G + g) * SEQ + t) * 16 + ch) = pack8(acc[ai][bj][m][0], acc[ai][bj][m][1]); } }
        } else if (pn < 6) {
            const bool isq = pn < 4; const float* gv = isq ? qg : kg; const float sc = isq ? QSCALE : 1.0f;
            bf16* dst = (isq ? Q : Kb) + 256 * (pn - (isq ? 2 : 4)) + 64 * wc + 8 * fq;
            f32x4 gg[2][2];
#pragma unroll
            for (int bj = 0; bj < 2; ++bj)
#pragma unroll
                for (int n = 0; n < 2; ++n) gg[bj][n] = *(const f32x4*)(gv + 32 * bj + 8 * fq + 4 * n) * sc;
#pragma unroll
            for (int ai = 0; ai < 2; ++ai)
#pragma unroll
                for (int m = 0; m < 4; ++m) { const int row = row0 + ai * 128 + m * 16; float ss = 0.f;
#pragma unroll
                    for (int bj = 0; bj < 2; ++bj)
#pragma unroll
                        for (int n = 0; n < 2; ++n) { const f32x4 x = acc[ai][bj][m][n]; ss += (x[0] * x[0] + x[1] * x[1]) + (x[2] * x[2] + x[3] * x[3]); }
                    ss += __shfl_xor(ss, 16); ss += __shfl_xor(ss, 32);
                    const float rs = 1.0f / sqrtf(ss * (1.0f / 64.0f) + RMS_EPS);
#pragma unroll
                    for (int bj = 0; bj < 2; ++bj) *(v4u*)(dst + (size_t)row * 512 + 32 * bj) = pack8(acc[ai][bj][m][0] * rs * gg[bj][0], acc[ai][bj][m][1] * rs * gg[bj][1]); }
        } else if (pn < 8) {
            bf16* dst = V + 256 * (pn - 6) + 64 * wc + 8 * fq;
#pragma unroll
            for (int ai = 0; ai < 2; ++ai)
#pragma unroll
                for (int m = 0; m < 4; ++m) { const int row = row0 + ai * 128 + m * 16;
#pragma unroll
                    for (int bj = 0; bj < 2; ++bj) *(v4u*)(dst + (size_t)row * 512 + 32 * bj) = pack8(acc[ai][bj][m][0], acc[ai][bj][m][1]); }
        } else {
            const int gc = 256 * (pn - 8) + 64 * wc + 8 * fq;
            bf16* dst = (gc < 1024 ? G1 + gc : G2 + (gc - 1024));
            f32x4 bb[2][2];
#pragma unroll
            for (int bj = 0; bj < 2; ++bj)
#pragma unroll
                for (int n = 0; n < 2; ++n) bb[bj][n] = *(const f32x4*)(bgate + gc + 32 * bj + 4 * n);
#pragma unroll
            for (int ai = 0; ai < 2; ++ai)
#pragma unroll
                for (int m = 0; m < 4; ++m) { const int row = row0 + ai * 128 + m * 16;
#pragma unroll
                    for (int bj = 0; bj < 2; ++bj) { f32x4 a = acc[ai][bj][m][0] + bb[bj][0], b = acc[ai][bj][m][1] + bb[bj][1];
#pragma unroll
                        for (int e = 0; e < 4; ++e) { a[e] = fsigmoid(a[e]); b[e] = fsigmoid(b[e]); }
                        *(v4u*)(dst + (size_t)row * 1024 + 32 * bj) = pack8(a, b); } }
        }
    }
};
template <int MODE> struct EpiMix {
    static constexpr bool PERM = true;
    __device__ __forceinline__ bool keep(const pg8::Unit&) const { return false; }
    const bf16* P0; const bf16* P1; bf16* O; const float* bias; int ld;
    __device__ __forceinline__ void operator()(AccRef acc, const pg8::Unit& u, int wr, int wc, int fr, int fq, const LAS int*) const {
        const int row0 = u.pm * 256 + wr * 64 + fr, col0 = u.pn * 256 + wc * 32 + 8 * fq;
        f32x4 bb[2][2];
#pragma unroll
        for (int bj = 0; bj < 2; ++bj)
#pragma unroll
            for (int n = 0; n < 2; ++n) bb[bj][n] = (MODE == 0) ? *(const f32x4*)(bias + col0 + bj * 128 + 4 * n) : (f32x4){0.f, 0.f, 0.f, 0.f};
#pragma unroll
        for (int ai = 0; ai < 2; ++ai) {
            v4u q0[4][2], q1[4][2];
#pragma unroll
            for (int m = 0; m < 4; ++m)
#pragma unroll
                for (int bj = 0; bj < 2; ++bj) { const size_t off = (size_t)(row0 + ai * 128 + m * 16) * ld + col0 + bj * 128; q0[m][bj] = *(const v4u*)(P0 + off); if (MODE == 2) q1[m][bj] = *(const v4u*)(P1 + off); }
#pragma unroll
            for (int m = 0; m < 4; ++m) { const size_t off = (size_t)(row0 + ai * 128 + m * 16) * ld + col0;
#pragma unroll
                for (int bj = 0; bj < 2; ++bj) { f32x4 a = acc[ai][bj][m][0], b = acc[ai][bj][m][1], p0a, p0b;
                    unpack8(q0[m][bj], p0a, p0b);
                    if (MODE == 0) { a += bb[bj][0]; b += bb[bj][1];
#pragma unroll
                        for (int e = 0; e < 4; ++e) { a[e] = p0a[e] * fsigmoid(a[e]); b[e] = p0b[e] * fsigmoid(b[e]); } }
                    else if (MODE == 1) { a *= p0a; b *= p0b; }
                    else { f32x4 p1a, p1b; unpack8(q1[m][bj], p1a, p1b); a = p0a + p1a * a; b = p0b + p1b * b; }
                    *(v4u*)(O + off + bj * 128) = pack8(a, b); } } }
    }
};
struct EpiOut {
    static constexpr bool PERM = false;
    __device__ __forceinline__ bool keep(const pg8::Unit&) const { return false; }
    const float* X; float* H; unsigned char* HB;
    __device__ __forceinline__ void operator()(AccRef acc, const pg8::Unit& u, int wr, int wc, int fr, int fq, const LAS int*) const {
        const int row0 = u.pm * 256 + wr * 64 + fr, col0 = u.pn * 256 + wc * 32 + 4 * fq;
#pragma unroll
        for (int ai = 0; ai < 2; ++ai) {
            f32x4 xv[4][2][2];
#pragma unroll
            for (int m = 0; m < 4; ++m)
#pragma unroll
                for (int bj = 0; bj < 2; ++bj)
#pragma unroll
                    for (int n = 0; n < 2; ++n) xv[m][bj][n] = *(const f32x4*)(X + (size_t)(row0 + ai * 128 + m * 16) * DM + col0 + bj * 128 + n * 16);
#pragma unroll
            for (int m = 0; m < 4; ++m) { const size_t off = (size_t)(row0 + ai * 128 + m * 16) * DM + col0;
#pragma unroll
                for (int bj = 0; bj < 2; ++bj)
#pragma unroll
                    for (int n = 0; n < 2; ++n) { const f32x4 h = xv[m][bj][n] + acc[ai][bj][m][n];
                        *(f32x4*)(H + off + bj * 128 + n * 16) = h; *(unsigned*)(HB + off + bj * 128 + n * 16) = pk4_fp8(h[0], h[1], h[2], h[3]); } } }
    }
};
struct ChainOrder {
    pg8::StaticOrder so; const bf16* A_att; const bf16* A_ssm;
    __device__ __forceinline__ bool next(int i, pg8::Unit& u) const { pg8::Unit t; if (!so.next(i >> 1, t)) return false; u.pm = t.pm; u.pn = (i & 1) ? t.pn : 4 + t.pn; return true; }
    __device__ __forceinline__ int row_slot(const pg8::Unit&, int) const { return 0; }
    __device__ __forceinline__ int a_row(const pg8::Unit& u, int r, int) const { return u.pm * 256 + r; }
    __device__ __forceinline__ const char* a_base(const pg8::Gemm&, const pg8::Unit& u, size_t tstep) const { return (const char*)(u.pn >= 4 ? A_att : A_ssm) + (size_t)u.pm * tstep; }
};
struct EpiChain {
    static constexpr bool PERM = true;
    const bf16* G1; const bf16* G2; bf16* MX;
    __device__ __forceinline__ bool keep(const pg8::Unit& u) const { return u.pn >= 4; }
    __device__ __forceinline__ void operator()(pg8::f32x4 (&acc)[2][2][4][2], const pg8::Unit& u, int wr, int wc, int fr, int fq, const LAS int*) const {
        const bool att = u.pn >= 4; const int row0 = u.pm * 256 + wr * 64 + fr, col0 = (u.pn & 3) * 256 + wc * 32 + 8 * fq;
#pragma unroll
        for (int ai = 0; ai < 2; ++ai) {
            v4u q1[4][2], q2[4][2];
#pragma unroll
            for (int m = 0; m < 4; ++m)
#pragma unroll
                for (int bj = 0; bj < 2; ++bj) { const size_t off = (size_t)(row0 + ai * 128 + m * 16) * DM + col0 + bj * 128; q1[m][bj] = *(const v4u*)(G1 + off); if (att) q2[m][bj] = *(const v4u*)(G2 + off); }
#pragma unroll
            for (int m = 0; m < 4; ++m)
#pragma unroll
                for (int bj = 0; bj < 2; ++bj) { f32x4 g1a, g1b; unpack8(q1[m][bj], g1a, g1b);
                    if (att) { f32x4 g2a, g2b; unpack8(q2[m][bj], g2a, g2b);
#pragma unroll
                        for (int e = 0; e < 4; ++e) { acc[ai][bj][m][0][e] *= g2a[e] * __builtin_amdgcn_rcpf(g1a[e]); acc[ai][bj][m][1][e] *= g2b[e] * __builtin_amdgcn_rcpf(g1b[e]); } }
                    else *(v4u*)(MX + (size_t)(row0 + ai * 128 + m * 16) * DM + col0 + bj * 128) = pack8(acc[ai][bj][m][0] * g1a, acc[ai][bj][m][1] * g1b); } }
    }
};
template <int NN, bool TOKROWS> struct MoeOrder {
    int nunits, G, vcu; const LAS int* cnt; const LAS int* tstart; const LAS int* tile2e; const int* elist;
    __device__ __forceinline__ bool next(int i, pg8::Unit& u) const { const long L = (long)i * G + vcu; if (L >= nunits) return false; const int pm = (int)(L / NN), pnl = (int)(L % NN);
        u.pm = pm; u.pn = tile2e[pm] * NN + pnl; return true; }
    __device__ __forceinline__ int row_slot(const pg8::Unit& u, int r) const { const int e = u.pn / NN, pos = (u.pm - tstart[e]) * 256 + r; return pos < cnt[e] ? elist[e * M + pos] : -1; }
    __device__ __forceinline__ int a_row(const pg8::Unit& u, int r, int slot) const { return TOKROWS ? (slot < 0 ? 0 : (slot >> 2)) : u.pm * 256 + r; }
    __device__ __forceinline__ const char* a_base(const pg8::Gemm& g, const pg8::Unit&, size_t) const { return (const char*)g.A; }
};
struct EpiUp {
    static constexpr bool PERM = true;
    __device__ __forceinline__ bool keep(const pg8::Unit&) const { return false; }
    unsigned char* ACT; const float* bup; const float* rs2;
    __device__ __forceinline__ void operator()(AccRef acc, const pg8::Unit& u, int wr, int wc, int fr, int fq, const LAS int* tab) const {
        const int e = u.pn >> 3, pnl = u.pn & 7, j0 = 128 * pnl + 32 * wc + 8 * fq;
        f32x4 bb[4];
#pragma unroll
        for (int q = 0; q < 4; ++q) bb[q] = *(const f32x4*)(bup + (size_t)e * UPW + 2 * j0 + 4 * q);
        int sl[2][4]; float rsv[2][4];
#pragma unroll
        for (int ai = 0; ai < 2; ++ai)
#pragma unroll
            for (int m = 0; m < 4; ++m) { sl[ai][m] = tab[ai * 128 + wr * 64 + m * 16 + fr]; rsv[ai][m] = rs2[sl[ai][m] < 0 ? 0 : (sl[ai][m] >> 2)]; }
#pragma unroll
        for (int ai = 0; ai < 2; ++ai)
#pragma unroll
            for (int m = 0; m < 4; ++m) { const int r = ai * 128 + wr * 64 + m * 16 + fr, slot = sl[ai][m];
                if (slot >= 0) { const float rs = rsv[ai][m]; f32x4 o[2];
#pragma unroll
                    for (int n = 0; n < 2; ++n)
#pragma unroll
                        for (int e4 = 0; e4 < 4; ++e4) { const int j = 4 * n + e4;
                            float gl = acc[ai][0][m][n][e4] * rs + bb[(2 * j) >> 2][(2 * j) & 3], li = acc[ai][1][m][n][e4] * rs + bb[(2 * j + 1) >> 2][(2 * j + 1) & 3];
                            gl = fminf(gl, 7.0f); li = fminf(fmaxf(li, -7.0f), 7.0f);
                            o[n][e4] = gl * fsigmoid(1.702f * gl) * (li + 1.0f) * 4.0f; }
                    v2u ov; ov.x = pk4_fp8(o[0][0], o[0][1], o[0][2], o[0][3]); ov.y = pk4_fp8(o[1][0], o[1][1], o[1][2], o[1][3]); *(v2u*)(ACT + (size_t)(u.pm * 256 + r) * DE + j0) = ov; } }
    }
};
struct EpiDown {
    static constexpr bool PERM = true;
    __device__ __forceinline__ bool keep(const pg8::Unit&) const { return false; }
    bf16* YS2; const float* bdn; const float* wslot;
    __device__ __forceinline__ void operator()(AccRef acc, const pg8::Unit& u, int wr, int wc, int fr, int fq, const LAS int* tab) const {
        const int e = u.pn >> 2, pnl = u.pn & 3, c0 = 256 * pnl + 32 * wc + 8 * fq;
        f32x4 bb[2][2];
#pragma unroll
        for (int bj = 0; bj < 2; ++bj)
#pragma unroll
            for (int n = 0; n < 2; ++n) bb[bj][n] = *(const f32x4*)(bdn + (size_t)e * DM + c0 + bj * 128 + 4 * n);
        int sl[2][4]; float wv[2][4];
#pragma unroll
        for (int ai = 0; ai < 2; ++ai)
#pragma unroll
            for (int m = 0; m < 4; ++m) { sl[ai][m] = tab[ai * 128 + wr * 64 + m * 16 + fr]; wv[ai][m] = wslot[sl[ai][m] < 0 ? 0 : sl[ai][m]]; }
#pragma unroll
        for (int ai = 0; ai < 2; ++ai)
#pragma unroll
            for (int m = 0; m < 4; ++m) { const int slot = sl[ai][m];
                if (slot >= 0) { const float w = wv[ai][m];
#pragma unroll
                    for (int bj = 0; bj < 2; ++bj) *(v4u*)(YS2 + (size_t)slot * DM + c0 + bj * 128) = pack8((acc[ai][bj][m][0] + bb[bj][0]) * w, (acc[ai][bj][m][1] + bb[bj][1]) * w); } }
    }
};

constexpr int S5_UPITCH = 528, S5_SX_OFF = 128 * S5_UPITCH, S5_XPITCH = 132;
__device__ __forceinline__ void s5_unit(Frame& F, int b, int g) {
    LAS unsigned char* Uimg = F.lds + RING_OFF; LAS float* SX = (LAS float*)(F.lds + RING_OFF + S5_SX_OFF);
    const int tid = F.tid, lane = F.lane, w = F.wave, r32 = lane & 31, hi = lane >> 5;
    const bf16* Ug = (const bf16*)(F.ws + WS_U) + (size_t)(b * SSM_G + g) * SEQ * 16;
    const bf16* W1T = (const bf16*)(F.ws + WS_S5 + (size_t)g * 262144); const bf16* M2T = W1T + 128 * 256; const bf16* W3T = M2T + 256 * 256;
#pragma unroll
    for (int j = 0; j < 8; ++j) { const int q = tid + 512 * j; *(LAS v4u*)(Uimg + (q >> 5) * S5_UPITCH + (q & 31) * 16) = *(const v4u*)(Ug + (size_t)q * 8); }
    __syncthreads();
    { const int nt = w & 3, mt0 = 2 * (w >> 2);
      f32x16 s0 = {0}, s1 = {0};
#pragma unroll 4
      for (int ks = 0; ks < 16; ++ks) {
          const bf16x8 bf = *(const bf16x8*)(W1T + (size_t)(32 * nt + r32) * 256 + 16 * ks + 8 * hi);
          const bf16x8 a0 = *(const LAS bf16x8*)(Uimg + (32 * mt0 + r32) * S5_UPITCH + (16 * ks + 8 * hi) * 2);
          const bf16x8 a1 = *(const LAS bf16x8*)(Uimg + (32 * (mt0 + 1) + r32) * S5_UPITCH + (16 * ks + 8 * hi) * 2);
          s0 = __builtin_amdgcn_mfma_f32_32x32x16_bf16(a0, bf, s0, 0, 0, 0); s1 = __builtin_amdgcn_mfma_f32_32x32x16_bf16(a1, bf, s1, 0, 0, 0); }
#pragma unroll
      for (int r = 0; r < 16; ++r) { SX[(32 * mt0 + crow(r, hi)) * S5_XPITCH + 32 * nt + r32] = s0[r]; SX[(32 * (mt0 + 1) + crow(r, hi)) * S5_XPITCH + 32 * nt + r32] = s1[r]; } }
    __syncthreads();
    if (tid < 64) {
        const float* a16 = (const float*)(F.ws + WS_A16) + (g * 64 + tid) * 2; const float ar = a16[0], ai = a16[1]; float xr = 0.f, xi = 0.f;
#pragma unroll 8
        for (int c = 0; c < SSM_NC; ++c) { const float sr = SX[c * S5_XPITCH + tid], si = SX[c * S5_XPITCH + 64 + tid];
            SX[c * S5_XPITCH + tid] = xr; SX[c * S5_XPITCH + 64 + tid] = xi;
            const float nr = ar * xr - ai * xi + sr, ni = ar * xi + ai * xr + si; xr = nr; xi = ni; }
    }
    __syncthreads();
    { f32x16 y[4] = {{0}, {0}, {0}, {0}};
      const int nks = 2 * w + 2;
      for (int ks = 0; ks < nks; ++ks) {
          const bf16x8 bf = *(const bf16x8*)(M2T + (size_t)(32 * w + r32) * 256 + 16 * ks + 8 * hi);
#pragma unroll
          for (int mt = 0; mt < 4; ++mt) { const bf16x8 a = *(const LAS bf16x8*)(Uimg + (32 * mt + r32) * S5_UPITCH + (16 * ks + 8 * hi) * 2); y[mt] = __builtin_amdgcn_mfma_f32_32x32x16_bf16(a, bf, y[mt], 0, 0, 0); } }
#pragma unroll 2
      for (int ks = 0; ks < 8; ++ks) {
          const bf16x8 bf = *(const bf16x8*)(W3T + (size_t)(32 * w + r32) * 128 + 16 * ks + 8 * hi);
#pragma unroll
          for (int mt = 0; mt < 4; ++mt) { const LAS f32x4* xp = (const LAS f32x4*)(SX + (32 * mt + r32) * S5_XPITCH + 16 * ks + 8 * hi); const f32x4 x0 = xp[0], x1 = xp[1];
              const v4u pk = pack8(x0, x1); y[mt] = __builtin_amdgcn_mfma_f32_32x32x16_bf16(__builtin_bit_cast(bf16x8, pk), bf, y[mt], 0, 0, 0); } }
      bf16* YG = (bf16*)(F.ws + WS_YG); const int i = 2 * w + (r32 >> 4), ho = r32 & 15;
#pragma unroll
      for (int mt = 0; mt < 4; ++mt)
#pragma unroll
          for (int r = 0; r < 16; ++r) { const int c = 32 * mt + crow(r, hi); YG[(size_t)(b * SEQ + 16 * c + i) * SSM_W + g * 16 + ho] = (bf16)f2bf(gelu_tanh(y[mt][r])); } }
    __syncthreads();
}

constexpr int AT_KP = 272, AT_VP = 320, AT_KB = 64 * AT_KP, AT_VB = 64 * AT_VP, AT_BUF = AT_KB + AT_VB;
__device__ __forceinline__ s16x4 vtr(const LAS unsigned char* p) { typedef short v4i16_t __attribute__((ext_vector_type(4))); return __builtin_bit_cast(s16x4, __builtin_amdgcn_ds_read_tr16_b64_v4i16((LAS v4i16_t*)p)); }
__device__ __forceinline__ void attn_unit(Frame& F, int b, int h, int qb, float lam) {
    const int tid = F.tid, lane = F.lane, w = F.wave, rg = w >> 1, t = w & 1, r32 = lane & 31, hi = lane >> 5;
    const bf16* Q = (const bf16*)(F.ws + WS_Q); const bf16* K = (const bf16*)(F.ws + WS_K); const bf16* V = (const bf16*)(F.ws + WS_V); bf16* OB = (bf16*)(F.ws + WS_OB);
    LAS unsigned char* L = F.lds + RING_OFF;
    const int qrow = b * SEQ + qb * 128 + rg * 32 + r32;
    bf16x8 qf[4];
#pragma unroll
    for (int ks = 0; ks < 4; ++ks) qf[ks] = *(const bf16x8*)(Q + (size_t)qrow * QK_W + h * 128 + t * 64 + 16 * ks + 8 * hi);
    const int ntile = 2 * qb + 2, mylim = 2 * qb + (rg >> 1);
    const int kr0 = tid >> 4, cc = tid & 15;
    const size_t gbase = (size_t)(b * SEQ) * 512 + h * 128 + cc * 8;
    v4u kregA[2], vregA[2], kregB[2], vregB[2];
#define AT_LOAD(j, kreg, vreg) do { _Pragma("unroll") for (int i_ = 0; i_ < 2; ++i_) { const size_t o_ = gbase + (size_t)(64 * (j) + kr0 + 32 * i_) * 512; kreg[i_] = *(const v4u*)(K + o_); vreg[i_] = *(const v4u*)(V + o_); } } while (0)
#define AT_STORE(buf, kreg, vreg) do { _Pragma("unroll") for (int i_ = 0; i_ < 2; ++i_) { *(LAS v4u*)(L + (buf) * AT_BUF + (kr0 + 32 * i_) * AT_KP + cc * 16) = kreg[i_]; \
        *(LAS v4u*)(L + (buf) * AT_BUF + AT_KB + (kr0 + 32 * i_) * AT_VP + cc * 16) = vreg[i_]; } } while (0)
    AT_LOAD(0, kregB, vregB); AT_LOAD(1, kregA, vregA); AT_STORE(0, kregB, vregB);
    __syncthreads();
    f32x16 o[4] = {{0}, {0}, {0}, {0}};
    float mrun = -60.0f, lrun = 0.f;
    f32x16 negm;
#pragma unroll
    for (int r = 0; r < 16; ++r) negm[r] = 60.0f;
    const int g4 = lane >> 4, i16 = lane & 15;
    const int vlane = (4 * (g4 >> 1) + (i16 >> 2)) * AT_VP + (16 * (g4 & 1) + 4 * (i16 & 3)) * 2;
#define AT_COMPUTE(j, buf) do { \
        if (j <= mylim) { \
            const LAS unsigned char* Kb = L + buf * AT_BUF + t * 128 + hi * 16 + r32 * AT_KP; \
            const LAS unsigned char* Vb = L + buf * AT_BUF + AT_KB + vlane; \
            f32x16 s0, s1; \
        _Pragma("unroll") \
            for (int ks = 0; ks < 4; ++ks) { const bf16x8 k0 = *(const LAS bf16x8*)(Kb + ks * 32), k1 = *(const LAS bf16x8*)(Kb + 32 * AT_KP + ks * 32); \
                if (ks == 0) { s0 = __builtin_amdgcn_mfma_f32_32x32x16_bf16(k0, qf[0], negm, 0, 0, 0); s1 = __builtin_amdgcn_mfma_f32_32x32x16_bf16(k1, qf[0], negm, 0, 0, 0); } \
                else { s0 = __builtin_amdgcn_mfma_f32_32x32x16_bf16(k0, qf[ks], s0, 0, 0, 0); s1 = __builtin_amdgcn_mfma_f32_32x32x16_bf16(k1, qf[ks], s1, 0, 0, 0); } } \
            float mx = fmaxf(fmaxf(s0[0], s0[1]), s0[2]); \
        _Pragma("unroll") \
            for (int r = 3; r < 15; r += 2) mx = fmaxf(fmaxf(mx, s0[r]), s0[r + 1]); \
            mx = fmaxf(mx, s0[15]); \
        _Pragma("unroll") \
            for (int r = 0; r < 16; r += 2) mx = fmaxf(fmaxf(mx, s1[r]), s1[r + 1]); \
            mx = fmaxf(mx, __shfl_xor(mx, 32)); \
            if (__builtin_amdgcn_ballot_w64(mx > 8.0f) != 0ull) { \
                const float dm = (mx > 8.0f) ? mx : 0.0f, alpha = __builtin_amdgcn_exp2f(-dm); lrun *= alpha; mrun += dm; \
        _Pragma("unroll") \
                for (int dt = 0; dt < 4; ++dt) o[dt] *= alpha; \
        _Pragma("unroll") \
                for (int r = 0; r < 16; ++r) { s0[r] -= dm; s1[r] -= dm; negm[r] = -mrun; } } \
            float ps = 0.f; \
        _Pragma("unroll") \
            for (int r = 0; r < 16; ++r) { s0[r] = __builtin_amdgcn_exp2f(s0[r]); s1[r] = __builtin_amdgcn_exp2f(s1[r]); ps += s0[r] + s1[r]; } \
            lrun += ps; \
        _Pragma("unroll") \
            for (int s = 0; s < 4; ++s) { \
                v4u pk; const int rb = 8 * (s & 1); \
                if (s < 2) { pk.x = cvt_pk_bf16(s0[rb], s0[rb + 1]); pk.y = cvt_pk_bf16(s0[rb + 2], s0[rb + 3]); pk.z = cvt_pk_bf16(s0[rb + 4], s0[rb + 5]); pk.w = cvt_pk_bf16(s0[rb + 6], s0[rb + 7]); } \
                else       { pk.x = cvt_pk_bf16(s1[rb], s1[rb + 1]); pk.y = cvt_pk_bf16(s1[rb + 2], s1[rb + 3]); pk.z = cvt_pk_bf16(s1[rb + 4], s1[rb + 5]); pk.w = cvt_pk_bf16(s1[rb + 6], s1[rb + 7]); } \
                const bf16x8 pf = __builtin_bit_cast(bf16x8, pk); \
        _Pragma("unroll") \
                for (int dt = 0; dt < 4; ++dt) { const s16x4 lo = vtr(Vb + s * 16 * AT_VP + dt * 64), hh = vtr(Vb + s * 16 * AT_VP + dt * 64 + 8 * AT_VP); \
                    const bf16x8 vf = (bf16x8){lo[0], lo[1], lo[2], lo[3], hh[0], hh[1], hh[2], hh[3]}; \
                    o[dt] = __builtin_amdgcn_mfma_f32_32x32x16_bf16(vf, pf, o[dt], 0, 0, 0); } } \
        } \
    } while (0)
    for (int j = 0; j < ntile; j += 2) {
        { const int jn = (j + 2 < ntile) ? j + 2 : ntile - 1; AT_LOAD(jn, kregB, vregB); }
        AT_COMPUTE(j, 0);
        AT_STORE(1, kregA, vregA);
        __syncthreads();
        { const int jn = (j + 3 < ntile) ? j + 3 : ntile - 1; AT_LOAD(jn, kregA, vregA); }
        AT_COMPUTE(j + 1, 1);
        AT_STORE(0, kregB, vregB);
        __syncthreads();
    }
#undef AT_COMPUTE
#undef AT_LOAD
#undef AT_STORE
    const float ltot = lrun + __shfl_xor(lrun, 32), inv = 1.0f / ltot;
    LAS float* EX = (LAS float*)L + rg * 4096;
    if (t == 1) {
        const float sc = inv * lam;
#pragma unroll
        for (int dt = 0; dt < 4; ++dt)
#pragma unroll
            for (int r = 0; r < 16; ++r) EX[(dt * 16 + r) * 64 + lane] = o[dt][r] * sc;
    }
    __syncthreads();
    if (t == 0) {
        float ss = 0.f;
#pragma unroll
        for (int dt = 0; dt < 4; ++dt)
#pragma unroll
            for (int r = 0; r < 16; ++r) { const float y = o[dt][r] * inv - EX[(dt * 16 + r) * 64 + lane]; o[dt][r] = y; ss += y * y; }
        ss += __shfl_xor(ss, 32);
        const float rn = (1.0f - LAMBDA_INIT) / sqrtf(ss * (1.0f / 128.0f) + RMS_EPS);
        const float* sg = F.in[I_SUBLN];
        f32x4 ggv[4][4];
#pragma unroll
        for (int dt = 0; dt < 4; ++dt)
#pragma unroll
            for (int rq = 0; rq < 4; ++rq) ggv[dt][rq] = *(const f32x4*)(sg + 32 * dt + 8 * rq + 4 * hi);
#pragma unroll
        for (int dt = 0; dt < 4; ++dt)
#pragma unroll
            for (int rq = 0; rq < 4; ++rq) { const int d = 32 * dt + 8 * rq + 4 * hi; const f32x4 gg = ggv[dt][rq];
                v2u wv; wv.x = cvt_pk_bf16(o[dt][4 * rq] * rn * gg[0], o[dt][4 * rq + 1] * rn * gg[1]); wv.y = cvt_pk_bf16(o[dt][4 * rq + 2] * rn * gg[2], o[dt][4 * rq + 3] * rn * gg[3]);
                *(v2u*)(OB + (size_t)qrow * V_W + h * 128 + d) = wv; }
    }
    __syncthreads();
}

constexpr int CW_CNT_STRIDE = 64;
__device__ __forceinline__ void router_phase(Frame& F, const bool dummy = false) {
    const int lane = F.lane, tid = F.tid, w = F.wave, tt = w >> 1, kh = w & 1;
    LAS float* LG = (LAS float*)(F.lds + RING_OFF);
    LAS float* SS = LG + 4 * 2 * 16 * 33;
    LAS int* LC = (LAS int*)(SS + 128);
    const float* Hf = F.out; const float* wrT = (const float*)(F.ws + WS_WRT); const float* br = F.in[I_BR];
    float* rs2 = (float*)(F.ws + (dummy ? WS_YS2 : WS_RS2)); float* wslot = (float*)(F.ws + (dummy ? WS_YS2 + MiB : WS_WSLOT)); int* elist = (int*)(F.ws + (dummy ? WS_YS2 + 2 * MiB : WS_ELIST));
    unsigned* cnt = (unsigned*)(F.ctl + CW_CNT + (dummy ? 32 : 0));
    const int i16 = lane & 15, kq = lane >> 4;
    for (int tg = F.vcu; tg < M / 64; tg += F.G) {
        if (tid < 64) LC[tid] = 0;
        const int tok0 = tg * 64 + tt * 16;
        f32x4 a0 = {0.f, 0.f, 0.f, 0.f}, a1 = {0.f, 0.f, 0.f, 0.f}; float ssq = 0.f;
        const float* hp = Hf + (size_t)(tok0 + i16) * DM + kh * 512 + 4 * kq; const float* w0 = wrT + (size_t)i16 * DM + kh * 512 + 4 * kq; const float* w1 = w0 + 16 * DM;
#pragma unroll 8
        for (int s = 0; s < 32; ++s) { const f32x4 a = *(const f32x4*)(hp + 16 * s), b0 = *(const f32x4*)(w0 + 16 * s), b1 = *(const f32x4*)(w1 + 16 * s);
            ssq += (a[0] * a[0] + a[1] * a[1]) + (a[2] * a[2] + a[3] * a[3]);
#pragma unroll
            for (int q = 0; q < 4; ++q) { a0 = __builtin_amdgcn_mfma_f32_16x16x4f32(a[q], b0[q], a0, 0, 0, 0); a1 = __builtin_amdgcn_mfma_f32_16x16x4f32(a[q], b1[q], a1, 0, 0, 0); } }
        ssq += __shfl_xor(ssq, 16); ssq += __shfl_xor(ssq, 32);
        LAS float* lg = LG + (tt * 2 + kh) * 16 * 33;
#pragma unroll
        for (int r = 0; r < 4; ++r) { lg[(4 * kq + r) * 33 + i16] = a0[r]; lg[(4 * kq + r) * 33 + 16 + i16] = a1[r]; }
        if (kq == 0) SS[(tt * 2 + kh) * 16 + i16] = ssq;
        __syncthreads();
        int ti[4]; float wv[4]; int lpos[4]; float rsv = 0.f;
        if (tid < 64) {
            const int t4 = tid >> 4, t16 = tid & 15;
            rsv = 1.0f / sqrtf((SS[(t4 * 2) * 16 + t16] + SS[(t4 * 2 + 1) * 16 + t16]) * (1.0f / DM) + RMS_EPS);
            float lgv[32];
#pragma unroll
            for (int e = 0; e < 32; ++e) lgv[e] = (LG[((t4 * 2) * 16 + t16) * 33 + e] + LG[((t4 * 2 + 1) * 16 + t16) * 33 + e]) * rsv + br[e];
            float tv[4];
#pragma unroll
            for (int k = 0; k < 4; ++k) { float best = -3.0e38f; int bi = 0;
#pragma unroll
                for (int e = 0; e < 32; ++e) { const bool tk = lgv[e] > best; best = tk ? lgv[e] : best; bi = tk ? e : bi; }
                tv[k] = best; ti[k] = bi;
#pragma unroll
                for (int e = 0; e < 32; ++e) lgv[e] = (e == bi) ? -3.0e38f : lgv[e]; }
            const float e1 = __expf(tv[1] - tv[0]), e2 = __expf(tv[2] - tv[0]), e3 = __expf(tv[3] - tv[0]), den = 1.0f / (1.0f + e1 + e2 + e3);
            wv[0] = den; wv[1] = e1 * den; wv[2] = e2 * den; wv[3] = e3 * den;
#pragma unroll
            for (int k = 0; k < 4; ++k) lpos[k] = __hip_atomic_fetch_add(LC + ti[k], 1, __ATOMIC_RELAXED, __HIP_MEMORY_SCOPE_WORKGROUP);
        }
        __syncthreads();
        if (tid < 32) { const int c = LC[tid]; LC[32 + tid] = c ? (int)atomicAdd(cnt + tid * CW_CNT_STRIDE, (unsigned)c) : 0; }
        __syncthreads();
        if (tid < 64) {
            const int tok = tg * 64 + tid;
            rs2[tok] = rsv;
#pragma unroll
            for (int k = 0; k < 4; ++k) { elist[ti[k] * M + LC[32 + ti[k]] + lpos[k]] = tok * 4 + k; wslot[tok * 4 + k] = wv[k]; }
        }
        __syncthreads();
    }
}
__device__ __forceinline__ int moe_tables(Frame& F) {
    LAS int* T = (LAS int*)(F.lds + MOE_LDS_OFF); LAS int* cnt = T, *tstart = T + 32, *tile2e = T + 72;
    if (F.tid < 32) cnt[F.tid] = (int)__hip_atomic_load((unsigned*)(F.ctl + CW_CNT) + F.tid * CW_CNT_STRIDE, RLX_AGENT);
    __syncthreads();
    if (F.tid == 0) { int s = 0; for (int e = 0; e < 32; ++e) { tstart[e] = s; s += (cnt[e] + 255) >> 8; } tstart[32] = s; }
    __syncthreads();
    if (F.tid < 32) { for (int p = tstart[F.tid]; p < tstart[F.tid + 1]; ++p) tile2e[p] = F.tid; }
    __syncthreads();
    return tstart[32];
}
__device__ __forceinline__ void combine_phase(Frame& F, float* dst) {
    const int lane = F.lane, gw = F.vcu * NWAVES + F.wave, NGW = F.G * NWAVES;
    const bf16* YS2 = (const bf16*)(F.ws + WS_YS2);
    for (int tk = gw; tk < M; tk += NGW) {
        GAS f32x4* orow = (GAS f32x4*)(F.out + (size_t)tk * DM) + lane; GAS f32x4* drow = (GAS f32x4*)(dst + (size_t)tk * DM) + lane;
#pragma unroll
        for (int j = 0; j < 4; ++j) { f32x4 v = orow[64 * j];
#pragma unroll
            for (int k = 0; k < 4; ++k) { const v2u y = *((const GAS v2u*)(YS2 + (size_t)(tk * 4 + k) * DM) + lane + 64 * j); v += (f32x4){bflo(y.x), bfhi(y.x), bflo(y.y), bfhi(y.y)}; }
            drow[64 * j] = v; }
    }
}

struct Args { const float* in[31]; float* out; unsigned char* ws; int ph_lo, ph_hi; };
__global__ void __launch_bounds__(NWAVES * 64, 2) mk_fwd(Args args) {
    extern __shared__ __attribute__((aligned(16))) unsigned char lds[];
    Frame F;
    F.lds = (LAS unsigned char*)lds;
    F.MISC = (volatile LAS unsigned*)(F.lds + MISC_OFF);
    F.tid = threadIdx.x; F.lane = F.tid & 63; F.wave = __builtin_amdgcn_readfirstlane(F.tid >> 6);
    F.G = gridDim.x; { const int bx = blockIdx.x; F.vcu = (F.G % 8 == 0) ? (bx % 8) * (F.G / 8) + bx / 8 : bx; }
    F.ws = args.ws; F.ctl = (gu32*)(args.ws + WS_CTL); F.out = args.out;
#pragma unroll
    for (int i = 0; i < 31; ++i) F.in[i] = args.in[i];
    for (int u = F.tid; u < 64; u += NWAVES * 64) F.MISC[u] = 0u;
    __syncthreads();
    XcdBarrier bar; bar.bar = (unsigned*)(F.ctl + CW_BAR); bar.x = 0; bar.st = nullptr;
    if (N_LAUNCHES != PER_PHASE) bar = xcd_barrier_post((unsigned*)(F.ctl + CW_BAR), F.MISC + 8);
#define GRID_BAR() do { if (N_LAUNCHES != PER_PHASE) xcd_barrier(bar); } while (0)
    const int lo = args.ph_lo, hi = args.ph_hi;
#define IN(k) (lo <= (k) && (k) < hi)
#define BOTH(k) (IN(k) && IN((k) + 1))
    unsigned char* ws = args.ws;

    if (IN(0)) { for (int rep = 0; rep < NREP(0); ++rep) { p0_prologue(F); if (BOTH(0)) GRID_BAR(); } }

    if (IN(1)) for (int rep = 0; rep < NREP(1); ++rep) {
        pg8::Gemm g{(const bf16*)(ws + WS_XN), (const bf16*)(ws + WS_WIN), M, IN_W, DM}; pg8::StaticOrder S; S.init(M, IN_W, F.G, (int)blockIdx.x);
        EpiInProj E{(bf16*)(ws + WS_U), (bf16*)(ws + WS_Q), (bf16*)(ws + WS_K), (bf16*)(ws + WS_V), (bf16*)(ws + WS_G1), (bf16*)(ws + WS_G2), F.in[I_BGATE], F.in[I_QG], F.in[I_KG]};
        pg8::gemm_phase<EpiInProj, pg8::StaticOrder, true>(F.lds + RING_OFF, g, S, E);
        if (BOTH(1)) GRID_BAR();
    }

    if (PROBE_REP == 30 && IN(1) && IN(2)) { GRID_BAR(); GRID_BAR(); GRID_BAR(); GRID_BAR(); }
    if (IN(2)) {
        for (int rep = 0; rep < NREP(20); ++rep) for (int u = F.vcu; u < BATCH * SSM_G; u += F.G) { const int g = (u >> 5) * 4 + ((u & 31) >> 3), b = u & 7; s5_unit(F, b, g); }
        float lam;
        { const float a = wave_sum(F.in[I_LQ1][F.lane] * F.in[I_LK1][F.lane]), c = wave_sum(F.in[I_LQ2][F.lane] * F.in[I_LK2][F.lane]); lam = __expf(a) - __expf(c) + LAMBDA_INIT; }
        for (int rep = 0; rep < NREP(21); ++rep) for (int u = F.vcu; u < BATCH * ATT_H * 8; u += F.G) { const int bh = u >> 3, qp = u & 7; attn_unit(F, bh >> 2, bh & 3, 15 - qp, lam); attn_unit(F, bh >> 2, bh & 3, qp, lam); }
        if (BOTH(2)) GRID_BAR();
    }

    if (IN(3)) for (int rep = 0; rep < NREP(3); ++rep) {
        { pg8::Gemm g{(const bf16*)(ws + WS_YG), (const bf16*)(ws + WS_WGLU), M, 512, 512}; pg8::StaticOrder S; S.init(M, 512, F.G, (int)blockIdx.x);
          EpiMix<0> E{(const bf16*)(ws + WS_YG), nullptr, (bf16*)(ws + WS_YS), F.in[I_BGLU], 512};
          pg8::gemm_phase<EpiMix<0>, pg8::StaticOrder, true>(F.lds + RING_OFF, g, S, E); }
        if (BOTH(3)) GRID_BAR();
    }

    if (IN(4)) for (int rep = 0; rep < NREP(4); ++rep) {
        pg8::Gemm g{(const bf16*)(ws + WS_OB), (const bf16*)(ws + WS_WPS), M, DM, 512};
        ChainOrder S; S.so.init(M, DM, F.G, (int)blockIdx.x); S.A_att = (const bf16*)(ws + WS_OB); S.A_ssm = (const bf16*)(ws + WS_YS);
        EpiChain E{(const bf16*)(ws + WS_G1), (const bf16*)(ws + WS_G2), (bf16*)(ws + WS_MX)};
        pg8::gemm_phase<EpiChain, ChainOrder, true>(F.lds + RING_OFF, g, S, E);
        if (BOTH(4)) GRID_BAR();
    }

    if (IN(5)) for (int rep = 0; rep < NREP(5); ++rep) {
        pg8::Gemm g{(const bf16*)(ws + WS_MX), (const bf16*)(ws + WS_WOUT), M, DM, DM}; pg8::StaticOrder S; S.init(M, DM, F.G, (int)blockIdx.x);
        EpiOut E{F.in[I_X], F.out, ws + WS_HB};
        pg8::gemm_phase<EpiOut, pg8::StaticOrder, true>(F.lds + RING_OFF, g, S, E);
        if (BOTH(5)) GRID_BAR();
    }

    if (IN(6)) { router_phase(F); if (BOTH(6)) GRID_BAR(); }

    if (IN(7)) for (int rep = 0; rep < NREP(7); ++rep) {
        const int nmt = moe_tables(F); LAS int* T = (LAS int*)(F.lds + MOE_LDS_OFF);
        pg8::Gemm g{(const bf16*)(ws + WS_HB), (const bf16*)(ws + WS_WUP), M, UPW, DM};
        MoeOrder<8, true> S{nmt * 8, F.G, F.vcu, T, T + 32, T + 72, (const int*)(ws + WS_ELIST)};
        EpiUp E{ws + WS_ACT, F.in[I_BUP], (const float*)(ws + WS_RS2)};
        pg8::gemm_phase<EpiUp, MoeOrder<8, true>, true, true, true, true>(F.lds + RING_OFF, g, S, E, 127, 122);
        if (BOTH(7)) GRID_BAR();
    }

    if (IN(8)) for (int rep = 0; rep < NREP(8); ++rep) {
        const int nmt = moe_tables(F); LAS int* T = (LAS int*)(F.lds + MOE_LDS_OFF);
        pg8::Gemm g{(const bf16*)(ws + WS_ACT), (const bf16*)(ws + WS_WDN), MOE_ROWS_MAX, DM, DE};
        MoeOrder<4, false> S{nmt * 4, F.G, F.vcu, T, T + 32, T + 72, (const int*)(ws + WS_ELIST)};
        EpiDown E{(bf16*)(ws + WS_YS2), F.in[I_BDN], (const float*)(ws + WS_WSLOT)};
        pg8::gemm_phase<EpiDown, MoeOrder<4, false>, true, true, true, true>(F.lds + RING_OFF, g, S, E, 125, 122);
        if (BOTH(8)) GRID_BAR();
    }

    if (IN(9)) { combine_phase(F, F.out); }
    if (IN(16)) router_phase(F, true);
    if (IN(19)) combine_phase(F, (float*)(ws + WS_TA));
#undef IN
#undef BOTH
#undef GRID_BAR
}

extern "C" void kernel_launch(void* const* d_in, const int* in_sizes, int n_in, void* d_out, int out_size, void* d_ws, size_t ws_size, hipStream_t stream) {
    static int grid = 0;
    if (grid == 0) {
        if (n_in != 31 || in_sizes[0] != M * DM || out_size != M * DM || ws_size < WS_END) {
            fprintf(stderr, "kernel_launch: unexpected shapes (n_in %d, in0 %d, out %d, ws %zu < %zu); nothing launched\n", n_in, n_in > 0 ? in_sizes[0] : -1, out_size, ws_size, (size_t)WS_END); grid = -1; return; }
        int dev = 0, cus = 0;
        if (hipGetDevice(&dev) != hipSuccess || hipDeviceGetAttribute(&cus, hipDeviceAttributeMultiprocessorCount, dev) != hipSuccess) { grid = -1; return; }
        if (hipFuncSetAttribute((const void*)mk_fwd, hipFuncAttributeMaxDynamicSharedMemorySize, LDS_BYTES) != hipSuccess) { fprintf(stderr, "kernel_launch: hipFuncSetAttribute failed\n"); grid = -1; return; }
        int per_cu = 0;
        if (hipOccupancyMaxActiveBlocksPerMultiprocessor(&per_cu, (const void*)mk_fwd, NWAVES * 64, LDS_BYTES) != hipSuccess || per_cu < 1) fprintf(stderr, "kernel_launch: occupancy query reports %d\n", per_cu);
        (void)hipGetLastError();
        grid = cus;
    }
    if (grid < 0) return;
    (void)hipMemsetAsync((char*)d_ws + WS_CTL, 0, CTL_ZERO_BYTES, stream);
    Args a{};
    for (int i = 0; i < 31; ++i) a.in[i] = (const float*)d_in[i];
    a.out = (float*)d_out; a.ws = (unsigned char*)d_ws;
    if (N_LAUNCHES == 1) { a.ph_lo = 0; a.ph_hi = PER_PHASE; hipLaunchKernelGGL(mk_fwd, dim3(grid), dim3(NWAVES * 64), LDS_BYTES, stream, a); }
    else for (int p = 0; p < PER_PHASE; ++p) { a.ph_lo = p; a.ph_hi = p + 1; if (PROBE_REP - 110 == p) { a.ph_lo = p + 10; a.ph_hi = p + 11; hipLaunchKernelGGL(mk_fwd, dim3(grid), dim3(NWAVES * 64), LDS_BYTES, stream, a); a.ph_lo = p; a.ph_hi = p + 1; }
        for (int rep = 0; rep < ((PROBE_REP - 100 == p) ? 2 : 1); ++rep) hipLaunchKernelGGL(mk_fwd, dim3(grid), dim3(NWAVES * 64), LDS_BYTES, stream, a); }
}
```

```cpp
#include <hip/hip_runtime.h>
#include <cstdio>
#include <cstdint>

#ifndef MK_N_LAUNCHES
#define MK_N_LAUNCHES 1
#endif
#ifndef PROBE_REP
#define PROBE_REP -1
#endif
#define NREP(k) ((PROBE_REP == (k)) ? 2 : 1)

namespace pg8 {
#define PG8_LAS __attribute__((address_space(3)))
typedef unsigned short bf16_t;
typedef short bf16x8 __attribute__((ext_vector_type(8)));
typedef float f32x4 __attribute__((ext_vector_type(4)));
typedef unsigned u32x4 __attribute__((ext_vector_type(4)));
typedef unsigned u32x2 __attribute__((ext_vector_type(2)));
constexpr int BM = 256, BK = 64, HALF = 128, HTB = HALF * BK * 2  , STAGE_BYTES = 8 * HTB, NXCD = 8, WGM = 8;

__host__ __device__ __forceinline__ int lds_byte(int r, int c) { const int st = (r >> 4) * 2 + (c >> 5), rr = r & 15, cc = c & 31, ob = rr * 64 + cc * 2; return st * 1024 + (ob ^ (((ob >> 9) & 1) * 48)); }
__host__ __device__ __forceinline__ void stage_rc(int b, int& R, int& C) { const int st = b / 1024, sb = b % 1024, swz = sb ^ (((sb >> 9) & 1) * 48); R = (st >> 1) * 16 + swz / 64; C = (st & 1) * 32 + (swz % 64) / 2; }
__host__ __device__ __forceinline__ int perm32(int rho) { const int n = rho >> 4, i = rho & 15; return 8 * (i >> 2) + 4 * n + (i & 3); }

struct Unit { int pm, pn; };
struct Gemm { const bf16_t* A; const bf16_t* Bt; int M, N, K; };

struct StaticOrder {
    int nM, nN, nwg, G, c;
    __host__ __device__ void init(int M, int N, int G_, int c_) { nM = M / BM; nN = N / BM; nwg = nM * nN; G = G_; c = c_; }
    __host__ __device__ bool next(int i, Unit& u) const {
        const long L = (long)i * G + c; if (L >= nwg) return false;
        int wgid = (int)L; { const int q = nwg / NXCD, r = nwg % NXCD, xcd = wgid % NXCD, off = wgid / NXCD; wgid = (xcd < r ? xcd * (q + 1) : r * (q + 1) + (xcd - r) * q) + off; }
        const int nig = WGM * nN, gid = wgid / nig, fm = gid * WGM, gsz = (nM - fm) < WGM ? (nM - fm) : WGM;
        u.pm = fm + ((wgid % nig) % gsz); u.pn = (wgid % nig) / gsz; return true;
    }
    __device__ __forceinline__ int row_slot(const Unit&, int) const { return 0; }
    __device__ __forceinline__ int a_row(const Unit& u, int r, int) const { return u.pm * BM + r; }
    __device__ __forceinline__ const char* a_base(const Gemm& g, const Unit& u, size_t tstep) const { return (const char*)g.A + (size_t)u.pm * tstep; }
    __device__ __forceinline__ void a_ready(const Unit&) const {}
    __device__ __forceinline__ void done(const Unit&) const {}
};

__device__ __forceinline__ unsigned cvt_pk_bf16(float lo, float hi) { unsigned r; asm volatile("v_cvt_pk_bf16_f32 %0, %1, %2" : "=v"(r) : "v"(lo), "v"(hi)); return r; }

typedef int v8i __attribute__((ext_vector_type(8)));
typedef int v4i __attribute__((ext_vector_type(4)));
template <class Epi, class Sched, bool ALIGN_EPI = false, bool ROWTAB = false, bool GATHER = false, bool FP8 = false>
__device__ __forceinline__ void gemm_phase(PG8_LAS unsigned char* lds, const Gemm g, const Sched& S, const Epi& E, const int sA8 = 127, const int sB8 = 127) {
    static_assert(!GATHER || ROWTAB, "GATHER needs ROWTAB");
    const int tid = threadIdx.x, wid = __builtin_amdgcn_readfirstlane(tid >> 6), lane = tid & 63, wr = wid >> 2, wc = wid & 3, fr = lane & 15, fq = lane >> 4;
    const int K = g.K, RB = FP8 ? K : 2 * K  , nt = RB / (2 * BK);
    unsigned voffA[2], voffB[2];
#pragma unroll
    for (int i = 0; i < 2; ++i) { int R, C; stage_rc(tid * 16 + i * 8192, R, C); const int Rb = Epi::PERM ? ((R & ~31) + perm32(R & 31)) : R;
        voffA[i] = (unsigned)(R * RB + 2 * C); voffB[i] = (unsigned)(Rb * RB + 2 * C); }
    unsigned vA[2][2] = {{0u, 0u}, {0u, 0u}};
    const size_t kstep = (size_t)(BK * 2);
    const size_t hstep = (size_t)HALF * RB;
    const size_t tstep = 2 * hstep;
    const unsigned ldsw = (unsigned)wid * 1024u;
    const int aoff = FP8 ? lds_byte(wr * 64 + fr, fq * 16) : lds_byte(wr * 64 + fr, fq * 8), boff = FP8 ? lds_byte(wc * 32 + fr, fq * 16) : lds_byte(wc * 32 + fr, fq * 8);
    PG8_LAS int* tab = (PG8_LAS int*)(lds + STAGE_BYTES);
#define PG8_SA(b, h) (((b) * 2 + (h)) * HTB)
#define PG8_SB(b, h) ((4 + (b) * 2 + (h)) * HTB)
#define PG8_STAGE(bufoff, gbase, voff) do { _Pragma("unroll") for (int _i = 0; _i < 2; ++_i) \
        __builtin_amdgcn_global_load_lds((const unsigned*)((const char*)(gbase) + (voff)[_i]), (PG8_LAS unsigned*)(lds + (bufoff) + ldsw + _i * 8192), 16, 0, 0); } while (0)
#define PG8_STAGE_A(bufoff, kbase, h) do { if constexpr (GATHER) { PG8_STAGE(bufoff, kbase, vA[h]); } else { PG8_STAGE(bufoff, (kbase) + (h) * hstep, voffA); } } while (0)
#define PG8_LOAD_VA(sel, un) do { _Pragma("unroll") for (int _i = 0; _i < 2; ++_i) { int R_, C_; stage_rc(tid * 16 + _i * 8192, R_, C_); \
        _Pragma("unroll") for (int _h = 0; _h < 2; ++_h) { const int s_ = tab[(sel) * 256 + _h * HALF + R_]; vA[_h][_i] = (unsigned)(S.a_row(un, _h * HALF + R_, s_) * RB + 2 * C_); } } } while (0)
#define PG8_LDA(dst, b, h) do { _Pragma("unroll") for (int m = 0; m < 4; ++m) _Pragma("unroll") for (int k = 0; k < 2; ++k) dst[m][k] = *(const PG8_LAS bf16x8*)(lds + PG8_SA(b, h) + (FP8 ? (aoff ^ (16 * k)) : aoff + k * 1024) + m * 2048); } while (0)
#define PG8_LDB(dst, b, h) do { _Pragma("unroll") for (int n = 0; n < 2; ++n) _Pragma("unroll") for (int k = 0; k < 2; ++k) dst[n][k] = *(const PG8_LAS bf16x8*)(lds + PG8_SB(b, h) + (FP8 ? (boff ^ (16 * k)) : boff + k * 1024) + n * 2048); } while (0)
#define PG8_V8(x) __builtin_shufflevector(__builtin_bit_cast(v4i, (x)[0]), __builtin_bit_cast(v4i, (x)[1]), 0, 1, 2, 3, 4, 5, 6, 7)
#define PG8_MMA(ai, bj, At, Bt) do { __builtin_amdgcn_s_setprio(1); if constexpr (FP8) { _Pragma("unroll") for (int m = 0; m < 4; ++m) _Pragma("unroll") for (int n = 0; n < 2; ++n) \
        acc[ai][bj][m][n] = __builtin_amdgcn_mfma_scale_f32_16x16x128_f8f6f4(PG8_V8(Bt[n]), PG8_V8(At[m]), acc[ai][bj][m][n], 0, 0, 0, sB8, 0, sA8); } else { \
        _Pragma("unroll") for (int m = 0; m < 4; ++m) _Pragma("unroll") for (int n = 0; n < 2; ++n) _Pragma("unroll") for (int k = 0; k < 2; ++k) \
        acc[ai][bj][m][n] = __builtin_amdgcn_mfma_f32_16x16x32_bf16(Bt[n][k], At[m][k], acc[ai][bj][m][n], 0, 0, 0); } __builtin_amdgcn_s_setprio(0); } while (0)
#define PG8_WAIT_V(n) asm volatile("s_waitcnt vmcnt(" #n ")" ::: "memory")
#define PG8_WAIT_L(n) asm volatile("s_waitcnt lgkmcnt(" #n ")" ::: "memory")
#define PG8_BAR __builtin_amdgcn_s_barrier()
#define PG8_SCHED __builtin_amdgcn_sched_barrier(0)
    Unit cur, nxt; int ui = 0;
    if (!S.next(0, cur)) return;
    S.a_ready(cur);
    f32x4 acc[2][2][4][2];
#pragma unroll
    for (int a = 0; a < 2; ++a)
#pragma unroll
        for (int b = 0; b < 2; ++b)
#pragma unroll
            for (int m = 0; m < 4; ++m)
#pragma unroll
                for (int n = 0; n < 2; ++n) acc[a][b][m][n] = (f32x4){0.f, 0.f, 0.f, 0.f};
    bf16x8 At[4][2], B0[2][2], B1[2][2];
    if constexpr (ROWTAB) {
        if (tid < 256) tab[tid] = S.row_slot(cur, tid);
        PG8_WAIT_L(0); PG8_BAR; asm volatile("" ::: "memory");
        if constexpr (GATHER) { PG8_LOAD_VA(0, cur); }
    }
    const char* cA = GATHER ? (const char*)g.A : S.a_base(g, cur, tstep); const char* cB = (const char*)g.Bt + (size_t)cur.pn * tstep;
    PG8_STAGE(PG8_SB(0, 0), cB, voffB); PG8_STAGE(PG8_SB(0, 1), cB + hstep, voffB); PG8_STAGE_A(PG8_SA(0, 0), cA, 0); PG8_STAGE_A(PG8_SA(0, 1), cA, 1);
    if (wr == 1) PG8_BAR;
    PG8_WAIT_V(2); PG8_BAR;
    PG8_STAGE(PG8_SB(1, 0), cB + kstep, voffB); PG8_STAGE_A(PG8_SA(1, 0), cA + kstep, 0); PG8_STAGE(PG8_SB(1, 1), cB + hstep + kstep, voffB);
    PG8_WAIT_V(6); PG8_BAR;
    for (;;) {
        const bool has_next = S.next(ui + 1, nxt);
        if (has_next) S.a_ready(nxt);
        if constexpr (ROWTAB) { if (has_next && tid < 256) tab[((ui + 1) % 3) * 256 + tid] = S.row_slot(nxt, tid); }
        const char* nA = has_next ? (GATHER ? (const char*)g.A : S.a_base(g, nxt, tstep)) : cA; const char* nB = has_next ? (const char*)g.Bt + (size_t)nxt.pn * tstep : cB;
        for (int t = 0; t < nt; t += 2) {
            const bool last = (t == nt - 2);
            const char* a1 = cA + (size_t)(t + 1) * kstep;
            const char* a2 = last ? nA : cA + (size_t)(t + 2) * kstep; const char* b2 = last ? nB : cB + (size_t)(t + 2) * kstep;
            const char* a3 = a2 + kstep; const char* b3 = b2 + kstep;
            PG8_LDB(B0, 0, 0); PG8_LDB(B1, 0, 1); PG8_SCHED; PG8_LDA(At, 0, 0); PG8_STAGE_A(PG8_SA(1, 1), a1, 1);
            if constexpr (GATHER) { if (last && has_next) { PG8_LOAD_VA((ui + 1) % 3, nxt); } }
            PG8_WAIT_V(8); PG8_WAIT_L(0); PG8_BAR; PG8_MMA(0, 0, At, B0); PG8_MMA(0, 1, At, B1); PG8_BAR; PG8_SCHED;
            PG8_LDA(At, 0, 1); PG8_STAGE(PG8_SB(0, 0), b2, voffB); PG8_STAGE(PG8_SB(0, 1), b2 + hstep, voffB); PG8_STAGE_A(PG8_SA(0, 0), a2, 0);
            PG8_WAIT_V(8); PG8_WAIT_L(0); PG8_BAR; PG8_MMA(1, 0, At, B0); PG8_MMA(1, 1, At, B1); PG8_BAR; PG8_SCHED;
            PG8_LDB(B0, 1, 0); PG8_LDB(B1, 1, 1); PG8_SCHED; PG8_LDA(At, 1, 0); PG8_STAGE_A(PG8_SA(0, 1), a2, 1);
            PG8_WAIT_V(8); PG8_WAIT_L(0); PG8_BAR; PG8_MMA(0, 0, At, B0); PG8_MMA(0, 1, At, B1); PG8_BAR; PG8_SCHED;
            PG8_LDA(At, 1, 1); PG8_STAGE(PG8_SB(1, 0), b3, voffB); PG8_STAGE(PG8_SB(1, 1), b3 + hstep, voffB); PG8_STAGE_A(PG8_SA(1, 0), a3, 0);
            PG8_WAIT_V(8); PG8_WAIT_L(0); PG8_BAR; PG8_MMA(1, 0, At, B0); PG8_MMA(1, 1, At, B1); PG8_BAR; PG8_SCHED;
        }
        if constexpr (ALIGN_EPI) { if (wr == 0) PG8_BAR; }
        E(acc, cur, wr, wc, fr, fq, (const PG8_LAS int*)(tab + (ui % 3) * 256));
        S.done(cur);
        if (!has_next) break;
        if (!E.keep(cur)) {
#pragma unroll
        for (int a = 0; a < 2; ++a)
#pragma unroll
            for (int b = 0; b < 2; ++b)
#pragma unroll
                for (int m = 0; m < 4; ++m)
#pragma unroll
                    for (int n = 0; n < 2; ++n) acc[a][b][m][n] = (f32x4){0.f, 0.f, 0.f, 0.f}; }
        cur = nxt; cA = nA; cB = nB; ++ui;
        if constexpr (ALIGN_EPI) { if (wr == 1) PG8_BAR; }
    }
    PG8_WAIT_V(0);
    if constexpr (!ALIGN_EPI) { if (wr == 0) PG8_BAR; }
    PG8_BAR;
#undef PG8_SA
#undef PG8_SB
#undef PG8_STAGE
#undef PG8_STAGE_A
#undef PG8_LOAD_VA
#undef PG8_LDA
#undef PG8_LDB
#undef PG8_MMA
#undef PG8_V8
#undef PG8_WAIT_V
#undef PG8_WAIT_L
#undef PG8_BAR
#undef PG8_SCHED
}
}

constexpr int NWAVES = 8;
constexpr int N_LAUNCHES = MK_N_LAUNCHES;
constexpr int PER_PHASE = 10;
constexpr int BATCH = 8, SEQ = 2048, DM = 1024, M = BATCH * SEQ;
constexpr int SSM_W = 512, SSM_G = 32, SSM_H = 16, SSM_P = 64, SSM_T = 16, SSM_NC = SEQ / SSM_T;
constexpr int ATT_H = 4, ATT_D = 64, ATT_V = 128, QK_W = 512, V_W = 512;
constexpr int IN_W = 4096;
constexpr int NE = 32, TOPK = 4, DE = 1024, UPW = 2048;
constexpr float RMS_EPS = 1e-6f;
constexpr float LAMBDA_INIT = 0.2f;
constexpr float QSCALE = 0.125f * 1.4426950408889634f;
constexpr int MOE_ROWS_MAX = M * TOPK + NE * 256;
constexpr int MOE_MT_MAX = MOE_ROWS_MAX / 256;

constexpr size_t MiB = 1u << 20;
constexpr size_t WS_CTL = 0, CTL_ZERO_BYTES = 1 * MiB;
constexpr size_t WS_WIN = 2 * MiB;
constexpr size_t WS_WGLU = 10 * MiB;
constexpr size_t WS_WPS = 11 * MiB;
constexpr size_t WS_WPA = 12 * MiB;
constexpr size_t WS_WOUT = 13 * MiB;
constexpr size_t WS_WRT = 15 * MiB;
constexpr size_t WS_S5 = 16 * MiB;
constexpr size_t WS_A16 = 24 * MiB;
constexpr size_t WS_WUP = 32 * MiB;
constexpr size_t WS_WDN = 160 * MiB;
constexpr size_t WS_XN = 224 * MiB;
constexpr size_t WS_U = 256 * MiB;
constexpr size_t WS_Q = 272 * MiB, WS_K = 288 * MiB, WS_V = 304 * MiB;
constexpr size_t WS_G1 = 320 * MiB, WS_G2 = 352 * MiB;
constexpr size_t WS_YG = 384 * MiB, WS_YS = 400 * MiB, WS_OB = 416 * MiB;
constexpr size_t WS_TA = 432 * MiB, WS_MX = 464 * MiB;
constexpr size_t WS_HB = 496 * MiB;
constexpr size_t WS_RS2 = 528 * MiB;
constexpr size_t WS_WSLOT = 529 * MiB;
constexpr size_t WS_ELIST = 530 * MiB;
constexpr size_t WS_ACT = 544 * MiB;
constexpr size_t WS_YS2 = 688 * MiB;
constexpr size_t WS_END = 816 * MiB;
constexpr int CW_BAR = 4096;
constexpr int CW_Q = 20480;
constexpr int CW_CNT = 16384;

constexpr int RING_OFF = 0, RING_BYTES = 139264;
constexpr int LDSCTL_OFF = RING_BYTES, MISC_OFF = LDSCTL_OFF;
constexpr int MOE_LDS_OFF = LDSCTL_OFF + 256;
constexpr int LDS_BYTES = 147456;

#define GAS __attribute__((address_space(1)))
#define LAS __attribute__((address_space(3)))
typedef unsigned short bf16;
typedef unsigned v4u __attribute__((ext_vector_type(4)));
typedef unsigned v2u __attribute__((ext_vector_type(2)));
typedef float f32x4 __attribute__((ext_vector_type(4)));
typedef float f32x16 __attribute__((ext_vector_type(16)));
typedef short bf16x8 __attribute__((ext_vector_type(8)));
typedef short s16x4 __attribute__((ext_vector_type(4)));
typedef GAS unsigned gu32;
#define RLX_AGENT __ATOMIC_RELAXED, __HIP_MEMORY_SCOPE_AGENT
#define LDS_WAIT() asm volatile("s_waitcnt lgkmcnt(0)" ::: "memory")
#define VM_WAIT() asm volatile("s_waitcnt vmcnt(0)" ::: "memory")
using pg8::cvt_pk_bf16;
__device__ __forceinline__ unsigned f2bf(float f) { unsigned u = __builtin_bit_cast(unsigned, f); return (u + 0x7fffu + ((u >> 16) & 1u)) >> 16; }
__device__ __forceinline__ unsigned pk4_fp8(float a, float b, float c, float d) { unsigned w = 0; w = __builtin_amdgcn_cvt_pk_fp8_f32(a, b, w, false); w = __builtin_amdgcn_cvt_pk_fp8_f32(c, d, w, true); return w; }
__device__ __forceinline__ float bf2f(unsigned b) { return __builtin_bit_cast(float, b << 16); }
__device__ __forceinline__ float bflo(unsigned w) { return __builtin_bit_cast(float, w << 16); }
__device__ __forceinline__ float bfhi(unsigned w) { return __builtin_bit_cast(float, w & 0xffff0000u); }
__device__ __forceinline__ float fsigmoid(float x) { return 1.0f / (1.0f + __expf(-x)); }
__device__ __forceinline__ float gelu_tanh(float x) { const float z = 1.5957691216057308f * (x + 0.044715f * x * x * x); return x / (1.0f + __expf(-z)); }
__device__ __forceinline__ int crow(int r, int hi) { return (r & 3) + 8 * (r >> 2) + 4 * hi; }
__device__ __forceinline__ float wave_sum(float v) {
#pragma unroll
    for (int o = 1; o < 64; o <<= 1) v += __shfl_xor(v, o);
    return v;
}

#define XB_TMO      128
#define XB_XCNT(j)  (256  + 64 * (j))
#define XB_XSUB(j)  (1280 + 64 * (j))
#define XB_XGEN(j)  (2304 + 64 * (j))
#define XB_TOP      3328
#define XB_TOPGEN   3392
#define XCD_BAR_WORDS 3456
#define XB_SPIN_CAP (1u << 18)
__device__ __forceinline__ unsigned xb_ld(unsigned* p)              { return __hip_atomic_load(p, __ATOMIC_RELAXED, __HIP_MEMORY_SCOPE_AGENT); }
__device__ __forceinline__ unsigned xb_add(unsigned* p, unsigned v) { return __hip_atomic_fetch_add(p, v, __ATOMIC_RELAXED, __HIP_MEMORY_SCOPE_AGENT); }
__device__ __forceinline__ unsigned xb_xcc_id() { return (unsigned)__builtin_amdgcn_s_getreg((3 << 11) | 20) & 0xFu; }
#define XB_SPIN(cond, bar) do { unsigned _sp = 0; while (cond) { __builtin_amdgcn_s_sleep(1); \
    if ((++_sp & 255u) == 0u) { if (xb_ld(&(bar)[XB_TMO])) break; if (_sp > XB_SPIN_CAP) { atomicAdd(&(bar)[XB_TMO], 1u); break; } } } } while (0)
struct XcdBarrier { unsigned* bar; unsigned x; volatile LAS unsigned* st; };
__device__ __forceinline__ XcdBarrier xcd_barrier_post(unsigned* bar, volatile LAS unsigned* st) {
    XcdBarrier b; b.bar = bar; b.x = xb_xcc_id(); b.st = st;
    if (threadIdx.x == 0) (void)xb_add(&bar[XB_XCNT(b.x)], 1u);
    return b;
}
__device__ __forceinline__ void xcd_barrier_complete(unsigned* bar, unsigned x, unsigned& nloc, unsigned& nx) {
    const unsigned G = gridDim.x * gridDim.y * gridDim.z;
    unsigned sum, cnt, mine, sp = 0u;
    for (;;) {
        sum = 0u; cnt = 0u; mine = 0u;
#pragma unroll
        for (unsigned j = 0; j < 16; ++j) { const unsigned c = xb_ld(&bar[XB_XCNT(j)]); sum += c; cnt += (c > 0u) ? 1u : 0u; mine = (j == x) ? c : mine; }
        if (sum == G) break;
        __builtin_amdgcn_s_sleep(1);
        if ((++sp & 255u) == 0u) { if (xb_ld(&bar[XB_TMO])) break; if (sp > XB_SPIN_CAP) { atomicAdd(&bar[XB_TMO], 1u); break; } }
    }
    nloc = mine > 0u ? mine : 1u; nx = cnt > 0u ? cnt : 1u;
}
__device__ __forceinline__ void xcd_barrier(const XcdBarrier& b) {
    asm volatile("s_waitcnt vmcnt(0)" ::: "memory");
    __syncthreads();
    if (threadIdx.x == 0) {
        unsigned* bar = b.bar;
        __builtin_amdgcn_s_waitcnt(0);
        unsigned nloc = b.st[0], nx = b.st[1];
        if (nloc == 0u) { xcd_barrier_complete(bar, b.x, nloc, nx); b.st[0] = nloc; b.st[1] = nx; }
        const unsigned old = xb_add(&bar[XB_XSUB(b.x)], 1u);
        const unsigned gen = old / nloc;
        if (old + 1u == (gen + 1u) * nloc) {
            __builtin_amdgcn_fence(__ATOMIC_RELEASE, "agent");
            asm volatile("s_waitcnt vmcnt(0)" ::: "memory");
            const unsigned og = xb_add(&bar[XB_TOP], 1u);
            const unsigned tg = og / nx;
            if (og + 1u == (tg + 1u) * nx) xb_add(&bar[XB_TOPGEN], 1u);
            else XB_SPIN(xb_ld(&bar[XB_TOPGEN]) == tg, bar);
            __builtin_amdgcn_fence(__ATOMIC_ACQUIRE, "agent");
            xb_add(&bar[XB_XGEN(b.x)], 1u);
            asm volatile("s_waitcnt vmcnt(0)" ::: "memory");
        } else {
            XB_SPIN(xb_ld(&bar[XB_XGEN(b.x)]) == gen, bar);
            __builtin_amdgcn_fence(__ATOMIC_ACQUIRE, "agent");
            asm volatile("s_waitcnt vmcnt(0)" ::: "memory");
        }
    }
    __syncthreads();
}

struct Frame {
    LAS unsigned char* lds;
    volatile LAS unsigned* MISC;
    gu32* ctl;
    unsigned char* ws;
    int tid, lane, wave;
    int vcu, G;
    const float* in[31];
    float* out;
};
enum { I_X = 0, I_N1G, I_WIN, I_BGATE, I_ARE, I_AIM, I_LOGDT, I_BRE, I_BIM, I_CRE, I_CIM, I_SSMD, I_WGLU, I_BGLU, I_QG, I_KG, I_LQ1, I_LK1, I_LQ2, I_LK2, I_SUBLN,
       I_WPS, I_WPA, I_WOUT, I_N2G, I_WR, I_BR, I_WUP, I_BUP, I_WDN, I_BDN };

template <int MODE>
__device__ __forceinline__ int physrow(int c) {
    if (MODE == 1) { const int w = c & 63; return (c & ~255) + 128 * (w >> 5) + 32 * ((c >> 6) & 3) + (w & 31); }
    if (MODE == 2) { const int j = c >> 1; return 256 * (j >> 7) + 128 * (c & 1) + (j & 127); }
    return c;
}
struct P0Item { const float* src; void* dst; const float* kscale; int N, K, mode, out8, k0, c0; };
__device__ __forceinline__ int physrow_rt(int mode, int c) { return mode == 1 ? physrow<1>(c) : (mode == 2 ? physrow<2>(c) : c); }
__device__ __forceinline__ void p0_item_load(const P0Item& d, f32x4 (&v)[16], int lane) {
    const int lr = lane >> 4, lc = lane & 15;
#pragma unroll
    for (int i = 0; i < 16; ++i) v[i] = __builtin_nontemporal_load((const f32x4*)(d.src + (size_t)(d.k0 + lr + 4 * i) * d.N + d.c0 + 4 * lc));
}
__device__ __forceinline__ void p0_item_finish(const P0Item& d, const f32x4 (&v)[16], LAS float* scr, int lane) {
    const int lr = lane >> 4, lc = lane & 15;
#pragma unroll
    for (int i = 0; i < 16; ++i) { const int k = lr + 4 * i; *(LAS f32x4*)(scr + k * 64 + 4 * (lc ^ ((k >> 3) & 7))) = v[i]; }
    LDS_WAIT(); asm volatile("" ::: "memory");
    const int a = lane & 7, bq = lane >> 3;
    float ks[8];
#pragma unroll
    for (int i = 0; i < 8; ++i) ks[i] = (d.kscale ? d.kscale[d.k0 + 8 * a + i] : 1.0f) * (d.out8 ? 32.0f : 1.0f);
#pragma unroll
    for (int j = 0; j < 8; ++j) { const int cl = bq + 8 * j; float x[8];
#pragma unroll
        for (int i = 0; i < 8; ++i) x[i] = scr[(8 * a + i) * 64 + 4 * ((cl >> 2) ^ a) + (cl & 3)] * ks[i];
        const size_t ro = (size_t)physrow_rt(d.mode, d.c0 + cl) * d.K + d.k0 + 8 * a;
        if (d.out8) { v2u o; o.x = pk4_fp8(x[0], x[1], x[2], x[3]); o.y = pk4_fp8(x[4], x[5], x[6], x[7]); __builtin_nontemporal_store(o, (GAS v2u*)((unsigned char*)d.dst + ro)); }
        else { v4u o; o.x = cvt_pk_bf16(x[0], x[1]); o.y = cvt_pk_bf16(x[2], x[3]); o.z = cvt_pk_bf16(x[4], x[5]); o.w = cvt_pk_bf16(x[6], x[7]); *(GAS v4u*)((bf16*)d.dst + ro) = o; } }
    LDS_WAIT(); asm volatile("" ::: "memory");
}
__device__ __forceinline__ void rms_row_to_bf16(int lane, const float* xrow, const float* g, bf16* orow) {
    const GAS f32x4* xr = (const GAS f32x4*)xrow + lane; const GAS f32x4* gr = (const GAS f32x4*)g + lane;
    f32x4 v[4]; float s = 0.f;
#pragma unroll
    for (int j = 0; j < 4; ++j) { v[j] = xr[64 * j]; s += (v[j].x * v[j].x + v[j].y * v[j].y) + (v[j].z * v[j].z + v[j].w * v[j].w); }
    const float rs = 1.0f / sqrtf(wave_sum(s) * (1.f / DM) + RMS_EPS);
    GAS unsigned long long* o8 = (GAS unsigned long long*)orow + lane;
#pragma unroll
    for (int j = 0; j < 4; ++j) { const f32x4 gg = gr[64 * j];
        o8[64 * j] = (unsigned long long)cvt_pk_bf16(v[j].x * rs * gg.x, v[j].y * rs * gg.y) | ((unsigned long long)cvt_pk_bf16(v[j].z * rs * gg.z, v[j].w * rs * gg.w) << 32); }
}
__device__ __forceinline__ void p0_s5_group(Frame& F, int g) {
    LAS float* AP = (LAS float*)(F.lds + RING_OFF);
    LAS float* BB = AP + 17 * 64 * 2;
    LAS float* CC = BB + 64 * 16 * 2;
    LAS float* KM = CC + 16 * 64 * 2;
    const float* are = F.in[I_ARE] + g * SSM_P; const float* aim = F.in[I_AIM] + g * SSM_P;
    const double dt = exp((double)F.in[I_LOGDT][g]);
    for (int e = F.tid; e < 17 * 64; e += NWAVES * 64) { const int m = e >> 6, p = e & 63; const double lr = are[p], li = aim[p];
        const double mag = exp(lr * dt * m), ang = li * dt * m; AP[e * 2] = (float)(mag * cos(ang)); AP[e * 2 + 1] = (float)(mag * sin(ang)); }
    for (int e = F.tid; e < 64 * 16; e += NWAVES * 64) { const int p = e >> 4, h = e & 15; const double lr = are[p], li = aim[p];
        const double mag = exp(lr * dt), ar = mag * cos(li * dt), ai = mag * sin(li * dt), den = lr * lr + li * li, nr = ar - 1.0, ni = ai;
        const double cr = (nr * lr + ni * li) / den, ci = (ni * lr - nr * li) / den;
        const double br = F.in[I_BRE][(size_t)(g * SSM_P + p) * SSM_H + h], bi = F.in[I_BIM][(size_t)(g * SSM_P + p) * SSM_H + h];
        BB[e * 2] = (float)(cr * br - ci * bi); BB[e * 2 + 1] = (float)(cr * bi + ci * br); }
    for (int e = F.tid; e < 16 * 64; e += NWAVES * 64) { CC[e * 2] = F.in[I_CRE][(size_t)g * 1024 + e]; CC[e * 2 + 1] = F.in[I_CIM][(size_t)g * 1024 + e]; }
    __syncthreads();
    if (F.tid < 64) { float* a16 = (float*)(F.ws + WS_A16) + (g * 64 + F.tid) * 2; a16[0] = AP[(16 * 64 + F.tid) * 2]; a16[1] = AP[(16 * 64 + F.tid) * 2 + 1]; }
    for (int e = F.tid; e < 16 * 256; e += NWAVES * 64) { const int m = e >> 8, ho = (e >> 4) & 15, hi = e & 15; float s = 0.f;
        for (int p = 0; p < 64; ++p) { const float cr = CC[(ho * 64 + p) * 2], ci = CC[(ho * 64 + p) * 2 + 1], ar = AP[(m * 64 + p) * 2], ai = AP[(m * 64 + p) * 2 + 1];
            const float tr = cr * ar - ci * ai, ti = cr * ai + ci * ar; s += tr * BB[(p * 16 + hi) * 2] - ti * BB[(p * 16 + hi) * 2 + 1]; }
        KM[e] = s; }
    __syncthreads();
    bf16* W1T = (bf16*)(F.ws + WS_S5 + (size_t)g * 262144); bf16* M2T = W1T + 128 * 256; bf16* W3T = M2T + 256 * 256;
    for (int e = F.tid; e < 128 * 256; e += NWAVES * 64) { const int n = e >> 8, k = e & 255, p = n & 63, j = k >> 4, hi = k & 15;
        const float ar = AP[((15 - j) * 64 + p) * 2], ai = AP[((15 - j) * 64 + p) * 2 + 1], br = BB[(p * 16 + hi) * 2], bi = BB[(p * 16 + hi) * 2 + 1];
        W1T[e] = (bf16)f2bf(n < 64 ? ar * br - ai * bi : ar * bi + ai * br); }
    for (int e = F.tid; e < 256 * 128; e += NWAVES * 64) { const int n = e >> 7, k = e & 127, i = n >> 4, ho = n & 15, p = k & 63;
        const float cr = CC[(ho * 64 + p) * 2], ci = CC[(ho * 64 + p) * 2 + 1], ar = AP[((i + 1) * 64 + p) * 2], ai = AP[((i + 1) * 64 + p) * 2 + 1];
        W3T[e] = (bf16)f2bf(k < 64 ? cr * ar - ci * ai : -(cr * ai + ci * ar)); }
    const float* dsk = F.in[I_SSMD] + g * 16;
    for (int e = F.tid; e < 256 * 256; e += NWAVES * 64) { const int n = e >> 8, k = e & 255, i = n >> 4, ho = n & 15, j = k >> 4, hi = k & 15;
        float v = 0.f; if (j <= i) { v = KM[((i - j) * 16 + ho) * 16 + hi]; if (i == j && ho == hi) v += dsk[ho]; }
        M2T[e] = (bf16)f2bf(v); }
    __syncthreads();
}
__device__ __forceinline__ void p0_prologue(Frame& F) {
    if (F.vcu < SSM_G) p0_s5_group(F, F.vcu);
    LAS float* scr = (LAS float*)(F.lds + RING_OFF + F.wave * 16384);
    const int gw = F.vcu * NWAVES + F.wave, NGW = F.G * NWAVES;
    { float* wrT = (float*)(F.ws + WS_WRT); const float* wr = F.in[I_WR]; const float* g2 = F.in[I_N2G];
      for (int e = gw * 64 + F.lane; e < NE * DM; e += NGW * 64) { const int ex = e >> 10, k = e & 1023; wrT[e] = g2[k] * wr[k * NE + ex]; } }
    for (int m = gw; m < M; m += NGW) rms_row_to_bf16(F.lane, F.in[I_X] + (size_t)m * DM, F.in[I_N1G], (bf16*)(F.ws + WS_XN) + (size_t)m * DM);
    constexpr int IT_IN = (DM / 64) * (IN_W / 64), IT_GLU = (512 / 64) * (512 / 64), IT_PS = (512 / 64) * (DM / 64), IT_OUT = (DM / 64) * (DM / 64);
    constexpr int IT_UP1 = (DM / 64) * (UPW / 64), IT_DN1 = (DE / 64) * (DM / 64);
    constexpr int NITEMS = IT_IN + IT_GLU + 2 * IT_PS + IT_OUT + NE * IT_UP1 + NE * IT_DN1;
#define P0_DECODE(it, d) do { int r_ = (it); int nb_; \
        if (r_ < IT_IN) { d.src = F.in[I_WIN]; d.dst = F.ws + WS_WIN; d.kscale = nullptr; d.N = IN_W; d.K = DM; d.mode = 1; d.out8 = 0; } \
        else if ((r_ -= IT_IN) < IT_GLU) { d.src = F.in[I_WGLU]; d.dst = F.ws + WS_WGLU; d.kscale = nullptr; d.N = 512; d.K = 512; d.mode = 0; d.out8 = 0; } \
        else if ((r_ -= IT_GLU) < IT_PS) { d.src = F.in[I_WPS]; d.dst = F.ws + WS_WPS; d.kscale = nullptr; d.N = DM; d.K = 512; d.mode = 0; d.out8 = 0; } \
        else if ((r_ -= IT_PS) < IT_PS) { d.src = F.in[I_WPA]; d.dst = F.ws + WS_WPA; d.kscale = nullptr; d.N = DM; d.K = 512; d.mode = 0; d.out8 = 0; } \
        else if ((r_ -= IT_PS) < IT_OUT) { d.src = F.in[I_WOUT]; d.dst = F.ws + WS_WOUT; d.kscale = nullptr; d.N = DM; d.K = DM; d.mode = 0; d.out8 = 0; } \
        else if ((r_ -= IT_OUT) < NE * IT_UP1) { const int e_ = r_ / IT_UP1; r_ -= e_ * IT_UP1; d.src = F.in[I_WUP] + (size_t)e_ * DM * UPW; d.dst = F.ws + WS_WUP + (size_t)e_ * UPW * DM; d.kscale = F.in[I_N2G]; d.N = UPW; d.K = DM; d.mode = 2; d.out8 = 1; } \
        else { r_ -= NE * IT_UP1; const int e_ = r_ / IT_DN1; r_ -= e_ * IT_DN1; d.src = F.in[I_WDN] + (size_t)e_ * DE * DM; d.dst = F.ws + WS_WDN + (size_t)e_ * DM * DE; d.kscale = nullptr; d.N = DM; d.K = DE; d.mode = 0; d.out8 = 1; } \
        nb_ = d.N / 64; d.k0 = 64 * (r_ / nb_); d.c0 = 64 * (r_ % nb_); } while (0)
    int qcur = 0, qend = 0;
#define P0_DRAW(it) do { if (qcur == qend) { unsigned q_ = 0; if (F.lane == 0) q_ = atomicAdd((unsigned*)(F.ctl + CW_Q), 1u); qcur = 8 * (int)__builtin_amdgcn_readfirstlane(q_); qend = qcur + 8; } it = qcur++; } while (0)
    {
        P0Item dA, dB; f32x4 vA[16], vB[16]; int itA, itB;
        P0_DRAW(itA);
        if (itA < NITEMS) { P0_DECODE(itA, dA); p0_item_load(dA, vA, F.lane);
            for (;;) {
                P0_DRAW(itB); const bool hasB = itB < NITEMS;
                if (hasB) { P0_DECODE(itB, dB); p0_item_load(dB, vB, F.lane); }
                p0_item_finish(dA, vA, scr, F.lane);
                if (!hasB) break;
                P0_DRAW(itA); const bool hasA = itA < NITEMS;
                if (hasA) { P0_DECODE(itA, dA); p0_item_load(dA, vA, F.lane); }
                p0_item_finish(dB, vB, scr, F.lane);
                if (!hasA) break;
            } }
    }
#undef P0_DECODE
#undef P0_DRAW
}

typedef const pg8::f32x4 (&AccRef)[2][2][4][2];
__device__ __forceinline__ v4u pack8(const f32x4 a, const f32x4 b) { v4u w; w.x = cvt_pk_bf16(a[0], a[1]); w.y = cvt_pk_bf16(a[2], a[3]); w.z = cvt_pk_bf16(b[0], b[1]); w.w = cvt_pk_bf16(b[2], b[3]); return w; }
__device__ __forceinline__ void unpack8(const v4u w, f32x4& a, f32x4& b) { a = (f32x4){bflo(w.x), bfhi(w.x), bflo(w.y), bfhi(w.y)}; b = (f32x4){bflo(w.z), bfhi(w.z), bflo(w.w), bfhi(w.w)}; }

struct EpiInProj {
    static constexpr bool PERM = true;
    __device__ __forceinline__ bool keep(const pg8::Unit&) const { return false; }
    bf16 *U, *Q, *Kb, *V, *G1, *G2; const float *bgate, *qg, *kg;
    __device__ __forceinline__ void operator()(AccRef acc, const pg8::Unit& u, int wr, int wc, int fr, int fq, const LAS int*) const {
        const int pn = u.pn, row0 = u.pm * 256 + wr * 64 + fr;
        if (pn < 2) {
#pragma unroll
            for (int ai = 0; ai < 2; ++ai)
#pragma unroll
                for (int m = 0; m < 4; ++m) { const int row = row0 + ai * 128 + m * 16, b = row >> 11, t = row & 2047;
#pragma unroll
                    for (int bj = 0; bj < 2; ++bj) { const int lc = 256 * pn + 64 * wc + 32 * bj + 8 * fq, g = lc >> 4, ch = lc & 15;
                        *(v4u*)(U + ((size_t)(b * SSM_G + g) * SEQ + t) * 16 + ch) = pack8(acc[ai][bj][m][0], acc[ai][bj][m][1]); } }
        } else if (pn < 6) {
            const bool isq = pn < 4; const float* gv = isq ? qg : kg; const float sc = isq ? QSCALE : 1.0f;
            bf16* dst = (isq ? Q : Kb) + 256 * (pn - (isq ? 2 : 4)) + 64 * wc + 8 * fq;
            f32x4 gg[2][2];
#pragma unroll
            for (int bj = 0; bj < 2; ++bj)
#pragma unroll
                for (int n = 0; n < 2; ++n) gg[bj][n] = *(const f32x4*)(gv + 32 * bj + 8 * fq + 4 * n) * sc;
#pragma unroll
            for (int ai = 0; ai < 2; ++ai)
#pragma unroll
                for (int m = 0; m < 4; ++m) { const int row = row0 + ai * 128 + m * 16; float ss = 0.f;
#pragma unroll
                    for (int bj = 0; bj < 2; ++bj)
#pragma unroll
                        for (int n = 0; n < 2; ++n) { const f32x4 x = acc[ai][bj][m][n]; ss += (x[0] * x[0] + x[1] * x[1]) + (x[2] * x[2] + x[3] * x[3]); }
                    ss += __shfl_xor(ss, 16); ss += __shfl_xor(ss, 32);
                    const float rs = 1.0f / sqrtf(ss * (1.0f / 64.0f) + RMS_EPS);
#pragma unroll
                    for (int bj = 0; bj < 2; ++bj) *(v4u*)(dst + (size_t)row * 512 + 32 * bj) = pack8(acc[ai][bj][m][0] * rs * gg[bj][0], acc[ai][bj][m][1] * rs * gg[bj][1]); }
        } else if (pn < 8) {
            bf16* dst = V + 256 * (pn - 6) + 64 * wc + 8 * fq;
#pragma unroll
            for (int ai = 0; ai < 2; ++ai)
#pragma unroll
                for (int m = 0; m < 4; ++m) { const int row = row0 + ai * 128 + m * 16;
#pragma unroll
                    for (int bj = 0; bj < 2; ++bj) *(v4u*)(dst + (size_t)row * 512 + 32 * bj) = pack8(acc[ai][bj][m][0], acc[ai][bj][m][1]); }
        } else {
            const int gc = 256 * (pn - 8) + 64 * wc + 8 * fq;
            bf16* dst = (gc < 1024 ? G1 + gc : G2 + (gc - 1024));
            f32x4 bb[2][2];
#pragma unroll
            for (int bj = 0; bj < 2; ++bj)
#pragma unroll
                for (int n = 0; n < 2; ++n) bb[bj][n] = *(const f32x4*)(bgate + gc + 32 * bj + 4 * n);
#pragma unroll
            for (int ai = 0; ai < 2; ++ai)
#pragma unroll
                for (int m = 0; m < 4; ++m) { const int row = row0 + ai * 128 + m * 16;
#pragma unroll
                    for (int bj = 0; bj < 2; ++bj) { f32x4 a = acc[ai][bj][m][0] + bb[bj][0], b = acc[ai][bj][m][1] + bb[bj][1];
#pragma unroll
                        for (int e = 0; e < 4; ++e) { a[e] = fsigmoid(a[e]); b[e] = fsigmoid(b[e]); }
                        *(v4u*)(dst + (size_t)row * 1024 + 32 * bj) = pack8(a, b); } }
        }
    }
};
template <int MODE> struct EpiMix {
    static constexpr bool PERM = true;
    __device__ __forceinline__ bool keep(const pg8::Unit&) const { return false; }
    const bf16* P0; const bf16* P1; bf16* O; const float* bias; int ld;
    __device__ __forceinline__ void operator()(AccRef acc, const pg8::Unit& u, int wr, int wc, int fr, int fq, const LAS int*) const {
        const int row0 = u.pm * 256 + wr * 64 + fr, col0 = u.pn * 256 + wc * 32 + 8 * fq;
        f32x4 bb[2][2];
#pragma unroll
        for (int bj = 0; bj < 2; ++bj)
#pragma unroll
            for (int n = 0; n < 2; ++n) bb[bj][n] = (MODE == 0) ? *(const f32x4*)(bias + col0 + bj * 128 + 4 * n) : (f32x4){0.f, 0.f, 0.f, 0.f};
#pragma unroll
        for (int ai = 0; ai < 2; ++ai) {
            v4u q0[4][2], q1[4][2];
#pragma unroll
            for (int m = 0; m < 4; ++m)
#pragma unroll
                for (int bj = 0; bj < 2; ++bj) { const size_t off = (size_t)(row0 + ai * 128 + m * 16) * ld + col0 + bj * 128; q0[m][bj] = *(const v4u*)(P0 + off); if (MODE == 2) q1[m][bj] = *(const v4u*)(P1 + off); }
#pragma unroll
            for (int m = 0; m < 4; ++m) { const size_t off = (size_t)(row0 + ai * 128 + m * 16) * ld + col0;
#pragma unroll
                for (int bj = 0; bj < 2; ++bj) { f32x4 a = acc[ai][bj][m][0], b = acc[ai][bj][m][1], p0a, p0b;
                    unpack8(q0[m][bj], p0a, p0b);
                    if (MODE == 0) { a += bb[bj][0]; b += bb[bj][1];
#pragma unroll
                        for (int e = 0; e < 4; ++e) { a[e] = p0a[e] * fsigmoid(a[e]); b[e] = p0b[e] * fsigmoid(b[e]); } }
                    else if (MODE == 1) { a *= p0a; b *= p0b; }
                    else { f32x4 p1a, p1b; unpack8(q1[m][bj], p1a, p1b); a = p0a + p1a * a; b = p0b + p1b * b; }
                    *(v4u*)(O + off + bj * 128) = pack8(a, b); } } }
    }
};
struct EpiOut {
    static constexpr bool PERM = false;
    __device__ __forceinline__ bool keep(const pg8::Unit&) const { return false; }
    const float* X; float* H; unsigned char* HB;
    __device__ __forceinline__ void operator()(AccRef acc, const pg8::Unit& u, int wr, int wc, int fr, int fq, const LAS int*) const {
        const int row0 = u.pm * 256 + wr * 64 + fr, col0 = u.pn * 256 + wc * 32 + 4 * fq;
#pragma unroll
        for (int ai = 0; ai < 2; ++ai) {
            f32x4 xv[4][2][2];
#pragma unroll
            for (int m = 0; m < 4; ++m)
#pragma unroll
                for (int bj = 0; bj < 2; ++bj)
#pragma unroll
                    for (int n = 0; n < 2; ++n) xv[m][bj][n] = *(const f32x4*)(X + (size_t)(row0 + ai * 128 + m * 16) * DM + col0 + bj * 128 + n * 16);
#pragma unroll
            for (int m = 0; m < 4; ++m) { const size_t off = (size_t)(row0 + ai * 128 + m * 16) * DM + col0;
#pragma unroll
                for (int bj = 0; bj < 2; ++bj)
#pragma unroll
                    for (int n = 0; n < 2; ++n) { const f32x4 h = xv[m][bj][n] + acc[ai][bj][m][n];
                        *(f32x4*)(H + off + bj * 128 + n * 16) = h; *(unsigned*)(HB + off + bj * 128 + n * 16) = pk4_fp8(h[0], h[1], h[2], h[3]); } } }
    }
};
struct ChainOrder {
    pg8::StaticOrder so; const bf16* A_att; const bf16* A_ssm;
    __device__ __forceinline__ bool next(int i, pg8::Unit& u) const { pg8::Unit t; if (!so.next(i >> 1, t)) return false; u.pm = t.pm; u.pn = (i & 1) ? t.pn : 4 + t.pn; return true; }
    __device__ __forceinline__ int row_slot(const pg8::Unit&, int) const { return 0; }
    __device__ __forceinline__ int a_row(const pg8::Unit& u, int r, int) const { return u.pm * 256 + r; }
    __device__ __forceinline__ const char* a_base(const pg8::Gemm&, const pg8::Unit& u, size_t tstep) const { return (const char*)(u.pn >= 4 ? A_att : A_ssm) + (size_t)u.pm * tstep; }
    __device__ __forceinline__ void a_ready(const pg8::Unit&) const {}
    __device__ __forceinline__ void done(const pg8::Unit&) const {}
};
struct EpiChain {
    static constexpr bool PERM = true;
    const bf16* G1; const bf16* G2; bf16* MX;
    __device__ __forceinline__ bool keep(const pg8::Unit& u) const { return u.pn >= 4; }
    __device__ __forceinline__ void operator()(pg8::f32x4 (&acc)[2][2][4][2], const pg8::Unit& u, int wr, int wc, int fr, int fq, const LAS int*) const {
        const bool att = u.pn >= 4; const int row0 = u.pm * 256 + wr * 64 + fr, col0 = (u.pn & 3) * 256 + wc * 32 + 8 * fq;
#pragma unroll
        for (int ai = 0; ai < 2; ++ai) {
            v4u q1[4][2], q2[4][2];
#pragma unroll
            for (int m = 0; m < 4; ++m)
#pragma unroll
                for (int bj = 0; bj < 2; ++bj) { const size_t off = (size_t)(row0 + ai * 128 + m * 16) * DM + col0 + bj * 128; q1[m][bj] = *(const v4u*)(G1 + off); if (att) q2[m][bj] = *(const v4u*)(G2 + off); }
#pragma unroll
            for (int m = 0; m < 4; ++m)
#pragma unroll
                for (int bj = 0; bj < 2; ++bj) { f32x4 g1a, g1b; unpack8(q1[m][bj], g1a, g1b);
                    if (att) { f32x4 g2a, g2b; unpack8(q2[m][bj], g2a, g2b);
#pragma unroll
                        for (int e = 0; e < 4; ++e) { acc[ai][bj][m][0][e] *= g2a[e] * __builtin_amdgcn_rcpf(g1a[e]); acc[ai][bj][m][1][e] *= g2b[e] * __builtin_amdgcn_rcpf(g1b[e]); } }
                    else *(v4u*)(MX + (size_t)(row0 + ai * 128 + m * 16) * DM + col0 + bj * 128) = pack8(acc[ai][bj][m][0] * g1a, acc[ai][bj][m][1] * g1b); } }
    }
};
constexpr int CW_MFLAG = 32768, MFLAG_STRIDE = 16;
template <int NN, bool TOKROWS> struct MoeOrder {
    int nunits, G, vcu; const LAS int* cnt; const LAS int* tstart; const LAS int* tile2e; const int* elist; unsigned* mflag;
    __device__ __forceinline__ void a_ready(const pg8::Unit& u) const {
        if constexpr (!TOKROWS) { unsigned* f = mflag + u.pm * MFLAG_STRIDE; unsigned spins = 0;
            while (__hip_atomic_load(f, __ATOMIC_RELAXED, __HIP_MEMORY_SCOPE_AGENT) < 8u && ++spins < (1u << 22)) __builtin_amdgcn_s_sleep(2);
            asm volatile("" ::: "memory"); } }
    __device__ __forceinline__ void done(const pg8::Unit& u) const {
        if constexpr (TOKROWS) { asm volatile("s_waitcnt vmcnt(0)" ::: "memory"); __builtin_amdgcn_s_barrier(); asm volatile("" ::: "memory");
            if (threadIdx.x == 0) __hip_atomic_fetch_add(mflag + u.pm * MFLAG_STRIDE, 1u, __ATOMIC_RELAXED, __HIP_MEMORY_SCOPE_AGENT); } }
    __device__ __forceinline__ bool next(int i, pg8::Unit& u) const { const long L = (long)i * G + vcu; if (L >= nunits) return false; const int pm = (int)(L / NN), pnl = (int)(L % NN);
        u.pm = pm; u.pn = tile2e[pm] * NN + pnl; return true; }
    __device__ __forceinline__ int row_slot(const pg8::Unit& u, int r) const { const int e = u.pn / NN, pos = (u.pm - tstart[e]) * 256 + r; return pos < cnt[e] ? elist[e * M + pos] : -1; }
    __device__ __forceinline__ int a_row(const pg8::Unit& u, int r, int slot) const { return TOKROWS ? (slot < 0 ? 0 : (slot >> 2)) : u.pm * 256 + r; }
    __device__ __forceinline__ const char* a_base(const pg8::Gemm& g, const pg8::Unit&, size_t) const { return (const char*)g.A; }
};
struct EpiUp {
    static constexpr bool PERM = true;
    __device__ __forceinline__ bool keep(const pg8::Unit&) const { return false; }
    unsigned char* ACT; const float* bup; const float* rs2;
    __device__ __forceinline__ void operator()(AccRef acc, const pg8::Unit& u, int wr, int wc, int fr, int fq, const LAS int* tab) const {
        const int e = u.pn >> 3, pnl = u.pn & 7, j0 = 128 * pnl + 32 * wc + 8 * fq;
        f32x4 bb[4];
#pragma unroll
        for (int q = 0; q < 4; ++q) bb[q] = *(const f32x4*)(bup + (size_t)e * UPW + 2 * j0 + 4 * q);
        int sl[2][4]; float rsv[2][4];
#pragma unroll
        for (int ai = 0; ai < 2; ++ai)
#pragma unroll
            for (int m = 0; m < 4; ++m) { sl[ai][m] = tab[ai * 128 + wr * 64 + m * 16 + fr]; rsv[ai][m] = rs2[sl[ai][m] < 0 ? 0 : (sl[ai][m] >> 2)]; }
#pragma unroll
        for (int ai = 0; ai < 2; ++ai)
#pragma unroll
            for (int m = 0; m < 4; ++m) { const int r = ai * 128 + wr * 64 + m * 16 + fr, slot = sl[ai][m];
                if (slot >= 0) { const float rs = rsv[ai][m]; f32x4 o[2];
#pragma unroll
                    for (int n = 0; n < 2; ++n)
#pragma unroll
                        for (int e4 = 0; e4 < 4; ++e4) { const int j = 4 * n + e4;
                            float gl = acc[ai][0][m][n][e4] * rs + bb[(2 * j) >> 2][(2 * j) & 3], li = acc[ai][1][m][n][e4] * rs + bb[(2 * j + 1) >> 2][(2 * j + 1) & 3];
                            gl = fminf(gl, 7.0f); li = fminf(fmaxf(li, -7.0f), 7.0f);
                            o[n][e4] = gl * fsigmoid(1.702f * gl) * (li + 1.0f) * 4.0f; }
                    const unsigned long long ov = (unsigned long long)pk4_fp8(o[0][0], o[0][1], o[0][2], o[0][3]) | ((unsigned long long)pk4_fp8(o[1][0], o[1][1], o[1][2], o[1][3]) << 32);
                    __hip_atomic_store((unsigned long long*)(ACT + (size_t)(u.pm * 256 + r) * DE + j0), ov, __ATOMIC_RELAXED, __HIP_MEMORY_SCOPE_AGENT); } }
    }
};
struct EpiDown {
    static constexpr bool PERM = true;
    __device__ __forceinline__ bool keep(const pg8::Unit&) const { return false; }
    bf16* YS2; const float* bdn; const float* wslot;
    __device__ __forceinline__ void operator()(AccRef acc, const pg8::Unit& u, int wr, int wc, int fr, int fq, const LAS int* tab) const {
        const int e = u.pn >> 2, pnl = u.pn & 3, c0 = 256 * pnl + 32 * wc + 8 * fq;
        f32x4 bb[2][2];
#pragma unroll
        for (int bj = 0; bj < 2; ++bj)
#pragma unroll
            for (int n = 0; n < 2; ++n) bb[bj][n] = *(const f32x4*)(bdn + (size_t)e * DM + c0 + bj * 128 + 4 * n);
        int sl[2][4]; float wv[2][4];
#pragma unroll
        for (int ai = 0; ai < 2; ++ai)
#pragma unroll
            for (int m = 0; m < 4; ++m) { sl[ai][m] = tab[ai * 128 + wr * 64 + m * 16 + fr]; wv[ai][m] = wslot[sl[ai][m] < 0 ? 0 : sl[ai][m]]; }
#pragma unroll
        for (int ai = 0; ai < 2; ++ai)
#pragma unroll
            for (int m = 0; m < 4; ++m) { const int slot = sl[ai][m];
                if (slot >= 0) { const float w = wv[ai][m];
#pragma unroll
                    for (int bj = 0; bj < 2; ++bj) *(v4u*)(YS2 + (size_t)slot * DM + c0 + bj * 128) = pack8((acc[ai][bj][m][0] + bb[bj][0]) * w, (acc[ai][bj][m][1] + bb[bj][1]) * w); } }
    }
};

constexpr int S5_UPITCH = 528, S5_SX_OFF = 128 * S5_UPITCH, S5_XPITCH = 132;
__device__ __forceinline__ void s5_unit(Frame& F, int b, int g) {
    LAS unsigned char* Uimg = F.lds + RING_OFF; LAS float* SX = (LAS float*)(F.lds + RING_OFF + S5_SX_OFF);
    const int tid = F.tid, lane = F.lane, w = F.wave, r32 = lane & 31, hi = lane >> 5;
    const bf16* Ug = (const bf16*)(F.ws + WS_U) + (size_t)(b * SSM_G + g) * SEQ * 16;
    const bf16* W1T = (const bf16*)(F.ws + WS_S5 + (size_t)g * 262144); const bf16* M2T = W1T + 128 * 256; const bf16* W3T = M2T + 256 * 256;
#pragma unroll
    for (int j = 0; j < 8; ++j) { const int q = tid + 512 * j; *(LAS v4u*)(Uimg + (q >> 5) * S5_UPITCH + (q & 31) * 16) = *(const v4u*)(Ug + (size_t)q * 8); }
    __syncthreads();
    { const int nt = w & 3, mt0 = 2 * (w >> 2);
      f32x16 s0 = {0}, s1 = {0};
#pragma unroll 4
      for (int ks = 0; ks < 16; ++ks) {
          const bf16x8 bf = *(const bf16x8*)(W1T + (size_t)(32 * nt + r32) * 256 + 16 * ks + 8 * hi);
          const bf16x8 a0 = *(const LAS bf16x8*)(Uimg + (32 * mt0 + r32) * S5_UPITCH + (16 * ks + 8 * hi) * 2);
          const bf16x8 a1 = *(const LAS bf16x8*)(Uimg + (32 * (mt0 + 1) + r32) * S5_UPITCH + (16 * ks + 8 * hi) * 2);
          s0 = __builtin_amdgcn_mfma_f32_32x32x16_bf16(a0, bf, s0, 0, 0, 0); s1 = __builtin_amdgcn_mfma_f32_32x32x16_bf16(a1, bf, s1, 0, 0, 0); }
#pragma unroll
      for (int r = 0; r < 16; ++r) { SX[(32 * mt0 + crow(r, hi)) * S5_XPITCH + 32 * nt + r32] = s0[r]; SX[(32 * (mt0 + 1) + crow(r, hi)) * S5_XPITCH + 32 * nt + r32] = s1[r]; } }
    __syncthreads();
    if (tid < 64) {
        const float* a16 = (const float*)(F.ws + WS_A16) + (g * 64 + tid) * 2; const float ar = a16[0], ai = a16[1]; float xr = 0.f, xi = 0.f;
#pragma unroll 8
        for (int c = 0; c < SSM_NC; ++c) { const float sr = SX[c * S5_XPITCH + tid], si = SX[c * S5_XPITCH + 64 + tid];
            SX[c * S5_XPITCH + tid] = xr; SX[c * S5_XPITCH + 64 + tid] = xi;
            const float nr = ar * xr - ai * xi + sr, ni = ar * xi + ai * xr + si; xr = nr; xi = ni; }
    }
    __syncthreads();
    { f32x16 y[4] = {{0}, {0}, {0}, {0}};
      const int nks = 2 * w + 2;
      for (int ks = 0; ks < nks; ++ks) {
          const bf16x8 bf = *(const bf16x8*)(M2T + (size_t)(32 * w + r32) * 256 + 16 * ks + 8 * hi);
#pragma unroll
          for (int mt = 0; mt < 4; ++mt) { const bf16x8 a = *(const LAS bf16x8*)(Uimg + (32 * mt + r32) * S5_UPITCH + (16 * ks + 8 * hi) * 2); y[mt] = __builtin_amdgcn_mfma_f32_32x32x16_bf16(a, bf, y[mt], 0, 0, 0); } }
#pragma unroll 2
      for (int ks = 0; ks < 8; ++ks) {
          const bf16x8 bf = *(const bf16x8*)(W3T + (size_t)(32 * w + r32) * 128 + 16 * ks + 8 * hi);
#pragma unroll
          for (int mt = 0; mt < 4; ++mt) { const LAS f32x4* xp = (const LAS f32x4*)(SX + (32 * mt + r32) * S5_XPITCH + 16 * ks + 8 * hi); const f32x4 x0 = xp[0], x1 = xp[1];
              const v4u pk = pack8(x0, x1); y[mt] = __builtin_amdgcn_mfma_f32_32x32x16_bf16(__builtin_bit_cast(bf16x8, pk), bf, y[mt], 0, 0, 0); } }
      bf16* YG = (bf16*)(F.ws + WS_YG); const int i = 2 * w + (r32 >> 4), ho = r32 & 15;
#pragma unroll
      for (int mt = 0; mt < 4; ++mt)
#pragma unroll
          for (int r = 0; r < 16; ++r) { const int c = 32 * mt + crow(r, hi); YG[(size_t)(b * SEQ + 16 * c + i) * SSM_W + g * 16 + ho] = (bf16)f2bf(gelu_tanh(y[mt][r])); } }
    __syncthreads();
}

constexpr int AT_KP = 272, AT_VP = 320, AT_KB = 64 * AT_KP, AT_VB = 64 * AT_VP, AT_BUF = AT_KB + AT_VB;
__device__ __forceinline__ s16x4 vtr(const LAS unsigned char* p) { typedef short v4i16_t __attribute__((ext_vector_type(4))); return __builtin_bit_cast(s16x4, __builtin_amdgcn_ds_read_tr16_b64_v4i16((LAS v4i16_t*)p)); }
__device__ __forceinline__ void attn_unit(Frame& F, int b, int h, int qb, float lam) {
    const int tid = F.tid, lane = F.lane, w = F.wave, rg = w >> 1, t = w & 1, r32 = lane & 31, hi = lane >> 5;
    const bf16* Q = (const bf16*)(F.ws + WS_Q); const bf16* K = (const bf16*)(F.ws + WS_K); const bf16* V = (const bf16*)(F.ws + WS_V); bf16* OB = (bf16*)(F.ws + WS_OB);
    LAS unsigned char* L = F.lds + RING_OFF;
    const int qrow = b * SEQ + qb * 128 + rg * 32 + r32;
    bf16x8 qf[4];
#pragma unroll
    for (int ks = 0; ks < 4; ++ks) qf[ks] = *(const bf16x8*)(Q + (size_t)qrow * QK_W + h * 128 + t * 64 + 16 * ks + 8 * hi);
    const int ntile = 2 * qb + 2, mylim = 2 * qb + (rg >> 1);
    const int kr0 = tid >> 4, cc = tid & 15;
    const size_t gbase = (size_t)(b * SEQ) * 512 + h * 128 + cc * 8;
    v4u kregA[2], vregA[2], kregB[2], vregB[2];
#define AT_LOAD(j, kreg, vreg) do { _Pragma("unroll") for (int i_ = 0; i_ < 2; ++i_) { const size_t o_ = gbase + (size_t)(64 * (j) + kr0 + 32 * i_) * 512; kreg[i_] = *(const v4u*)(K + o_); vreg[i_] = *(const v4u*)(V + o_); } } while (0)
#define AT_STORE(buf, kreg, vreg) do { _Pragma("unroll") for (int i_ = 0; i_ < 2; ++i_) { *(LAS v4u*)(L + (buf) * AT_BUF + (kr0 + 32 * i_) * AT_KP + cc * 16) = kreg[i_]; \
        *(LAS v4u*)(L + (buf) * AT_BUF + AT_KB + (kr0 + 32 * i_) * AT_VP + cc * 16) = vreg[i_]; } } while (0)
    AT_LOAD(0, kregB, vregB); AT_LOAD(1, kregA, vregA); AT_STORE(0, kregB, vregB);
    __syncthreads();
    f32x16 o[4] = {{0}, {0}, {0}, {0}};
    float mrun = -60.0f, lrun = 0.f;
    f32x16 negm;
#pragma unroll
    for (int r = 0; r < 16; ++r) negm[r] = 60.0f;
    const int g4 = lane >> 4, i16 = lane & 15;
    const int vlane = (4 * (g4 >> 1) + (i16 >> 2)) * AT_VP + (16 * (g4 & 1) + 4 * (i16 & 3)) * 2;
#define AT_COMPUTE(j, buf) do { \
        if (j <= mylim) { \
            const LAS unsigned char* Kb = L + buf * AT_BUF + t * 128 + hi * 16 + r32 * AT_KP; \
            const LAS unsigned char* Vb = L + buf * AT_BUF + AT_KB + vlane; \
            f32x16 s0, s1; \
            __builtin_amdgcn_s_setprio(1); \
        _Pragma("unroll") \
            for (int ks = 0; ks < 4; ++ks) { const bf16x8 k0 = *(const LAS bf16x8*)(Kb + ks * 32), k1 = *(const LAS bf16x8*)(Kb + 32 * AT_KP + ks * 32); \
                if (ks == 0) { s0 = __builtin_amdgcn_mfma_f32_32x32x16_bf16(k0, qf[0], negm, 0, 0, 0); s1 = __builtin_amdgcn_mfma_f32_32x32x16_bf16(k1, qf[0], negm, 0, 0, 0); } \
                else { s0 = __builtin_amdgcn_mfma_f32_32x32x16_bf16(k0, qf[ks], s0, 0, 0, 0); s1 = __builtin_amdgcn_mfma_f32_32x32x16_bf16(k1, qf[ks], s1, 0, 0, 0); } } \
            __builtin_amdgcn_s_setprio(0); \
            float mx = fmaxf(fmaxf(s0[0], s0[1]), s0[2]); \
        _Pragma("unroll") \
            for (int r = 3; r < 15; r += 2) mx = fmaxf(fmaxf(mx, s0[r]), s0[r + 1]); \
            mx = fmaxf(mx, s0[15]); \
        _Pragma("unroll") \
            for (int r = 0; r < 16; r += 2) mx = fmaxf(fmaxf(mx, s1[r]), s1[r + 1]); \
            mx = fmaxf(mx, __shfl_xor(mx, 32)); \
            if (__builtin_amdgcn_ballot_w64(mx > 8.0f) != 0ull) { \
                const float dm = (mx > 8.0f) ? mx : 0.0f, alpha = __builtin_amdgcn_exp2f(-dm); lrun *= alpha; mrun += dm; \
        _Pragma("unroll") \
                for (int dt = 0; dt < 4; ++dt) o[dt] *= alpha; \
        _Pragma("unroll") \
                for (int r = 0; r < 16; ++r) { s0[r] -= dm; s1[r] -= dm; negm[r] = -mrun; } } \
            float ps = 0.f; \
        _Pragma("unroll") \
            for (int r = 0; r < 16; ++r) { s0[r] = __builtin_amdgcn_exp2f(s0[r]); s1[r] = __builtin_amdgcn_exp2f(s1[r]); ps += s0[r] + s1[r]; } \
            lrun += ps; \
        _Pragma("unroll") \
            for (int s = 0; s < 4; ++s) { \
                v4u pk; const int rb = 8 * (s & 1); \
                if (s < 2) { pk.x = cvt_pk_bf16(s0[rb], s0[rb + 1]); pk.y = cvt_pk_bf16(s0[rb + 2], s0[rb + 3]); pk.z = cvt_pk_bf16(s0[rb + 4], s0[rb + 5]); pk.w = cvt_pk_bf16(s0[rb + 6], s0[rb + 7]); } \
                else       { pk.x = cvt_pk_bf16(s1[rb], s1[rb + 1]); pk.y = cvt_pk_bf16(s1[rb + 2], s1[rb + 3]); pk.z = cvt_pk_bf16(s1[rb + 4], s1[rb + 5]); pk.w = cvt_pk_bf16(s1[rb + 6], s1[rb + 7]); } \
                const bf16x8 pf = __builtin_bit_cast(bf16x8, pk); \
                __builtin_amdgcn_s_setprio(1); \
        _Pragma("unroll") \
                for (int dt = 0; dt < 4; ++dt) { const s16x4 lo = vtr(Vb + s * 16 * AT_VP + dt * 64), hh = vtr(Vb + s * 16 * AT_VP + dt * 64 + 8 * AT_VP); \
                    const bf16x8 vf = (bf16x8){lo[0], lo[1], lo[2], lo[3], hh[0], hh[1], hh[2], hh[3]}; \
                    o[dt] = __builtin_amdgcn_mfma_f32_32x32x16_bf16(vf, pf, o[dt], 0, 0, 0); } \
                __builtin_amdgcn_s_setprio(0); } \
        } \
    } while (0)
    for (int j = 0; j < ntile; j += 2) {
        { const int jn = (j + 2 < ntile) ? j + 2 : ntile - 1; AT_LOAD(jn, kregB, vregB); }
        AT_COMPUTE(j, 0);
        AT_STORE(1, kregA, vregA);
        __syncthreads();
        { const int jn = (j + 3 < ntile) ? j + 3 : ntile - 1; AT_LOAD(jn, kregA, vregA); }
        AT_COMPUTE(j + 1, 1);
        AT_STORE(0, kregB, vregB);
        __syncthreads();
    }
#undef AT_COMPUTE
#undef AT_LOAD
#undef AT_STORE
    const float ltot = lrun + __shfl_xor(lrun, 32), inv = 1.0f / ltot;
    LAS float* EX = (LAS float*)L + rg * 4096;
    if (t == 1) {
        const float sc = inv * lam;
#pragma unroll
        for (int dt = 0; dt < 4; ++dt)
#pragma unroll
            for (int r = 0; r < 16; ++r) EX[(dt * 16 + r) * 64 + lane] = o[dt][r] * sc;
    }
    __syncthreads();
    if (t == 0) {
        float ss = 0.f;
#pragma unroll
        for (int dt = 0; dt < 4; ++dt)
#pragma unroll
            for (int r = 0; r < 16; ++r) { const float y = o[dt][r] * inv - EX[(dt * 16 + r) * 64 + lane]; o[dt][r] = y; ss += y * y; }
        ss += __shfl_xor(ss, 32);
        const float rn = (1.0f - LAMBDA_INIT) / sqrtf(ss * (1.0f / 128.0f) + RMS_EPS);
        const float* sg = F.in[I_SUBLN];
        f32x4 ggv[4][4];
#pragma unroll
        for (int dt = 0; dt < 4; ++dt)
#pragma unroll
            for (int rq = 0; rq < 4; ++rq) ggv[dt][rq] = *(const f32x4*)(sg + 32 * dt + 8 * rq + 4 * hi);
#pragma unroll
        for (int dt = 0; dt < 4; ++dt)
#pragma unroll
            for (int rq = 0; rq < 4; ++rq) { const int d = 32 * dt + 8 * rq + 4 * hi; const f32x4 gg = ggv[dt][rq];
                v2u wv; wv.x = cvt_pk_bf16(o[dt][4 * rq] * rn * gg[0], o[dt][4 * rq + 1] * rn * gg[1]); wv.y = cvt_pk_bf16(o[dt][4 * rq + 2] * rn * gg[2], o[dt][4 * rq + 3] * rn * gg[3]);
                *(v2u*)(OB + (size_t)qrow * V_W + h * 128 + d) = wv; }
    }
    __syncthreads();
}

constexpr int CW_CNT_STRIDE = 64;
__device__ __forceinline__ void router_phase(Frame& F, const bool dummy = false) {
    const int lane = F.lane, tid = F.tid, w = F.wave, tt = w >> 1, kh = w & 1;
    LAS float* LG = (LAS float*)(F.lds + RING_OFF);
    LAS float* SS = LG + 4 * 2 * 16 * 33;
    LAS int* LC = (LAS int*)(SS + 128);
    const float* Hf = F.out; const float* wrT = (const float*)(F.ws + WS_WRT); const float* br = F.in[I_BR];
    float* rs2 = (float*)(F.ws + (dummy ? WS_YS2 : WS_RS2)); float* wslot = (float*)(F.ws + (dummy ? WS_YS2 + MiB : WS_WSLOT)); int* elist = (int*)(F.ws + (dummy ? WS_YS2 + 2 * MiB : WS_ELIST));
    unsigned* cnt = (unsigned*)(F.ctl + CW_CNT + (dummy ? 32 : 0));
    const int i16 = lane & 15, kq = lane >> 4;
    for (int tg = F.vcu; tg < M / 64; tg += F.G) {
        if (tid < 64) LC[tid] = 0;
        const int tok0 = tg * 64 + tt * 16;
        f32x4 a0 = {0.f, 0.f, 0.f, 0.f}, a1 = {0.f, 0.f, 0.f, 0.f}; float ssq = 0.f;
        const float* hp = Hf + (size_t)(tok0 + i16) * DM + kh * 512 + 4 * kq; const float* w0 = wrT + (size_t)i16 * DM + kh * 512 + 4 * kq; const float* w1 = w0 + 16 * DM;
#pragma unroll 8
        for (int s = 0; s < 32; ++s) { const f32x4 a = *(const f32x4*)(hp + 16 * s), b0 = *(const f32x4*)(w0 + 16 * s), b1 = *(const f32x4*)(w1 + 16 * s);
            ssq += (a[0] * a[0] + a[1] * a[1]) + (a[2] * a[2] + a[3] * a[3]);
#pragma unroll
            for (int q = 0; q < 4; ++q) { a0 = __builtin_amdgcn_mfma_f32_16x16x4f32(a[q], b0[q], a0, 0, 0, 0); a1 = __builtin_amdgcn_mfma_f32_16x16x4f32(a[q], b1[q], a1, 0, 0, 0); } }
        ssq += __shfl_xor(ssq, 16); ssq += __shfl_xor(ssq, 32);
        LAS float* lg = LG + (tt * 2 + kh) * 16 * 33;
#pragma unroll
        for (int r = 0; r < 4; ++r) { lg[(4 * kq + r) * 33 + i16] = a0[r]; lg[(4 * kq + r) * 33 + 16 + i16] = a1[r]; }
        if (kq == 0) SS[(tt * 2 + kh) * 16 + i16] = ssq;
        __syncthreads();
        int ti[4]; float wv[4]; int lpos[4]; float rsv = 0.f;
        if (tid < 64) {
            const int t4 = tid >> 4, t16 = tid & 15;
            rsv = 1.0f / sqrtf((SS[(t4 * 2) * 16 + t16] + SS[(t4 * 2 + 1) * 16 + t16]) * (1.0f / DM) + RMS_EPS);
            float lgv[32];
#pragma unroll
            for (int e = 0; e < 32; ++e) lgv[e] = (LG[((t4 * 2) * 16 + t16) * 33 + e] + LG[((t4 * 2 + 1) * 16 + t16) * 33 + e]) * rsv + br[e];
            float tv[4];
#pragma unroll
            for (int k = 0; k < 4; ++k) { float best = -3.0e38f; int bi = 0;
#pragma unroll
                for (int e = 0; e < 32; ++e) { const bool tk = lgv[e] > best; best = tk ? lgv[e] : best; bi = tk ? e : bi; }
                tv[k] = best; ti[k] = bi;
#pragma unroll
                for (int e = 0; e < 32; ++e) lgv[e] = (e == bi) ? -3.0e38f : lgv[e]; }
            const float e1 = __expf(tv[1] - tv[0]), e2 = __expf(tv[2] - tv[0]), e3 = __expf(tv[3] - tv[0]), den = 1.0f / (1.0f + e1 + e2 + e3);
            wv[0] = den; wv[1] = e1 * den; wv[2] = e2 * den; wv[3] = e3 * den;
#pragma unroll
            for (int k = 0; k < 4; ++k) lpos[k] = __hip_atomic_fetch_add(LC + ti[k], 1, __ATOMIC_RELAXED, __HIP_MEMORY_SCOPE_WORKGROUP);
        }
        __syncthreads();
        if (tid < 32) { const int c = LC[tid]; LC[32 + tid] = c ? (int)atomicAdd(cnt + tid * CW_CNT_STRIDE, (unsigned)c) : 0; }
        __syncthreads();
        if (tid < 64) {
            const int tok = tg * 64 + tid;
            rs2[tok] = rsv;
#pragma unroll
            for (int k = 0; k < 4; ++k) { elist[ti[k] * M + LC[32 + ti[k]] + lpos[k]] = tok * 4 + k; wslot[tok * 4 + k] = wv[k]; }
        }
        __syncthreads();
    }
}
__device__ __forceinline__ int moe_tables(Frame& F) {
    LAS int* T = (LAS int*)(F.lds + MOE_LDS_OFF); LAS int* cnt = T, *tstart = T + 32, *tile2e = T + 72;
    if (F.tid < 32) cnt[F.tid] = (int)__hip_atomic_load((unsigned*)(F.ctl + CW_CNT) + F.tid * CW_CNT_STRIDE, RLX_AGENT);
    __syncthreads();
    if (F.tid == 0) { int s = 0; for (int e = 0; e < 32; ++e) { tstart[e] = s; s += (cnt[e] + 255) >> 8; } tstart[32] = s; }
    __syncthreads();
    if (F.tid < 32) { for (int p = tstart[F.tid]; p < tstart[F.tid + 1]; ++p) tile2e[p] = F.tid; }
    __syncthreads();
    return tstart[32];
}
__device__ __forceinline__ void combine_phase(Frame& F, float* dst) {
    const int lane = F.lane, gw = F.vcu * NWAVES + F.wave, NGW = F.G * NWAVES;
    const bf16* YS2 = (const bf16*)(F.ws + WS_YS2);
    for (int tk = gw; tk < M; tk += NGW) {
        GAS f32x4* orow = (GAS f32x4*)(F.out + (size_t)tk * DM) + lane; GAS f32x4* drow = (GAS f32x4*)(dst + (size_t)tk * DM) + lane;
#pragma unroll
        for (int j = 0; j < 4; ++j) { f32x4 v = orow[64 * j];
#pragma unroll
            for (int k = 0; k < 4; ++k) { const v2u y = *((const GAS v2u*)(YS2 + (size_t)(tk * 4 + k) * DM) + lane + 64 * j); v += (f32x4){bflo(y.x), bfhi(y.x), bflo(y.y), bfhi(y.y)}; }
            drow[64 * j] = v; }
    }
}

struct Args { const float* in[31]; float* out; unsigned char* ws; int ph_lo, ph_hi; };
__global__ void __launch_bounds__(NWAVES * 64, 2) mk_fwd(Args args) {
    extern __shared__ __attribute__((aligned(16))) unsigned char lds[];
    Frame F;
    F.lds = (LAS unsigned char*)lds;
    F.MISC = (volatile LAS unsigned*)(F.lds + MISC_OFF);
    F.tid = threadIdx.x; F.lane = F.tid & 63; F.wave = __builtin_amdgcn_readfirstlane(F.tid >> 6);
    F.G = gridDim.x; { const int bx = blockIdx.x; F.vcu = (F.G % 8 == 0) ? (bx % 8) * (F.G / 8) + bx / 8 : bx; }
    F.ws = args.ws; F.ctl = (gu32*)(args.ws + WS_CTL); F.out = args.out;
#pragma unroll
    for (int i = 0; i < 31; ++i) F.in[i] = args.in[i];
    for (int u = F.tid; u < 64; u += NWAVES * 64) F.MISC[u] = 0u;
    __syncthreads();
    XcdBarrier bar; bar.bar = (unsigned*)(F.ctl + CW_BAR); bar.x = 0; bar.st = nullptr;
    if (N_LAUNCHES != PER_PHASE) bar = xcd_barrier_post((unsigned*)(F.ctl + CW_BAR), F.MISC + 8);
#define GRID_BAR() do { if (N_LAUNCHES != PER_PHASE) xcd_barrier(bar); } while (0)
    const int lo = args.ph_lo, hi = args.ph_hi;
#define IN(k) (lo <= (k) && (k) < hi)
#define BOTH(k) (IN(k) && IN((k) + 1))
    unsigned char* ws = args.ws;

    if (IN(0)) { for (int rep = 0; rep < NREP(0); ++rep) { p0_prologue(F); if (BOTH(0)) GRID_BAR(); } }

    if (IN(1)) for (int rep = 0; rep < NREP(1); ++rep) {
        pg8::Gemm g{(const bf16*)(ws + WS_XN), (const bf16*)(ws + WS_WIN), M, IN_W, DM}; pg8::StaticOrder S; S.init(M, IN_W, F.G, (int)blockIdx.x);
        EpiInProj E{(bf16*)(ws + WS_U), (bf16*)(ws + WS_Q), (bf16*)(ws + WS_K), (bf16*)(ws + WS_V), (bf16*)(ws + WS_G1), (bf16*)(ws + WS_G2), F.in[I_BGATE], F.in[I_QG], F.in[I_KG]};
        pg8::gemm_phase<EpiInProj, pg8::StaticOrder, true>(F.lds + RING_OFF, g, S, E);
        if (BOTH(1)) GRID_BAR();
    }

    if (PROBE_REP == 30 && IN(1) && IN(2)) { GRID_BAR(); GRID_BAR(); GRID_BAR(); GRID_BAR(); }
    if (IN(2)) {
        for (int rep = 0; rep < NREP(20); ++rep) for (int u = F.vcu; u < BATCH * SSM_G; u += F.G) { const int g = (u >> 5) * 4 + ((u & 31) >> 3), b = u & 7; s5_unit(F, b, g); }
        float lam;
        { const float a = wave_sum(F.in[I_LQ1][F.lane] * F.in[I_LK1][F.lane]), c = wave_sum(F.in[I_LQ2][F.lane] * F.in[I_LK2][F.lane]); lam = __expf(a) - __expf(c) + LAMBDA_INIT; }
        for (int rep = 0; rep < NREP(21); ++rep) for (int u = F.vcu; u < BATCH * ATT_H * 8; u += F.G) { const int bh = u >> 3, qp = u & 7; attn_unit(F, bh >> 2, bh & 3, 15 - qp, lam); attn_unit(F, bh >> 2, bh & 3, qp, lam); }
        if (BOTH(2)) GRID_BAR();
    }

    if (IN(3)) for (int rep = 0; rep < NREP(3); ++rep) {
        { pg8::Gemm g{(const bf16*)(ws + WS_YG), (const bf16*)(ws + WS_WGLU), M, 512, 512}; pg8::StaticOrder S; S.init(M, 512, F.G, (int)blockIdx.x);
          EpiMix<0> E{(const bf16*)(ws + WS_YG), nullptr, (bf16*)(ws + WS_YS), F.in[I_BGLU], 512};
          pg8::gemm_phase<EpiMix<0>, pg8::StaticOrder, true>(F.lds + RING_OFF, g, S, E); }
        if (BOTH(3)) GRID_BAR();
    }

    if (IN(4)) for (int rep = 0; rep < NREP(4); ++rep) {
        pg8::Gemm g{(const bf16*)(ws + WS_OB), (const bf16*)(ws + WS_WPS), M, DM, 512};
        ChainOrder S; S.so.init(M, DM, F.G, (int)blockIdx.x); S.A_att = (const bf16*)(ws + WS_OB); S.A_ssm = (const bf16*)(ws + WS_YS);
        EpiChain E{(const bf16*)(ws + WS_G1), (const bf16*)(ws + WS_G2), (bf16*)(ws + WS_MX)};
        pg8::gemm_phase<EpiChain, ChainOrder, true>(F.lds + RING_OFF, g, S, E);
        if (BOTH(4)) GRID_BAR();
    }

    if (IN(5)) for (int rep = 0; rep < NREP(5); ++rep) {
        pg8::Gemm g{(const bf16*)(ws + WS_MX), (const bf16*)(ws + WS_WOUT), M, DM, DM}; pg8::StaticOrder S; S.init(M, DM, F.G, (int)blockIdx.x);
        EpiOut E{F.in[I_X], F.out, ws + WS_HB};
        pg8::gemm_phase<EpiOut, pg8::StaticOrder, true>(F.lds + RING_OFF, g, S, E);
        if (BOTH(5)) GRID_BAR();
    }

    if (IN(6)) { router_phase(F); if (BOTH(6)) GRID_BAR(); }

    if (IN(7)) for (int rep = 0; rep < NREP(7); ++rep) {
        const int nmt = moe_tables(F); LAS int* T = (LAS int*)(F.lds + MOE_LDS_OFF); unsigned* mflag = (unsigned*)(F.ctl + CW_MFLAG) + (rep ? 288 * MFLAG_STRIDE : 0);
        { pg8::Gemm g{(const bf16*)(ws + WS_HB), (const bf16*)(ws + WS_WUP), M, UPW, DM};
          MoeOrder<8, true> S{nmt * 8, F.G, F.vcu, T, T + 32, T + 72, (const int*)(ws + WS_ELIST), mflag};
          EpiUp E{ws + WS_ACT, F.in[I_BUP], (const float*)(ws + WS_RS2)};
          pg8::gemm_phase<EpiUp, MoeOrder<8, true>, true, true, true, true>(F.lds + RING_OFF, g, S, E, 127, 122); }
        { pg8::Gemm g{(const bf16*)(ws + WS_ACT), (const bf16*)(ws + WS_WDN), MOE_ROWS_MAX, DM, DE};
          MoeOrder<4, false> S{nmt * 4, F.G, F.G - 1 - F.vcu, T, T + 32, T + 72, (const int*)(ws + WS_ELIST), mflag};
          EpiDown E{(bf16*)(ws + WS_YS2), F.in[I_BDN], (const float*)(ws + WS_WSLOT)};
          pg8::gemm_phase<EpiDown, MoeOrder<4, false>, true, true, true, true>(F.lds + RING_OFF, g, S, E, 125, 122); }
        if (BOTH(7)) GRID_BAR();
    }

    if (IN(9)) { combine_phase(F, F.out); }
    if (IN(16)) router_phase(F, true);
    if (IN(19)) combine_phase(F, (float*)(ws + WS_TA));
#undef IN
#undef BOTH
#undef GRID_BAR
}

extern "C" void kernel_launch(void* const* d_in, const int* in_sizes, int n_in, void* d_out, int out_size, void* d_ws, size_t ws_size, hipStream_t stream) {
    static int grid = 0;
    if (grid == 0) {
        if (n_in != 31 || in_sizes[0] != M * DM || out_size != M * DM || ws_size < WS_END) {
            fprintf(stderr, "kernel_launch: unexpected shapes (n_in %d, in0 %d, out %d, ws %zu < %zu); nothing launched\n", n_in, n_in > 0 ? in_sizes[0] : -1, out_size, ws_size, (size_t)WS_END); grid = -1; return; }
        int dev = 0, cus = 0;
        if (hipGetDevice(&dev) != hipSuccess || hipDeviceGetAttribute(&cus, hipDeviceAttributeMultiprocessorCount, dev) != hipSuccess) { grid = -1; return; }
        if (hipFuncSetAttribute((const void*)mk_fwd, hipFuncAttributeMaxDynamicSharedMemorySize, LDS_BYTES) != hipSuccess) { fprintf(stderr, "kernel_launch: hipFuncSetAttribute failed\n"); grid = -1; return; }
        int per_cu = 0;
        if (hipOccupancyMaxActiveBlocksPerMultiprocessor(&per_cu, (const void*)mk_fwd, NWAVES * 64, LDS_BYTES) != hipSuccess || per_cu < 1) fprintf(stderr, "kernel_launch: occupancy query reports %d\n", per_cu);
        (void)hipGetLastError();
        grid = cus;
    }
    if (grid < 0) return;
    (void)hipMemsetAsync((char*)d_ws + WS_CTL, 0, CTL_ZERO_BYTES, stream);
    Args a{};
    for (int i = 0; i < 31; ++i) a.in[i] = (const float*)d_in[i];
    a.out = (float*)d_out; a.ws = (unsigned char*)d_ws;
    if (N_LAUNCHES == 1) { a.ph_lo = 0; a.ph_hi = PER_PHASE; hipLaunchKernelGGL(mk_fwd, dim3(grid), dim3(NWAVES * 64), LDS_BYTES, stream, a); }
    else for (int p = 0; p < PER_PHASE; ++p) { a.ph_lo = p; a.ph_hi = p + 1; if (PROBE_REP - 110 == p) { a.ph_lo = p + 10; a.ph_hi = p + 11; hipLaunchKernelGGL(mk_fwd, dim3(grid), dim3(NWAVES * 64), LDS_BYTES, stream, a); a.ph_lo = p; a.ph_hi = p + 1; }
        for (int rep = 0; rep < ((PROBE_REP - 100 == p) ? 2 : 1); ++rep) hipLaunchKernelGGL(mk_fwd, dim3(grid), dim3(NWAVES * 64), LDS_BYTES, stream, a); }
}
```

```cpp
#include <hip/hip_runtime.h>
#include <cstdio>
#include <cstdint>

#ifndef MK_N_LAUNCHES
#define MK_N_LAUNCHES 1
#endif
#ifndef PROBE_REP
#define PROBE_REP -1
#endif
#define NREP(k) ((PROBE_REP == (k)) ? 2 : 1)

namespace pg8 {
#define PG8_LAS __attribute__((address_space(3)))
typedef unsigned short bf16_t;
typedef short bf16x8 __attribute__((ext_vector_type(8)));
typedef float f32x4 __attribute__((ext_vector_type(4)));
typedef unsigned u32x4 __attribute__((ext_vector_type(4)));
typedef unsigned u32x2 __attribute__((ext_vector_type(2)));
constexpr int BM = 256, BK = 64, HALF = 128, HTB = HALF * BK * 2  , STAGE_BYTES = 8 * HTB, NXCD = 8, WGM = 8;

__host__ __device__ __forceinline__ int lds_byte(int r, int c) { const int st = (r >> 4) * 2 + (c >> 5), rr = r & 15, cc = c & 31, ob = rr * 64 + cc * 2; return st * 1024 + (ob ^ (((ob >> 9) & 1) * 48)); }
__host__ __device__ __forceinline__ void stage_rc(int b, int& R, int& C) { const int st = b / 1024, sb = b % 1024, swz = sb ^ (((sb >> 9) & 1) * 48); R = (st >> 1) * 16 + swz / 64; C = (st & 1) * 32 + (swz % 64) / 2; }
__host__ __device__ __forceinline__ int perm32(int rho) { const int n = rho >> 4, i = rho & 15; return 8 * (i >> 2) + 4 * n + (i & 3); }

struct Unit { int pm, pn; };
struct Gemm { const bf16_t* A; const bf16_t* Bt; int M, N, K; };

struct StaticOrder {
    int nM, nN, nwg, G, c;
    __host__ __device__ void init(int M, int N, int G_, int c_) { nM = M / BM; nN = N / BM; nwg = nM * nN; G = G_; c = c_; }
    __host__ __device__ bool next(int i, Unit& u) const {
        const long L = (long)i * G + c; if (L >= nwg) return false;
        int wgid = (int)L; { const int q = nwg / NXCD, r = nwg % NXCD, xcd = wgid % NXCD, off = wgid / NXCD; wgid = (xcd < r ? xcd * (q + 1) : r * (q + 1) + (xcd - r) * q) + off; }
        const int nig = WGM * nN, gid = wgid / nig, fm = gid * WGM, gsz = (nM - fm) < WGM ? (nM - fm) : WGM;
        u.pm = fm + ((wgid % nig) % gsz); u.pn = (wgid % nig) / gsz; return true;
    }
    __device__ __forceinline__ int row_slot(const Unit&, int) const { return 0; }
    __device__ __forceinline__ int a_row(const Unit& u, int r, int) const { return u.pm * BM + r; }
    __device__ __forceinline__ const char* a_base(const Gemm& g, const Unit& u, size_t tstep) const { return (const char*)g.A + (size_t)u.pm * tstep; }
    __device__ __forceinline__ void a_ready(const Unit&) const {}
    __device__ __forceinline__ void done(const Unit&) const {}
};

__device__ __forceinline__ unsigned cvt_pk_bf16(float lo, float hi) { unsigned r; asm volatile("v_cvt_pk_bf16_f32 %0, %1, %2" : "=v"(r) : "v"(lo), "v"(hi)); return r; }

typedef int v8i __attribute__((ext_vector_type(8)));
typedef int v4i __attribute__((ext_vector_type(4)));
template <class Epi, class Sched, bool ALIGN_EPI = false, bool ROWTAB = false, bool GATHER = false, bool FP8 = false>
__device__ __forceinline__ void gemm_phase(PG8_LAS unsigned char* lds, const Gemm g, const Sched& S, const Epi& E, const int sA8 = 127, const int sB8 = 127) {
    static_assert(!GATHER || ROWTAB, "GATHER needs ROWTAB");
    const int tid = threadIdx.x, wid = __builtin_amdgcn_readfirstlane(tid >> 6), lane = tid & 63, wr = wid >> 2, wc = wid & 3, fr = lane & 15, fq = lane >> 4;
    const int K = g.K, RB = FP8 ? K : 2 * K  , nt = RB / (2 * BK);
    unsigned voffA[2], voffB[2];
#pragma unroll
    for (int i = 0; i < 2; ++i) { int R, C; stage_rc(tid * 16 + i * 8192, R, C); const int Rb = Epi::PERM ? ((R & ~31) + perm32(R & 31)) : R;
        voffA[i] = (unsigned)(R * RB + 2 * C); voffB[i] = (unsigned)(Rb * RB + 2 * C); }
    unsigned vA[2][2] = {{0u, 0u}, {0u, 0u}};
    const size_t kstep = (size_t)(BK * 2);
    const size_t hstep = (size_t)HALF * RB;
    const size_t tstep = 2 * hstep;
    const unsigned ldsw = (unsigned)wid * 1024u;
    const int aoff = FP8 ? lds_byte(wr * 64 + fr, fq * 16) : lds_byte(wr * 64 + fr, fq * 8), boff = FP8 ? lds_byte(wc * 32 + fr, fq * 16) : lds_byte(wc * 32 + fr, fq * 8);
    PG8_LAS int* tab = (PG8_LAS int*)(lds + STAGE_BYTES);
#define PG8_SA(b, h) (((b) * 2 + (h)) * HTB)
#define PG8_SB(b, h) ((4 + (b) * 2 + (h)) * HTB)
#define PG8_STAGE(bufoff, gbase, voff) do { _Pragma("unroll") for (int _i = 0; _i < 2; ++_i) \
        __builtin_amdgcn_global_load_lds((const unsigned*)((const char*)(gbase) + (voff)[_i]), (PG8_LAS unsigned*)(lds + (bufoff) + ldsw + _i * 8192), 16, 0, 0); } while (0)
#define PG8_STAGE_A(bufoff, kbase, h) do { if constexpr (GATHER) { PG8_STAGE(bufoff, kbase, vA[h]); } else { PG8_STAGE(bufoff, (kbase) + (h) * hstep, voffA); } } while (0)
#define PG8_LOAD_VA(sel, un) do { _Pragma("unroll") for (int _i = 0; _i < 2; ++_i) { int R_, C_; stage_rc(tid * 16 + _i * 8192, R_, C_); \
        _Pragma("unroll") for (int _h = 0; _h < 2; ++_h) { const int s_ = tab[(sel) * 256 + _h * HALF + R_]; vA[_h][_i] = (unsigned)(S.a_row(un, _h * HALF + R_, s_) * RB + 2 * C_); } } } while (0)
#define PG8_LDA(dst, b, h) do { _Pragma("unroll") for (int m = 0; m < 4; ++m) _Pragma("unroll") for (int k = 0; k < 2; ++k) dst[m][k] = *(const PG8_LAS bf16x8*)(lds + PG8_SA(b, h) + (FP8 ? (aoff ^ (16 * k)) : aoff + k * 1024) + m * 2048); } while (0)
#define PG8_LDB(dst, b, h) do { _Pragma("unroll") for (int n = 0; n < 2; ++n) _Pragma("unroll") for (int k = 0; k < 2; ++k) dst[n][k] = *(const PG8_LAS bf16x8*)(lds + PG8_SB(b, h) + (FP8 ? (boff ^ (16 * k)) : boff + k * 1024) + n * 2048); } while (0)
#define PG8_V8(x) __builtin_shufflevector(__builtin_bit_cast(v4i, (x)[0]), __builtin_bit_cast(v4i, (x)[1]), 0, 1, 2, 3, 4, 5, 6, 7)
#define PG8_MMA(ai, bj, At, Bt) do { __builtin_amdgcn_s_setprio(1); if constexpr (FP8) { _Pragma("unroll") for (int m = 0; m < 4; ++m) _Pragma("unroll") for (int n = 0; n < 2; ++n) \
        acc[ai][bj][m][n] = __builtin_amdgcn_mfma_scale_f32_16x16x128_f8f6f4(PG8_V8(Bt[n]), PG8_V8(At[m]), acc[ai][bj][m][n], 0, 0, 0, sB8, 0, sA8); } else { \
        _Pragma("unroll") for (int m = 0; m < 4; ++m) _Pragma("unroll") for (int n = 0; n < 2; ++n) _Pragma("unroll") for (int k = 0; k < 2; ++k) \
        acc[ai][bj][m][n] = __builtin_amdgcn_mfma_f32_16x16x32_bf16(Bt[n][k], At[m][k], acc[ai][bj][m][n], 0, 0, 0); } __builtin_amdgcn_s_setprio(0); } while (0)
#define PG8_WAIT_V(n) asm volatile("s_waitcnt vmcnt(" #n ")" ::: "memory")
#define PG8_WAIT_L(n) asm volatile("s_waitcnt lgkmcnt(" #n ")" ::: "memory")
#define PG8_BAR __builtin_amdgcn_s_barrier()
#define PG8_SCHED __builtin_amdgcn_sched_barrier(0)
    Unit cur, nxt; int ui = 0;
    if (!S.next(0, cur)) return;
    S.a_ready(cur);
    f32x4 acc[2][2][4][2];
#pragma unroll
    for (int a = 0; a < 2; ++a)
#pragma unroll
        for (int b = 0; b < 2; ++b)
#pragma unroll
            for (int m = 0; m < 4; ++m)
#pragma unroll
                for (int n = 0; n < 2; ++n) acc[a][b][m][n] = (f32x4){0.f, 0.f, 0.f, 0.f};
    bf16x8 At[4][2], B0[2][2], B1[2][2];
    if constexpr (ROWTAB) {
        if (tid < 256) tab[tid] = S.row_slot(cur, tid);
        PG8_WAIT_L(0); PG8_BAR; asm volatile("" ::: "memory");
        if constexpr (GATHER) { PG8_LOAD_VA(0, cur); }
    }
    const char* cA = GATHER ? (const char*)g.A : S.a_base(g, cur, tstep); const char* cB = (const char*)g.Bt + (size_t)cur.pn * tstep;
    PG8_STAGE(PG8_SB(0, 0), cB, voffB); PG8_STAGE(PG8_SB(0, 1), cB + hstep, voffB); PG8_STAGE_A(PG8_SA(0, 0), cA, 0); PG8_STAGE_A(PG8_SA(0, 1), cA, 1);
    if (wr == 1) PG8_BAR;
    PG8_WAIT_V(2); PG8_BAR;
    PG8_STAGE(PG8_SB(1, 0), cB + kstep, voffB); PG8_STAGE_A(PG8_SA(1, 0), cA + kstep, 0); PG8_STAGE(PG8_SB(1, 1), cB + hstep + kstep, voffB);
    PG8_WAIT_V(6); PG8_BAR;
    for (;;) {
        const bool has_next = S.next(ui + 1, nxt);
        if (has_next) S.a_ready(nxt);
        if constexpr (ROWTAB) { if (has_next && tid < 256) tab[((ui + 1) % 3) * 256 + tid] = S.row_slot(nxt, tid); }
        const char* nA = has_next ? (GATHER ? (const char*)g.A : S.a_base(g, nxt, tstep)) : cA; const char* nB = has_next ? (const char*)g.Bt + (size_t)nxt.pn * tstep : cB;
        for (int t = 0; t < nt; t += 2) {
            const bool last = (t == nt - 2);
            const char* a1 = cA + (size_t)(t + 1) * kstep;
            const char* a2 = last ? nA : cA + (size_t)(t + 2) * kstep; const char* b2 = last ? nB : cB + (size_t)(t + 2) * kstep;
            const char* a3 = a2 + kstep; const char* b3 = b2 + kstep;
            PG8_LDB(B0, 0, 0); PG8_LDB(B1, 0, 1); PG8_SCHED; PG8_LDA(At, 0, 0); PG8_STAGE_A(PG8_SA(1, 1), a1, 1);
            if constexpr (GATHER) { if (last && has_next) { PG8_LOAD_VA((ui + 1) % 3, nxt); } }
            PG8_WAIT_V(8); PG8_WAIT_L(0); PG8_BAR; PG8_MMA(0, 0, At, B0); PG8_MMA(0, 1, At, B1); PG8_BAR; PG8_SCHED;
            PG8_LDA(At, 0, 1); PG8_STAGE(PG8_SB(0, 0), b2, voffB); PG8_STAGE(PG8_SB(0, 1), b2 + hstep, voffB); PG8_STAGE_A(PG8_SA(0, 0), a2, 0);
            PG8_WAIT_V(8); PG8_WAIT_L(0); PG8_BAR; PG8_MMA(1, 0, At, B0); PG8_MMA(1, 1, At, B1); PG8_BAR; PG8_SCHED;
            PG8_LDB(B0, 1, 0); PG8_LDB(B1, 1, 1); PG8_SCHED; PG8_LDA(At, 1, 0); PG8_STAGE_A(PG8_SA(0, 1), a2, 1);
            PG8_WAIT_V(8); PG8_WAIT_L(0); PG8_BAR; PG8_MMA(0, 0, At, B0); PG8_MMA(0, 1, At, B1); PG8_BAR; PG8_SCHED;
            PG8_LDA(At, 1, 1); PG8_STAGE(PG8_SB(1, 0), b3, voffB); PG8_STAGE(PG8_SB(1, 1), b3 + hstep, voffB); PG8_STAGE_A(PG8_SA(1, 0), a3, 0);
            PG8_WAIT_V(8); PG8_WAIT_L(0); PG8_BAR; PG8_MMA(1, 0, At, B0); PG8_MMA(1, 1, At, B1); PG8_BAR; PG8_SCHED;
        }
        if constexpr (ALIGN_EPI) { if (wr == 0) PG8_BAR; }
        E(acc, cur, wr, wc, fr, fq, (const PG8_LAS int*)(tab + (ui % 3) * 256));
        S.done(cur);
        if (!has_next) break;
        if (!E.keep(cur)) {
#pragma unroll
        for (int a = 0; a < 2; ++a)
#pragma unroll
            for (int b = 0; b < 2; ++b)
#pragma unroll
                for (int m = 0; m < 4; ++m)
#pragma unroll
                    for (int n = 0; n < 2; ++n) acc[a][b][m][n] = (f32x4){0.f, 0.f, 0.f, 0.f}; }
        cur = nxt; cA = nA; cB = nB; ++ui;
        if constexpr (ALIGN_EPI) { if (wr == 1) PG8_BAR; }
    }
    PG8_WAIT_V(0);
    if constexpr (!ALIGN_EPI) { if (wr == 0) PG8_BAR; }
    PG8_BAR;
#undef PG8_SA
#undef PG8_SB
#undef PG8_STAGE
#undef PG8_STAGE_A
#undef PG8_LOAD_VA
#undef PG8_LDA
#undef PG8_LDB
#undef PG8_MMA
#undef PG8_V8
#undef PG8_WAIT_V
#undef PG8_WAIT_L
#undef PG8_BAR
#undef PG8_SCHED
}
}

constexpr int NWAVES = 8;
constexpr int N_LAUNCHES = MK_N_LAUNCHES;
constexpr int PER_PHASE = 10;
constexpr int BATCH = 8, SEQ = 2048, DM = 1024, M = BATCH * SEQ;
constexpr int SSM_W = 512, SSM_G = 32, SSM_H = 16, SSM_P = 64, SSM_T = 16, SSM_NC = SEQ / SSM_T;
constexpr int ATT_H = 4, ATT_D = 64, ATT_V = 128, QK_W = 512, V_W = 512;
constexpr int IN_W = 4096;
constexpr int NE = 32, TOPK = 4, DE = 1024, UPW = 2048;
constexpr float RMS_EPS = 1e-6f;
constexpr float LAMBDA_INIT = 0.2f;
constexpr float QSCALE = 0.125f * 1.4426950408889634f;
constexpr int MOE_ROWS_MAX = M * TOPK + NE * 256;
constexpr int MOE_MT_MAX = MOE_ROWS_MAX / 256;

constexpr size_t MiB = 1u << 20;
constexpr size_t WS_CTL = 0, CTL_ZERO_BYTES = 1 * MiB;
constexpr size_t HI = (size_t)1 << 40;
constexpr size_t WS_WIN_OLD = 2 * MiB;
constexpr size_t WS_WGLU = 10 * MiB;
constexpr size_t WS_WPS = 11 * MiB;
constexpr size_t WS_WPA = 12 * MiB;
constexpr size_t WS_WOUT = 13 * MiB;
constexpr size_t WS_WRT = 15 * MiB;
constexpr size_t WS_S5 = 16 * MiB;
constexpr size_t WS_A16 = 24 * MiB;
constexpr size_t WS_WUP_OLD = 32 * MiB;
constexpr size_t WS_WDN_OLD = 160 * MiB;
constexpr size_t WS_XN_OLD = 224 * MiB;
constexpr size_t WS_U = 256 * MiB;
constexpr size_t WS_Q = 272 * MiB, WS_K = 288 * MiB, WS_V = 304 * MiB;
constexpr size_t WS_G1 = 320 * MiB, WS_G2 = 352 * MiB;
constexpr size_t WS_YG = 384 * MiB, WS_YS = 400 * MiB, WS_OB = 416 * MiB;
constexpr size_t WS_TA = 432 * MiB, WS_MX = 464 * MiB;
constexpr size_t WS_HB = 496 * MiB;
constexpr size_t WS_RS2 = 528 * MiB;
constexpr size_t WS_WSLOT = 529 * MiB;
constexpr size_t WS_ELIST = 530 * MiB;
constexpr size_t WS_ACT = 544 * MiB;
constexpr size_t WS_YS2 = 32 * MiB;
constexpr size_t WS_YS2_OLD = 688 * MiB;
constexpr size_t WS_END = 1024 * MiB;
constexpr size_t WS_WUP = HI + 0 * MiB, WS_WDN = HI + 64 * MiB, WS_XN = HI + 96 * MiB, WS_WIN = HI + 128 * MiB;
constexpr int CW_BAR = 4096;
constexpr int CW_Q = 20480;
constexpr int CW_CNT = 16384;

constexpr int RING_OFF = 0, RING_BYTES = 139264;
constexpr int LDSCTL_OFF = RING_BYTES, MISC_OFF = LDSCTL_OFF;
constexpr int MOE_LDS_OFF = LDSCTL_OFF + 256;
constexpr int LDS_BYTES = 147456;

#define GAS __attribute__((address_space(1)))
#define LAS __attribute__((address_space(3)))
typedef unsigned short bf16;
typedef unsigned v4u __attribute__((ext_vector_type(4)));
typedef unsigned v2u __attribute__((ext_vector_type(2)));
typedef float f32x4 __attribute__((ext_vector_type(4)));
typedef float f32x16 __attribute__((ext_vector_type(16)));
typedef short bf16x8 __attribute__((ext_vector_type(8)));
typedef short s16x4 __attribute__((ext_vector_type(4)));
typedef GAS unsigned gu32;
#define RLX_AGENT __ATOMIC_RELAXED, __HIP_MEMORY_SCOPE_AGENT
#define LDS_WAIT() asm volatile("s_waitcnt lgkmcnt(0)" ::: "memory")
#define VM_WAIT() asm volatile("s_waitcnt vmcnt(0)" ::: "memory")
using pg8::cvt_pk_bf16;
__device__ __forceinline__ unsigned f2bf(float f) { unsigned u = __builtin_bit_cast(unsigned, f); return (u + 0x7fffu + ((u >> 16) & 1u)) >> 16; }
__device__ __forceinline__ unsigned pk4_fp8(float a, float b, float c, float d) { unsigned w = 0; w = __builtin_amdgcn_cvt_pk_fp8_f32(a, b, w, false); w = __builtin_amdgcn_cvt_pk_fp8_f32(c, d, w, true); return w; }
__device__ __forceinline__ float bf2f(unsigned b) { return __builtin_bit_cast(float, b << 16); }
__device__ __forceinline__ float bflo(unsigned w) { return __builtin_bit_cast(float, w << 16); }
__device__ __forceinline__ float bfhi(unsigned w) { return __builtin_bit_cast(float, w & 0xffff0000u); }
__device__ __forceinline__ float fsigmoid(float x) { return 1.0f / (1.0f + __expf(-x)); }
__device__ __forceinline__ float fsigmoid_fast(float x) { return __builtin_amdgcn_rcpf(1.0f + __builtin_amdgcn_exp2f(-1.4426950408889634f * x)); }
__device__ __forceinline__ float gelu_tanh(float x) { const float z = 1.5957691216057308f * (x + 0.044715f * x * x * x); return x * fsigmoid_fast(z); }
__device__ __forceinline__ int crow(int r, int hi) { return (r & 3) + 8 * (r >> 2) + 4 * hi; }
__device__ __forceinline__ float wave_sum(float v) {
#pragma unroll
    for (int o = 1; o < 64; o <<= 1) v += __shfl_xor(v, o);
    return v;
}

#define XB_TMO      128
#define XB_XCNT(j)  (256  + 64 * (j))
#define XB_XSUB(j)  (1280 + 64 * (j))
#define XB_XGEN(j)  (2304 + 64 * (j))
#define XB_TOP      3328
#define XB_TOPGEN   3392
#define XCD_BAR_WORDS 3456
#define XB_SPIN_CAP (1u << 18)
__device__ __forceinline__ unsigned xb_ld(unsigned* p)              { return __hip_atomic_load(p, __ATOMIC_RELAXED, __HIP_MEMORY_SCOPE_AGENT); }
__device__ __forceinline__ unsigned xb_add(unsigned* p, unsigned v) { return __hip_atomic_fetch_add(p, v, __ATOMIC_RELAXED, __HIP_MEMORY_SCOPE_AGENT); }
__device__ __forceinline__ unsigned xb_xcc_id() { return (unsigned)__builtin_amdgcn_s_getreg((3 << 11) | 20) & 0xFu; }
#define XB_SPIN(cond, bar) do { unsigned _sp = 0; while (cond) { __builtin_amdgcn_s_sleep(1); \
    if ((++_sp & 255u) == 0u) { if (xb_ld(&(bar)[XB_TMO])) break; if (_sp > XB_SPIN_CAP) { atomicAdd(&(bar)[XB_TMO], 1u); break; } } } } while (0)
struct XcdBarrier { unsigned* bar; unsigned x; volatile LAS unsigned* st; };
__device__ __forceinline__ XcdBarrier xcd_barrier_post(unsigned* bar, volatile LAS unsigned* st) {
    XcdBarrier b; b.bar = bar; b.x = xb_xcc_id(); b.st = st;
    if (threadIdx.x == 0) (void)xb_add(&bar[XB_XCNT(b.x)], 1u);
    return b;
}
__device__ __forceinline__ void xcd_barrier_complete(unsigned* bar, unsigned x, unsigned& nloc, unsigned& nx) {
    const unsigned G = gridDim.x * gridDim.y * gridDim.z;
    unsigned sum, cnt, mine, sp = 0u;
    for (;;) {
        sum = 0u; cnt = 0u; mine = 0u;
#pragma unroll
        for (unsigned j = 0; j < 16; ++j) { const unsigned c = xb_ld(&bar[XB_XCNT(j)]); sum += c; cnt += (c > 0u) ? 1u : 0u; mine = (j == x) ? c : mine; }
        if (sum == G) break;
        __builtin_amdgcn_s_sleep(1);
        if ((++sp & 255u) == 0u) { if (xb_ld(&bar[XB_TMO])) break; if (sp > XB_SPIN_CAP) { atomicAdd(&bar[XB_TMO], 1u); break; } }
    }
    nloc = mine > 0u ? mine : 1u; nx = cnt > 0u ? cnt : 1u;
}
__device__ __forceinline__ void xcd_barrier(const XcdBarrier& b) {
    asm volatile("s_waitcnt vmcnt(0)" ::: "memory");
    __syncthreads();
    if (threadIdx.x == 0) {
        unsigned* bar = b.bar;
        __builtin_amdgcn_s_waitcnt(0);
        unsigned nloc = b.st[0], nx = b.st[1];
        if (nloc == 0u) { xcd_barrier_complete(bar, b.x, nloc, nx); b.st[0] = nloc; b.st[1] = nx; }
        const unsigned old = xb_add(&bar[XB_XSUB(b.x)], 1u);
        const unsigned gen = old / nloc;
        if (old + 1u == (gen + 1u) * nloc) {
            __builtin_amdgcn_fence(__ATOMIC_RELEASE, "agent");
            asm volatile("s_waitcnt vmcnt(0)" ::: "memory");
            const unsigned og = xb_add(&bar[XB_TOP], 1u);
            const unsigned tg = og / nx;
            if (og + 1u == (tg + 1u) * nx) xb_add(&bar[XB_TOPGEN], 1u);
            else XB_SPIN(xb_ld(&bar[XB_TOPGEN]) == tg, bar);
            __builtin_amdgcn_fence(__ATOMIC_ACQUIRE, "agent");
            xb_add(&bar[XB_XGEN(b.x)], 1u);
            asm volatile("s_waitcnt vmcnt(0)" ::: "memory");
        } else {
            XB_SPIN(xb_ld(&bar[XB_XGEN(b.x)]) == gen, bar);
            __builtin_amdgcn_fence(__ATOMIC_ACQUIRE, "agent");
            asm volatile("s_waitcnt vmcnt(0)" ::: "memory");
        }
    }
    __syncthreads();
}

struct Frame {
    LAS unsigned char* lds;
    volatile LAS unsigned* MISC;
    gu32* ctl;
    unsigned char* ws; unsigned char* hi;
    int tid, lane, wave;
    int vcu, G;
    const float* in[31];
    float* out;
};
enum { I_X = 0, I_N1G, I_WIN, I_BGATE, I_ARE, I_AIM, I_LOGDT, I_BRE, I_BIM, I_CRE, I_CIM, I_SSMD, I_WGLU, I_BGLU, I_QG, I_KG, I_LQ1, I_LK1, I_LQ2, I_LK2, I_SUBLN,
       I_WPS, I_WPA, I_WOUT, I_N2G, I_WR, I_BR, I_WUP, I_BUP, I_WDN, I_BDN };

template <int MODE>
__device__ __forceinline__ int physrow(int c) {
    if (MODE == 1) { const int w = c & 63; return (c & ~255) + 128 * (w >> 5) + 32 * ((c >> 6) & 3) + (w & 31); }
    if (MODE == 2) { const int j = c >> 1; return 256 * (j >> 7) + 128 * (c & 1) + (j & 127); }
    return c;
}
struct P0Item { const float* src; void* dst; const float* kscale; int N, K, mode, out8, k0, c0; };
__device__ __forceinline__ int physrow_rt(int mode, int c) { return mode == 1 ? physrow<1>(c) : (mode == 2 ? physrow<2>(c) : c); }
__device__ __forceinline__ void p0_item_load(const P0Item& d, f32x4 (&v)[16], int lane) {
    const int lr = lane >> 4, lc = lane & 15;
#pragma unroll
    for (int i = 0; i < 16; ++i) v[i] = __builtin_nontemporal_load((const f32x4*)(d.src + (size_t)(d.k0 + lr + 4 * i) * d.N + d.c0 + 4 * lc));
}
__device__ __forceinline__ void p0_item_finish(const P0Item& d, const f32x4 (&v)[16], LAS float* scr, int lane) {
    const int lr = lane >> 4, lc = lane & 15;
#pragma unroll
    for (int i = 0; i < 16; ++i) { const int k = lr + 4 * i; *(LAS f32x4*)(scr + k * 64 + 4 * (lc ^ ((k >> 3) & 7))) = v[i]; }
    LDS_WAIT(); asm volatile("" ::: "memory");
    const int a = lane & 7, bq = lane >> 3;
    float ks[8];
#pragma unroll
    for (int i = 0; i < 8; ++i) ks[i] = (d.kscale ? d.kscale[d.k0 + 8 * a + i] : 1.0f) * (d.out8 ? 32.0f : 1.0f);
#pragma unroll
    for (int j = 0; j < 8; ++j) { const int cl = bq + 8 * j; float x[8];
#pragma unroll
        for (int i = 0; i < 8; ++i) x[i] = scr[(8 * a + i) * 64 + 4 * ((cl >> 2) ^ a) + (cl & 3)] * ks[i];
        const size_t ro = (size_t)physrow_rt(d.mode, d.c0 + cl) * d.K + d.k0 + 8 * a;
        if (d.out8) { v2u o; o.x = pk4_fp8(x[0], x[1], x[2], x[3]); o.y = pk4_fp8(x[4], x[5], x[6], x[7]); __builtin_nontemporal_store(o, (GAS v2u*)((unsigned char*)d.dst + ro)); }
        else { v4u o; o.x = cvt_pk_bf16(x[0], x[1]); o.y = cvt_pk_bf16(x[2], x[3]); o.z = cvt_pk_bf16(x[4], x[5]); o.w = cvt_pk_bf16(x[6], x[7]); *(GAS v4u*)((bf16*)d.dst + ro) = o; } }
    LDS_WAIT(); asm volatile("" ::: "memory");
}
__device__ __forceinline__ void rms_row_to_bf16(int lane, const float* xrow, const float* g, bf16* orow) {
    const GAS f32x4* xr = (const GAS f32x4*)xrow + lane; const GAS f32x4* gr = (const GAS f32x4*)g + lane;
    f32x4 v[4]; float s = 0.f;
#pragma unroll
    for (int j = 0; j < 4; ++j) { v[j] = xr[64 * j]; s += (v[j].x * v[j].x + v[j].y * v[j].y) + (v[j].z * v[j].z + v[j].w * v[j].w); }
    const float rs = 1.0f / sqrtf(wave_sum(s) * (1.f / DM) + RMS_EPS);
    GAS unsigned long long* o8 = (GAS unsigned long long*)orow + lane;
#pragma unroll
    for (int j = 0; j < 4; ++j) { const f32x4 gg = gr[64 * j];
        o8[64 * j] = (unsigned long long)cvt_pk_bf16(v[j].x * rs * gg.x, v[j].y * rs * gg.y) | ((unsigned long long)cvt_pk_bf16(v[j].z * rs * gg.z, v[j].w * rs * gg.w) << 32); }
}
__device__ __forceinline__ void p0_s5_group(Frame& F, int g) {
    LAS float* AP = (LAS float*)(F.lds + RING_OFF);
    LAS float* BB = AP + 17 * 64 * 2;
    LAS float* CC = BB + 64 * 16 * 2;
    LAS float* KM = CC + 16 * 64 * 2;
    const float* are = F.in[I_ARE] + g * SSM_P; const float* aim = F.in[I_AIM] + g * SSM_P;
    const double dt = exp((double)F.in[I_LOGDT][g]);
    for (int e = F.tid; e < 17 * 64; e += NWAVES * 64) { const int m = e >> 6, p = e & 63; const double lr = are[p], li = aim[p];
        const double mag = exp(lr * dt * m), ang = li * dt * m; AP[e * 2] = (float)(mag * cos(ang)); AP[e * 2 + 1] = (float)(mag * sin(ang)); }
    for (int e = F.tid; e < 64 * 16; e += NWAVES * 64) { const int p = e >> 4, h = e & 15; const double lr = are[p], li = aim[p];
        const double mag = exp(lr * dt), ar = mag * cos(li * dt), ai = mag * sin(li * dt), den = lr * lr + li * li, nr = ar - 1.0, ni = ai;
        const double cr = (nr * lr + ni * li) / den, ci = (ni * lr - nr * li) / den;
        const double br = F.in[I_BRE][(size_t)(g * SSM_P + p) * SSM_H + h], bi = F.in[I_BIM][(size_t)(g * SSM_P + p) * SSM_H + h];
        BB[e * 2] = (float)(cr * br - ci * bi); BB[e * 2 + 1] = (float)(cr * bi + ci * br); }
    for (int e = F.tid; e < 16 * 64; e += NWAVES * 64) { CC[e * 2] = F.in[I_CRE][(size_t)g * 1024 + e]; CC[e * 2 + 1] = F.in[I_CIM][(size_t)g * 1024 + e]; }
    __syncthreads();
    if (F.tid < 64) { float* a16 = (float*)(F.ws + WS_A16) + (g * 64 + F.tid) * 2; a16[0] = AP[(16 * 64 + F.tid) * 2]; a16[1] = AP[(16 * 64 + F.tid) * 2 + 1]; }
    for (int e = F.tid; e < 16 * 256; e += NWAVES * 64) { const int m = e >> 8, ho = (e >> 4) & 15, hi = e & 15; float s = 0.f;
        for (int p = 0; p < 64; ++p) { const float cr = CC[(ho * 64 + p) * 2], ci = CC[(ho * 64 + p) * 2 + 1], ar = AP[(m * 64 + p) * 2], ai = AP[(m * 64 + p) * 2 + 1];
            const float tr = cr * ar - ci * ai, ti = cr * ai + ci * ar; s += tr * BB[(p * 16 + hi) * 2] - ti * BB[(p * 16 + hi) * 2 + 1]; }
        KM[e] = s; }
    __syncthreads();
    bf16* W1T = (bf16*)(F.ws + WS_S5 + (size_t)g * 262144); bf16* M2T = W1T + 128 * 256; bf16* W3T = M2T + 256 * 256;
    for (int e = F.tid; e < 128 * 256; e += NWAVES * 64) { const int n = e >> 8, k = e & 255, p = n & 63, j = k >> 4, hi = k & 15;
        const float ar = AP[((15 - j) * 64 + p) * 2], ai = AP[((15 - j) * 64 + p) * 2 + 1], br = BB[(p * 16 + hi) * 2], bi = BB[(p * 16 + hi) * 2 + 1];
        W1T[e] = (bf16)f2bf(n < 64 ? ar * br - ai * bi : ar * bi + ai * br); }
    for (int e = F.tid; e < 256 * 128; e += NWAVES * 64) { const int n = e >> 7, k = e & 127, i = n >> 4, ho = n & 15, p = k & 63;
        const float cr = CC[(ho * 64 + p) * 2], ci = CC[(ho * 64 + p) * 2 + 1], ar = AP[((i + 1) * 64 + p) * 2], ai = AP[((i + 1) * 64 + p) * 2 + 1];
        W3T[e] = (bf16)f2bf(k < 64 ? cr * ar - ci * ai : -(cr * ai + ci * ar)); }
    const float* dsk = F.in[I_SSMD] + g * 16;
    for (int e = F.tid; e < 256 * 256; e += NWAVES * 64) { const int n = e >> 8, k = e & 255, i = n >> 4, ho = n & 15, j = k >> 4, hi = k & 15;
        float v = 0.f; if (j <= i) { v = KM[((i - j) * 16 + ho) * 16 + hi]; if (i == j && ho == hi) v += dsk[ho]; }
        M2T[e] = (bf16)f2bf(v); }
    __syncthreads();
}
__device__ __forceinline__ void p0_prologue(Frame& F) {
    if (F.vcu < SSM_G) p0_s5_group(F, F.vcu);
    LAS float* scr = (LAS float*)(F.lds + RING_OFF + F.wave * 16384);
    const int gw = F.vcu * NWAVES + F.wave, NGW = F.G * NWAVES;
    { float* wrT = (float*)(F.ws + WS_WRT); const float* wr = F.in[I_WR]; const float* g2 = F.in[I_N2G];
      for (int e = gw * 64 + F.lane; e < NE * DM; e += NGW * 64) { const int ex = e >> 10, k = e & 1023; wrT[e] = g2[k] * wr[k * NE + ex]; } }
    for (int m = gw; m < M; m += NGW) rms_row_to_bf16(F.lane, F.in[I_X] + (size_t)m * DM, F.in[I_N1G], (bf16*)(F.hi + (WS_XN - HI)) + (size_t)m * DM);
    constexpr int IT_IN = (DM / 64) * (IN_W / 64), IT_GLU = (512 / 64) * (512 / 64), IT_PS = (512 / 64) * (DM / 64), IT_OUT = (DM / 64) * (DM / 64);
    constexpr int IT_UP1 = (DM / 64) * (UPW / 64), IT_DN1 = (DE / 64) * (DM / 64);
    constexpr int NITEMS = IT_IN + IT_GLU + 2 * IT_PS + IT_OUT + NE * IT_UP1 + NE * IT_DN1;
#define P0_DECODE(it, d) do { int r_ = (it); int nb_; \
        if (r_ < IT_IN) { d.src = F.in[I_WIN]; d.dst = F.hi + (WS_WIN - HI); d.kscale = nullptr; d.N = IN_W; d.K = DM; d.mode = 1; d.out8 = 0; } \
        else if ((r_ -= IT_IN) < IT_GLU) { d.src = F.in[I_WGLU]; d.dst = F.ws + WS_WGLU; d.kscale = nullptr; d.N = 512; d.K = 512; d.mode = 0; d.out8 = 0; } \
        else if ((r_ -= IT_GLU) < IT_PS) { d.src = F.in[I_WPS]; d.dst = F.ws + WS_WPS; d.kscale = nullptr; d.N = DM; d.K = 512; d.mode = 0; d.out8 = 0; } \
        else if ((r_ -= IT_PS) < IT_PS) { d.src = F.in[I_WPA]; d.dst = F.ws + WS_WPA; d.kscale = nullptr; d.N = DM; d.K = 512; d.mode = 0; d.out8 = 0; } \
        else if ((r_ -= IT_PS) < IT_OUT) { d.src = F.in[I_WOUT]; d.dst = F.ws + WS_WOUT; d.kscale = nullptr; d.N = DM; d.K = DM; d.mode = 0; d.out8 = 0; } \
        else if ((r_ -= IT_OUT) < NE * IT_UP1) { const int e_ = r_ / IT_UP1; r_ -= e_ * IT_UP1; d.src = F.in[I_WUP] + (size_t)e_ * DM * UPW; d.dst = F.hi + (WS_WUP - HI) + (size_t)e_ * UPW * DM; d.kscale = F.in[I_N2G]; d.N = UPW; d.K = DM; d.mode = 2; d.out8 = 1; } \
        else { r_ -= NE * IT_UP1; const int e_ = r_ / IT_DN1; r_ -= e_ * IT_DN1; d.src = F.in[I_WDN] + (size_t)e_ * DE * DM; d.dst = F.hi + (WS_WDN - HI) + (size_t)e_ * DM * DE; d.kscale = nullptr; d.N = DM; d.K = DE; d.mode = 0; d.out8 = 1; } \
        nb_ = d.N / 64; d.k0 = 64 * (r_ / nb_); d.c0 = 64 * (r_ % nb_); } while (0)
    int qcur = 0, qend = 0;
#define P0_DRAW(it) do { if (qcur == qend) { unsigned q_ = 0; if (F.lane == 0) q_ = atomicAdd((unsigned*)(F.ctl + CW_Q), 1u); qcur = 8 * (int)__builtin_amdgcn_readfirstlane(q_); qend = qcur + 8; } it = qcur++; } while (0)
    {
        P0Item dA, dB; f32x4 vA[16], vB[16]; int itA, itB;
        P0_DRAW(itA);
        if (itA < NITEMS) { P0_DECODE(itA, dA); p0_item_load(dA, vA, F.lane);
            for (;;) {
                P0_DRAW(itB); const bool hasB = itB < NITEMS;
                if (hasB) { P0_DECODE(itB, dB); p0_item_load(dB, vB, F.lane); }
                p0_item_finish(dA, vA, scr, F.lane);
                if (!hasB) break;
                P0_DRAW(itA); const bool hasA = itA < NITEMS;
                if (hasA) { P0_DECODE(itA, dA); p0_item_load(dA, vA, F.lane); }
                p0_item_finish(dB, vB, scr, F.lane);
                if (!hasA) break;
            } }
    }
#undef P0_DECODE
#undef P0_DRAW
}

typedef const pg8::f32x4 (&AccRef)[2][2][4][2];
__device__ __forceinline__ v4u pack8(const f32x4 a, const f32x4 b) { v4u w; w.x = cvt_pk_bf16(a[0], a[1]); w.y = cvt_pk_bf16(a[2], a[3]); w.z = cvt_pk_bf16(b[0], b[1]); w.w = cvt_pk_bf16(b[2], b[3]); return w; }
__device__ __forceinline__ void unpack8(const v4u w, f32x4& a, f32x4& b) { a = (f32x4){bflo(w.x), bfhi(w.x), bflo(w.y), bfhi(w.y)}; b = (f32x4){bflo(w.z), bfhi(w.z), bflo(w.w), bfhi(w.w)}; }

struct EpiInProj {
    static constexpr bool PERM = true;
    __device__ __forceinline__ bool keep(const pg8::Unit&) const { return false; }
    bf16 *U, *Q, *Kb, *V, *G1, *G2; const float *bgate, *qg, *kg;
    __device__ __forceinline__ void operator()(AccRef acc, const pg8::Unit& u, int wr, int wc, int fr, int fq, const LAS int*) const {
        const int pn = u.pn, row0 = u.pm * 256 + wr * 64 + fr;
        if (pn < 2) {
#pragma unroll
            for (int ai = 0; ai < 2; ++ai)
#pragma unroll
                for (int m = 0; m < 4; ++m) { const int row = row0 + ai * 128 + m * 16, b = row >> 11, t = row & 2047;
#pragma unroll
                    for (int bj = 0; bj < 2; ++bj) { const int lc = 256 * pn + 64 * wc + 32 * bj + 8 * fq, g = lc >> 4, ch = lc & 15;
                        *(v4u*)(U + ((size_t)(b * SSM_G + g) * SEQ + t) * 16 + ch) = pack8(acc[ai][bj][m][0], acc[ai][bj][m][1]); } }
        } else if (pn < 6) {
            const bool isq = pn < 4; const float* gv = isq ? qg : kg; const float sc = isq ? QSCALE : 1.0f;
            bf16* dst = (isq ? Q : Kb) + 256 * (pn - (isq ? 2 : 4)) + 64 * wc + 8 * fq;
            f32x4 gg[2][2];
#pragma unroll
            for (int bj = 0; bj < 2; ++bj)
#pragma unroll
                for (int n = 0; n < 2; ++n) gg[bj][n] = *(const f32x4*)(gv + 32 * bj + 8 * fq + 4 * n) * sc;
#pragma unroll
            for (int ai = 0; ai < 2; ++ai)
#pragma unroll
                for (int m = 0; m < 4; ++m) { const int row = row0 + ai * 128 + m * 16; float ss = 0.f;
#pragma unroll
                    for (int bj = 0; bj < 2; ++bj)
#pragma unroll
                        for (int n = 0; n < 2; ++n) { const f32x4 x = acc[ai][bj][m][n]; ss += (x[0] * x[0] + x[1] * x[1]) + (x[2] * x[2] + x[3] * x[3]); }
                    ss += __shfl_xor(ss, 16); ss += __shfl_xor(ss, 32);
                    const float rs = __builtin_amdgcn_rsqf(ss * (1.0f / 64.0f) + RMS_EPS);
#pragma unroll
                    for (int bj = 0; bj < 2; ++bj) *(v4u*)(dst + (size_t)row * 512 + 32 * bj) = pack8(acc[ai][bj][m][0] * rs * gg[bj][0], acc[ai][bj][m][1] * rs * gg[bj][1]); }
        } else if (pn < 8) {
            bf16* dst = V + 256 * (pn - 6) + 64 * wc + 8 * fq;
#pragma unroll
            for (int ai = 0; ai < 2; ++ai)
#pragma unroll
                for (int m = 0; m < 4; ++m) { const int row = row0 + ai * 128 + m * 16;
#pragma unroll
                    for (int bj = 0; bj < 2; ++bj) *(v4u*)(dst + (size_t)row * 512 + 32 * bj) = pack8(acc[ai][bj][m][0], acc[ai][bj][m][1]); }
        } else {
            const int gc = 256 * (pn - 8) + 64 * wc + 8 * fq;
            bf16* dst = (gc < 1024 ? G1 + gc : G2 + (gc - 1024));
            f32x4 bb[2][2];
#pragma unroll
            for (int bj = 0; bj < 2; ++bj)
#pragma unroll
                for (int n = 0; n < 2; ++n) bb[bj][n] = *(const f32x4*)(bgate + gc + 32 * bj + 4 * n);
#pragma unroll
            for (int ai = 0; ai < 2; ++ai)
#pragma unroll
                for (int m = 0; m < 4; ++m) { const int row = row0 + ai * 128 + m * 16;
#pragma unroll
                    for (int bj = 0; bj < 2; ++bj) { f32x4 a = acc[ai][bj][m][0] + bb[bj][0], b = acc[ai][bj][m][1] + bb[bj][1];
#pragma unroll
                        for (int e = 0; e < 4; ++e) { a[e] = fsigmoid(a[e]); b[e] = fsigmoid(b[e]); }
                        *(v4u*)(dst + (size_t)row * 1024 + 32 * bj) = pack8(a, b); } }
        }
    }
};
template <int MODE> struct EpiMix {
    static constexpr bool PERM = true;
    __device__ __forceinline__ bool keep(const pg8::Unit&) const { return false; }
    const bf16* P0; const bf16* P1; bf16* O; const float* bias; int ld;
    __device__ __forceinline__ void operator()(AccRef acc, const pg8::Unit& u, int wr, int wc, int fr, int fq, const LAS int*) const {
        const int row0 = u.pm * 256 + wr * 64 + fr, col0 = u.pn * 256 + wc * 32 + 8 * fq;
        f32x4 bb[2][2];
#pragma unroll
        for (int bj = 0; bj < 2; ++bj)
#pragma unroll
            for (int n = 0; n < 2; ++n) bb[bj][n] = (MODE == 0) ? *(const f32x4*)(bias + col0 + bj * 128 + 4 * n) : (f32x4){0.f, 0.f, 0.f, 0.f};
#pragma unroll
        for (int ai = 0; ai < 2; ++ai) {
            v4u q0[4][2], q1[4][2];
#pragma unroll
            for (int m = 0; m < 4; ++m)
#pragma unroll
                for (int bj = 0; bj < 2; ++bj) { const size_t off = (size_t)(row0 + ai * 128 + m * 16) * ld + col0 + bj * 128; q0[m][bj] = *(const v4u*)(P0 + off); if (MODE == 2) q1[m][bj] = *(const v4u*)(P1 + off); }
#pragma unroll
            for (int m = 0; m < 4; ++m) { const size_t off = (size_t)(row0 + ai * 128 + m * 16) * ld + col0;
#pragma unroll
                for (int bj = 0; bj < 2; ++bj) { f32x4 a = acc[ai][bj][m][0], b = acc[ai][bj][m][1], p0a, p0b;
                    unpack8(q0[m][bj], p0a, p0b);
                    if (MODE == 0) { a += bb[bj][0]; b += bb[bj][1];
#pragma unroll
                        for (int e = 0; e < 4; ++e) { a[e] = p0a[e] * fsigmoid_fast(a[e]); b[e] = p0b[e] * fsigmoid_fast(b[e]); } }
                    else if (MODE == 1) { a *= p0a; b *= p0b; }
                    else { f32x4 p1a, p1b; unpack8(q1[m][bj], p1a, p1b); a = p0a + p1a * a; b = p0b + p1b * b; }
                    *(v4u*)(O + off + bj * 128) = pack8(a, b); } } }
    }
};
struct EpiOut {
    static constexpr bool PERM = false;
    __device__ __forceinline__ bool keep(const pg8::Unit&) const { return false; }
    const float* X; float* H; unsigned char* HB;
    __device__ __forceinline__ void operator()(AccRef acc, const pg8::Unit& u, int wr, int wc, int fr, int fq, const LAS int*) const {
        const int row0 = u.pm * 256 + wr * 64 + fr, col0 = u.pn * 256 + wc * 32 + 4 * fq;
#pragma unroll
        for (int ai = 0; ai < 2; ++ai) {
            f32x4 xv[4][2][2];
#pragma unroll
            for (int m = 0; m < 4; ++m)
#pragma unroll
                for (int bj = 0; bj < 2; ++bj)
#pragma unroll
                    for (int n = 0; n < 2; ++n) xv[m][bj][n] = *(const f32x4*)(X + (size_t)(row0 + ai * 128 + m * 16) * DM + col0 + bj * 128 + n * 16);
#pragma unroll
            for (int m = 0; m < 4; ++m) { const size_t off = (size_t)(row0 + ai * 128 + m * 16) * DM + col0;
#pragma unroll
                for (int bj = 0; bj < 2; ++bj)
#pragma unroll
                    for (int n = 0; n < 2; ++n) { const f32x4 h = xv[m][bj][n] + acc[ai][bj][m][n];
                        *(f32x4*)(H + off + bj * 128 + n * 16) = h; *(unsigned*)(HB + off + bj * 128 + n * 16) = pk4_fp8(h[0], h[1], h[2], h[3]); } } }
    }
};
struct ChainOrder {
    pg8::StaticOrder so; const bf16* A_att; const bf16* A_ssm;
    __device__ __forceinline__ bool next(int i, pg8::Unit& u) const { pg8::Unit t; if (!so.next(i >> 1, t)) return false; u.pm = t.pm; u.pn = (i & 1) ? t.pn : 4 + t.pn; return true; }
    __device__ __forceinline__ int row_slot(const pg8::Unit&, int) const { return 0; }
    __device__ __forceinline__ int a_row(const pg8::Unit& u, int r, int) const { return u.pm * 256 + r; }
    __device__ __forceinline__ const char* a_base(const pg8::Gemm&, const pg8::Unit& u, size_t tstep) const { return (const char*)(u.pn >= 4 ? A_att : A_ssm) + (size_t)u.pm * tstep; }
    __device__ __forceinline__ void a_ready(const pg8::Unit&) const {}
    __device__ __forceinline__ void done(const pg8::Unit&) const {}
};
struct EpiChain {
    static constexpr bool PERM = true;
    const bf16* G1; const bf16* G2; bf16* MX;
    __device__ __forceinline__ bool keep(const pg8::Unit& u) const { return u.pn >= 4; }
    __device__ __forceinline__ void operator()(pg8::f32x4 (&acc)[2][2][4][2], const pg8::Unit& u, int wr, int wc, int fr, int fq, const LAS int*) const {
        const bool att = u.pn >= 4; const int row0 = u.pm * 256 + wr * 64 + fr, col0 = (u.pn & 3) * 256 + wc * 32 + 8 * fq;
#pragma unroll
        for (int ai = 0; ai < 2; ++ai) {
            v4u q1[4][2], q2[4][2];
#pragma unroll
            for (int m = 0; m < 4; ++m)
#pragma unroll
                for (int bj = 0; bj < 2; ++bj) { const size_t off = (size_t)(row0 + ai * 128 + m * 16) * DM + col0 + bj * 128; q1[m][bj] = *(const v4u*)(G1 + off); if (att) q2[m][bj] = *(const v4u*)(G2 + off); }
#pragma unroll
            for (int m = 0; m < 4; ++m)
#pragma unroll
                for (int bj = 0; bj < 2; ++bj) { f32x4 g1a, g1b; unpack8(q1[m][bj], g1a, g1b);
                    if (att) { f32x4 g2a, g2b; unpack8(q2[m][bj], g2a, g2b);
#pragma unroll
                        for (int e = 0; e < 4; ++e) { acc[ai][bj][m][0][e] *= g2a[e] * __builtin_amdgcn_rcpf(g1a[e]); acc[ai][bj][m][1][e] *= g2b[e] * __builtin_amdgcn_rcpf(g1b[e]); } }
                    else *(v4u*)(MX + (size_t)(row0 + ai * 128 + m * 16) * DM + col0 + bj * 128) = pack8(acc[ai][bj][m][0] * g1a, acc[ai][bj][m][1] * g1b); } }
    }
};
constexpr int CW_MFLAG = 32768, MFLAG_STRIDE = 16;
template <int NN, bool TOKROWS> struct MoeOrder {
    int nunits, G, vcu; const LAS int* cnt; const LAS int* tstart; const LAS int* tile2e; const int* elist; unsigned* mflag;
    __device__ __forceinline__ void a_ready(const pg8::Unit& u) const {
        if constexpr (!TOKROWS) { unsigned* f = mflag + u.pm * MFLAG_STRIDE; unsigned spins = 0;
            while (__hip_atomic_load(f, __ATOMIC_RELAXED, __HIP_MEMORY_SCOPE_AGENT) < 8u && ++spins < (1u << 22)) __builtin_amdgcn_s_sleep(2);
            asm volatile("" ::: "memory"); } }
    __device__ __forceinline__ void done(const pg8::Unit& u) const {
        if constexpr (TOKROWS) { asm volatile("s_waitcnt vmcnt(0)" ::: "memory"); __builtin_amdgcn_s_barrier(); asm volatile("" ::: "memory");
            if (threadIdx.x == 0) __hip_atomic_fetch_add(mflag + u.pm * MFLAG_STRIDE, 1u, __ATOMIC_RELAXED, __HIP_MEMORY_SCOPE_AGENT); } }
    __device__ __forceinline__ bool next(int i, pg8::Unit& u) const { const long L = (long)i * G + vcu; if (L >= nunits) return false; const int pm = (int)(L / NN), pnl = (int)(L % NN);
        u.pm = pm; u.pn = tile2e[pm] * NN + pnl; return true; }
    __device__ __forceinline__ int row_slot(const pg8::Unit& u, int r) const { const int e = u.pn / NN, pos = (u.pm - tstart[e]) * 256 + r; return pos < cnt[e] ? elist[e * M + pos] : -1; }
    __device__ __forceinline__ int a_row(const pg8::Unit& u, int r, int slot) const { return TOKROWS ? (slot < 0 ? 0 : (slot >> 2)) : u.pm * 256 + r; }
    __device__ __forceinline__ const char* a_base(const pg8::Gemm& g, const pg8::Unit&, size_t) const { return (const char*)g.A; }
};
struct EpiUp {
    static constexpr bool PERM = true;
    __device__ __forceinline__ bool keep(const pg8::Unit&) const { return false; }
    unsigned char* ACT; const float* bup; const float* rs2;
    __device__ __forceinline__ void operator()(AccRef acc, const pg8::Unit& u, int wr, int wc, int fr, int fq, const LAS int* tab) const {
        const int e = u.pn >> 3, pnl = u.pn & 7, j0 = 128 * pnl + 32 * wc + 8 * fq;
        f32x4 bb[4];
#pragma unroll
        for (int q = 0; q < 4; ++q) bb[q] = *(const f32x4*)(bup + (size_t)e * UPW + 2 * j0 + 4 * q);
        int sl[2][4]; float rsv[2][4];
#pragma unroll
        for (int ai = 0; ai < 2; ++ai)
#pragma unroll
            for (int m = 0; m < 4; ++m) { sl[ai][m] = tab[ai * 128 + wr * 64 + m * 16 + fr]; rsv[ai][m] = rs2[sl[ai][m] < 0 ? 0 : (sl[ai][m] >> 2)]; }
#pragma unroll
        for (int ai = 0; ai < 2; ++ai)
#pragma unroll
            for (int m = 0; m < 4; ++m) { const int r = ai * 128 + wr * 64 + m * 16 + fr, slot = sl[ai][m];
                if (slot >= 0) { const float rs = rsv[ai][m]; f32x4 o[2];
#pragma unroll
                    for (int n = 0; n < 2; ++n)
#pragma unroll
                        for (int e4 = 0; e4 < 4; ++e4) { const int j = 4 * n + e4;
                            float gl = acc[ai][0][m][n][e4] * rs + bb[(2 * j) >> 2][(2 * j) & 3], li = acc[ai][1][m][n][e4] * rs + bb[(2 * j + 1) >> 2][(2 * j + 1) & 3];
                            gl = fminf(gl, 7.0f); li = fminf(fmaxf(li, -7.0f), 7.0f);
                            o[n][e4] = gl * fsigmoid_fast(1.702f * gl) * (li + 1.0f) * 4.0f; }
                    const unsigned long long ov = (unsigned long long)pk4_fp8(o[0][0], o[0][1], o[0][2], o[0][3]) | ((unsigned long long)pk4_fp8(o[1][0], o[1][1], o[1][2], o[1][3]) << 32);
                    __hip_atomic_store((unsigned long long*)(ACT + (size_t)(u.pm * 256 + r) * DE + j0), ov, __ATOMIC_RELAXED, __HIP_MEMORY_SCOPE_AGENT); } }
    }
};
struct EpiDown {
    static constexpr bool PERM = true;
    __device__ __forceinline__ bool keep(const pg8::Unit&) const { return false; }
    bf16* YS2; const float* bdn; const float* wslot;
    __device__ __forceinline__ void operator()(AccRef acc, const pg8::Unit& u, int wr, int wc, int fr, int fq, const LAS int* tab) const {
        const int e = u.pn >> 2, pnl = u.pn & 3, c0 = 256 * pnl + 32 * wc + 8 * fq;
        f32x4 bb[2][2];
#pragma unroll
        for (int bj = 0; bj < 2; ++bj)
#pragma unroll
            for (int n = 0; n < 2; ++n) bb[bj][n] = *(const f32x4*)(bdn + (size_t)e * DM + c0 + bj * 128 + 4 * n);
        int sl[2][4]; float wv[2][4];
#pragma unroll
        for (int ai = 0; ai < 2; ++ai)
#pragma unroll
            for (int m = 0; m < 4; ++m) { sl[ai][m] = tab[ai * 128 + wr * 64 + m * 16 + fr]; wv[ai][m] = wslot[sl[ai][m] < 0 ? 0 : sl[ai][m]]; }
#pragma unroll
        for (int ai = 0; ai < 2; ++ai)
#pragma unroll
            for (int m = 0; m < 4; ++m) { const int slot = sl[ai][m];
                if (slot >= 0) { const float w = wv[ai][m];
#pragma unroll
                    for (int bj = 0; bj < 2; ++bj) *(v4u*)(YS2 + (size_t)slot * DM + c0 + bj * 128) = pack8((acc[ai][bj][m][0] + bb[bj][0]) * w, (acc[ai][bj][m][1] + bb[bj][1]) * w); } }
    }
};

constexpr int S5_UPITCH = 528, S5_SX_OFF = 128 * S5_UPITCH, S5_XPITCH = 132;
__device__ __forceinline__ void s5_unit(Frame& F, int b, int g) {
    LAS unsigned char* Uimg = F.lds + RING_OFF; LAS float* SX = (LAS float*)(F.lds + RING_OFF + S5_SX_OFF);
    const int tid = F.tid, lane = F.lane, w = F.wave, r32 = lane & 31, hi = lane >> 5;
    const bf16* Ug = (const bf16*)(F.ws + WS_U) + (size_t)(b * SSM_G + g) * SEQ * 16;
    const bf16* W1T = (const bf16*)(F.ws + WS_S5 + (size_t)g * 262144); const bf16* M2T = W1T + 128 * 256; const bf16* W3T = M2T + 256 * 256;
#pragma unroll
    for (int j = 0; j < 8; ++j) { const int q = tid + 512 * j; *(LAS v4u*)(Uimg + (q >> 5) * S5_UPITCH + (q & 31) * 16) = *(const v4u*)(Ug + (size_t)q * 8); }
    __syncthreads();
    { const int nt = w & 3, mt0 = 2 * (w >> 2);
      f32x16 s0 = {0}, s1 = {0};
#pragma unroll 4
      for (int ks = 0; ks < 16; ++ks) {
          const bf16x8 bf = *(const bf16x8*)(W1T + (size_t)(32 * nt + r32) * 256 + 16 * ks + 8 * hi);
          const bf16x8 a0 = *(const LAS bf16x8*)(Uimg + (32 * mt0 + r32) * S5_UPITCH + (16 * ks + 8 * hi) * 2);
          const bf16x8 a1 = *(const LAS bf16x8*)(Uimg + (32 * (mt0 + 1) + r32) * S5_UPITCH + (16 * ks + 8 * hi) * 2);
          s0 = __builtin_amdgcn_mfma_f32_32x32x16_bf16(a0, bf, s0, 0, 0, 0); s1 = __builtin_amdgcn_mfma_f32_32x32x16_bf16(a1, bf, s1, 0, 0, 0); }
#pragma unroll
      for (int r = 0; r < 16; ++r) { SX[(32 * mt0 + crow(r, hi)) * S5_XPITCH + 32 * nt + r32] = s0[r]; SX[(32 * (mt0 + 1) + crow(r, hi)) * S5_XPITCH + 32 * nt + r32] = s1[r]; } }
    __syncthreads();
    if (tid < 64) {
        const float* a16 = (const float*)(F.ws + WS_A16) + (g * 64 + tid) * 2; const float ar = a16[0], ai = a16[1]; float xr = 0.f, xi = 0.f;
#pragma unroll 8
        for (int c = 0; c < SSM_NC; ++c) { const float sr = SX[c * S5_XPITCH + tid], si = SX[c * S5_XPITCH + 64 + tid];
            SX[c * S5_XPITCH + tid] = xr; SX[c * S5_XPITCH + 64 + tid] = xi;
            const float nr = ar * xr - ai * xi + sr, ni = ar * xi + ai * xr + si; xr = nr; xi = ni; }
    }
    __syncthreads();
    { f32x16 y[4] = {{0}, {0}, {0}, {0}};
      const int nks = 2 * w + 2;
      for (int ks = 0; ks < nks; ++ks) {
          const bf16x8 bf = *(const bf16x8*)(M2T + (size_t)(32 * w + r32) * 256 + 16 * ks + 8 * hi);
#pragma unroll
          for (int mt = 0; mt < 4; ++mt) { const bf16x8 a = *(const LAS bf16x8*)(Uimg + (32 * mt + r32) * S5_UPITCH + (16 * ks + 8 * hi) * 2); y[mt] = __builtin_amdgcn_mfma_f32_32x32x16_bf16(a, bf, y[mt], 0, 0, 0); } }
#pragma unroll 2
      for (int ks = 0; ks < 8; ++ks) {
          const bf16x8 bf = *(const bf16x8*)(W3T + (size_t)(32 * w + r32) * 128 + 16 * ks + 8 * hi);
#pragma unroll
          for (int mt = 0; mt < 4; ++mt) { const LAS f32x4* xp = (const LAS f32x4*)(SX + (32 * mt + r32) * S5_XPITCH + 16 * ks + 8 * hi); const f32x4 x0 = xp[0], x1 = xp[1];
              const v4u pk = pack8(x0, x1); y[mt] = __builtin_amdgcn_mfma_f32_32x32x16_bf16(__builtin_bit_cast(bf16x8, pk), bf, y[mt], 0, 0, 0); } }
      bf16* YG = (bf16*)(F.ws + WS_YG); const int i = 2 * w + (r32 >> 4), ho = r32 & 15;
#pragma unroll
      for (int mt = 0; mt < 4; ++mt)
#pragma unroll
          for (int r = 0; r < 16; ++r) { const int c = 32 * mt + crow(r, hi); YG[(size_t)(b * SEQ + 16 * c + i) * SSM_W + g * 16 + ho] = (bf16)f2bf(gelu_tanh(y[mt][r])); } }
    __syncthreads();
}

constexpr int AT_KP = 272, AT_VP = 320, AT_KB = 64 * AT_KP, AT_VB = 64 * AT_VP, AT_BUF = AT_KB + AT_VB;
__device__ __forceinline__ s16x4 vtr(const LAS unsigned char* p) { typedef short v4i16_t __attribute__((ext_vector_type(4))); return __builtin_bit_cast(s16x4, __builtin_amdgcn_ds_read_tr16_b64_v4i16((LAS v4i16_t*)p)); }
__device__ __forceinline__ void attn_unit(Frame& F, int b, int h, int qb, float lam) {
    const int tid = F.tid, lane = F.lane, w = F.wave, rg = w >> 1, t = w & 1, r32 = lane & 31, hi = lane >> 5;
    const bf16* Q = (const bf16*)(F.ws + WS_Q); const bf16* K = (const bf16*)(F.ws + WS_K); const bf16* V = (const bf16*)(F.ws + WS_V); bf16* OB = (bf16*)(F.ws + WS_OB);
    LAS unsigned char* L = F.lds + RING_OFF;
    const int qrow = b * SEQ + qb * 128 + rg * 32 + r32;
    bf16x8 qf[4];
#pragma unroll
    for (int ks = 0; ks < 4; ++ks) qf[ks] = *(const bf16x8*)(Q + (size_t)qrow * QK_W + h * 128 + t * 64 + 16 * ks + 8 * hi);
    const int ntile = 2 * qb + 2, mylim = 2 * qb + (rg >> 1);
    const int kr0 = tid >> 4, cc = tid & 15;
    const size_t gbase = (size_t)(b * SEQ) * 512 + h * 128 + cc * 8;
    v4u kregA[2], vregA[2], kregB[2], vregB[2];
#define AT_LOAD(j, kreg, vreg) do { _Pragma("unroll") for (int i_ = 0; i_ < 2; ++i_) { const size_t o_ = gbase + (size_t)(64 * (j) + kr0 + 32 * i_) * 512; kreg[i_] = *(const v4u*)(K + o_); vreg[i_] = *(const v4u*)(V + o_); } } while (0)
#define AT_STORE(buf, kreg, vreg) do { _Pragma("unroll") for (int i_ = 0; i_ < 2; ++i_) { *(LAS v4u*)(L + (buf) * AT_BUF + (kr0 + 32 * i_) * AT_KP + cc * 16) = kreg[i_]; \
        *(LAS v4u*)(L + (buf) * AT_BUF + AT_KB + (kr0 + 32 * i_) * AT_VP + cc * 16) = vreg[i_]; } } while (0)
    AT_LOAD(0, kregB, vregB); AT_LOAD(1, kregA, vregA); AT_STORE(0, kregB, vregB);
    __syncthreads();
    f32x16 o[4] = {{0}, {0}, {0}, {0}};
    float mrun = -60.0f, lrun = 0.f;
    f32x16 negm;
#pragma unroll
    for (int r = 0; r < 16; ++r) negm[r] = 60.0f;
    const int g4 = lane >> 4, i16 = lane & 15;
    const int vlane = (4 * (g4 >> 1) + (i16 >> 2)) * AT_VP + (16 * (g4 & 1) + 4 * (i16 & 3)) * 2;
#define AT_COMPUTE(j, buf) do { \
        if (j <= mylim) { \
            const LAS unsigned char* Kb = L + buf * AT_BUF + t * 128 + hi * 16 + r32 * AT_KP; \
            const LAS unsigned char* Vb = L + buf * AT_BUF + AT_KB + vlane; \
            f32x16 s0, s1; \
            __builtin_amdgcn_s_setprio(1); \
        _Pragma("unroll") \
            for (int ks = 0; ks < 4; ++ks) { const bf16x8 k0 = *(const LAS bf16x8*)(Kb + ks * 32), k1 = *(const LAS bf16x8*)(Kb + 32 * AT_KP + ks * 32); \
                if (ks == 0) { s0 = __builtin_amdgcn_mfma_f32_32x32x16_bf16(k0, qf[0], negm, 0, 0, 0); s1 = __builtin_amdgcn_mfma_f32_32x32x16_bf16(k1, qf[0], negm, 0, 0, 0); } \
                else { s0 = __builtin_amdgcn_mfma_f32_32x32x16_bf16(k0, qf[ks], s0, 0, 0, 0); s1 = __builtin_amdgcn_mfma_f32_32x32x16_bf16(k1, qf[ks], s1, 0, 0, 0); } } \
            __builtin_amdgcn_s_setprio(0); \
            float mx = fmaxf(fmaxf(s0[0], s0[1]), s0[2]); \
        _Pragma("unroll") \
            for (int r = 3; r < 15; r += 2) mx = fmaxf(fmaxf(mx, s0[r]), s0[r + 1]); \
            mx = fmaxf(mx, s0[15]); \
        _Pragma("unroll") \
            for (int r = 0; r < 16; r += 2) mx = fmaxf(fmaxf(mx, s1[r]), s1[r + 1]); \
            mx = fmaxf(mx, __shfl_xor(mx, 32)); \
            if (__builtin_amdgcn_ballot_w64(mx > 8.0f) != 0ull) { \
                const float dm = (mx > 8.0f) ? mx : 0.0f, alpha = __builtin_amdgcn_exp2f(-dm); lrun *= alpha; mrun += dm; \
        _Pragma("unroll") \
                for (int dt = 0; dt < 4; ++dt) o[dt] *= alpha; \
        _Pragma("unroll") \
                for (int r = 0; r < 16; ++r) { s0[r] -= dm; s1[r] -= dm; negm[r] = -mrun; } } \
            float ps = 0.f; \
        _Pragma("unroll") \
            for (int r = 0; r < 16; ++r) { s0[r] = __builtin_amdgcn_exp2f(s0[r]); s1[r] = __builtin_amdgcn_exp2f(s1[r]); ps += s0[r] + s1[r]; } \
            lrun += ps; \
        _Pragma("unroll") \
            for (int s = 0; s < 4; ++s) { \
                v4u pk; const int rb = 8 * (s & 1); \
                if (s < 2) { pk.x = cvt_pk_bf16(s0[rb], s0[rb + 1]); pk.y = cvt_pk_bf16(s0[rb + 2], s0[rb + 3]); pk.z = cvt_pk_bf16(s0[rb + 4], s0[rb + 5]); pk.w = cvt_pk_bf16(s0[rb + 6], s0[rb + 7]); } \
                else       { pk.x = cvt_pk_bf16(s1[rb], s1[rb + 1]); pk.y = cvt_pk_bf16(s1[rb + 2], s1[rb + 3]); pk.z = cvt_pk_bf16(s1[rb + 4], s1[rb + 5]); pk.w = cvt_pk_bf16(s1[rb + 6], s1[rb + 7]); } \
                const bf16x8 pf = __builtin_bit_cast(bf16x8, pk); \
                __builtin_amdgcn_s_setprio(1); \
        _Pragma("unroll") \
                for (int dt = 0; dt < 4; ++dt) { const s16x4 lo = vtr(Vb + s * 16 * AT_VP + dt * 64), hh = vtr(Vb + s * 16 * AT_VP + dt * 64 + 8 * AT_VP); \
                    const bf16x8 vf = (bf16x8){lo[0], lo[1], lo[2], lo[3], hh[0], hh[1], hh[2], hh[3]}; \
                    o[dt] = __builtin_amdgcn_mfma_f32_32x32x16_bf16(vf, pf, o[dt], 0, 0, 0); } \
                __builtin_amdgcn_s_setprio(0); } \
        } \
    } while (0)
    for (int j = 0; j < ntile; j += 2) {
        { const int jn = (j + 2 < ntile) ? j + 2 : ntile - 1; AT_LOAD(jn, kregB, vregB); }
        AT_COMPUTE(j, 0);
        AT_STORE(1, kregA, vregA);
        __syncthreads();
        { const int jn = (j + 3 < ntile) ? j + 3 : ntile - 1; AT_LOAD(jn, kregA, vregA); }
        AT_COMPUTE(j + 1, 1);
        AT_STORE(0, kregB, vregB);
        __syncthreads();
    }
#undef AT_COMPUTE
#undef AT_LOAD
#undef AT_STORE
    const float ltot = lrun + __shfl_xor(lrun, 32), inv = 1.0f / ltot;
    LAS float* EX = (LAS float*)L + rg * 4096;
    if (t == 1) {
        const float sc = inv * lam;
#pragma unroll
        for (int dt = 0; dt < 4; ++dt)
#pragma unroll
            for (int r = 0; r < 16; ++r) EX[(dt * 16 + r) * 64 + lane] = o[dt][r] * sc;
    }
    __syncthreads();
    if (t == 0) {
        float ss = 0.f;
#pragma unroll
        for (int dt = 0; dt < 4; ++dt)
#pragma unroll
            for (int r = 0; r < 16; ++r) { const float y = o[dt][r] * inv - EX[(dt * 16 + r) * 64 + lane]; o[dt][r] = y; ss += y * y; }
        ss += __shfl_xor(ss, 32);
        const float rn = (1.0f - LAMBDA_INIT) / sqrtf(ss * (1.0f / 128.0f) + RMS_EPS);
        const float* sg = F.in[I_SUBLN];
        f32x4 ggv[4][4];
#pragma unroll
        for (int dt = 0; dt < 4; ++dt)
#pragma unroll
            for (int rq = 0; rq < 4; ++rq) ggv[dt][rq] = *(const f32x4*)(sg + 32 * dt + 8 * rq + 4 * hi);
#pragma unroll
        for (int dt = 0; dt < 4; ++dt)
#pragma unroll
            for (int rq = 0; rq < 4; ++rq) { const int d = 32 * dt + 8 * rq + 4 * hi; const f32x4 gg = ggv[dt][rq];
                v2u wv; wv.x = cvt_pk_bf16(o[dt][4 * rq] * rn * gg[0], o[dt][4 * rq + 1] * rn * gg[1]); wv.y = cvt_pk_bf16(o[dt][4 * rq + 2] * rn * gg[2], o[dt][4 * rq + 3] * rn * gg[3]);
                *(v2u*)(OB + (size_t)qrow * V_W + h * 128 + d) = wv; }
    }
    __syncthreads();
}

constexpr int CW_CNT_STRIDE = 64;
__device__ __forceinline__ void router_phase(Frame& F, const bool dummy = false) {
    const int lane = F.lane, tid = F.tid, w = F.wave, tt = w >> 1, kh = w & 1;
    LAS float* LG = (LAS float*)(F.lds + RING_OFF);
    LAS float* SS = LG + 4 * 2 * 16 * 33;
    LAS int* LC = (LAS int*)(SS + 128);
    const float* Hf = F.out; const float* wrT = (const float*)(F.ws + WS_WRT); const float* br = F.in[I_BR];
    float* rs2 = (float*)(F.ws + (dummy ? WS_YS2 : WS_RS2)); float* wslot = (float*)(F.ws + (dummy ? WS_YS2 + MiB : WS_WSLOT)); int* elist = (int*)(F.ws + (dummy ? WS_YS2 + 2 * MiB : WS_ELIST));
    unsigned* cnt = (unsigned*)(F.ctl + CW_CNT + (dummy ? 32 : 0));
    const int i16 = lane & 15, kq = lane >> 4;
    for (int tg = F.vcu; tg < M / 64; tg += F.G) {
        if (tid < 64) LC[tid] = 0;
        const int tok0 = tg * 64 + tt * 16;
        f32x4 a0 = {0.f, 0.f, 0.f, 0.f}, a1 = {0.f, 0.f, 0.f, 0.f}; float ssq = 0.f;
        const float* hp = Hf + (size_t)(tok0 + i16) * DM + kh * 512 + 4 * kq; const float* w0 = wrT + (size_t)i16 * DM + kh * 512 + 4 * kq; const float* w1 = w0 + 16 * DM;
#pragma unroll 8
        for (int s = 0; s < 32; ++s) { const f32x4 a = *(const f32x4*)(hp + 16 * s), b0 = *(const f32x4*)(w0 + 16 * s), b1 = *(const f32x4*)(w1 + 16 * s);
            ssq += (a[0] * a[0] + a[1] * a[1]) + (a[2] * a[2] + a[3] * a[3]);
#pragma unroll
            for (int q = 0; q < 4; ++q) { a0 = __builtin_amdgcn_mfma_f32_16x16x4f32(a[q], b0[q], a0, 0, 0, 0); a1 = __builtin_amdgcn_mfma_f32_16x16x4f32(a[q], b1[q], a1, 0, 0, 0); } }
        ssq += __shfl_xor(ssq, 16); ssq += __shfl_xor(ssq, 32);
        LAS float* lg = LG + (tt * 2 + kh) * 16 * 33;
#pragma unroll
        for (int r = 0; r < 4; ++r) { lg[(4 * kq + r) * 33 + i16] = a0[r]; lg[(4 * kq + r) * 33 + 16 + i16] = a1[r]; }
        if (kq == 0) SS[(tt * 2 + kh) * 16 + i16] = ssq;
        __syncthreads();
        int ti[4]; float wv[4]; int lpos[4]; float rsv = 0.f;
        if (tid < 64) {
            const int t4 = tid >> 4, t16 = tid & 15;
            rsv = 1.0f / sqrtf((SS[(t4 * 2) * 16 + t16] + SS[(t4 * 2 + 1) * 16 + t16]) * (1.0f / DM) + RMS_EPS);
            float lgv[32];
#pragma unroll
            for (int e = 0; e < 32; ++e) lgv[e] = (LG[((t4 * 2) * 16 + t16) * 33 + e] + LG[((t4 * 2 + 1) * 16 + t16) * 33 + e]) * rsv + br[e];
            float tv[4];
#pragma unroll
            for (int k = 0; k < 4; ++k) { float best = -3.0e38f; int bi = 0;
#pragma unroll
                for (int e = 0; e < 32; ++e) { const bool tk = lgv[e] > best; best = tk ? lgv[e] : best; bi = tk ? e : bi; }
                tv[k] = best; ti[k] = bi;
#pragma unroll
                for (int e = 0; e < 32; ++e) lgv[e] = (e == bi) ? -3.0e38f : lgv[e]; }
            const float e1 = __expf(tv[1] - tv[0]), e2 = __expf(tv[2] - tv[0]), e3 = __expf(tv[3] - tv[0]), den = 1.0f / (1.0f + e1 + e2 + e3);
            wv[0] = den; wv[1] = e1 * den; wv[2] = e2 * den; wv[3] = e3 * den;
#pragma unroll
            for (int k = 0; k < 4; ++k) lpos[k] = __hip_atomic_fetch_add(LC + ti[k], 1, __ATOMIC_RELAXED, __HIP_MEMORY_SCOPE_WORKGROUP);
        }
        __syncthreads();
        if (tid < 32) { const int c = LC[tid]; LC[32 + tid] = c ? (int)atomicAdd(cnt + tid * CW_CNT_STRIDE, (unsigned)c) : 0; }
        __syncthreads();
        if (tid < 64) {
            const int tok = tg * 64 + tid;
            rs2[tok] = rsv;
#pragma unroll
            for (int k = 0; k < 4; ++k) { elist[ti[k] * M + LC[32 + ti[k]] + lpos[k]] = tok * 4 + k; wslot[tok * 4 + k] = wv[k]; }
        }
        __syncthreads();
    }
}
__device__ __forceinline__ int moe_tables(Frame& F) {
    LAS int* T = (LAS int*)(F.lds + MOE_LDS_OFF); LAS int* cnt = T, *tstart = T + 32, *tile2e = T + 72;
    if (F.tid < 32) cnt[F.tid] = (int)__hip_atomic_load((unsigned*)(F.ctl + CW_CNT) + F.tid * CW_CNT_STRIDE, RLX_AGENT);
    __syncthreads();
    if (F.tid == 0) { int s = 0; for (int e = 0; e < 32; ++e) { tstart[e] = s; s += (cnt[e] + 255) >> 8; } tstart[32] = s; }
    __syncthreads();
    if (F.tid < 32) { for (int p = tstart[F.tid]; p < tstart[F.tid + 1]; ++p) tile2e[p] = F.tid; }
    __syncthreads();
    return tstart[32];
}
__device__ __forceinline__ void combine_phase(Frame& F, float* dst) {
    const int lane = F.lane, gw = F.vcu * NWAVES + F.wave, NGW = F.G * NWAVES;
    const bf16* YS2 = (const bf16*)(F.ws + WS_YS2);
    for (int tk = gw; tk < M; tk += NGW) {
        GAS f32x4* orow = (GAS f32x4*)(F.out + (size_t)tk * DM) + lane; GAS f32x4* drow = (GAS f32x4*)(dst + (size_t)tk * DM) + lane;
#pragma unroll
        for (int j = 0; j < 4; ++j) { f32x4 v = orow[64 * j];
#pragma unroll
            for (int k = 0; k < 4; ++k) { const v2u y = *((const GAS v2u*)(YS2 + (size_t)(tk * 4 + k) * DM) + lane + 64 * j); v += (f32x4){bflo(y.x), bfhi(y.x), bflo(y.y), bfhi(y.y)}; }
            drow[64 * j] = v; }
    }
}

struct Args { const float* in[31]; float* out; unsigned char* ws; unsigned char* hi; int ph_lo, ph_hi; };
__global__ void __launch_bounds__(NWAVES * 64, 2) mk_fwd(Args args) {
    extern __shared__ __attribute__((aligned(16))) unsigned char lds[];
    Frame F;
    F.lds = (LAS unsigned char*)lds;
    F.MISC = (volatile LAS unsigned*)(F.lds + MISC_OFF);
    F.tid = threadIdx.x; F.lane = F.tid & 63; F.wave = __builtin_amdgcn_readfirstlane(F.tid >> 6);
    F.G = gridDim.x; { const int bx = blockIdx.x; F.vcu = (F.G % 8 == 0) ? (bx % 8) * (F.G / 8) + bx / 8 : bx; }
    F.ws = args.ws; F.hi = args.hi; F.ctl = (gu32*)(args.ws + WS_CTL); F.out = args.out;
#pragma unroll
    for (int i = 0; i < 31; ++i) F.in[i] = args.in[i];
    for (int u = F.tid; u < 64; u += NWAVES * 64) F.MISC[u] = 0u;
    __syncthreads();
    XcdBarrier bar; bar.bar = (unsigned*)(F.ctl + CW_BAR); bar.x = 0; bar.st = nullptr;
    if (N_LAUNCHES != PER_PHASE) bar = xcd_barrier_post((unsigned*)(F.ctl + CW_BAR), F.MISC + 8);
#define GRID_BAR() do { if (N_LAUNCHES != PER_PHASE) xcd_barrier(bar); } while (0)
    const int lo = args.ph_lo, hi = args.ph_hi;
#define IN(k) (lo <= (k) && (k) < hi)
#define BOTH(k) (IN(k) && IN((k) + 1))
    unsigned char* ws = args.ws; unsigned char* wsh = args.hi;

    if (IN(0)) { for (int rep = 0; rep < NREP(0); ++rep) { p0_prologue(F); if (BOTH(0)) GRID_BAR(); } }

    if (IN(1)) for (int rep = 0; rep < NREP(1); ++rep) {
        pg8::Gemm g{(const bf16*)(wsh + (WS_XN - HI)), (const bf16*)(wsh + (WS_WIN - HI)), M, IN_W, DM}; pg8::StaticOrder S; S.init(M, IN_W, F.G, (int)blockIdx.x);
        EpiInProj E{(bf16*)(ws + WS_U), (bf16*)(ws + WS_Q), (bf16*)(ws + WS_K), (bf16*)(ws + WS_V), (bf16*)(ws + WS_G1), (bf16*)(ws + WS_G2), F.in[I_BGATE], F.in[I_QG], F.in[I_KG]};
        pg8::gemm_phase<EpiInProj, pg8::StaticOrder, true>(F.lds + RING_OFF, g, S, E);
        if (BOTH(1)) GRID_BAR();
    }

    if (PROBE_REP == 30 && IN(1) && IN(2)) { GRID_BAR(); GRID_BAR(); GRID_BAR(); GRID_BAR(); }
    if (IN(2)) {
        for (int rep = 0; rep < NREP(20); ++rep) for (int u = F.vcu; u < BATCH * SSM_G; u += F.G) { const int g = (u >> 5) * 4 + ((u & 31) >> 3), b = u & 7; s5_unit(F, b, g); }
        float lam;
        { const float a = wave_sum(F.in[I_LQ1][F.lane] * F.in[I_LK1][F.lane]), c = wave_sum(F.in[I_LQ2][F.lane] * F.in[I_LK2][F.lane]); lam = __expf(a) - __expf(c) + LAMBDA_INIT; }
        for (int rep = 0; rep < NREP(21); ++rep) for (int u = F.vcu; u < BATCH * ATT_H * 8; u += F.G) { const int bh = u >> 3, qp = u & 7; attn_unit(F, bh >> 2, bh & 3, 15 - qp, lam); attn_unit(F, bh >> 2, bh & 3, qp, lam); }
        if (BOTH(2)) GRID_BAR();
    }

    if (IN(3)) for (int rep = 0; rep < NREP(3); ++rep) {
        { pg8::Gemm g{(const bf16*)(ws + WS_YG), (const bf16*)(ws + WS_WGLU), M, 512, 512}; pg8::StaticOrder S; S.init(M, 512, F.G, (int)blockIdx.x);
          EpiMix<0> E{(const bf16*)(ws + WS_YG), nullptr, (bf16*)(ws + WS_YS), F.in[I_BGLU], 512};
          pg8::gemm_phase<EpiMix<0>, pg8::StaticOrder, true>(F.lds + RING_OFF, g, S, E); }
        if (BOTH(3)) GRID_BAR();
    }

    if (IN(4)) for (int rep = 0; rep < NREP(4); ++rep) {
        pg8::Gemm g{(const bf16*)(ws + WS_OB), (const bf16*)(ws + WS_WPS), M, DM, 512};
        ChainOrder S; S.so.init(M, DM, F.G, (int)blockIdx.x); S.A_att = (const bf16*)(ws + WS_OB); S.A_ssm = (const bf16*)(ws + WS_YS);
        EpiChain E{(const bf16*)(ws + WS_G1), (const bf16*)(ws + WS_G2), (bf16*)(ws + WS_MX)};
        pg8::gemm_phase<EpiChain, ChainOrder, true>(F.lds + RING_OFF, g, S, E);
        if (BOTH(4)) GRID_BAR();
    }

    if (IN(5)) for (int rep = 0; rep < NREP(5); ++rep) {
        pg8::Gemm g{(const bf16*)(ws + WS_MX), (const bf16*)(ws + WS_WOUT), M, DM, DM}; pg8::StaticOrder S; S.init(M, DM, F.G, (int)blockIdx.x);
        EpiOut E{F.in[I_X], F.out, ws + WS_HB};
        pg8::gemm_phase<EpiOut, pg8::StaticOrder, true>(F.lds + RING_OFF, g, S, E);
        if (BOTH(5)) GRID_BAR();
    }

    if (IN(6)) { router_phase(F); if (BOTH(6)) GRID_BAR(); }

    if (IN(7)) for (int rep = 0; rep < NREP(7); ++rep) {
        const int nmt = moe_tables(F); LAS int* T = (LAS int*)(F.lds + MOE_LDS_OFF); unsigned* mflag = (unsigned*)(F.ctl + CW_MFLAG) + (rep ? 288 * MFLAG_STRIDE : 0);
        { pg8::Gemm g{(const bf16*)(ws + WS_HB), (const bf16*)(wsh + (WS_WUP - HI)), M, UPW, DM};
          MoeOrder<8, true> S{nmt * 8, F.G, F.vcu, T, T + 32, T + 72, (const int*)(ws + WS_ELIST), mflag};
          EpiUp E{ws + WS_ACT, F.in[I_BUP], (const float*)(ws + WS_RS2)};
          pg8::gemm_phase<EpiUp, MoeOrder<8, true>, true, true, true, true>(F.lds + RING_OFF, g, S, E, 127, 122); }
        { pg8::Gemm g{(const bf16*)(ws + WS_ACT), (const bf16*)(wsh + (WS_WDN - HI)), MOE_ROWS_MAX, DM, DE};
          MoeOrder<4, false> S{nmt * 4, F.G, F.G - 1 - F.vcu, T, T + 32, T + 72, (const int*)(ws + WS_ELIST), mflag};
          EpiDown E{(bf16*)(ws + WS_YS2), F.in[I_BDN], (const float*)(ws + WS_WSLOT)};
          pg8::gemm_phase<EpiDown, MoeOrder<4, false>, true, true, true, true>(F.lds + RING_OFF, g, S, E, 125, 122); }
        if (BOTH(7)) GRID_BAR();
    }

    if (IN(9)) { combine_phase(F, F.out); }
    if (IN(16)) router_phase(F, true);
    if (IN(19)) combine_phase(F, (float*)(ws + WS_TA));
#undef IN
#undef BOTH
#undef GRID_BAR
}

extern "C" void kernel_launch(void* const* d_in, const int* in_sizes, int n_in, void* d_out, int out_size, void* d_ws, size_t ws_size, hipStream_t stream) {
    static int grid = 0;
    if (grid == 0) {
        if (n_in != 31 || in_sizes[0] != M * DM || out_size != M * DM || ws_size < WS_END) {
            fprintf(stderr, "kernel_launch: unexpected shapes (n_in %d, in0 %d, out %d, ws %zu < %zu); nothing launched\n", n_in, n_in > 0 ? in_sizes[0] : -1, out_size, ws_size, (size_t)WS_END); grid = -1; return; }
        int dev = 0, cus = 0;
        if (hipGetDevice(&dev) != hipSuccess || hipDeviceGetAttribute(&cus, hipDeviceAttributeMultiprocessorCount, dev) != hipSuccess) { grid = -1; return; }
        if (hipFuncSetAttribute((const void*)mk_fwd, hipFuncAttributeMaxDynamicSharedMemorySize, LDS_BYTES) != hipSuccess) { fprintf(stderr, "kernel_launch: hipFuncSetAttribute failed\n"); grid = -1; return; }
        int per_cu = 0;
        if (hipOccupancyMaxActiveBlocksPerMultiprocessor(&per_cu, (const void*)mk_fwd, NWAVES * 64, LDS_BYTES) != hipSuccess || per_cu < 1) fprintf(stderr, "kernel_launch: occupancy query reports %d\n", per_cu);
        (void)hipGetLastError();
        grid = cus;
    }
    if (grid < 0) return;
    (void)hipMemsetAsync((char*)d_ws + WS_CTL, 0, CTL_ZERO_BYTES, stream);
    Args a{};
    for (int i = 0; i < 31; ++i) a.in[i] = (const float*)d_in[i];
    a.out = (float*)d_out; a.ws = (unsigned char*)d_ws; a.hi = (unsigned char*)d_ws + ((ws_size - 256 * MiB) & ~(size_t)0xfffff);
    if (N_LAUNCHES == 1) { a.ph_lo = 0; a.ph_hi = PER_PHASE; hipLaunchKernelGGL(mk_fwd, dim3(grid), dim3(NWAVES * 64), LDS_BYTES, stream, a); }
    else for (int p = 0; p < PER_PHASE; ++p) { a.ph_lo = p; a.ph_hi = p + 1; if (PROBE_REP - 110 == p) { a.ph_lo = p + 10; a.ph_hi = p + 11; hipLaunchKernelGGL(mk_fwd, dim3(grid), dim3(NWAVES * 64), LDS_BYTES, stream, a); a.ph_lo = p; a.ph_hi = p + 1; }
        for (int rep = 0; rep < ((PROBE_REP - 100 == p) ? 2 : 1); ++rep) hipLaunchKernelGGL(mk_fwd, dim3(grid), dim3(NWAVES * 64), LDS_BYTES, stream, a); }
}
```

```cpp
#include <hip/hip_runtime.h>
#include <cstdio>
#include <cstdint>

#ifndef MK_N_LAUNCHES
#define MK_N_LAUNCHES 1
#endif
#ifndef PROBE_REP
#define PROBE_REP -1
#endif
#define NREP(k) ((PROBE_REP == (k)) ? 2 : 1)

namespace pg8 {
#define PG8_LAS __attribute__((address_space(3)))
typedef unsigned short bf16_t;
typedef short bf16x8 __attribute__((ext_vector_type(8)));
typedef float f32x4 __attribute__((ext_vector_type(4)));
typedef unsigned u32x4 __attribute__((ext_vector_type(4)));
typedef unsigned u32x2 __attribute__((ext_vector_type(2)));
constexpr int BM = 256, BK = 64, HALF = 128, HTB = HALF * BK * 2  , STAGE_BYTES = 8 * HTB, NXCD = 8, WGM = 8;

__host__ __device__ __forceinline__ int lds_byte(int r, int c) { const int st = (r >> 4) * 2 + (c >> 5), rr = r & 15, cc = c & 31, ob = rr * 64 + cc * 2; return st * 1024 + (ob ^ (((ob >> 9) & 1) * 48)); }
__host__ __device__ __forceinline__ void stage_rc(int b, int& R, int& C) { const int st = b / 1024, sb = b % 1024, swz = sb ^ (((sb >> 9) & 1) * 48); R = (st >> 1) * 16 + swz / 64; C = (st & 1) * 32 + (swz % 64) / 2; }
__host__ __device__ __forceinline__ int perm32(int rho) { const int n = rho >> 4, i = rho & 15; return 8 * (i >> 2) + 4 * n + (i & 3); }

struct Unit { int pm, pn; };
struct Gemm { const bf16_t* A; const bf16_t* Bt; int M, N, K; };

struct StaticOrder {
    int nM, nN, nwg, G, c;
    __host__ __device__ void init(int M, int N, int G_, int c_) { nM = M / BM; nN = N / BM; nwg = nM * nN; G = G_; c = c_; }
    __host__ __device__ bool next(int i, Unit& u) const {
        const long L = (long)i * G + c; if (L >= nwg) return false;
        int wgid = (int)L; { const int q = nwg / NXCD, r = nwg % NXCD, xcd = wgid % NXCD, off = wgid / NXCD; wgid = (xcd < r ? xcd * (q + 1) : r * (q + 1) + (xcd - r) * q) + off; }
        const int nig = WGM * nN, gid = wgid / nig, fm = gid * WGM, gsz = (nM - fm) < WGM ? (nM - fm) : WGM;
        u.pm = fm + ((wgid % nig) % gsz); u.pn = (wgid % nig) / gsz; return true;
    }
    __device__ __forceinline__ int row_slot(const Unit&, int) const { return 0; }
    __device__ __forceinline__ int a_row(const Unit& u, int r, int) const { return u.pm * BM + r; }
    __device__ __forceinline__ const char* a_base(const Gemm& g, const Unit& u, size_t tstep) const { return (const char*)g.A + (size_t)u.pm * tstep; }
    __device__ __forceinline__ void a_ready(const Unit&) const {}
    __device__ __forceinline__ void done(const Unit&) const {}
};

__device__ __forceinline__ unsigned cvt_pk_bf16(float lo, float hi) { unsigned r; asm volatile("v_cvt_pk_bf16_f32 %0, %1, %2" : "=v"(r) : "v"(lo), "v"(hi)); return r; }

typedef int v8i __attribute__((ext_vector_type(8)));
typedef int v4i __attribute__((ext_vector_type(4)));
template <class Epi, class Sched, bool ALIGN_EPI = false, bool ROWTAB = false, bool GATHER = false, bool FP8 = false>
__device__ __forceinline__ void gemm_phase(PG8_LAS unsigned char* lds, const Gemm g, const Sched& S, const Epi& E, const int sA8 = 0, const int sB8 = 0) {
    static_assert(!GATHER || ROWTAB, "GATHER needs ROWTAB");
    const int tid = threadIdx.x, wid = __builtin_amdgcn_readfirstlane(tid >> 6), lane = tid & 63, wr = wid >> 2, wc = wid & 3, fr = lane & 15, fq = lane >> 4;
    const int K = g.K, RB = FP8 ? K : 2 * K  , nt = RB / (2 * BK);
    unsigned voffA[2], voffB[2];
#pragma unroll
    for (int i = 0; i < 2; ++i) { int R, C; stage_rc(tid * 16 + i * 8192, R, C); const int Rb = Epi::PERM ? ((R & ~31) + perm32(R & 31)) : R;
        voffA[i] = (unsigned)(R * RB + 2 * C); voffB[i] = (unsigned)(Rb * RB + 2 * C); }
    unsigned vA[2][2] = {{0u, 0u}, {0u, 0u}};
    const size_t kstep = (size_t)(BK * 2);
    const size_t hstep = (size_t)HALF * RB;
    const size_t tstep = 2 * hstep;
    const unsigned ldsw = (unsigned)wid * 1024u;
    const int aoff = FP8 ? lds_byte(wr * 64 + fr, fq * 16) : lds_byte(wr * 64 + fr, fq * 8), boff = FP8 ? lds_byte(wc * 32 + fr, fq * 16) : lds_byte(wc * 32 + fr, fq * 8);
    PG8_LAS int* tab = (PG8_LAS int*)(lds + STAGE_BYTES);
#define PG8_SA(b, h) (((b) * 2 + (h)) * HTB)
#define PG8_SB(b, h) ((4 + (b) * 2 + (h)) * HTB)
#define PG8_STAGE(bufoff, gbase, voff) do { _Pragma("unroll") for (int _i = 0; _i < 2; ++_i) \
        __builtin_amdgcn_global_load_lds((const unsigned*)((const char*)(gbase) + (voff)[_i]), (PG8_LAS unsigned*)(lds + (bufoff) + ldsw + _i * 8192), 16, 0, 0); } while (0)
#define PG8_STAGE_A(bufoff, kbase, h) do { if constexpr (GATHER) { PG8_STAGE(bufoff, kbase, vA[h]); } else { PG8_STAGE(bufoff, (kbase) + (h) * hstep, voffA); } } while (0)
#define PG8_LOAD_VA(sel, un) do { _Pragma("unroll") for (int _i = 0; _i < 2; ++_i) { int R_, C_; stage_rc(tid * 16 + _i * 8192, R_, C_); \
        _Pragma("unroll") for (int _h = 0; _h < 2; ++_h) { const int s_ = tab[(sel) * 256 + _h * HALF + R_]; vA[_h][_i] = (unsigned)(S.a_row(un, _h * HALF + R_, s_) * RB + 2 * C_); } } } while (0)
#define PG8_LDA(dst, b, h) do { _Pragma("unroll") for (int m = 0; m < 4; ++m) _Pragma("unroll") for (int k = 0; k < 2; ++k) dst[m][k] = *(const PG8_LAS bf16x8*)(lds + PG8_SA(b, h) + (FP8 ? (aoff ^ (16 * k)) : aoff + k * 1024) + m * 2048); } while (0)
#define PG8_LDB(dst, b, h) do { _Pragma("unroll") for (int n = 0; n < 2; ++n) _Pragma("unroll") for (int k = 0; k < 2; ++k) dst[n][k] = *(const PG8_LAS bf16x8*)(lds + PG8_SB(b, h) + (FP8 ? (boff ^ (16 * k)) : boff + k * 1024) + n * 2048); } while (0)
#define PG8_V8(x) __builtin_shufflevector(__builtin_bit_cast(v4i, (x)[0]), __builtin_bit_cast(v4i, (x)[1]), 0, 1, 2, 3, 4, 5, 6, 7)
#define PG8_MMA(ai, bj, At, Bt) do { __builtin_amdgcn_s_setprio(1); if constexpr (FP8) { _Pragma("unroll") for (int m = 0; m < 4; ++m) _Pragma("unroll") for (int n = 0; n < 2; ++n) \
        acc[ai][bj][m][n] = __builtin_amdgcn_mfma_scale_f32_16x16x128_f8f6f4(PG8_V8(Bt[n]), PG8_V8(At[m]), acc[ai][bj][m][n], 0, 0, 0, sB8, 0, sA8); } else { \
        _Pragma("unroll") for (int m = 0; m < 4; ++m) _Pragma("unroll") for (int n = 0; n < 2; ++n) _Pragma("unroll") for (int k = 0; k < 2; ++k) \
        acc[ai][bj][m][n] = __builtin_amdgcn_mfma_f32_16x16x32_bf16(Bt[n][k], At[m][k], acc[ai][bj][m][n], 0, 0, 0); } __builtin_amdgcn_s_setprio(0); } while (0)
#define PG8_WAIT_V(n) asm volatile("s_waitcnt vmcnt(" #n ")" ::: "memory")
#define PG8_WAIT_L(n) asm volatile("s_waitcnt lgkmcnt(" #n ")" ::: "memory")
#define PG8_BAR __builtin_amdgcn_s_barrier()
#define PG8_SCHED __builtin_amdgcn_sched_barrier(0)
    Unit cur, nxt; int ui = 0;
    if (!S.next(0, cur)) return;
    S.a_ready(cur);
    f32x4 acc[2][2][4][2];
#pragma unroll
    for (int a = 0; a < 2; ++a)
#pragma unroll
        for (int b = 0; b < 2; ++b)
#pragma unroll
            for (int m = 0; m < 4; ++m)
#pragma unroll
                for (int n = 0; n < 2; ++n) acc[a][b][m][n] = (f32x4){0.f, 0.f, 0.f, 0.f};
    bf16x8 At[4][2], B0[2][2], B1[2][2];
    if constexpr (ROWTAB) {
        if (tid < 256) tab[tid] = S.row_slot(cur, tid);
        PG8_WAIT_L(0); PG8_BAR; asm volatile("" ::: "memory");
        if constexpr (GATHER) { PG8_LOAD_VA(0, cur); }
    }
    const char* cA = GATHER ? (const char*)g.A : S.a_base(g, cur, tstep); const char* cB = (const char*)g.Bt + (size_t)cur.pn * tstep;
    PG8_STAGE(PG8_SB(0, 0), cB, voffB); PG8_STAGE(PG8_SB(0, 1), cB + hstep, voffB); PG8_STAGE_A(PG8_SA(0, 0), cA, 0); PG8_STAGE_A(PG8_SA(0, 1), cA, 1);
    if (wr == 1) PG8_BAR;
    PG8_WAIT_V(2); PG8_BAR;
    PG8_STAGE(PG8_SB(1, 0), cB + kstep, voffB); PG8_STAGE_A(PG8_SA(1, 0), cA + kstep, 0); PG8_STAGE(PG8_SB(1, 1), cB + hstep + kstep, voffB);
    PG8_WAIT_V(6); PG8_BAR;
    for (;;) {
        const bool has_next = S.next(ui + 1, nxt);
        if (has_next) S.a_ready(nxt);
        if constexpr (ROWTAB) { if (has_next && tid < 256) tab[((ui + 1) % 3) * 256 + tid] = S.row_slot(nxt, tid); }
        const char* nA = has_next ? (GATHER ? (const char*)g.A : S.a_base(g, nxt, tstep)) : cA; const char* nB = has_next ? (const char*)g.Bt + (size_t)nxt.pn * tstep : cB;
        for (int t = 0; t < nt; t += 2) {
            const bool last = (t == nt - 2);
            const char* a1 = cA + (size_t)(t + 1) * kstep;
            const char* a2 = last ? nA : cA + (size_t)(t + 2) * kstep; const char* b2 = last ? nB : cB + (size_t)(t + 2) * kstep;
            const char* a3 = a2 + kstep; const char* b3 = b2 + kstep;
            PG8_LDB(B0, 0, 0); PG8_LDB(B1, 0, 1); PG8_SCHED; PG8_LDA(At, 0, 0); PG8_STAGE_A(PG8_SA(1, 1), a1, 1);
            if constexpr (GATHER) { if (last && has_next) { PG8_LOAD_VA((ui + 1) % 3, nxt); } }
            PG8_WAIT_V(8); PG8_WAIT_L(0); PG8_BAR; PG8_MMA(0, 0, At, B0); PG8_MMA(0, 1, At, B1); PG8_BAR; PG8_SCHED;
            PG8_LDA(At, 0, 1); PG8_STAGE(PG8_SB(0, 0), b2, voffB); PG8_STAGE(PG8_SB(0, 1), b2 + hstep, voffB); PG8_STAGE_A(PG8_SA(0, 0), a2, 0);
            PG8_WAIT_V(8); PG8_WAIT_L(0); PG8_BAR; PG8_MMA(1, 0, At, B0); PG8_MMA(1, 1, At, B1); PG8_BAR; PG8_SCHED;
            PG8_LDB(B0, 1, 0); PG8_LDB(B1, 1, 1); PG8_SCHED; PG8_LDA(At, 1, 0); PG8_STAGE_A(PG8_SA(0, 1), a2, 1);
            PG8_WAIT_V(8); PG8_WAIT_L(0); PG8_BAR; PG8_MMA(0, 0, At, B0); PG8_MMA(0, 1, At, B1); PG8_BAR; PG8_SCHED;
            PG8_LDA(At, 1, 1); PG8_STAGE(PG8_SB(1, 0), b3, voffB); PG8_STAGE(PG8_SB(1, 1), b3 + hstep, voffB); PG8_STAGE_A(PG8_SA(1, 0), a3, 0);
            PG8_WAIT_V(8); PG8_WAIT_L(0); PG8_BAR; PG8_MMA(1, 0, At, B0); PG8_MMA(1, 1, At, B1); PG8_BAR; PG8_SCHED;
        }
        if constexpr (ALIGN_EPI) { if (wr == 0) PG8_BAR; }
        E(acc, cur, wr, wc, fr, fq, (const PG8_LAS int*)(tab + (ui % 3) * 256));
        S.done(cur);
        if (!has_next) break;
        if (!E.keep(cur)) {
#pragma unroll
        for (int a = 0; a < 2; ++a)
#pragma unroll
            for (int b = 0; b < 2; ++b)
#pragma unroll
                for (int m = 0; m < 4; ++m)
#pragma unroll
                    for (int n = 0; n < 2; ++n) acc[a][b][m][n] = (f32x4){0.f, 0.f, 0.f, 0.f}; }
        cur = nxt; cA = nA; cB = nB; ++ui;
        if constexpr (ALIGN_EPI) { if (wr == 1) PG8_BAR; }
    }
    PG8_WAIT_V(0);
    if constexpr (!ALIGN_EPI) { if (wr == 0) PG8_BAR; }
    PG8_BAR;
#undef PG8_SA
#undef PG8_SB
#undef PG8_STAGE
#undef PG8_STAGE_A
#undef PG8_LOAD_VA
#undef PG8_LDA
#undef PG8_LDB
#undef PG8_MMA
#undef PG8_V8
#undef PG8_WAIT_V
#undef PG8_WAIT_L
#undef PG8_BAR
#undef PG8_SCHED
}
}

constexpr int NWAVES = 8;
constexpr int N_LAUNCHES = MK_N_LAUNCHES;
constexpr int PER_PHASE = 10;
constexpr int BATCH = 8, SEQ = 2048, DM = 1024, M = BATCH * SEQ;
constexpr int SSM_W = 512, SSM_G = 32, SSM_H = 16, SSM_P = 64, SSM_T = 16, SSM_NC = SEQ / SSM_T;
constexpr int ATT_H = 4, ATT_D = 64, ATT_V = 128, QK_W = 512, V_W = 512;
constexpr int IN_W = 4096;
constexpr int NE = 32, TOPK = 4, DE = 1024, UPW = 2048;
constexpr float RMS_EPS = 1e-6f;
constexpr float LAMBDA_INIT = 0.2f;
constexpr float QSCALE = 0.125f * 1.4426950408889634f;
constexpr int MOE_ROWS_MAX = M * TOPK + NE * 256;
constexpr int MOE_MT_MAX = MOE_ROWS_MAX / 256;

constexpr size_t MiB = 1u << 20;
constexpr size_t WS_CTL = 0, CTL_ZERO_BYTES = 1 * MiB;
constexpr size_t HI = (size_t)1 << 40;
constexpr size_t WS_WIN_OLD = 2 * MiB;
constexpr size_t WS_WGLU = 10 * MiB;
constexpr size_t WS_WPS = 11 * MiB;
constexpr size_t WS_WPA = 12 * MiB;
constexpr size_t WS_WOUT = 13 * MiB;
constexpr size_t WS_WRT = 15 * MiB;
constexpr size_t WS_S5 = 16 * MiB;
constexpr size_t WS_A16 = 24 * MiB;
constexpr size_t WS_WUP_OLD = 32 * MiB;
constexpr size_t WS_WDN_OLD = 160 * MiB;
constexpr size_t WS_XN_OLD = 224 * MiB;
constexpr size_t WS_U = 256 * MiB;
constexpr size_t WS_Q = 272 * MiB, WS_K = 288 * MiB, WS_V = 304 * MiB;
constexpr size_t WS_G1 = 320 * MiB, WS_G2 = 352 * MiB;
constexpr size_t WS_YG = 384 * MiB, WS_YS = 400 * MiB, WS_OB = 416 * MiB;
constexpr size_t WS_TA = 432 * MiB, WS_MX = 464 * MiB;
constexpr size_t WS_HB = 496 * MiB;
constexpr size_t WS_RS2 = 528 * MiB;
constexpr size_t WS_WSLOT = 529 * MiB;
constexpr size_t WS_ELIST = 530 * MiB;
constexpr size_t WS_ACT = 544 * MiB;
constexpr size_t WS_YS2 = 32 * MiB;
constexpr size_t WS_YS2_OLD = 688 * MiB;
constexpr size_t WS_END = 1024 * MiB;
constexpr size_t WS_WUP = HI + 0 * MiB, WS_WDN = HI + 64 * MiB, WS_XN = HI + 96 * MiB, WS_WIN = HI + 128 * MiB;
constexpr int CW_BAR = 4096;
constexpr int CW_Q = 20480;
constexpr int CW_CNT = 16384;

constexpr int RING_OFF = 0, RING_BYTES = 139264;
constexpr int LDSCTL_OFF = RING_BYTES, MISC_OFF = LDSCTL_OFF;
constexpr int MOE_LDS_OFF = LDSCTL_OFF + 256;
constexpr int LDS_BYTES = 147456;

#define GAS __attribute__((address_space(1)))
#define LAS __attribute__((address_space(3)))
typedef unsigned short bf16;
typedef unsigned v4u __attribute__((ext_vector_type(4)));
typedef unsigned v2u __attribute__((ext_vector_type(2)));
typedef float f32x4 __attribute__((ext_vector_type(4)));
typedef float f32x16 __attribute__((ext_vector_type(16)));
typedef float f32x2 __attribute__((ext_vector_type(2)));
typedef short bf16x8 __attribute__((ext_vector_type(8)));
typedef short s16x4 __attribute__((ext_vector_type(4)));
typedef GAS unsigned gu32;
#define RLX_AGENT __ATOMIC_RELAXED, __HIP_MEMORY_SCOPE_AGENT
#define LDS_WAIT() asm volatile("s_waitcnt lgkmcnt(0)" ::: "memory")
#define VM_WAIT() asm volatile("s_waitcnt vmcnt(0)" ::: "memory")
using pg8::cvt_pk_bf16;
__device__ __forceinline__ unsigned f2bf(float f) { unsigned u = __builtin_bit_cast(unsigned, f); return (u + 0x7fffu + ((u >> 16) & 1u)) >> 16; }
__device__ __forceinline__ unsigned pk4_fp8(float a, float b, float c, float d) { unsigned w = 0; w = __builtin_amdgcn_cvt_pk_fp8_f32(a, b, w, false); w = __builtin_amdgcn_cvt_pk_fp8_f32(c, d, w, true); return w; }
__device__ __forceinline__ float bf2f(unsigned b) { return __builtin_bit_cast(float, b << 16); }
__device__ __forceinline__ float bflo(unsigned w) { return __builtin_bit_cast(float, w << 16); }
__device__ __forceinline__ float bfhi(unsigned w) { return __builtin_bit_cast(float, w & 0xffff0000u); }
__device__ __forceinline__ float fsigmoid(float x) { return 1.0f / (1.0f + __expf(-x)); }
__device__ __forceinline__ float fsigmoid_fast(float x) { return __builtin_amdgcn_rcpf(1.0f + __builtin_amdgcn_exp2f(-1.4426950408889634f * x)); }
__device__ __forceinline__ float gelu_tanh(float x) { const float z = 1.5957691216057308f * (x + 0.044715f * x * x * x); return x * fsigmoid_fast(z); }
__device__ __forceinline__ int crow(int r, int hi) { return (r & 3) + 8 * (r >> 2) + 4 * hi; }
__device__ __forceinline__ float wave_sum(float v) {
#pragma unroll
    for (int o = 1; o < 64; o <<= 1) v += __shfl_xor(v, o);
    return v;
}

#define XB_TMO      128
#define XB_XCNT(j)  (256  + 64 * (j))
#define XB_XSUB(j)  (1280 + 64 * (j))
#define XB_XGEN(j)  (2304 + 64 * (j))
#define XB_TOP      3328
#define XB_TOPGEN   3392
#define XCD_BAR_WORDS 3456
#define XB_SPIN_CAP (1u << 18)
__device__ __forceinline__ unsigned xb_ld(unsigned* p)              { return __hip_atomic_load(p, __ATOMIC_RELAXED, __HIP_MEMORY_SCOPE_AGENT); }
__device__ __forceinline__ unsigned xb_add(unsigned* p, unsigned v) { return __hip_atomic_fetch_add(p, v, __ATOMIC_RELAXED, __HIP_MEMORY_SCOPE_AGENT); }
__device__ __forceinline__ unsigned xb_xcc_id() { return (unsigned)__builtin_amdgcn_s_getreg((3 << 11) | 20) & 0xFu; }
#define XB_SPIN(cond, bar) do { unsigned _sp = 0; while (cond) { __builtin_amdgcn_s_sleep(1); \
    if ((++_sp & 255u) == 0u) { if (xb_ld(&(bar)[XB_TMO])) break; if (_sp > XB_SPIN_CAP) { atomicAdd(&(bar)[XB_TMO], 1u); break; } } } } while (0)
struct XcdBarrier { unsigned* bar; unsigned x; volatile LAS unsigned* st; };
__device__ __forceinline__ XcdBarrier xcd_barrier_post(unsigned* bar, volatile LAS unsigned* st) {
    XcdBarrier b; b.bar = bar; b.x = xb_xcc_id(); b.st = st;
    if (threadIdx.x == 0) (void)xb_add(&bar[XB_XCNT(b.x)], 1u);
    return b;
}
__device__ __forceinline__ void xcd_barrier_complete(unsigned* bar, unsigned x, unsigned& nloc, unsigned& nx) {
    const unsigned G = gridDim.x * gridDim.y * gridDim.z;
    unsigned sum, cnt, mine, sp = 0u;
    for (;;) {
        sum = 0u; cnt = 0u; mine = 0u;
#pragma unroll
        for (unsigned j = 0; j < 16; ++j) { const unsigned c = xb_ld(&bar[XB_XCNT(j)]); sum += c; cnt += (c > 0u) ? 1u : 0u; mine = (j == x) ? c : mine; }
        if (sum == G) break;
        __builtin_amdgcn_s_sleep(1);
        if ((++sp & 255u) == 0u) { if (xb_ld(&bar[XB_TMO])) break; if (sp > XB_SPIN_CAP) { atomicAdd(&bar[XB_TMO], 1u); break; } }
    }
    nloc = mine > 0u ? mine : 1u; nx = cnt > 0u ? cnt : 1u;
}
__device__ __forceinline__ void xcd_barrier(const XcdBarrier& b) {
    asm volatile("s_waitcnt vmcnt(0)" ::: "memory");
    __syncthreads();
    if (threadIdx.x == 0) {
        unsigned* bar = b.bar;
        __builtin_amdgcn_s_waitcnt(0);
        unsigned nloc = b.st[0], nx = b.st[1];
        if (nloc == 0u) { xcd_barrier_complete(bar, b.x, nloc, nx); b.st[0] = nloc; b.st[1] = nx; }
        const unsigned old = xb_add(&bar[XB_XSUB(b.x)], 1u);
        const unsigned gen = old / nloc;
        if (old + 1u == (gen + 1u) * nloc) {
            __builtin_amdgcn_fence(__ATOMIC_RELEASE, "agent");
            asm volatile("s_waitcnt vmcnt(0)" ::: "memory");
            const unsigned og = xb_add(&bar[XB_TOP], 1u);
            const unsigned tg = og / nx;
            if (og + 1u == (tg + 1u) * nx) xb_add(&bar[XB_TOPGEN], 1u);
            else XB_SPIN(xb_ld(&bar[XB_TOPGEN]) == tg, bar);
            __builtin_amdgcn_fence(__ATOMIC_ACQUIRE, "agent");
            xb_add(&bar[XB_XGEN(b.x)], 1u);
            asm volatile("s_waitcnt vmcnt(0)" ::: "memory");
        } else {
            XB_SPIN(xb_ld(&bar[XB_XGEN(b.x)]) == gen, bar);
            __builtin_amdgcn_fence(__ATOMIC_ACQUIRE, "agent");
            asm volatile("s_waitcnt vmcnt(0)" ::: "memory");
        }
    }
    __syncthreads();
}

struct Frame {
    LAS unsigned char* lds;
    volatile LAS unsigned* MISC;
    gu32* ctl;
    unsigned char* ws; unsigned char* hi;
    int tid, lane, wave;
    int vcu, G;
    const float* in[31];
    float* out;
};
enum { I_X = 0, I_N1G, I_WIN, I_BGATE, I_ARE, I_AIM, I_LOGDT, I_BRE, I_BIM, I_CRE, I_CIM, I_SSMD, I_WGLU, I_BGLU, I_QG, I_KG, I_LQ1, I_LK1, I_LQ2, I_LK2, I_SUBLN,
       I_WPS, I_WPA, I_WOUT, I_N2G, I_WR, I_BR, I_WUP, I_BUP, I_WDN, I_BDN };

template <int MODE>
__device__ __forceinline__ int physrow(int c) {
    if (MODE == 1) { const int w = c & 63; return (c & ~255) + 128 * (w >> 5) + 32 * ((c >> 6) & 3) + (w & 31); }
    if (MODE == 2) { const int j = c >> 1; return 256 * (j >> 7) + 128 * (c & 1) + (j & 127); }
    return c;
}
struct P0Item { const float* src; void* dst; const float* kscale; int N, K, mode, out8, k0, c0; };
__device__ __forceinline__ int physrow_rt(int mode, int c) { return mode == 1 ? physrow<1>(c) : (mode == 2 ? physrow<2>(c) : c); }
__device__ __forceinline__ void p0_item_load(const P0Item& d, f32x4 (&v)[16], int lane) {
    const int lr = lane >> 4, lc = lane & 15;
#pragma unroll
    for (int i = 0; i < 16; ++i) v[i] = __builtin_nontemporal_load((const f32x4*)(d.src + (size_t)(d.k0 + lr + 4 * i) * d.N + d.c0 + 4 * lc));
}
__device__ __forceinline__ void p0_item_finish(const P0Item& d, const f32x4 (&v)[16], LAS float* scr, int lane) {
    const int lr = lane >> 4, lc = lane & 15;
#pragma unroll
    for (int i = 0; i < 16; ++i) { const int k = lr + 4 * i; *(LAS f32x4*)(scr + k * 64 + 4 * (lc ^ ((k >> 3) & 7))) = v[i]; }
    LDS_WAIT(); asm volatile("" ::: "memory");
    const int a = lane & 7, bq = lane >> 3;
    float ks[8];
#pragma unroll
    for (int i = 0; i < 8; ++i) ks[i] = (d.kscale ? d.kscale[d.k0 + 8 * a + i] : 1.0f) * (d.out8 ? 32.0f : 1.0f);
#pragma unroll
    for (int j = 0; j < 8; ++j) { const int cl = bq + 8 * j; float x[8];
#pragma unroll
        for (int i = 0; i < 8; ++i) x[i] = scr[(8 * a + i) * 64 + 4 * ((cl >> 2) ^ a) + (cl & 3)] * ks[i];
        const size_t ro = (size_t)physrow_rt(d.mode, d.c0 + cl) * d.K + d.k0 + 8 * a;
        if (d.out8) { v2u o; o.x = pk4_fp8(x[0], x[1], x[2], x[3]); o.y = pk4_fp8(x[4], x[5], x[6], x[7]); __builtin_nontemporal_store(o, (GAS v2u*)((unsigned char*)d.dst + ro)); }
        else { v4u o; o.x = cvt_pk_bf16(x[0], x[1]); o.y = cvt_pk_bf16(x[2], x[3]); o.z = cvt_pk_bf16(x[4], x[5]); o.w = cvt_pk_bf16(x[6], x[7]); *(GAS v4u*)((bf16*)d.dst + ro) = o; } }
    LDS_WAIT(); asm volatile("" ::: "memory");
}
__device__ __forceinline__ void rms_row_to_bf16(int lane, const float* xrow, const float* g, bf16* orow) {
    const GAS f32x4* xr = (const GAS f32x4*)xrow + lane; const GAS f32x4* gr = (const GAS f32x4*)g + lane;
    f32x4 v[4]; float s = 0.f;
#pragma unroll
    for (int j = 0; j < 4; ++j) { v[j] = xr[64 * j]; s += (v[j].x * v[j].x + v[j].y * v[j].y) + (v[j].z * v[j].z + v[j].w * v[j].w); }
    const float rs = 1.0f / sqrtf(wave_sum(s) * (1.f / DM) + RMS_EPS);
    GAS unsigned long long* o8 = (GAS unsigned long long*)orow + lane;
#pragma unroll
    for (int j = 0; j < 4; ++j) { const f32x4 gg = gr[64 * j];
        o8[64 * j] = (unsigned long long)cvt_pk_bf16(v[j].x * rs * gg.x, v[j].y * rs * gg.y) | ((unsigned long long)cvt_pk_bf16(v[j].z * rs * gg.z, v[j].w * rs * gg.w) << 32); }
}
__device__ __forceinline__ void p0_s5_group(Frame& F, int g) {
    LAS float* AP = (LAS float*)(F.lds + RING_OFF);
    LAS float* BB = AP + 17 * 64 * 2;
    LAS float* CC = BB + 64 * 16 * 2;
    LAS float* KM = CC + 16 * 64 * 2;
    const float* are = F.in[I_ARE] + g * SSM_P; const float* aim = F.in[I_AIM] + g * SSM_P;
    const double dt = exp((double)F.in[I_LOGDT][g]);
    for (int e = F.tid; e < 17 * 64; e += NWAVES * 64) { const int m = e >> 6, p = e & 63; const double lr = are[p], li = aim[p];
        const double mag = exp(lr * dt * m), ang = li * dt * m; AP[e * 2] = (float)(mag * cos(ang)); AP[e * 2 + 1] = (float)(mag * sin(ang)); }
    for (int e = F.tid; e < 64 * 16; e += NWAVES * 64) { const int p = e >> 4, h = e & 15; const double lr = are[p], li = aim[p];
        const double mag = exp(lr * dt), ar = mag * cos(li * dt), ai = mag * sin(li * dt), den = lr * lr + li * li, nr = ar - 1.0, ni = ai;
        const double cr = (nr * lr + ni * li) / den, ci = (ni * lr - nr * li) / den;
        const double br = F.in[I_BRE][(size_t)(g * SSM_P + p) * SSM_H + h], bi = F.in[I_BIM][(size_t)(g * SSM_P + p) * SSM_H + h];
        BB[e * 2] = (float)(cr * br - ci * bi); BB[e * 2 + 1] = (float)(cr * bi + ci * br); }
    for (int e = F.tid; e < 16 * 64; e += NWAVES * 64) { CC[e * 2] = F.in[I_CRE][(size_t)g * 1024 + e]; CC[e * 2 + 1] = F.in[I_CIM][(size_t)g * 1024 + e]; }
    __syncthreads();
    if (F.tid < 64) { float* a16 = (float*)(F.ws + WS_A16) + (g * 64 + F.tid) * 2; a16[0] = AP[(16 * 64 + F.tid) * 2]; a16[1] = AP[(16 * 64 + F.tid) * 2 + 1]; }
    for (int e = F.tid; e < 16 * 256; e += NWAVES * 64) { const int m = e >> 8, ho = (e >> 4) & 15, hi = e & 15; float s = 0.f;
        for (int p = 0; p < 64; ++p) { const float cr = CC[(ho * 64 + p) * 2], ci = CC[(ho * 64 + p) * 2 + 1], ar = AP[(m * 64 + p) * 2], ai = AP[(m * 64 + p) * 2 + 1];
            const float tr = cr * ar - ci * ai, ti = cr * ai + ci * ar; s += tr * BB[(p * 16 + hi) * 2] - ti * BB[(p * 16 + hi) * 2 + 1]; }
        KM[e] = s; }
    __syncthreads();
    bf16* W1T = (bf16*)(F.ws + WS_S5 + (size_t)g * 262144); bf16* M2T = W1T + 128 * 256; bf16* W3T = M2T + 256 * 256;
    for (int e = F.tid; e < 128 * 256; e += NWAVES * 64) { const int n = e >> 8, k = e & 255, p = n & 63, j = k >> 4, hi = k & 15;
        const float ar = AP[((15 - j) * 64 + p) * 2], ai = AP[((15 - j) * 64 + p) * 2 + 1], br = BB[(p * 16 + hi) * 2], bi = BB[(p * 16 + hi) * 2 + 1];
        W1T[e] = (bf16)f2bf(n < 64 ? ar * br - ai * bi : ar * bi + ai * br); }
    for (int e = F.tid; e < 256 * 128; e += NWAVES * 64) { const int n = e >> 7, k = e & 127, i = n >> 4, ho = n & 15, p = k & 63;
        const float cr = CC[(ho * 64 + p) * 2], ci = CC[(ho * 64 + p) * 2 + 1], ar = AP[((i + 1) * 64 + p) * 2], ai = AP[((i + 1) * 64 + p) * 2 + 1];
        W3T[e] = (bf16)f2bf(k < 64 ? cr * ar - ci * ai : -(cr * ai + ci * ar)); }
    const float* dsk = F.in[I_SSMD] + g * 16;
    for (int e = F.tid; e < 256 * 256; e += NWAVES * 64) { const int n = e >> 8, k = e & 255, i = n >> 4, ho = n & 15, j = k >> 4, hi = k & 15;
        float v = 0.f; if (j <= i) { v = KM[((i - j) * 16 + ho) * 16 + hi]; if (i == j && ho == hi) v += dsk[ho]; }
        M2T[e] = (bf16)f2bf(v); }
    __syncthreads();
}
__device__ __forceinline__ void p0_prologue(Frame& F) {
    if (F.vcu < SSM_G) p0_s5_group(F, F.vcu);
    LAS float* scr = (LAS float*)(F.lds + RING_OFF + F.wave * 16384);
    const int gw = F.vcu * NWAVES + F.wave, NGW = F.G * NWAVES;
    { float* wrT = (float*)(F.ws + WS_WRT); const float* wr = F.in[I_WR]; const float* g2 = F.in[I_N2G];
      for (int e = gw * 64 + F.lane; e < NE * DM; e += NGW * 64) { const int ex = e >> 10, k = e & 1023; wrT[e] = g2[k] * wr[k * NE + ex]; } }
    for (int m = gw; m < M; m += NGW) rms_row_to_bf16(F.lane, F.in[I_X] + (size_t)m * DM, F.in[I_N1G], (bf16*)(F.hi + (WS_XN - HI)) + (size_t)m * DM);
    constexpr int IT_IN = (DM / 64) * (IN_W / 64), IT_GLU = (512 / 64) * (512 / 64), IT_PS = (512 / 64) * (DM / 64), IT_OUT = (DM / 64) * (DM / 64);
    constexpr int IT_UP1 = (DM / 64) * (UPW / 64), IT_DN1 = (DE / 64) * (DM / 64);
    constexpr int NITEMS = IT_IN + IT_GLU + 2 * IT_PS + IT_OUT + NE * IT_UP1 + NE * IT_DN1;
#define P0_DECODE(it, d) do { int r_ = (it); int nb_; \
        if (r_ < IT_IN) { d.src = F.in[I_WIN]; d.dst = F.hi + (WS_WIN - HI); d.kscale = nullptr; d.N = IN_W; d.K = DM; d.mode = 1; d.out8 = 0; } \
        else if ((r_ -= IT_IN) < IT_GLU) { d.src = F.in[I_WGLU]; d.dst = F.ws + WS_WGLU; d.kscale = nullptr; d.N = 512; d.K = 512; d.mode = 0; d.out8 = 0; } \
        else if ((r_ -= IT_GLU) < IT_PS) { d.src = F.in[I_WPS]; d.dst = F.ws + WS_WPS; d.kscale = nullptr; d.N = DM; d.K = 512; d.mode = 0; d.out8 = 0; } \
        else if ((r_ -= IT_PS) < IT_PS) { d.src = F.in[I_WPA]; d.dst = F.ws + WS_WPA; d.kscale = nullptr; d.N = DM; d.K = 512; d.mode = 0; d.out8 = 0; } \
        else if ((r_ -= IT_PS) < IT_OUT) { d.src = F.in[I_WOUT]; d.dst = F.ws + WS_WOUT; d.kscale = nullptr; d.N = DM; d.K = DM; d.mode = 0; d.out8 = 0; } \
        else if ((r_ -= IT_OUT) < NE * IT_UP1) { const int e_ = r_ / IT_UP1; r_ -= e_ * IT_UP1; d.src = F.in[I_WUP] + (size_t)e_ * DM * UPW; d.dst = F.hi + (WS_WUP - HI) + (size_t)e_ * UPW * DM; d.kscale = F.in[I_N2G]; d.N = UPW; d.K = DM; d.mode = 2; d.out8 = 1; } \
        else { r_ -= NE * IT_UP1; const int e_ = r_ / IT_DN1; r_ -= e_ * IT_DN1; d.src = F.in[I_WDN] + (size_t)e_ * DE * DM; d.dst = F.hi + (WS_WDN - HI) + (size_t)e_ * DM * DE; d.kscale = nullptr; d.N = DM; d.K = DE; d.mode = 0; d.out8 = 1; } \
        nb_ = d.N / 64; d.k0 = 64 * (r_ / nb_); d.c0 = 64 * (r_ % nb_); } while (0)
    int qcur = 0, qend = 0;
#define P0_DRAW(it) do { if (qcur == qend) { unsigned q_ = 0; if (F.lane == 0) q_ = atomicAdd((unsigned*)(F.ctl + CW_Q), 1u); qcur = 8 * (int)__builtin_amdgcn_readfirstlane(q_); qend = qcur + 8; } it = qcur++; } while (0)
    {
        P0Item dA, dB; f32x4 vA[16], vB[16]; int itA, itB;
        P0_DRAW(itA);
        if (itA < NITEMS) { P0_DECODE(itA, dA); p0_item_load(dA, vA, F.lane);
            for (;;) {
                P0_DRAW(itB); const bool hasB = itB < NITEMS;
                if (hasB) { P0_DECODE(itB, dB); p0_item_load(dB, vB, F.lane); }
                p0_item_finish(dA, vA, scr, F.lane);
                if (!hasB) break;
                P0_DRAW(itA); const bool hasA = itA < NITEMS;
                if (hasA) { P0_DECODE(itA, dA); p0_item_load(dA, vA, F.lane); }
                p0_item_finish(dB, vB, scr, F.lane);
                if (!hasA) break;
            } }
    }
#undef P0_DECODE
#undef P0_DRAW
}

typedef const pg8::f32x4 (&AccRef)[2][2][4][2];
__device__ __forceinline__ v4u pack8(const f32x4 a, const f32x4 b) { v4u w; w.x = cvt_pk_bf16(a[0], a[1]); w.y = cvt_pk_bf16(a[2], a[3]); w.z = cvt_pk_bf16(b[0], b[1]); w.w = cvt_pk_bf16(b[2], b[3]); return w; }
__device__ __forceinline__ void unpack8(const v4u w, f32x4& a, f32x4& b) { a = (f32x4){bflo(w.x), bfhi(w.x), bflo(w.y), bfhi(w.y)}; b = (f32x4){bflo(w.z), bfhi(w.z), bflo(w.w), bfhi(w.w)}; }

struct EpiInProj {
    static constexpr bool PERM = true;
    __device__ __forceinline__ bool keep(const pg8::Unit&) const { return false; }
    bf16 *U, *Q, *Kb, *V, *G1, *G2; const float *bgate, *qg, *kg;
    __device__ __forceinline__ void operator()(AccRef acc, const pg8::Unit& u, int wr, int wc, int fr, int fq, const LAS int*) const {
        const int pn = u.pn, row0 = u.pm * 256 + wr * 64 + fr;
        if (pn < 2) {
#pragma unroll
            for (int ai = 0; ai < 2; ++ai)
#pragma unroll
                for (int m = 0; m < 4; ++m) { const int row = row0 + ai * 128 + m * 16, b = row >> 11, t = row & 2047;
#pragma unroll
                    for (int bj = 0; bj < 2; ++bj) { const int lc = 256 * pn + 64 * wc + 32 * bj + 8 * fq, g = lc >> 4, ch = lc & 15;
                        *(v4u*)(U + ((size_t)(b * SSM_G + g) * SEQ + t) * 16 + ch) = pack8(acc[ai][bj][m][0], acc[ai][bj][m][1]); } }
        } else if (pn < 6) {
            const bool isq = pn < 4; const float* gv = isq ? qg : kg; const float sc = isq ? QSCALE : 1.0f;
            bf16* dst = (isq ? Q : Kb) + 256 * (pn - (isq ? 2 : 4)) + 64 * wc + 8 * fq;
            f32x4 gg[2][2];
#pragma unroll
            for (int bj = 0; bj < 2; ++bj)
#pragma unroll
                for (int n = 0; n < 2; ++n) gg[bj][n] = *(const f32x4*)(gv + 32 * bj + 8 * fq + 4 * n) * sc;
#pragma unroll
            for (int ai = 0; ai < 2; ++ai)
#pragma unroll
                for (int m = 0; m < 4; ++m) { const int row = row0 + ai * 128 + m * 16; float ss = 0.f;
#pragma unroll
                    for (int bj = 0; bj < 2; ++bj)
#pragma unroll
                        for (int n = 0; n < 2; ++n) { const f32x4 x = acc[ai][bj][m][n]; ss += (x[0] * x[0] + x[1] * x[1]) + (x[2] * x[2] + x[3] * x[3]); }
                    ss += __shfl_xor(ss, 16); ss += __shfl_xor(ss, 32);
                    const float rs = __builtin_amdgcn_rsqf(ss * (1.0f / 64.0f) + RMS_EPS);
#pragma unroll
                    for (int bj = 0; bj < 2; ++bj) *(v4u*)(dst + (size_t)row * 512 + 32 * bj) = pack8(acc[ai][bj][m][0] * rs * gg[bj][0], acc[ai][bj][m][1] * rs * gg[bj][1]); }
        } else if (pn < 8) {
            bf16* dst = V + 256 * (pn - 6) + 64 * wc + 8 * fq;
#pragma unroll
            for (int ai = 0; ai < 2; ++ai)
#pragma unroll
                for (int m = 0; m < 4; ++m) { const int row = row0 + ai * 128 + m * 16;
#pragma unroll
                    for (int bj = 0; bj < 2; ++bj) *(v4u*)(dst + (size_t)row * 512 + 32 * bj) = pack8(acc[ai][bj][m][0], acc[ai][bj][m][1]); }
        } else {
            const int gc = 256 * (pn - 8) + 64 * wc + 8 * fq;
            bf16* dst = (gc < 1024 ? G1 + gc : G2 + (gc - 1024));
            f32x4 bb[2][2];
#pragma unroll
            for (int bj = 0; bj < 2; ++bj)
#pragma unroll
                for (int n = 0; n < 2; ++n) bb[bj][n] = *(const f32x4*)(bgate + gc + 32 * bj + 4 * n);
#pragma unroll
            for (int ai = 0; ai < 2; ++ai)
#pragma unroll
                for (int m = 0; m < 4; ++m) { const int row = row0 + ai * 128 + m * 16;
#pragma unroll
                    for (int bj = 0; bj < 2; ++bj) { f32x4 a = acc[ai][bj][m][0] + bb[bj][0], b = acc[ai][bj][m][1] + bb[bj][1];
#pragma unroll
                        for (int e = 0; e < 4; ++e) { a[e] = fsigmoid(a[e]); b[e] = fsigmoid(b[e]); }
                        *(v4u*)(dst + (size_t)row * 1024 + 32 * bj) = pack8(a, b); } }
        }
    }
};
template <int MODE> struct EpiMix {
    static constexpr bool PERM = true;
    __device__ __forceinline__ bool keep(const pg8::Unit&) const { return false; }
    const bf16* P0; const bf16* P1; bf16* O; const float* bias; int ld;
    __device__ __forceinline__ void operator()(AccRef acc, const pg8::Unit& u, int wr, int wc, int fr, int fq, const LAS int*) const {
        const int row0 = u.pm * 256 + wr * 64 + fr, col0 = u.pn * 256 + wc * 32 + 8 * fq;
        f32x4 bb[2][2];
#pragma unroll
        for (int bj = 0; bj < 2; ++bj)
#pragma unroll
            for (int n = 0; n < 2; ++n) bb[bj][n] = (MODE == 0) ? *(const f32x4*)(bias + col0 + bj * 128 + 4 * n) : (f32x4){0.f, 0.f, 0.f, 0.f};
#pragma unroll
        for (int ai = 0; ai < 2; ++ai) {
            v4u q0[4][2], q1[4][2];
#pragma unroll
            for (int m = 0; m < 4; ++m)
#pragma unroll
                for (int bj = 0; bj < 2; ++bj) { const size_t off = (size_t)(row0 + ai * 128 + m * 16) * ld + col0 + bj * 128; q0[m][bj] = *(const v4u*)(P0 + off); if (MODE == 2) q1[m][bj] = *(const v4u*)(P1 + off); }
#pragma unroll
            for (int m = 0; m < 4; ++m) { const size_t off = (size_t)(row0 + ai * 128 + m * 16) * ld + col0;
#pragma unroll
                for (int bj = 0; bj < 2; ++bj) { f32x4 a = acc[ai][bj][m][0], b = acc[ai][bj][m][1], p0a, p0b;
                    unpack8(q0[m][bj], p0a, p0b);
                    if (MODE == 0) { a += bb[bj][0]; b += bb[bj][1];
#pragma unroll
                        for (int e = 0; e < 4; ++e) { a[e] = p0a[e] * fsigmoid_fast(a[e]); b[e] = p0b[e] * fsigmoid_fast(b[e]); } }
                    else if (MODE == 1) { a *= p0a; b *= p0b; }
                    else { f32x4 p1a, p1b; unpack8(q1[m][bj], p1a, p1b); a = p0a + p1a * a; b = p0b + p1b * b; }
                    *(v4u*)(O + off + bj * 128) = pack8(a, b); } } }
    }
};
struct EpiOut {
    static constexpr bool PERM = false;
    __device__ __forceinline__ bool keep(const pg8::Unit&) const { return false; }
    const float* X; float* H; unsigned char* HB;
    __device__ __forceinline__ void operator()(AccRef acc, const pg8::Unit& u, int wr, int wc, int fr, int fq, const LAS int*) const {
        const int row0 = u.pm * 256 + wr * 64 + fr, col0 = u.pn * 256 + wc * 32 + 4 * fq;
#pragma unroll
        for (int ai = 0; ai < 2; ++ai) {
            f32x4 xv[4][2][2];
#pragma unroll
            for (int m = 0; m < 4; ++m)
#pragma unroll
                for (int bj = 0; bj < 2; ++bj)
#pragma unroll
                    for (int n = 0; n < 2; ++n) xv[m][bj][n] = *(const f32x4*)(X + (size_t)(row0 + ai * 128 + m * 16) * DM + col0 + bj * 128 + n * 16);
#pragma unroll
            for (int m = 0; m < 4; ++m) { const size_t off = (size_t)(row0 + ai * 128 + m * 16) * DM + col0;
#pragma unroll
                for (int bj = 0; bj < 2; ++bj)
#pragma unroll
                    for (int n = 0; n < 2; ++n) { const f32x4 h = xv[m][bj][n] + acc[ai][bj][m][n];
                        *(f32x4*)(H + off + bj * 128 + n * 16) = h; *(unsigned*)(HB + off + bj * 128 + n * 16) = pk4_fp8(h[0], h[1], h[2], h[3]); } } }
    }
};
struct ChainOrder {
    pg8::StaticOrder so; const bf16* A_att; const bf16* A_ssm;
    __device__ __forceinline__ bool next(int i, pg8::Unit& u) const { pg8::Unit t; if (!so.next(i >> 1, t)) return false; u.pm = t.pm; u.pn = (i & 1) ? t.pn : 4 + t.pn; return true; }
    __device__ __forceinline__ int row_slot(const pg8::Unit&, int) const { return 0; }
    __device__ __forceinline__ int a_row(const pg8::Unit& u, int r, int) const { return u.pm * 256 + r; }
    __device__ __forceinline__ const char* a_base(const pg8::Gemm&, const pg8::Unit& u, size_t tstep) const { return (const char*)(u.pn >= 4 ? A_att : A_ssm) + (size_t)u.pm * tstep; }
    __device__ __forceinline__ void a_ready(const pg8::Unit&) const {}
    __device__ __forceinline__ void done(const pg8::Unit&) const {}
};
struct EpiChain {
    static constexpr bool PERM = true;
    const bf16* G1; const bf16* G2; bf16* MX;
    __device__ __forceinline__ bool keep(const pg8::Unit& u) const { return u.pn >= 4; }
    __device__ __forceinline__ void operator()(pg8::f32x4 (&acc)[2][2][4][2], const pg8::Unit& u, int wr, int wc, int fr, int fq, const LAS int*) const {
        const bool att = u.pn >= 4; const int row0 = u.pm * 256 + wr * 64 + fr, col0 = (u.pn & 3) * 256 + wc * 32 + 8 * fq;
#pragma unroll
        for (int ai = 0; ai < 2; ++ai) {
            v4u q1[4][2], q2[4][2];
#pragma unroll
            for (int m = 0; m < 4; ++m)
#pragma unroll
                for (int bj = 0; bj < 2; ++bj) { const size_t off = (size_t)(row0 + ai * 128 + m * 16) * DM + col0 + bj * 128; q1[m][bj] = *(const v4u*)(G1 + off); if (att) q2[m][bj] = *(const v4u*)(G2 + off); }
#pragma unroll
            for (int m = 0; m < 4; ++m)
#pragma unroll
                for (int bj = 0; bj < 2; ++bj) { f32x4 g1a, g1b; unpack8(q1[m][bj], g1a, g1b);
                    if (att) { f32x4 g2a, g2b; unpack8(q2[m][bj], g2a, g2b);
#pragma unroll
                        for (int e = 0; e < 4; ++e) { acc[ai][bj][m][0][e] *= g2a[e] * __builtin_amdgcn_rcpf(g1a[e]); acc[ai][bj][m][1][e] *= g2b[e] * __builtin_amdgcn_rcpf(g1b[e]); } }
                    else *(v4u*)(MX + (size_t)(row0 + ai * 128 + m * 16) * DM + col0 + bj * 128) = pack8(acc[ai][bj][m][0] * g1a, acc[ai][bj][m][1] * g1b); } }
    }
};
constexpr int CW_MFLAG = 32768, MFLAG_STRIDE = 16;
template <int NN, bool TOKROWS> struct MoeOrder {
    int nunits, G, vcu; const LAS int* cnt; const LAS int* tstart; const LAS int* tile2e; const int* elist; unsigned* mflag;
    __device__ __forceinline__ void a_ready(const pg8::Unit& u) const {
        if constexpr (!TOKROWS) { unsigned* f = mflag + u.pm * MFLAG_STRIDE; unsigned spins = 0;
            while (__hip_atomic_load(f, __ATOMIC_RELAXED, __HIP_MEMORY_SCOPE_AGENT) < 8u && ++spins < (1u << 22)) __builtin_amdgcn_s_sleep(2);
            asm volatile("" ::: "memory"); } }
    __device__ __forceinline__ void done(const pg8::Unit& u) const {
        if constexpr (TOKROWS) { asm volatile("s_waitcnt vmcnt(0)" ::: "memory"); __builtin_amdgcn_s_barrier(); asm volatile("" ::: "memory");
            if (threadIdx.x == 0) __hip_atomic_fetch_add(mflag + u.pm * MFLAG_STRIDE, 1u, __ATOMIC_RELAXED, __HIP_MEMORY_SCOPE_AGENT); } }
    __device__ __forceinline__ bool next(int i, pg8::Unit& u) const { const long L = (long)i * G + vcu; if (L >= nunits) return false; const int pm = (int)(L / NN), pnl = (int)(L % NN);
        u.pm = pm; u.pn = tile2e[pm] * NN + pnl; return true; }
    __device__ __forceinline__ int row_slot(const pg8::Unit& u, int r) const { const int e = u.pn / NN, pos = (u.pm - tstart[e]) * 256 + r; return pos < cnt[e] ? elist[e * M + pos] : -1; }
    __device__ __forceinline__ int a_row(const pg8::Unit& u, int r, int slot) const { return TOKROWS ? (slot < 0 ? 0 : (slot >> 2)) : u.pm * 256 + r; }
    __device__ __forceinline__ const char* a_base(const pg8::Gemm& g, const pg8::Unit&, size_t) const { return (const char*)g.A; }
};
struct EpiUp {
    static constexpr bool PERM = true;
    __device__ __forceinline__ bool keep(const pg8::Unit&) const { return false; }
    unsigned char* ACT; const float* bup; const float* rs2;
    __device__ __forceinline__ void operator()(AccRef acc, const pg8::Unit& u, int wr, int wc, int fr, int fq, const LAS int* tab) const {
        const int e = u.pn >> 3, pnl = u.pn & 7, j0 = 128 * pnl + 32 * wc + 8 * fq;
        f32x4 bb[4];
#pragma unroll
        for (int q = 0; q < 4; ++q) bb[q] = *(const f32x4*)(bup + (size_t)e * UPW + 2 * j0 + 4 * q);
        int sl[2][4]; float rsv[2][4];
#pragma unroll
        for (int ai = 0; ai < 2; ++ai)
#pragma unroll
            for (int m = 0; m < 4; ++m) { sl[ai][m] = tab[ai * 128 + wr * 64 + m * 16 + fr]; rsv[ai][m] = rs2[sl[ai][m] < 0 ? 0 : (sl[ai][m] >> 2)] * 0.03125f; }
#pragma unroll
        for (int ai = 0; ai < 2; ++ai)
#pragma unroll
            for (int m = 0; m < 4; ++m) { const int r = ai * 128 + wr * 64 + m * 16 + fr, slot = sl[ai][m];
                if (slot >= 0) { const float rs = rsv[ai][m]; f32x4 o[2];
#pragma unroll
                    for (int n = 0; n < 2; ++n)
#pragma unroll
                        for (int e4 = 0; e4 < 4; ++e4) { const int j = 4 * n + e4;
                            float gl = acc[ai][0][m][n][e4] * rs + bb[(2 * j) >> 2][(2 * j) & 3], li = acc[ai][1][m][n][e4] * rs + bb[(2 * j + 1) >> 2][(2 * j + 1) & 3];
                            gl = fminf(gl, 7.0f); li = fminf(fmaxf(li, -7.0f), 7.0f);
                            o[n][e4] = gl * fsigmoid_fast(1.702f * gl) * (li + 1.0f) * 4.0f; }
                    const unsigned long long ov = (unsigned long long)pk4_fp8(o[0][0], o[0][1], o[0][2], o[0][3]) | ((unsigned long long)pk4_fp8(o[1][0], o[1][1], o[1][2], o[1][3]) << 32);
                    __hip_atomic_store((unsigned long long*)(ACT + (size_t)(u.pm * 256 + r) * DE + j0), ov, __ATOMIC_RELAXED, __HIP_MEMORY_SCOPE_AGENT); } }
    }
};
struct EpiDown {
    static constexpr bool PERM = true;
    __device__ __forceinline__ bool keep(const pg8::Unit&) const { return false; }
    unsigned char* YS2; const float* bdn; const float* wslot;
    __device__ __forceinline__ void operator()(AccRef acc, const pg8::Unit& u, int wr, int wc, int fr, int fq, const LAS int* tab) const {
        const int e = u.pn >> 2, pnl = u.pn & 3, c0 = 256 * pnl + 32 * wc + 8 * fq;
        f32x4 bb[2][2];
#pragma unroll
        for (int bj = 0; bj < 2; ++bj)
#pragma unroll
            for (int n = 0; n < 2; ++n) bb[bj][n] = *(const f32x4*)(bdn + (size_t)e * DM + c0 + bj * 128 + 4 * n);
        int sl[2][4]; float wv[2][4];
#pragma unroll
        for (int ai = 0; ai < 2; ++ai)
#pragma unroll
            for (int m = 0; m < 4; ++m) { sl[ai][m] = tab[ai * 128 + wr * 64 + m * 16 + fr]; wv[ai][m] = wslot[sl[ai][m] < 0 ? 0 : sl[ai][m]]; }
#pragma unroll
        for (int ai = 0; ai < 2; ++ai)
#pragma unroll
            for (int m = 0; m < 4; ++m) { const int slot = sl[ai][m];
                if (slot >= 0) { const float w = wv[ai][m] * 16.0f;
#pragma unroll
                    for (int bj = 0; bj < 2; ++bj) { const f32x4 ya = (acc[ai][bj][m][0] * 0.0078125f + bb[bj][0]) * w, yb = (acc[ai][bj][m][1] * 0.0078125f + bb[bj][1]) * w; v2u ov; ov.x = pk4_fp8(ya[0], ya[1], ya[2], ya[3]); ov.y = pk4_fp8(yb[0], yb[1], yb[2], yb[3]);
                        *(v2u*)(YS2 + (size_t)slot * DM + c0 + bj * 128) = ov; } } }
    }
};

constexpr int S5_UPITCH = 528, S5_SX_OFF = 128 * S5_UPITCH, S5_XPITCH = 132;
__device__ __forceinline__ void s5_unit(Frame& F, int b, int g) {
    LAS unsigned char* Uimg = F.lds + RING_OFF; LAS float* SX = (LAS float*)(F.lds + RING_OFF + S5_SX_OFF);
    const int tid = F.tid, lane = F.lane, w = F.wave, r32 = lane & 31, hi = lane >> 5;
    const bf16* Ug = (const bf16*)(F.ws + WS_U) + (size_t)(b * SSM_G + g) * SEQ * 16;
    const bf16* W1T = (const bf16*)(F.ws + WS_S5 + (size_t)g * 262144); const bf16* M2T = W1T + 128 * 256; const bf16* W3T = M2T + 256 * 256;
#pragma unroll
    for (int j = 0; j < 8; ++j) { const int q = tid + 512 * j; *(LAS v4u*)(Uimg + (q >> 5) * S5_UPITCH + (q & 31) * 16) = *(const v4u*)(Ug + (size_t)q * 8); }
    __syncthreads();
    { const int nt = w & 3, mt0 = 2 * (w >> 2);
      f32x16 s0 = {0}, s1 = {0};
#pragma unroll 4
      for (int ks = 0; ks < 16; ++ks) {
          const bf16x8 bf = *(const bf16x8*)(W1T + (size_t)(32 * nt + r32) * 256 + 16 * ks + 8 * hi);
          const bf16x8 a0 = *(const LAS bf16x8*)(Uimg + (32 * mt0 + r32) * S5_UPITCH + (16 * ks + 8 * hi) * 2);
          const bf16x8 a1 = *(const LAS bf16x8*)(Uimg + (32 * (mt0 + 1) + r32) * S5_UPITCH + (16 * ks + 8 * hi) * 2);
          s0 = __builtin_amdgcn_mfma_f32_32x32x16_bf16(a0, bf, s0, 0, 0, 0); s1 = __builtin_amdgcn_mfma_f32_32x32x16_bf16(a1, bf, s1, 0, 0, 0); }
#pragma unroll
      for (int r = 0; r < 16; ++r) { SX[(32 * mt0 + crow(r, hi)) * S5_XPITCH + 32 * nt + r32] = s0[r]; SX[(32 * (mt0 + 1) + crow(r, hi)) * S5_XPITCH + 32 * nt + r32] = s1[r]; } }
    __syncthreads();
    if (tid < 64) {
        const float* a16 = (const float*)(F.ws + WS_A16) + (g * 64 + tid) * 2; const float ar = a16[0], ai = a16[1]; float xr = 0.f, xi = 0.f;
#pragma unroll 8
        for (int c = 0; c < SSM_NC; ++c) { const float sr = SX[c * S5_XPITCH + tid], si = SX[c * S5_XPITCH + 64 + tid];
            SX[c * S5_XPITCH + tid] = xr; SX[c * S5_XPITCH + 64 + tid] = xi;
            const float nr = ar * xr - ai * xi + sr, ni = ar * xi + ai * xr + si; xr = nr; xi = ni; }
    }
    __syncthreads();
    { f32x16 y[4] = {{0}, {0}, {0}, {0}};
      const int nks = 2 * w + 2;
      for (int ks = 0; ks < nks; ++ks) {
          const bf16x8 bf = *(const bf16x8*)(M2T + (size_t)(32 * w + r32) * 256 + 16 * ks + 8 * hi);
#pragma unroll
          for (int mt = 0; mt < 4; ++mt) { const bf16x8 a = *(const LAS bf16x8*)(Uimg + (32 * mt + r32) * S5_UPITCH + (16 * ks + 8 * hi) * 2); y[mt] = __builtin_amdgcn_mfma_f32_32x32x16_bf16(a, bf, y[mt], 0, 0, 0); } }
#pragma unroll 2
      for (int ks = 0; ks < 8; ++ks) {
          const bf16x8 bf = *(const bf16x8*)(W3T + (size_t)(32 * w + r32) * 128 + 16 * ks + 8 * hi);
#pragma unroll
          for (int mt = 0; mt < 4; ++mt) { const LAS f32x4* xp = (const LAS f32x4*)(SX + (32 * mt + r32) * S5_XPITCH + 16 * ks + 8 * hi); const f32x4 x0 = xp[0], x1 = xp[1];
              const v4u pk = pack8(x0, x1); y[mt] = __builtin_amdgcn_mfma_f32_32x32x16_bf16(__builtin_bit_cast(bf16x8, pk), bf, y[mt], 0, 0, 0); } }
      bf16* YG = (bf16*)(F.ws + WS_YG); const int i = 2 * w + (r32 >> 4), ho = r32 & 15;
#pragma unroll
      for (int mt = 0; mt < 4; ++mt)
#pragma unroll
          for (int r = 0; r < 16; ++r) { const int c = 32 * mt + crow(r, hi); YG[(size_t)(b * SEQ + 16 * c + i) * SSM_W + g * 16 + ho] = (bf16)f2bf(gelu_tanh(y[mt][r])); } }
    __syncthreads();
}

constexpr int AT_KP = 272, AT_VP = 320, AT_KB = 64 * AT_KP, AT_VB = 64 * AT_VP, AT_BUF = AT_KB + AT_VB;
__device__ __forceinline__ s16x4 vtr(const LAS unsigned char* p) { typedef short v4i16_t __attribute__((ext_vector_type(4))); return __builtin_bit_cast(s16x4, __builtin_amdgcn_ds_read_tr16_b64_v4i16((LAS v4i16_t*)p)); }
__device__ __forceinline__ void attn_unit(Frame& F, int b, int h, int qb, float lam) {
    const int tid = F.tid, lane = F.lane, w = F.wave, rg = w >> 1, t = w & 1, r32 = lane & 31, hi = lane >> 5;
    const bf16* Q = (const bf16*)(F.ws + WS_Q); const bf16* K = (const bf16*)(F.ws + WS_K); const bf16* V = (const bf16*)(F.ws + WS_V); bf16* OB = (bf16*)(F.ws + WS_OB);
    LAS unsigned char* L = F.lds + RING_OFF;
    const int qrow = b * SEQ + qb * 128 + rg * 32 + r32;
    bf16x8 qf[4];
#pragma unroll
    for (int ks = 0; ks < 4; ++ks) qf[ks] = *(const bf16x8*)(Q + (size_t)qrow * QK_W + h * 128 + t * 64 + 16 * ks + 8 * hi);
    const int ntile = 2 * qb + 2, mylim = 2 * qb + (rg >> 1);
    const int kr0 = tid >> 4, cc = tid & 15;
    const size_t gbase = (size_t)(b * SEQ) * 512 + h * 128 + cc * 8;
    v4u kregA[2], vregA[2], kregB[2], vregB[2];
#define AT_LOAD(j, kreg, vreg) do { _Pragma("unroll") for (int i_ = 0; i_ < 2; ++i_) { const size_t o_ = gbase + (size_t)(64 * (j) + kr0 + 32 * i_) * 512; kreg[i_] = *(const v4u*)(K + o_); vreg[i_] = *(const v4u*)(V + o_); } } while (0)
#define AT_STORE(buf, kreg, vreg) do { _Pragma("unroll") for (int i_ = 0; i_ < 2; ++i_) { *(LAS v4u*)(L + (buf) * AT_BUF + (kr0 + 32 * i_) * AT_KP + cc * 16) = kreg[i_]; \
        *(LAS v4u*)(L + (buf) * AT_BUF + AT_KB + (kr0 + 32 * i_) * AT_VP + cc * 16) = vreg[i_]; } } while (0)
    AT_LOAD(0, kregB, vregB); AT_LOAD(1, kregA, vregA); AT_STORE(0, kregB, vregB);
    __syncthreads();
    f32x16 o[4] = {{0}, {0}, {0}, {0}};
    float mrun = -60.0f, lrun = 0.f;
    f32x16 negm;
#pragma unroll
    for (int r = 0; r < 16; ++r) negm[r] = 60.0f;
    const int g4 = lane >> 4, i16 = lane & 15;
    const int vlane = (4 * (g4 >> 1) + (i16 >> 2)) * AT_VP + (16 * (g4 & 1) + 4 * (i16 & 3)) * 2;
#define AT_COMPUTE(j, buf) do { \
        if (j <= mylim) { \
            const LAS unsigned char* Kb = L + buf * AT_BUF + t * 128 + hi * 16 + r32 * AT_KP; \
            const LAS unsigned char* Vb = L + buf * AT_BUF + AT_KB + vlane; \
            f32x16 s0, s1; \
            __builtin_amdgcn_s_setprio(1); \
        _Pragma("unroll") \
            for (int ks = 0; ks < 4; ++ks) { const bf16x8 k0 = *(const LAS bf16x8*)(Kb + ks * 32), k1 = *(const LAS bf16x8*)(Kb + 32 * AT_KP + ks * 32); \
                if (ks == 0) { s0 = __builtin_amdgcn_mfma_f32_32x32x16_bf16(k0, qf[0], negm, 0, 0, 0); s1 = __builtin_amdgcn_mfma_f32_32x32x16_bf16(k1, qf[0], negm, 0, 0, 0); } \
                else { s0 = __builtin_amdgcn_mfma_f32_32x32x16_bf16(k0, qf[ks], s0, 0, 0, 0); s1 = __builtin_amdgcn_mfma_f32_32x32x16_bf16(k1, qf[ks], s1, 0, 0, 0); } } \
            __builtin_amdgcn_s_setprio(0); \
            float mx = fmaxf(fmaxf(s0[0], s0[1]), s0[2]); \
        _Pragma("unroll") \
            for (int r = 3; r < 15; r += 2) mx = fmaxf(fmaxf(mx, s0[r]), s0[r + 1]); \
            mx = fmaxf(mx, s0[15]); \
        _Pragma("unroll") \
            for (int r = 0; r < 16; r += 2) mx = fmaxf(fmaxf(mx, s1[r]), s1[r + 1]); \
            mx = fmaxf(mx, __shfl_xor(mx, 32)); \
            if (__builtin_amdgcn_ballot_w64(mx > 8.0f) != 0ull) { \
                const float dm = (mx > 8.0f) ? mx : 0.0f, alpha = __builtin_amdgcn_exp2f(-dm); lrun *= alpha; mrun += dm; \
        _Pragma("unroll") \
                for (int dt = 0; dt < 4; ++dt) o[dt] *= alpha; \
        _Pragma("unroll") \
                for (int r = 0; r < 16; ++r) { s0[r] -= dm; s1[r] -= dm; negm[r] = -mrun; } } \
            float ps = 0.f; \
        _Pragma("unroll") \
            for (int r = 0; r < 16; ++r) { s0[r] = __builtin_amdgcn_exp2f(s0[r]); s1[r] = __builtin_amdgcn_exp2f(s1[r]); ps += s0[r] + s1[r]; } \
            lrun += ps; \
        _Pragma("unroll") \
            for (int s = 0; s < 4; ++s) { \
                v4u pk; const int rb = 8 * (s & 1); \
                if (s < 2) { pk.x = cvt_pk_bf16(s0[rb], s0[rb + 1]); pk.y = cvt_pk_bf16(s0[rb + 2], s0[rb + 3]); pk.z = cvt_pk_bf16(s0[rb + 4], s0[rb + 5]); pk.w = cvt_pk_bf16(s0[rb + 6], s0[rb + 7]); } \
                else       { pk.x = cvt_pk_bf16(s1[rb], s1[rb + 1]); pk.y = cvt_pk_bf16(s1[rb + 2], s1[rb + 3]); pk.z = cvt_pk_bf16(s1[rb + 4], s1[rb + 5]); pk.w = cvt_pk_bf16(s1[rb + 6], s1[rb + 7]); } \
                const bf16x8 pf = __builtin_bit_cast(bf16x8, pk); \
                __builtin_amdgcn_s_setprio(1); \
        _Pragma("unroll") \
                for (int dt = 0; dt < 4; ++dt) { const s16x4 lo = vtr(Vb + s * 16 * AT_VP + dt * 64), hh = vtr(Vb + s * 16 * AT_VP + dt * 64 + 8 * AT_VP); \
                    const bf16x8 vf = (bf16x8){lo[0], lo[1], lo[2], lo[3], hh[0], hh[1], hh[2], hh[3]}; \
                    o[dt] = __builtin_amdgcn_mfma_f32_32x32x16_bf16(vf, pf, o[dt], 0, 0, 0); } \
                __builtin_amdgcn_s_setprio(0); } \
        } \
    } while (0)
    for (int j = 0; j < ntile; j += 2) {
        { const int jn = (j + 2 < ntile) ? j + 2 : ntile - 1; AT_LOAD(jn, kregB, vregB); }
        AT_COMPUTE(j, 0);
        AT_STORE(1, kregA, vregA);
        __syncthreads();
        { const int jn = (j + 3 < ntile) ? j + 3 : ntile - 1; AT_LOAD(jn, kregA, vregA); }
        AT_COMPUTE(j + 1, 1);
        AT_STORE(0, kregB, vregB);
        __syncthreads();
    }
#undef AT_COMPUTE
#undef AT_LOAD
#undef AT_STORE
    const float ltot = lrun + __shfl_xor(lrun, 32), inv = 1.0f / ltot;
    LAS float* EX = (LAS float*)L + rg * 4096;
    if (t == 1) {
        const float sc = inv * lam;
#pragma unroll
        for (int dt = 0; dt < 4; ++dt)
#pragma unroll
            for (int r = 0; r < 16; ++r) EX[(dt * 16 + r) * 64 + lane] = o[dt][r] * sc;
    }
    __syncthreads();
    if (t == 0) {
        float ss = 0.f;
#pragma unroll
        for (int dt = 0; dt < 4; ++dt)
#pragma unroll
            for (int r = 0; r < 16; ++r) { const float y = o[dt][r] * inv - EX[(dt * 16 + r) * 64 + lane]; o[dt][r] = y; ss += y * y; }
        ss += __shfl_xor(ss, 32);
        const float rn = (1.0f - LAMBDA_INIT) / sqrtf(ss * (1.0f / 128.0f) + RMS_EPS);
        const float* sg = F.in[I_SUBLN];
        f32x4 ggv[4][4];
#pragma unroll
        for (int dt = 0; dt < 4; ++dt)
#pragma unroll
            for (int rq = 0; rq < 4; ++rq) ggv[dt][rq] = *(const f32x4*)(sg + 32 * dt + 8 * rq + 4 * hi);
#pragma unroll
        for (int dt = 0; dt < 4; ++dt)
#pragma unroll
            for (int rq = 0; rq < 4; ++rq) { const int d = 32 * dt + 8 * rq + 4 * hi; const f32x4 gg = ggv[dt][rq];
                v2u wv; wv.x = cvt_pk_bf16(o[dt][4 * rq] * rn * gg[0], o[dt][4 * rq + 1] * rn * gg[1]); wv.y = cvt_pk_bf16(o[dt][4 * rq + 2] * rn * gg[2], o[dt][4 * rq + 3] * rn * gg[3]);
                *(v2u*)(OB + (size_t)qrow * V_W + h * 128 + d) = wv; }
    }
    __syncthreads();
}

constexpr int CW_CNT_STRIDE = 64;
__device__ __forceinline__ void router_phase(Frame& F, const bool dummy = false) {
    const int lane = F.lane, tid = F.tid, w = F.wave, tt = w >> 1, kh = w & 1;
    LAS float* LG = (LAS float*)(F.lds + RING_OFF);
    LAS float* SS = LG + 4 * 2 * 16 * 33;
    LAS int* LC = (LAS int*)(SS + 128);
    const float* Hf = F.out; const float* wrT = (const float*)(F.ws + WS_WRT); const float* br = F.in[I_BR];
    float* rs2 = (float*)(F.ws + (dummy ? WS_YS2 : WS_RS2)); float* wslot = (float*)(F.ws + (dummy ? WS_YS2 + MiB : WS_WSLOT)); int* elist = (int*)(F.ws + (dummy ? WS_YS2 + 2 * MiB : WS_ELIST));
    unsigned* cnt = (unsigned*)(F.ctl + CW_CNT + (dummy ? 32 : 0));
    const int i16 = lane & 15, kq = lane >> 4;
    for (int tg = F.vcu; tg < M / 64; tg += F.G) {
        if (tid < 64) LC[tid] = 0;
        const int tok0 = tg * 64 + tt * 16;
        f32x4 a0 = {0.f, 0.f, 0.f, 0.f}, a1 = {0.f, 0.f, 0.f, 0.f}; float ssq = 0.f;
        const float* hp = Hf + (size_t)(tok0 + i16) * DM + kh * 512 + 4 * kq; const float* w0 = wrT + (size_t)i16 * DM + kh * 512 + 4 * kq; const float* w1 = w0 + 16 * DM;
#pragma unroll 8
        for (int s = 0; s < 32; ++s) { const f32x4 a = *(const f32x4*)(hp + 16 * s), b0 = *(const f32x4*)(w0 + 16 * s), b1 = *(const f32x4*)(w1 + 16 * s);
            ssq += (a[0] * a[0] + a[1] * a[1]) + (a[2] * a[2] + a[3] * a[3]);
#pragma unroll
            for (int q = 0; q < 4; ++q) { a0 = __builtin_amdgcn_mfma_f32_16x16x4f32(a[q], b0[q], a0, 0, 0, 0); a1 = __builtin_amdgcn_mfma_f32_16x16x4f32(a[q], b1[q], a1, 0, 0, 0); } }
        ssq += __shfl_xor(ssq, 16); ssq += __shfl_xor(ssq, 32);
        LAS float* lg = LG + (tt * 2 + kh) * 16 * 33;
#pragma unroll
        for (int r = 0; r < 4; ++r) { lg[(4 * kq + r) * 33 + i16] = a0[r]; lg[(4 * kq + r) * 33 + 16 + i16] = a1[r]; }
        if (kq == 0) SS[(tt * 2 + kh) * 16 + i16] = ssq;
        __syncthreads();
        int ti[4]; float wv[4]; int lpos[4]; float rsv = 0.f;
        if (tid < 64) {
            const int t4 = tid >> 4, t16 = tid & 15;
            rsv = 1.0f / sqrtf((SS[(t4 * 2) * 16 + t16] + SS[(t4 * 2 + 1) * 16 + t16]) * (1.0f / DM) + RMS_EPS);
            float lgv[32];
#pragma unroll
            for (int e = 0; e < 32; ++e) lgv[e] = (LG[((t4 * 2) * 16 + t16) * 33 + e] + LG[((t4 * 2 + 1) * 16 + t16) * 33 + e]) * rsv + br[e];
            float tv[4];
#pragma unroll
            for (int k = 0; k < 4; ++k) { float best = -3.0e38f; int bi = 0;
#pragma unroll
                for (int e = 0; e < 32; ++e) { const bool tk = lgv[e] > best; best = tk ? lgv[e] : best; bi = tk ? e : bi; }
                tv[k] = best; ti[k] = bi;
#pragma unroll
                for (int e = 0; e < 32; ++e) lgv[e] = (e == bi) ? -3.0e38f : lgv[e]; }
            const float e1 = __expf(tv[1] - tv[0]), e2 = __expf(tv[2] - tv[0]), e3 = __expf(tv[3] - tv[0]), den = 1.0f / (1.0f + e1 + e2 + e3);
            wv[0] = den; wv[1] = e1 * den; wv[2] = e2 * den; wv[3] = e3 * den;
#pragma unroll
            for (int k = 0; k < 4; ++k) lpos[k] = __hip_atomic_fetch_add(LC + ti[k], 1, __ATOMIC_RELAXED, __HIP_MEMORY_SCOPE_WORKGROUP);
        }
        __syncthreads();
        if (tid < 32) { const int c = LC[tid]; LC[32 + tid] = c ? (int)atomicAdd(cnt + tid * CW_CNT_STRIDE, (unsigned)c) : 0; }
        __syncthreads();
        if (tid < 64) {
            const int tok = tg * 64 + tid;
            rs2[tok] = rsv;
#pragma unroll
            for (int k = 0; k < 4; ++k) { elist[ti[k] * M + LC[32 + ti[k]] + lpos[k]] = tok * 4 + k; wslot[tok * 4 + k] = wv[k]; }
        }
        __syncthreads();
    }
}
__device__ __forceinline__ int moe_tables(Frame& F) {
    LAS int* T = (LAS int*)(F.lds + MOE_LDS_OFF); LAS int* cnt = T, *tstart = T + 32, *tile2e = T + 72;
    if (F.tid < 32) cnt[F.tid] = (int)__hip_atomic_load((unsigned*)(F.ctl + CW_CNT) + F.tid * CW_CNT_STRIDE, RLX_AGENT);
    __syncthreads();
    if (F.tid == 0) { int s = 0; for (int e = 0; e < 32; ++e) { tstart[e] = s; s += (cnt[e] + 255) >> 8; } tstart[32] = s; }
    __syncthreads();
    if (F.tid < 32) { for (int p = tstart[F.tid]; p < tstart[F.tid + 1]; ++p) tile2e[p] = F.tid; }
    __syncthreads();
    return tstart[32];
}
__device__ __forceinline__ void combine_phase(Frame& F, float* dst) {
    const int lane = F.lane, gw = F.vcu * NWAVES + F.wave, NGW = F.G * NWAVES;
    const unsigned char* YS2 = F.ws + WS_YS2;
    for (int tk = gw; tk < M; tk += NGW) {
        GAS f32x4* orow = (GAS f32x4*)(F.out + (size_t)tk * DM) + lane; GAS f32x4* drow = (GAS f32x4*)(dst + (size_t)tk * DM) + lane;
#pragma unroll
        for (int j = 0; j < 4; ++j) { f32x4 v = orow[64 * j];
#pragma unroll
            for (int k = 0; k < 4; ++k) { const unsigned y = *((const GAS unsigned*)(YS2 + (size_t)(tk * 4 + k) * DM) + lane + 64 * j);
                const f32x2 lo = __builtin_amdgcn_cvt_pk_f32_fp8(y, false), hi = __builtin_amdgcn_cvt_pk_f32_fp8(y, true); v += (f32x4){lo[0], lo[1], hi[0], hi[1]} * 0.0625f; }
            drow[64 * j] = v; }
    }
}

struct Args { const float* in[31]; float* out; unsigned char* ws; unsigned char* hi; int ph_lo, ph_hi; };
__global__ void __launch_bounds__(NWAVES * 64, 2) mk_fwd(Args args) {
    extern __shared__ __attribute__((aligned(16))) unsigned char lds[];
    Frame F;
    F.lds = (LAS unsigned char*)lds;
    F.MISC = (volatile LAS unsigned*)(F.lds + MISC_OFF);
    F.tid = threadIdx.x; F.lane = F.tid & 63; F.wave = __builtin_amdgcn_readfirstlane(F.tid >> 6);
    F.G = gridDim.x; { const int bx = blockIdx.x; F.vcu = (F.G % 8 == 0) ? (bx % 8) * (F.G / 8) + bx / 8 : bx; }
    F.ws = args.ws; F.hi = args.hi; F.ctl = (gu32*)(args.ws + WS_CTL); F.out = args.out;
#pragma unroll
    for (int i = 0; i < 31; ++i) F.in[i] = args.in[i];
    for (int u = F.tid; u < 64; u += NWAVES * 64) F.MISC[u] = 0u;
    __syncthreads();
    XcdBarrier bar; bar.bar = (unsigned*)(F.ctl + CW_BAR); bar.x = 0; bar.st = nullptr;
    if (N_LAUNCHES != PER_PHASE) bar = xcd_barrier_post((unsigned*)(F.ctl + CW_BAR), F.MISC + 8);
#define GRID_BAR() do { if (N_LAUNCHES != PER_PHASE) xcd_barrier(bar); } while (0)
    const int lo = args.ph_lo, hi = args.ph_hi;
#define IN(k) (lo <= (k) && (k) < hi)
#define BOTH(k) (IN(k) && IN((k) + 1))
    unsigned char* ws = args.ws; unsigned char* wsh = args.hi;

    if (IN(0)) { for (int rep = 0; rep < NREP(0); ++rep) { p0_prologue(F); if (BOTH(0)) GRID_BAR(); } }

    if (IN(1)) for (int rep = 0; rep < NREP(1); ++rep) {
        pg8::Gemm g{(const bf16*)(wsh + (WS_XN - HI)), (const bf16*)(wsh + (WS_WIN - HI)), M, IN_W, DM}; pg8::StaticOrder S; S.init(M, IN_W, F.G, (int)blockIdx.x);
        EpiInProj E{(bf16*)(ws + WS_U), (bf16*)(ws + WS_Q), (bf16*)(ws + WS_K), (bf16*)(ws + WS_V), (bf16*)(ws + WS_G1), (bf16*)(ws + WS_G2), F.in[I_BGATE], F.in[I_QG], F.in[I_KG]};
        pg8::gemm_phase<EpiInProj, pg8::StaticOrder, true>(F.lds + RING_OFF, g, S, E);
        if (BOTH(1)) GRID_BAR();
    }

    if (PROBE_REP == 30 && IN(1) && IN(2)) { GRID_BAR(); GRID_BAR(); GRID_BAR(); GRID_BAR(); }
    if (IN(2)) {
        for (int rep = 0; rep < NREP(20); ++rep) for (int u = F.vcu; u < BATCH * SSM_G; u += F.G) { const int g = (u >> 5) * 4 + ((u & 31) >> 3), b = u & 7; s5_unit(F, b, g); }
        float lam;
        { const float a = wave_sum(F.in[I_LQ1][F.lane] * F.in[I_LK1][F.lane]), c = wave_sum(F.in[I_LQ2][F.lane] * F.in[I_LK2][F.lane]); lam = __expf(a) - __expf(c) + LAMBDA_INIT; }
        for (int rep = 0; rep < NREP(21); ++rep) for (int u = F.vcu; u < BATCH * ATT_H * 8; u += F.G) { const int bh = u >> 3, qp = u & 7; attn_unit(F, bh >> 2, bh & 3, 15 - qp, lam); attn_unit(F, bh >> 2, bh & 3, qp, lam); }
        if (BOTH(2)) GRID_BAR();
    }

    if (IN(3)) for (int rep = 0; rep < NREP(3); ++rep) {
        { pg8::Gemm g{(const bf16*)(ws + WS_YG), (const bf16*)(ws + WS_WGLU), M, 512, 512}; pg8::StaticOrder S; S.init(M, 512, F.G, (int)blockIdx.x);
          EpiMix<0> E{(const bf16*)(ws + WS_YG), nullptr, (bf16*)(ws + WS_YS), F.in[I_BGLU], 512};
          pg8::gemm_phase<EpiMix<0>, pg8::StaticOrder, true>(F.lds + RING_OFF, g, S, E); }
        if (BOTH(3)) GRID_BAR();
    }

    if (IN(4)) for (int rep = 0; rep < NREP(4); ++rep) {
        pg8::Gemm g{(const bf16*)(ws + WS_OB), (const bf16*)(ws + WS_WPS), M, DM, 512};
        ChainOrder S; S.so.init(M, DM, F.G, (int)blockIdx.x); S.A_att = (const bf16*)(ws + WS_OB); S.A_ssm = (const bf16*)(ws + WS_YS);
        EpiChain E{(const bf16*)(ws + WS_G1), (const bf16*)(ws + WS_G2), (bf16*)(ws + WS_MX)};
        pg8::gemm_phase<EpiChain, ChainOrder, true>(F.lds + RING_OFF, g, S, E);
        if (BOTH(4)) GRID_BAR();
    }

    if (IN(5)) for (int rep = 0; rep < NREP(5); ++rep) {
        pg8::Gemm g{(const bf16*)(ws + WS_MX), (const bf16*)(ws + WS_WOUT), M, DM, DM}; pg8::StaticOrder S; S.init(M, DM, F.G, (int)blockIdx.x);
        EpiOut E{F.in[I_X], F.out, ws + WS_HB};
        pg8::gemm_phase<EpiOut, pg8::StaticOrder, true>(F.lds + RING_OFF, g, S, E);
        if (BOTH(5)) GRID_BAR();
    }

    if (IN(6)) { router_phase(F); if (BOTH(6)) GRID_BAR(); }

    if (IN(7)) for (int rep = 0; rep < NREP(7); ++rep) {
        const int nmt = moe_tables(F); LAS int* T = (LAS int*)(F.lds + MOE_LDS_OFF); unsigned* mflag = (unsigned*)(F.ctl + CW_MFLAG) + (rep ? 288 * MFLAG_STRIDE : 0);
        { pg8::Gemm g{(const bf16*)(ws + WS_HB), (const bf16*)(wsh + (WS_WUP - HI)), M, UPW, DM};
          MoeOrder<8, true> S{nmt * 8, F.G, F.vcu, T, T + 32, T + 72, (const int*)(ws + WS_ELIST), mflag};
          EpiUp E{ws + WS_ACT, F.in[I_BUP], (const float*)(ws + WS_RS2)};
          pg8::gemm_phase<EpiUp, MoeOrder<8, true>, true, true, true, true>(F.lds + RING_OFF, g, S, E, 0, 0); }
        { pg8::Gemm g{(const bf16*)(ws + WS_ACT), (const bf16*)(wsh + (WS_WDN - HI)), MOE_ROWS_MAX, DM, DE};
          MoeOrder<4, false> S{nmt * 4, F.G, F.G - 1 - F.vcu, T, T + 32, T + 72, (const int*)(ws + WS_ELIST), mflag};
          EpiDown E{ws + WS_YS2, F.in[I_BDN], (const float*)(ws + WS_WSLOT)};
          pg8::gemm_phase<EpiDown, MoeOrder<4, false>, true, true, true, true>(F.lds + RING_OFF, g, S, E, 0, 0); }
        if (BOTH(7)) GRID_BAR();
    }

    if (IN(9)) { combine_phase(F, F.out); }
    if (IN(16)) router_phase(F, true);
    if (IN(19)) combine_phase(F, (float*)(ws + WS_TA));
#undef IN
#undef BOTH
#undef GRID_BAR
}

extern "C" void kernel_launch(void* const* d_in, const int* in_sizes, int n_in, void* d_out, int out_size, void* d_ws, size_t ws_size, hipStream_t stream) {
    static int grid = 0;
    if (grid == 0) {
        if (n_in != 31 || in_sizes[0] != M * DM || out_size != M * DM || ws_size < WS_END) {
            fprintf(stderr, "kernel_launch: unexpected shapes (n_in %d, in0 %d, out %d, ws %zu < %zu); nothing launched\n", n_in, n_in > 0 ? in_sizes[0] : -1, out_size, ws_size, (size_t)WS_END); grid = -1; return; }
        int dev = 0, cus = 0;
        if (hipGetDevice(&dev) != hipSuccess || hipDeviceGetAttribute(&cus, hipDeviceAttributeMultiprocessorCount, dev) != hipSuccess) { grid = -1; return; }
        if (hipFuncSetAttribute((const void*)mk_fwd, hipFuncAttributeMaxDynamicSharedMemorySize, LDS_BYTES) != hipSuccess) { fprintf(stderr, "kernel_launch: hipFuncSetAttribute failed\n"); grid = -1; return; }
        int per_cu = 0;
        if (hipOccupancyMaxActiveBlocksPerMultiprocessor(&per_cu, (const void*)mk_fwd, NWAVES * 64, LDS_BYTES) != hipSuccess || per_cu < 1) fprintf(stderr, "kernel_launch: occupancy query reports %d\n", per_cu);
        (void)hipGetLastError();
        grid = cus;
    }
    if (grid < 0) return;
    (void)hipMemsetAsync((char*)d_ws + WS_CTL, 0, CTL_ZERO_BYTES, stream);
    Args a{};
    for (int i = 0; i < 31; ++i) a.in[i] = (const float*)d_in[i];
    a.out = (float*)d_out; a.ws = (unsigned char*)d_ws; a.hi = (unsigned char*)d_ws + ((ws_size - 256 * MiB) & ~(size_t)0xfffff);
    if (N_LAUNCHES == 1) { a.ph_lo = 0; a.ph_hi = PER_PHASE; hipLaunchKernelGGL(mk_fwd, dim3(grid), dim3(NWAVES * 64), LDS_BYTES, stream, a); }
    else for (int p = 0; p < PER_PHASE; ++p) { a.ph_lo = p; a.ph_hi = p + 1; if (PROBE_REP - 110 == p) { a.ph_lo = p + 10; a.ph_hi = p + 11; hipLaunchKernelGGL(mk_fwd, dim3(grid), dim3(NWAVES * 64), LDS_BYTES, stream, a); a.ph_lo = p; a.ph_hi = p + 1; }
        for (int rep = 0; rep < ((PROBE_REP - 100 == p) ? 2 : 1); ++rep) hipLaunchKernelGGL(mk_fwd, dim3(grid), dim3(NWAVES * 64), LDS_BYTES, stream, a); }
}
```

```cpp
#include <hip/hip_runtime.h>
#include <cstdio>
#include <cstdint>

#ifndef MK_N_LAUNCHES
#define MK_N_LAUNCHES 1
#endif
#ifndef PROBE_REP
#define PROBE_REP -1
#endif
#define NREP(k) ((PROBE_REP == (k)) ? 2 : 1)

namespace pg8 {
#define PG8_LAS __attribute__((address_space(3)))
typedef unsigned short bf16_t;
typedef short bf16x8 __attribute__((ext_vector_type(8)));
typedef float f32x4 __attribute__((ext_vector_type(4)));
typedef unsigned u32x4 __attribute__((ext_vector_type(4)));
typedef unsigned u32x2 __attribute__((ext_vector_type(2)));
constexpr int BM = 256, BK = 64, HALF = 128, HTB = HALF * BK * 2  , STAGE_BYTES = 8 * HTB, NXCD = 8, WGM = 8;

__host__ __device__ __forceinline__ int lds_byte(int r, int c) { const int st = (r >> 4) * 2 + (c >> 5), rr = r & 15, cc = c & 31, ob = rr * 64 + cc * 2; return st * 1024 + (ob ^ (((ob >> 9) & 1) * 48)); }
__host__ __device__ __forceinline__ void stage_rc(int b, int& R, int& C) { const int st = b / 1024, sb = b % 1024, swz = sb ^ (((sb >> 9) & 1) * 48); R = (st >> 1) * 16 + swz / 64; C = (st & 1) * 32 + (swz % 64) / 2; }
__host__ __device__ __forceinline__ int perm32(int rho) { const int n = rho >> 4, i = rho & 15; return 8 * (i >> 2) + 4 * n + (i & 3); }

struct Unit { int pm, pn; };
struct Gemm { const bf16_t* A; const bf16_t* Bt; int M, N, K; };

struct StaticOrder {
    int nM, nN, nwg, G, c;
    __host__ __device__ void init(int M, int N, int G_, int c_) { nM = M / BM; nN = N / BM; nwg = nM * nN; G = G_; c = c_; }
    __host__ __device__ bool next(int i, Unit& u) const {
        const long L = (long)i * G + c; if (L >= nwg) return false;
        int wgid = (int)L; { const int q = nwg / NXCD, r = nwg % NXCD, xcd = wgid % NXCD, off = wgid / NXCD; wgid = (xcd < r ? xcd * (q + 1) : r * (q + 1) + (xcd - r) * q) + off; }
        const int nig = WGM * nN, gid = wgid / nig, fm = gid * WGM, gsz = (nM - fm) < WGM ? (nM - fm) : WGM;
        u.pm = fm + ((wgid % nig) % gsz); u.pn = (wgid % nig) / gsz; return true;
    }
    __device__ __forceinline__ int row_slot(const Unit&, int) const { return 0; }
    __device__ __forceinline__ int a_row(const Unit& u, int r, int) const { return u.pm * BM + r; }
    __device__ __forceinline__ const char* a_base(const Gemm& g, const Unit& u, size_t tstep) const { return (const char*)g.A + (size_t)u.pm * tstep; }
    __device__ __forceinline__ void a_ready(const Unit&) const {}
    __device__ __forceinline__ void done(const Unit&) const {}
};

__device__ __forceinline__ unsigned cvt_pk_bf16(float lo, float hi) { unsigned r; asm volatile("v_cvt_pk_bf16_f32 %0, %1, %2" : "=v"(r) : "v"(lo), "v"(hi)); return r; }

typedef int v8i __attribute__((ext_vector_type(8)));
typedef int v4i __attribute__((ext_vector_type(4)));
template <class Epi, class Sched, bool ALIGN_EPI = false, bool ROWTAB = false, bool GATHER = false, bool FP8 = false>
__device__ __forceinline__ void gemm_phase(PG8_LAS unsigned char* lds, const Gemm g, const Sched& S, const Epi& E, const int sA8 = 0, const int sB8 = 0) {
    static_assert(!GATHER || ROWTAB, "GATHER needs ROWTAB");
    const int tid = threadIdx.x, wid = __builtin_amdgcn_readfirstlane(tid >> 6), lane = tid & 63, wr = wid >> 2, wc = wid & 3, fr = lane & 15, fq = lane >> 4;
    const int K = g.K, RB = FP8 ? K : 2 * K  , nt = RB / (2 * BK);
    unsigned voffA[2], voffB[2];
#pragma unroll
    for (int i = 0; i < 2; ++i) { int R, C; stage_rc(tid * 16 + i * 8192, R, C); const int Rb = Epi::PERM ? ((R & ~31) + perm32(R & 31)) : R;
        voffA[i] = (unsigned)(R * RB + 2 * C); voffB[i] = (unsigned)(Rb * RB + 2 * C); }
    unsigned vA[2][2] = {{0u, 0u}, {0u, 0u}};
    const size_t kstep = (size_t)(BK * 2);
    const size_t hstep = (size_t)HALF * RB;
    const size_t tstep = 2 * hstep;
    const unsigned ldsw = (unsigned)wid * 1024u;
    const int aoff = FP8 ? lds_byte(wr * 64 + fr, fq * 16) : lds_byte(wr * 64 + fr, fq * 8), boff = FP8 ? lds_byte(wc * 32 + fr, fq * 16) : lds_byte(wc * 32 + fr, fq * 8);
    PG8_LAS int* tab = (PG8_LAS int*)(lds + STAGE_BYTES);
#define PG8_SA(b, h) (((b) * 2 + (h)) * HTB)
#define PG8_SB(b, h) ((4 + (b) * 2 + (h)) * HTB)
#define PG8_STAGE(bufoff, gbase, voff) do { _Pragma("unroll") for (int _i = 0; _i < 2; ++_i) \
        __builtin_amdgcn_global_load_lds((const unsigned*)((const char*)(gbase) + (voff)[_i]), (PG8_LAS unsigned*)(lds + (bufoff) + ldsw + _i * 8192), 16, 0, 0); } while (0)
#define PG8_STAGE_A(bufoff, kbase, h) do { if constexpr (GATHER) { PG8_STAGE(bufoff, kbase, vA[h]); } else { PG8_STAGE(bufoff, (kbase) + (h) * hstep, voffA); } } while (0)
#define PG8_LOAD_VA(sel, un) do { _Pragma("unroll") for (int _i = 0; _i < 2; ++_i) { int R_, C_; stage_rc(tid * 16 + _i * 8192, R_, C_); \
        _Pragma("unroll") for (int _h = 0; _h < 2; ++_h) { const int s_ = tab[(sel) * 256 + _h * HALF + R_]; vA[_h][_i] = (unsigned)(S.a_row(un, _h * HALF + R_, s_) * RB + 2 * C_); } } } while (0)
#define PG8_LDA(dst, b, h) do { _Pragma("unroll") for (int m = 0; m < 4; ++m) _Pragma("unroll") for (int k = 0; k < 2; ++k) dst[m][k] = *(const PG8_LAS bf16x8*)(lds + PG8_SA(b, h) + (FP8 ? (aoff ^ (16 * k)) : aoff + k * 1024) + m * 2048); } while (0)
#define PG8_LDB(dst, b, h) do { _Pragma("unroll") for (int n = 0; n < 2; ++n) _Pragma("unroll") for (int k = 0; k < 2; ++k) dst[n][k] = *(const PG8_LAS bf16x8*)(lds + PG8_SB(b, h) + (FP8 ? (boff ^ (16 * k)) : boff + k * 1024) + n * 2048); } while (0)
#define PG8_V8(x) __builtin_shufflevector(__builtin_bit_cast(v4i, (x)[0]), __builtin_bit_cast(v4i, (x)[1]), 0, 1, 2, 3, 4, 5, 6, 7)
#define PG8_MMA(ai, bj, At, Bt) do { __builtin_amdgcn_s_setprio(1); if constexpr (FP8) { _Pragma("unroll") for (int m = 0; m < 4; ++m) _Pragma("unroll") for (int n = 0; n < 2; ++n) \
        acc[ai][bj][m][n] = __builtin_amdgcn_mfma_scale_f32_16x16x128_f8f6f4(PG8_V8(Bt[n]), PG8_V8(At[m]), acc[ai][bj][m][n], 0, 0, 0, sB8, 0, sA8); } else { \
        _Pragma("unroll") for (int m = 0; m < 4; ++m) _Pragma("unroll") for (int n = 0; n < 2; ++n) _Pragma("unroll") for (int k = 0; k < 2; ++k) \
        acc[ai][bj][m][n] = __builtin_amdgcn_mfma_f32_16x16x32_bf16(Bt[n][k], At[m][k], acc[ai][bj][m][n], 0, 0, 0); } __builtin_amdgcn_s_setprio(0); } while (0)
#define PG8_WAIT_V(n) asm volatile("s_waitcnt vmcnt(" #n ")" ::: "memory")
#define PG8_WAIT_L(n) asm volatile("s_waitcnt lgkmcnt(" #n ")" ::: "memory")
#define PG8_BAR __builtin_amdgcn_s_barrier()
#define PG8_SCHED __builtin_amdgcn_sched_barrier(0)
    Unit cur, nxt; int ui = 0;
    if (!S.next(0, cur)) return;
    S.a_ready(cur);
    f32x4 acc[2][2][4][2];
#pragma unroll
    for (int a = 0; a < 2; ++a)
#pragma unroll
        for (int b = 0; b < 2; ++b)
#pragma unroll
            for (int m = 0; m < 4; ++m)
#pragma unroll
                for (int n = 0; n < 2; ++n) acc[a][b][m][n] = (f32x4){0.f, 0.f, 0.f, 0.f};
    bf16x8 At[4][2], B0[2][2], B1[2][2];
    if constexpr (ROWTAB) {
        if (tid < 256) tab[tid] = S.row_slot(cur, tid);
        PG8_WAIT_L(0); PG8_BAR; asm volatile("" ::: "memory");
        if constexpr (GATHER) { PG8_LOAD_VA(0, cur); }
    }
    const char* cA = GATHER ? (const char*)g.A : S.a_base(g, cur, tstep); const char* cB = (const char*)g.Bt + (size_t)cur.pn * tstep;
    PG8_STAGE(PG8_SB(0, 0), cB, voffB); PG8_STAGE(PG8_SB(0, 1), cB + hstep, voffB); PG8_STAGE_A(PG8_SA(0, 0), cA, 0); PG8_STAGE_A(PG8_SA(0, 1), cA, 1);
    if (wr == 1) PG8_BAR;
    PG8_WAIT_V(2); PG8_BAR;
    PG8_STAGE(PG8_SB(1, 0), cB + kstep, voffB); PG8_STAGE_A(PG8_SA(1, 0), cA + kstep, 0); PG8_STAGE(PG8_SB(1, 1), cB + hstep + kstep, voffB);
    PG8_WAIT_V(6); PG8_BAR;
    for (;;) {
        const bool has_next = S.next(ui + 1, nxt);
        if (has_next) S.a_ready(nxt);
        if constexpr (ROWTAB) { if (has_next && tid < 256) tab[((ui + 1) % 3) * 256 + tid] = S.row_slot(nxt, tid); }
        const char* nA = has_next ? (GATHER ? (const char*)g.A : S.a_base(g, nxt, tstep)) : cA; const char* nB = has_next ? (const char*)g.Bt + (size_t)nxt.pn * tstep : cB;
        for (int t = 0; t < nt; t += 2) {
            const bool last = (t == nt - 2);
            const char* a1 = cA + (size_t)(t + 1) * kstep;
            const char* a2 = last ? nA : cA + (size_t)(t + 2) * kstep; const char* b2 = last ? nB : cB + (size_t)(t + 2) * kstep;
            const char* a3 = a2 + kstep; const char* b3 = b2 + kstep;
            PG8_LDB(B0, 0, 0); PG8_LDB(B1, 0, 1); PG8_SCHED; PG8_LDA(At, 0, 0); PG8_STAGE_A(PG8_SA(1, 1), a1, 1);
            if constexpr (GATHER) { if (last && has_next) { PG8_LOAD_VA((ui + 1) % 3, nxt); } }
            PG8_WAIT_V(8); PG8_WAIT_L(0); PG8_BAR; PG8_MMA(0, 0, At, B0); PG8_MMA(0, 1, At, B1); PG8_BAR; PG8_SCHED;
            PG8_LDA(At, 0, 1); PG8_STAGE(PG8_SB(0, 0), b2, voffB); PG8_STAGE(PG8_SB(0, 1), b2 + hstep, voffB); PG8_STAGE_A(PG8_SA(0, 0), a2, 0);
            PG8_WAIT_V(8); PG8_WAIT_L(0); PG8_BAR; PG8_MMA(1, 0, At, B0); PG8_MMA(1, 1, At, B1); PG8_BAR; PG8_SCHED;
            PG8_LDB(B0, 1, 0); PG8_LDB(B1, 1, 1); PG8_SCHED; PG8_LDA(At, 1, 0); PG8_STAGE_A(PG8_SA(0, 1), a2, 1);
            PG8_WAIT_V(8); PG8_WAIT_L(0); PG8_BAR; PG8_MMA(0, 0, At, B0); PG8_MMA(0, 1, At, B1); PG8_BAR; PG8_SCHED;
            PG8_LDA(At, 1, 1); PG8_STAGE(PG8_SB(1, 0), b3, voffB); PG8_STAGE(PG8_SB(1, 1), b3 + hstep, voffB); PG8_STAGE_A(PG8_SA(1, 0), a3, 0);
            PG8_WAIT_V(8); PG8_WAIT_L(0); PG8_BAR; PG8_MMA(1, 0, At, B0); PG8_MMA(1, 1, At, B1); PG8_BAR; PG8_SCHED;
        }
        if constexpr (ALIGN_EPI) { if (wr == 0) PG8_BAR; }
        E(acc, cur, wr, wc, fr, fq, (const PG8_LAS int*)(tab + (ui % 3) * 256));
        S.done(cur);
        if (!has_next) break;
        if (!E.keep(cur)) {
#pragma unroll
        for (int a = 0; a < 2; ++a)
#pragma unroll
            for (int b = 0; b < 2; ++b)
#pragma unroll
                for (int m = 0; m < 4; ++m)
#pragma unroll
                    for (int n = 0; n < 2; ++n) acc[a][b][m][n] = (f32x4){0.f, 0.f, 0.f, 0.f}; }
        cur = nxt; cA = nA; cB = nB; ++ui;
        if constexpr (ALIGN_EPI) { if (wr == 1) PG8_BAR; }
    }
    PG8_WAIT_V(0);
    if constexpr (!ALIGN_EPI) { if (wr == 0) PG8_BAR; }
    PG8_BAR;
#undef PG8_SA
#undef PG8_SB
#undef PG8_STAGE
#undef PG8_STAGE_A
#undef PG8_LOAD_VA
#undef PG8_LDA
#undef PG8_LDB
#undef PG8_MMA
#undef PG8_V8
#undef PG8_WAIT_V
#undef PG8_WAIT_L
#undef PG8_BAR
#undef PG8_SCHED
}
}

constexpr int NWAVES = 8;
constexpr int N_LAUNCHES = MK_N_LAUNCHES;
constexpr int PER_PHASE = 10;
constexpr int BATCH = 8, SEQ = 2048, DM = 1024, M = BATCH * SEQ;
constexpr int SSM_W = 512, SSM_G = 32, SSM_H = 16, SSM_P = 64, SSM_T = 16, SSM_NC = SEQ / SSM_T;
constexpr int ATT_H = 4, ATT_D = 64, ATT_V = 128, QK_W = 512, V_W = 512;
constexpr int IN_W = 4096;
constexpr int NE = 32, TOPK = 4, DE = 1024, UPW = 2048;
constexpr float RMS_EPS = 1e-6f;
constexpr float LAMBDA_INIT = 0.2f;
constexpr float QSCALE = 0.125f * 1.4426950408889634f;
constexpr int MOE_ROWS_MAX = M * TOPK + NE * 256;
constexpr int MOE_MT_MAX = MOE_ROWS_MAX / 256;

constexpr size_t MiB = 1u << 20;
constexpr size_t WS_CTL = 0, CTL_ZERO_BYTES = 1 * MiB;
constexpr size_t HI = (size_t)1 << 40;
constexpr size_t WS_WIN_OLD = 2 * MiB;
constexpr size_t WS_WGLU = 10 * MiB;
constexpr size_t WS_WPS = 11 * MiB;
constexpr size_t WS_WPA = 12 * MiB;
constexpr size_t WS_WOUT = 13 * MiB;
constexpr size_t WS_WRT = 15 * MiB;
constexpr size_t WS_S5 = 16 * MiB;
constexpr size_t WS_A16 = 24 * MiB;
constexpr size_t WS_WUP_OLD = 32 * MiB;
constexpr size_t WS_WDN_OLD = 160 * MiB;
constexpr size_t WS_XN_OLD = 224 * MiB;
constexpr size_t WS_U = 256 * MiB;
constexpr size_t WS_Q = 272 * MiB, WS_K = 288 * MiB, WS_V = 304 * MiB;
constexpr size_t WS_G1 = 320 * MiB, WS_G2 = 352 * MiB;
constexpr size_t WS_YG = 384 * MiB, WS_YS = 400 * MiB, WS_OB = 416 * MiB;
constexpr size_t WS_TA = 432 * MiB, WS_MX = 464 * MiB;
constexpr size_t WS_HB = 496 * MiB;
constexpr size_t WS_RS2 = 528 * MiB;
constexpr size_t WS_WSLOT = 529 * MiB;
constexpr size_t WS_ELIST = 530 * MiB;
constexpr size_t WS_ACT = 544 * MiB;
constexpr size_t WS_YS2 = 32 * MiB;
constexpr size_t WS_YS2_OLD = 688 * MiB;
constexpr size_t WS_END = 1024 * MiB;
constexpr size_t WS_WUP = HI + 0 * MiB, WS_WDN = HI + 64 * MiB, WS_XN = HI + 96 * MiB, WS_WIN = HI + 128 * MiB;
constexpr int CW_BAR = 4096;
constexpr int CW_Q = 20480;
constexpr int CW_CNT = 16384;

constexpr int RING_OFF = 0, RING_BYTES = 139264;
constexpr int LDSCTL_OFF = RING_BYTES, MISC_OFF = LDSCTL_OFF;
constexpr int MOE_LDS_OFF = LDSCTL_OFF + 256;
constexpr int LDS_BYTES = 147456;

#define GAS __attribute__((address_space(1)))
#define LAS __attribute__((address_space(3)))
typedef unsigned short bf16;
typedef unsigned v4u __attribute__((ext_vector_type(4)));
typedef unsigned v2u __attribute__((ext_vector_type(2)));
typedef float f32x4 __attribute__((ext_vector_type(4)));
typedef float f32x16 __attribute__((ext_vector_type(16)));
typedef float f32x2 __attribute__((ext_vector_type(2)));
typedef short bf16x8 __attribute__((ext_vector_type(8)));
typedef short s16x4 __attribute__((ext_vector_type(4)));
typedef GAS unsigned gu32;
#define RLX_AGENT __ATOMIC_RELAXED, __HIP_MEMORY_SCOPE_AGENT
#define LDS_WAIT() asm volatile("s_waitcnt lgkmcnt(0)" ::: "memory")
#define VM_WAIT() asm volatile("s_waitcnt vmcnt(0)" ::: "memory")
using pg8::cvt_pk_bf16;
__device__ __forceinline__ unsigned f2bf(float f) { unsigned u = __builtin_bit_cast(unsigned, f); return (u + 0x7fffu + ((u >> 16) & 1u)) >> 16; }
__device__ __forceinline__ unsigned pk4_fp8(float a, float b, float c, float d) { unsigned w = 0; w = __builtin_amdgcn_cvt_pk_fp8_f32(a, b, w, false); w = __builtin_amdgcn_cvt_pk_fp8_f32(c, d, w, true); return w; }
__device__ __forceinline__ float bf2f(unsigned b) { return __builtin_bit_cast(float, b << 16); }
__device__ __forceinline__ float bflo(unsigned w) { return __builtin_bit_cast(float, w << 16); }
__device__ __forceinline__ float bfhi(unsigned w) { return __builtin_bit_cast(float, w & 0xffff0000u); }
__device__ __forceinline__ float fsigmoid(float x) { return 1.0f / (1.0f + __expf(-x)); }
__device__ __forceinline__ float fsigmoid_fast(float x) { return __builtin_amdgcn_rcpf(1.0f + __builtin_amdgcn_exp2f(-1.4426950408889634f * x)); }
__device__ __forceinline__ float gelu_tanh(float x) { const float z = 1.5957691216057308f * (x + 0.044715f * x * x * x); return x * fsigmoid_fast(z); }
__device__ __forceinline__ int crow(int r, int hi) { return (r & 3) + 8 * (r >> 2) + 4 * hi; }
__device__ __forceinline__ float wave_sum(float v) {
#pragma unroll
    for (int o = 1; o < 64; o <<= 1) v += __shfl_xor(v, o);
    return v;
}

#define XB_TMO      128
#define XB_XCNT(j)  (256  + 64 * (j))
#define XB_XSUB(j)  (1280 + 64 * (j))
#define XB_XGEN(j)  (2304 + 64 * (j))
#define XB_TOP      3328
#define XB_TOPGEN   3392
#define XCD_BAR_WORDS 3456
#define XB_SPIN_CAP (1u << 18)
__device__ __forceinline__ unsigned xb_ld(unsigned* p)              { return __hip_atomic_load(p, __ATOMIC_RELAXED, __HIP_MEMORY_SCOPE_AGENT); }
__device__ __forceinline__ unsigned xb_add(unsigned* p, unsigned v) { return __hip_atomic_fetch_add(p, v, __ATOMIC_RELAXED, __HIP_MEMORY_SCOPE_AGENT); }
__device__ __forceinline__ unsigned xb_xcc_id() { return (unsigned)__builtin_amdgcn_s_getreg((3 << 11) | 20) & 0xFu; }
#define XB_SPIN(cond, bar) do { unsigned _sp = 0; while (cond) { __builtin_amdgcn_s_sleep(1); \
    if ((++_sp & 255u) == 0u) { if (xb_ld(&(bar)[XB_TMO])) break; if (_sp > XB_SPIN_CAP) { atomicAdd(&(bar)[XB_TMO], 1u); break; } } } } while (0)
struct XcdBarrier { unsigned* bar; unsigned x; volatile LAS unsigned* st; };
__device__ __forceinline__ XcdBarrier xcd_barrier_post(unsigned* bar, volatile LAS unsigned* st) {
    XcdBarrier b; b.bar = bar; b.x = xb_xcc_id(); b.st = st;
    if (threadIdx.x == 0) (void)xb_add(&bar[XB_XCNT(b.x)], 1u);
    return b;
}
__device__ __forceinline__ void xcd_barrier_complete(unsigned* bar, unsigned x, unsigned& nloc, unsigned& nx) {
    const unsigned G = gridDim.x * gridDim.y * gridDim.z;
    unsigned sum, cnt, mine, sp = 0u;
    for (;;) {
        sum = 0u; cnt = 0u; mine = 0u;
#pragma unroll
        for (unsigned j = 0; j < 16; ++j) { const unsigned c = xb_ld(&bar[XB_XCNT(j)]); sum += c; cnt += (c > 0u) ? 1u : 0u; mine = (j == x) ? c : mine; }
        if (sum == G) break;
        __builtin_amdgcn_s_sleep(1);
        if ((++sp & 255u) == 0u) { if (xb_ld(&bar[XB_TMO])) break; if (sp > XB_SPIN_CAP) { atomicAdd(&bar[XB_TMO], 1u); break; } }
    }
    nloc = mine > 0u ? mine : 1u; nx = cnt > 0u ? cnt : 1u;
}
__device__ __forceinline__ void xcd_barrier(const XcdBarrier& b) {
    asm volatile("s_waitcnt vmcnt(0)" ::: "memory");
    __syncthreads();
    if (threadIdx.x == 0) {
        unsigned* bar = b.bar;
        __builtin_amdgcn_s_waitcnt(0);
        unsigned nloc = b.st[0], nx = b.st[1];
        if (nloc == 0u) { xcd_barrier_complete(bar, b.x, nloc, nx); b.st[0] = nloc; b.st[1] = nx; }
        const unsigned old = xb_add(&bar[XB_XSUB(b.x)], 1u);
        const unsigned gen = old / nloc;
        if (old + 1u == (gen + 1u) * nloc) {
            __builtin_amdgcn_fence(__ATOMIC_RELEASE, "agent");
            asm volatile("s_waitcnt vmcnt(0)" ::: "memory");
            const unsigned og = xb_add(&bar[XB_TOP], 1u);
            const unsigned tg = og / nx;
            if (og + 1u == (tg + 1u) * nx) xb_add(&bar[XB_TOPGEN], 1u);
            else XB_SPIN(xb_ld(&bar[XB_TOPGEN]) == tg, bar);
            __builtin_amdgcn_fence(__ATOMIC_ACQUIRE, "agent");
            xb_add(&bar[XB_XGEN(b.x)], 1u);
            asm volatile("s_waitcnt vmcnt(0)" ::: "memory");
        } else {
            XB_SPIN(xb_ld(&bar[XB_XGEN(b.x)]) == gen, bar);
            __builtin_amdgcn_fence(__ATOMIC_ACQUIRE, "agent");
            asm volatile("s_waitcnt vmcnt(0)" ::: "memory");
        }
    }
    __syncthreads();
}

struct Frame {
    LAS unsigned char* lds;
    volatile LAS unsigned* MISC;
    gu32* ctl;
    unsigned char* ws; unsigned char* hi;
    int tid, lane, wave;
    int vcu, G;
    const float* in[31];
    float* out;
};
enum { I_X = 0, I_N1G, I_WIN, I_BGATE, I_ARE, I_AIM, I_LOGDT, I_BRE, I_BIM, I_CRE, I_CIM, I_SSMD, I_WGLU, I_BGLU, I_QG, I_KG, I_LQ1, I_LK1, I_LQ2, I_LK2, I_SUBLN,
       I_WPS, I_WPA, I_WOUT, I_N2G, I_WR, I_BR, I_WUP, I_BUP, I_WDN, I_BDN };

template <int MODE>
__device__ __forceinline__ int physrow(int c) {
    if (MODE == 1) { const int w = c & 63; return (c & ~255) + 128 * (w >> 5) + 32 * ((c >> 6) & 3) + (w & 31); }
    if (MODE == 2) { const int j = c >> 1; return 256 * (j >> 7) + 128 * (c & 1) + (j & 127); }
    return c;
}
struct P0Item { const float* src; void* dst; const float* kscale; int N, K, mode, out8, k0, c0; };
__device__ __forceinline__ int physrow_rt(int mode, int c) { return mode == 1 ? physrow<1>(c) : (mode == 2 ? physrow<2>(c) : c); }
__device__ __forceinline__ void p0_item_load(const P0Item& d, f32x4 (&v)[16], int lane) {
    const int lr = lane >> 4, lc = lane & 15;
#pragma unroll
    for (int i = 0; i < 16; ++i) v[i] = __builtin_nontemporal_load((const f32x4*)(d.src + (size_t)(d.k0 + lr + 4 * i) * d.N + d.c0 + 4 * lc));
}
__device__ __forceinline__ void p0_item_finish(const P0Item& d, const f32x4 (&v)[16], LAS float* scr, int lane) {
    const int lr = lane >> 4, lc = lane & 15;
#pragma unroll
    for (int i = 0; i < 16; ++i) { const int k = lr + 4 * i; *(LAS f32x4*)(scr + k * 64 + 4 * (lc ^ ((k >> 3) & 7))) = v[i]; }
    LDS_WAIT(); asm volatile("" ::: "memory");
    const int a = lane & 7, bq = lane >> 3;
    float ks[8];
#pragma unroll
    for (int i = 0; i < 8; ++i) ks[i] = (d.kscale ? d.kscale[d.k0 + 8 * a + i] : 1.0f) * (d.out8 ? 32.0f : 1.0f);
#pragma unroll
    for (int j = 0; j < 8; ++j) { const int cl = bq + 8 * j; float x[8];
#pragma unroll
        for (int i = 0; i < 8; ++i) x[i] = scr[(8 * a + i) * 64 + 4 * ((cl >> 2) ^ a) + (cl & 3)] * ks[i];
        const size_t ro = (size_t)physrow_rt(d.mode, d.c0 + cl) * d.K + d.k0 + 8 * a;
        if (d.out8) { v2u o; o.x = pk4_fp8(x[0], x[1], x[2], x[3]); o.y = pk4_fp8(x[4], x[5], x[6], x[7]); __builtin_nontemporal_store(o, (GAS v2u*)((unsigned char*)d.dst + ro)); }
        else { v4u o; o.x = cvt_pk_bf16(x[0], x[1]); o.y = cvt_pk_bf16(x[2], x[3]); o.z = cvt_pk_bf16(x[4], x[5]); o.w = cvt_pk_bf16(x[6], x[7]); *(GAS v4u*)((bf16*)d.dst + ro) = o; } }
    LDS_WAIT(); asm volatile("" ::: "memory");
}
__device__ __forceinline__ void rms_row_to_bf16(int lane, const float* xrow, const float* g, bf16* orow) {
    const GAS f32x4* xr = (const GAS f32x4*)xrow + lane; const GAS f32x4* gr = (const GAS f32x4*)g + lane;
    f32x4 v[4]; float s = 0.f;
#pragma unroll
    for (int j = 0; j < 4; ++j) { v[j] = xr[64 * j]; s += (v[j].x * v[j].x + v[j].y * v[j].y) + (v[j].z * v[j].z + v[j].w * v[j].w); }
    const float rs = 1.0f / sqrtf(wave_sum(s) * (1.f / DM) + RMS_EPS);
    GAS unsigned long long* o8 = (GAS unsigned long long*)orow + lane;
#pragma unroll
    for (int j = 0; j < 4; ++j) { const f32x4 gg = gr[64 * j];
        o8[64 * j] = (unsigned long long)cvt_pk_bf16(v[j].x * rs * gg.x, v[j].y * rs * gg.y) | ((unsigned long long)cvt_pk_bf16(v[j].z * rs * gg.z, v[j].w * rs * gg.w) << 32); }
}
__device__ __forceinline__ void p0_s5_group(Frame& F, int g) {
    LAS float* AP = (LAS float*)(F.lds + RING_OFF);
    LAS float* BB = AP + 17 * 64 * 2;
    LAS float* CC = BB + 64 * 16 * 2;
    LAS float* KM = CC + 16 * 64 * 2;
    const float* are = F.in[I_ARE] + g * SSM_P; const float* aim = F.in[I_AIM] + g * SSM_P;
    const double dt = exp((double)F.in[I_LOGDT][g]);
    for (int e = F.tid; e < 17 * 64; e += NWAVES * 64) { const int m = e >> 6, p = e & 63; const double lr = are[p], li = aim[p];
        const double mag = exp(lr * dt * m), ang = li * dt * m; AP[e * 2] = (float)(mag * cos(ang)); AP[e * 2 + 1] = (float)(mag * sin(ang)); }
    for (int e = F.tid; e < 64 * 16; e += NWAVES * 64) { const int p = e >> 4, h = e & 15; const double lr = are[p], li = aim[p];
        const double mag = exp(lr * dt), ar = mag * cos(li * dt), ai = mag * sin(li * dt), den = lr * lr + li * li, nr = ar - 1.0, ni = ai;
        const double cr = (nr * lr + ni * li) / den, ci = (ni * lr - nr * li) / den;
        const double br = F.in[I_BRE][(size_t)(g * SSM_P + p) * SSM_H + h], bi = F.in[I_BIM][(size_t)(g * SSM_P + p) * SSM_H + h];
        BB[e * 2] = (float)(cr * br - ci * bi); BB[e * 2 + 1] = (float)(cr * bi + ci * br); }
    for (int e = F.tid; e < 16 * 64; e += NWAVES * 64) { CC[e * 2] = F.in[I_CRE][(size_t)g * 1024 + e]; CC[e * 2 + 1] = F.in[I_CIM][(size_t)g * 1024 + e]; }
    __syncthreads();
    if (F.tid < 64) { float* a16 = (float*)(F.ws + WS_A16) + (g * 64 + F.tid) * 2; a16[0] = AP[(16 * 64 + F.tid) * 2]; a16[1] = AP[(16 * 64 + F.tid) * 2 + 1]; }
    for (int e = F.tid; e < 16 * 256; e += NWAVES * 64) { const int m = e >> 8, ho = (e >> 4) & 15, hi = e & 15; float s = 0.f;
        for (int p = 0; p < 64; ++p) { const float cr = CC[(ho * 64 + p) * 2], ci = CC[(ho * 64 + p) * 2 + 1], ar = AP[(m * 64 + p) * 2], ai = AP[(m * 64 + p) * 2 + 1];
            const float tr = cr * ar - ci * ai, ti = cr * ai + ci * ar; s += tr * BB[(p * 16 + hi) * 2] - ti * BB[(p * 16 + hi) * 2 + 1]; }
        KM[e] = s; }
    __syncthreads();
    bf16* W1T = (bf16*)(F.ws + WS_S5 + (size_t)g * 262144); bf16* M2T = W1T + 128 * 256; bf16* W3T = M2T + 256 * 256;
    for (int e = F.tid; e < 128 * 256; e += NWAVES * 64) { const int n = e >> 8, k = e & 255, p = n & 63, j = k >> 4, hi = k & 15;
        const float ar = AP[((15 - j) * 64 + p) * 2], ai = AP[((15 - j) * 64 + p) * 2 + 1], br = BB[(p * 16 + hi) * 2], bi = BB[(p * 16 + hi) * 2 + 1];
        W1T[e] = (bf16)f2bf(n < 64 ? ar * br - ai * bi : ar * bi + ai * br); }
    for (int e = F.tid; e < 256 * 128; e += NWAVES * 64) { const int n = e >> 7, k = e & 127, i = n >> 4, ho = n & 15, p = k & 63;
        const float cr = CC[(ho * 64 + p) * 2], ci = CC[(ho * 64 + p) * 2 + 1], ar = AP[((i + 1) * 64 + p) * 2], ai = AP[((i + 1) * 64 + p) * 2 + 1];
        W3T[e] = (bf16)f2bf(k < 64 ? cr * ar - ci * ai : -(cr * ai + ci * ar)); }
    const float* dsk = F.in[I_SSMD] + g * 16;
    for (int e = F.tid; e < 256 * 256; e += NWAVES * 64) { const int n = e >> 8, k = e & 255, i = n >> 4, ho = n & 15, j = k >> 4, hi = k & 15;
        float v = 0.f; if (j <= i) { v = KM[((i - j) * 16 + ho) * 16 + hi]; if (i == j && ho == hi) v += dsk[ho]; }
        M2T[e] = (bf16)f2bf(v); }
    __syncthreads();
}
template <int MODE>
__device__ __forceinline__ void p0_big_item(Frame& F, const float* W, int N, unsigned char* WT, int K, const float* kscale, int item) {
    LAS float* T = (LAS float*)(F.lds + RING_OFF);
    const int nblk = N / 256, kb = item / nblk, nb = item % nblk, k0 = 128 * kb, c0 = 256 * nb, lane = F.lane, w = F.wave;
    f32x4 v[16];
#pragma unroll
    for (int i = 0; i < 16; ++i) v[i] = __builtin_nontemporal_load((const f32x4*)(W + (size_t)(k0 + 16 * w + i) * N + c0 + 4 * lane));
#pragma unroll
    for (int i = 0; i < 16; ++i) { const int k = 16 * w + i; *(LAS f32x4*)(T + k * 256 + 4 * (lane ^ ((k >> 4) & 7))) = v[i]; }
    __syncthreads();
    { const int r8 = lane >> 3, kc = lane & 7;
      float ksv[16];
#pragma unroll
      for (int i = 0; i < 16; ++i) ksv[i] = kscale ? kscale[k0 + 16 * kc + i] * 32.0f : 32.0f;
#pragma unroll
      for (int st = 0; st < 4; ++st) { const int cl = 32 * w + 8 * st + r8, chunk = cl >> 2, sub = cl & 3;
          float x[16];
#pragma unroll
          for (int i = 0; i < 16; ++i) x[i] = T[(16 * kc + i) * 256 + 4 * (chunk ^ kc) + sub] * ksv[i];
          v4u o; o.x = pk4_fp8(x[0], x[1], x[2], x[3]); o.y = pk4_fp8(x[4], x[5], x[6], x[7]); o.z = pk4_fp8(x[8], x[9], x[10], x[11]); o.w = pk4_fp8(x[12], x[13], x[14], x[15]);
          __builtin_nontemporal_store(o, (GAS v4u*)(WT + (size_t)physrow<MODE>(c0 + cl) * K + k0 + 16 * kc)); } }
    __syncthreads();
}
__device__ __forceinline__ void p0_prologue(Frame& F) {
    if (F.vcu < SSM_G) p0_s5_group(F, F.vcu);
    LAS float* scr = (LAS float*)(F.lds + RING_OFF + F.wave * 16384);
    const int gw = F.vcu * NWAVES + F.wave, NGW = F.G * NWAVES;
    { float* wrT = (float*)(F.ws + WS_WRT); const float* wr = F.in[I_WR]; const float* g2 = F.in[I_N2G];
      for (int e = gw * 64 + F.lane; e < NE * DM; e += NGW * 64) { const int ex = e >> 10, k = e & 1023; wrT[e] = g2[k] * wr[k * NE + ex]; } }
    for (int m = gw; m < M; m += NGW) rms_row_to_bf16(F.lane, F.in[I_X] + (size_t)m * DM, F.in[I_N1G], (bf16*)(F.hi + (WS_XN - HI)) + (size_t)m * DM);
    constexpr int IT_IN = (DM / 64) * (IN_W / 64), IT_GLU = (512 / 64) * (512 / 64), IT_PS = (512 / 64) * (DM / 64), IT_OUT = (DM / 64) * (DM / 64);
    constexpr int IT_UP1 = (DM / 64) * (UPW / 64), IT_DN1 = (DE / 64) * (DM / 64);
    constexpr int NITEMS = IT_IN + IT_GLU + 2 * IT_PS + IT_OUT;
#define P0_DECODE(it, d) do { int r_ = (it); int nb_; \
        if (r_ < IT_IN) { d.src = F.in[I_WIN]; d.dst = F.hi + (WS_WIN - HI); d.kscale = nullptr; d.N = IN_W; d.K = DM; d.mode = 1; d.out8 = 0; } \
        else if ((r_ -= IT_IN) < IT_GLU) { d.src = F.in[I_WGLU]; d.dst = F.ws + WS_WGLU; d.kscale = nullptr; d.N = 512; d.K = 512; d.mode = 0; d.out8 = 0; } \
        else if ((r_ -= IT_GLU) < IT_PS) { d.src = F.in[I_WPS]; d.dst = F.ws + WS_WPS; d.kscale = nullptr; d.N = DM; d.K = 512; d.mode = 0; d.out8 = 0; } \
        else if ((r_ -= IT_PS) < IT_PS) { d.src = F.in[I_WPA]; d.dst = F.ws + WS_WPA; d.kscale = nullptr; d.N = DM; d.K = 512; d.mode = 0; d.out8 = 0; } \
        else if ((r_ -= IT_PS) < IT_OUT) { d.src = F.in[I_WOUT]; d.dst = F.ws + WS_WOUT; d.kscale = nullptr; d.N = DM; d.K = DM; d.mode = 0; d.out8 = 0; } \
        else if ((r_ -= IT_OUT) < NE * IT_UP1) { const int e_ = r_ / IT_UP1; r_ -= e_ * IT_UP1; d.src = F.in[I_WUP] + (size_t)e_ * DM * UPW; d.dst = F.hi + (WS_WUP - HI) + (size_t)e_ * UPW * DM; d.kscale = F.in[I_N2G]; d.N = UPW; d.K = DM; d.mode = 2; d.out8 = 1; } \
        else { r_ -= NE * IT_UP1; const int e_ = r_ / IT_DN1; r_ -= e_ * IT_DN1; d.src = F.in[I_WDN] + (size_t)e_ * DE * DM; d.dst = F.hi + (WS_WDN - HI) + (size_t)e_ * DM * DE; d.kscale = nullptr; d.N = DM; d.K = DE; d.mode = 0; d.out8 = 1; } \
        nb_ = d.N / 64; d.k0 = 64 * (r_ / nb_); d.c0 = 64 * (r_ % nb_); } while (0)
    int qcur = 0, qend = 0;
#define P0_DRAW(it) do { if (qcur == qend) { unsigned q_ = 0; if (F.lane == 0) q_ = atomicAdd((unsigned*)(F.ctl + CW_Q), 1u); qcur = 8 * (int)__builtin_amdgcn_readfirstlane(q_); qend = qcur + 8; } it = qcur++; } while (0)
    {
        P0Item dA, dB; f32x4 vA[16], vB[16]; int itA, itB;
        P0_DRAW(itA);
        if (itA < NITEMS) { P0_DECODE(itA, dA); p0_item_load(dA, vA, F.lane);
            for (;;) {
                P0_DRAW(itB); const bool hasB = itB < NITEMS;
                if (hasB) { P0_DECODE(itB, dB); p0_item_load(dB, vB, F.lane); }
                p0_item_finish(dA, vA, scr, F.lane);
                if (!hasB) break;
                P0_DRAW(itA); const bool hasA = itA < NITEMS;
                if (hasA) { P0_DECODE(itA, dA); p0_item_load(dA, vA, F.lane); }
                p0_item_finish(dB, vB, scr, F.lane);
                if (!hasA) break;
            } }
    }
#undef P0_DECODE
#undef P0_DRAW
    __syncthreads();
    {
        LAS int* qs = (LAS int*)(F.lds + MOE_LDS_OFF);
        constexpr int BI_UP1 = (DM / 128) * (UPW / 256), BI_DN1 = (DE / 128) * (DM / 256), NBIG = NE * (BI_UP1 + BI_DN1);
        for (;;) {
            if (F.tid == 0) qs[0] = (int)atomicAdd((unsigned*)(F.ctl + CW_Q) + 64, 1u);
            __syncthreads();
            const int it = qs[0];
            __syncthreads();
            if (it >= NBIG) break;
            if (it < NE * BI_UP1) { const int e = it / BI_UP1, q = it % BI_UP1;
                p0_big_item<2>(F, F.in[I_WUP] + (size_t)e * DM * UPW, UPW, F.hi + (WS_WUP - HI) + (size_t)e * UPW * DM, DM, F.in[I_N2G], q); }
            else { const int r = it - NE * BI_UP1, e = r / BI_DN1, q = r % BI_DN1;
                p0_big_item<0>(F, F.in[I_WDN] + (size_t)e * DE * DM, DM, F.hi + (WS_WDN - HI) + (size_t)e * DM * DE, DE, nullptr, q); }
        }
    }
}

typedef const pg8::f32x4 (&AccRef)[2][2][4][2];
__device__ __forceinline__ v4u pack8(const f32x4 a, const f32x4 b) { v4u w; w.x = cvt_pk_bf16(a[0], a[1]); w.y = cvt_pk_bf16(a[2], a[3]); w.z = cvt_pk_bf16(b[0], b[1]); w.w = cvt_pk_bf16(b[2], b[3]); return w; }
__device__ __forceinline__ void unpack8(const v4u w, f32x4& a, f32x4& b) { a = (f32x4){bflo(w.x), bfhi(w.x), bflo(w.y), bfhi(w.y)}; b = (f32x4){bflo(w.z), bfhi(w.z), bflo(w.w), bfhi(w.w)}; }

struct EpiInProj {
    static constexpr bool PERM = true;
    __device__ __forceinline__ bool keep(const pg8::Unit&) const { return false; }
    bf16 *U, *Q, *Kb, *V, *G1, *G2; const float *bgate, *qg, *kg;
    __device__ __forceinline__ void operator()(AccRef acc, const pg8::Unit& u, int wr, int wc, int fr, int fq, const LAS int*) const {
        const int pn = u.pn, row0 = u.pm * 256 + wr * 64 + fr;
        if (pn < 2) {
#pragma unroll
            for (int ai = 0; ai < 2; ++ai)
#pragma unroll
                for (int m = 0; m < 4; ++m) { const int row = row0 + ai * 128 + m * 16, b = row >> 11, t = row & 2047;
#pragma unroll
                    for (int bj = 0; bj < 2; ++bj) { const int lc = 256 * pn + 64 * wc + 32 * bj + 8 * fq, g = lc >> 4, ch = lc & 15;
                        *(v4u*)(U + ((size_t)(b * SSM_G + g) * SEQ + t) * 16 + ch) = pack8(acc[ai][bj][m][0], acc[ai][bj][m][1]); } }
        } else if (pn < 6) {
            const bool isq = pn < 4; const float* gv = isq ? qg : kg; const float sc = isq ? QSCALE : 1.0f;
            bf16* dst = (isq ? Q : Kb) + 256 * (pn - (isq ? 2 : 4)) + 64 * wc + 8 * fq;
            f32x4 gg[2][2];
#pragma unroll
            for (int bj = 0; bj < 2; ++bj)
#pragma unroll
                for (int n = 0; n < 2; ++n) gg[bj][n] = *(const f32x4*)(gv + 32 * bj + 8 * fq + 4 * n) * sc;
#pragma unroll
            for (int ai = 0; ai < 2; ++ai)
#pragma unroll
                for (int m = 0; m < 4; ++m) { const int row = row0 + ai * 128 + m * 16; float ss = 0.f;
#pragma unroll
                    for (int bj = 0; bj < 2; ++bj)
#pragma unroll
                        for (int n = 0; n < 2; ++n) { const f32x4 x = acc[ai][bj][m][n]; ss += (x[0] * x[0] + x[1] * x[1]) + (x[2] * x[2] + x[3] * x[3]); }
                    ss += __shfl_xor(ss, 16); ss += __shfl_xor(ss, 32);
                    const float rs = __builtin_amdgcn_rsqf(ss * (1.0f / 64.0f) + RMS_EPS);
#pragma unroll
                    for (int bj = 0; bj < 2; ++bj) *(v4u*)(dst + (size_t)row * 512 + 32 * bj) = pack8(acc[ai][bj][m][0] * rs * gg[bj][0], acc[ai][bj][m][1] * rs * gg[bj][1]); }
        } else if (pn < 8) {
            bf16* dst = V + 256 * (pn - 6) + 64 * wc + 8 * fq;
#pragma unroll
            for (int ai = 0; ai < 2; ++ai)
#pragma unroll
                for (int m = 0; m < 4; ++m) { const int row = row0 + ai * 128 + m * 16;
#pragma unroll
                    for (int bj = 0; bj < 2; ++bj) *(v4u*)(dst + (size_t)row * 512 + 32 * bj) = pack8(acc[ai][bj][m][0], acc[ai][bj][m][1]); }
        } else {
            const int gc = 256 * (pn - 8) + 64 * wc + 8 * fq;
            bf16* dst = (gc < 1024 ? G1 + gc : G2 + (gc - 1024));
            f32x4 bb[2][2];
#pragma unroll
            for (int bj = 0; bj < 2; ++bj)
#pragma unroll
                for (int n = 0; n < 2; ++n) bb[bj][n] = *(const f32x4*)(bgate + gc + 32 * bj + 4 * n);
#pragma unroll
            for (int ai = 0; ai < 2; ++ai)
#pragma unroll
                for (int m = 0; m < 4; ++m) { const int row = row0 + ai * 128 + m * 16;
#pragma unroll
                    for (int bj = 0; bj < 2; ++bj) { f32x4 a = acc[ai][bj][m][0] + bb[bj][0], b = acc[ai][bj][m][1] + bb[bj][1];
#pragma unroll
                        for (int e = 0; e < 4; ++e) { a[e] = fsigmoid(a[e]); b[e] = fsigmoid(b[e]); }
                        *(v4u*)(dst + (size_t)row * 1024 + 32 * bj) = pack8(a, b); } }
        }
    }
};
template <int MODE> struct EpiMix {
    static constexpr bool PERM = true;
    __device__ __forceinline__ bool keep(const pg8::Unit&) const { return false; }
    const bf16* P0; const bf16* P1; bf16* O; const float* bias; int ld;
    __device__ __forceinline__ void operator()(AccRef acc, const pg8::Unit& u, int wr, int wc, int fr, int fq, const LAS int*) const {
        const int row0 = u.pm * 256 + wr * 64 + fr, col0 = u.pn * 256 + wc * 32 + 8 * fq;
        f32x4 bb[2][2];
#pragma unroll
        for (int bj = 0; bj < 2; ++bj)
#pragma unroll
            for (int n = 0; n < 2; ++n) bb[bj][n] = (MODE == 0) ? *(const f32x4*)(bias + col0 + bj * 128 + 4 * n) : (f32x4){0.f, 0.f, 0.f, 0.f};
#pragma unroll
        for (int ai = 0; ai < 2; ++ai) {
            v4u q0[4][2], q1[4][2];
#pragma unroll
            for (int m = 0; m < 4; ++m)
#pragma unroll
                for (int bj = 0; bj < 2; ++bj) { const size_t off = (size_t)(row0 + ai * 128 + m * 16) * ld + col0 + bj * 128; q0[m][bj] = *(const v4u*)(P0 + off); if (MODE == 2) q1[m][bj] = *(const v4u*)(P1 + off); }
#pragma unroll
            for (int m = 0; m < 4; ++m) { const size_t off = (size_t)(row0 + ai * 128 + m * 16) * ld + col0;
#pragma unroll
                for (int bj = 0; bj < 2; ++bj) { f32x4 a = acc[ai][bj][m][0], b = acc[ai][bj][m][1], p0a, p0b;
                    unpack8(q0[m][bj], p0a, p0b);
                    if (MODE == 0) { a += bb[bj][0]; b += bb[bj][1];
#pragma unroll
                        for (int e = 0; e < 4; ++e) { a[e] = p0a[e] * fsigmoid_fast(a[e]); b[e] = p0b[e] * fsigmoid_fast(b[e]); } }
                    else if (MODE == 1) { a *= p0a; b *= p0b; }
                    else { f32x4 p1a, p1b; unpack8(q1[m][bj], p1a, p1b); a = p0a + p1a * a; b = p0b + p1b * b; }
                    *(v4u*)(O + off + bj * 128) = pack8(a, b); } } }
    }
};
struct EpiOut {
    static constexpr bool PERM = false;
    __device__ __forceinline__ bool keep(const pg8::Unit&) const { return false; }
    const float* X; float* H; unsigned char* HB;
    __device__ __forceinline__ void operator()(AccRef acc, const pg8::Unit& u, int wr, int wc, int fr, int fq, const LAS int*) const {
        const int row0 = u.pm * 256 + wr * 64 + fr, col0 = u.pn * 256 + wc * 32 + 4 * fq;
#pragma unroll
        for (int ai = 0; ai < 2; ++ai) {
            f32x4 xv[4][2][2];
#pragma unroll
            for (int m = 0; m < 4; ++m)
#pragma unroll
                for (int bj = 0; bj < 2; ++bj)
#pragma unroll
                    for (int n = 0; n < 2; ++n) xv[m][bj][n] = *(const f32x4*)(X + (size_t)(row0 + ai * 128 + m * 16) * DM + col0 + bj * 128 + n * 16);
#pragma unroll
            for (int m = 0; m < 4; ++m) { const size_t off = (size_t)(row0 + ai * 128 + m * 16) * DM + col0;
#pragma unroll
                for (int bj = 0; bj < 2; ++bj)
#pragma unroll
                    for (int n = 0; n < 2; ++n) { const f32x4 h = xv[m][bj][n] + acc[ai][bj][m][n];
                        *(f32x4*)(H + off + bj * 128 + n * 16) = h; *(unsigned*)(HB + off + bj * 128 + n * 16) = pk4_fp8(h[0], h[1], h[2], h[3]); } } }
    }
};
struct ChainOrder {
    pg8::StaticOrder so; const bf16* A_att; const bf16* A_ssm;
    __device__ __forceinline__ bool next(int i, pg8::Unit& u) const { pg8::Unit t; if (!so.next(i >> 1, t)) return false; u.pm = t.pm; u.pn = (i & 1) ? t.pn : 4 + t.pn; return true; }
    __device__ __forceinline__ int row_slot(const pg8::Unit&, int) const { return 0; }
    __device__ __forceinline__ int a_row(const pg8::Unit& u, int r, int) const { return u.pm * 256 + r; }
    __device__ __forceinline__ const char* a_base(const pg8::Gemm&, const pg8::Unit& u, size_t tstep) const { return (const char*)(u.pn >= 4 ? A_att : A_ssm) + (size_t)u.pm * tstep; }
    __device__ __forceinline__ void a_ready(const pg8::Unit&) const {}
    __device__ __forceinline__ void done(const pg8::Unit&) const {}
};
struct EpiChain {
    static constexpr bool PERM = true;
    const bf16* G1; const bf16* G2; bf16* MX;
    __device__ __forceinline__ bool keep(const pg8::Unit& u) const { return u.pn >= 4; }
    __device__ __forceinline__ void operator()(pg8::f32x4 (&acc)[2][2][4][2], const pg8::Unit& u, int wr, int wc, int fr, int fq, const LAS int*) const {
        const bool att = u.pn >= 4; const int row0 = u.pm * 256 + wr * 64 + fr, col0 = (u.pn & 3) * 256 + wc * 32 + 8 * fq;
#pragma unroll
        for (int ai = 0; ai < 2; ++ai) {
            v4u q1[4][2], q2[4][2];
#pragma unroll
            for (int m = 0; m < 4; ++m)
#pragma unroll
                for (int bj = 0; bj < 2; ++bj) { const size_t off = (size_t)(row0 + ai * 128 + m * 16) * DM + col0 + bj * 128; q1[m][bj] = *(const v4u*)(G1 + off); if (att) q2[m][bj] = *(const v4u*)(G2 + off); }
#pragma unroll
            for (int m = 0; m < 4; ++m)
#pragma unroll
                for (int bj = 0; bj < 2; ++bj) { f32x4 g1a, g1b; unpack8(q1[m][bj], g1a, g1b);
                    if (att) { f32x4 g2a, g2b; unpack8(q2[m][bj], g2a, g2b);
#pragma unroll
                        for (int e = 0; e < 4; ++e) { acc[ai][bj][m][0][e] *= g2a[e] * __builtin_amdgcn_rcpf(g1a[e]); acc[ai][bj][m][1][e] *= g2b[e] * __builtin_amdgcn_rcpf(g1b[e]); } }
                    else *(v4u*)(MX + (size_t)(row0 + ai * 128 + m * 16) * DM + col0 + bj * 128) = pack8(acc[ai][bj][m][0] * g1a, acc[ai][bj][m][1] * g1b); } }
    }
};
constexpr int CW_MFLAG = 32768, MFLAG_STRIDE = 16;
template <int NN, bool TOKROWS> struct MoeOrder {
    int nunits, G, vcu; const LAS int* cnt; const LAS int* tstart; const LAS int* tile2e; const int* elist; unsigned* mflag;
    __device__ __forceinline__ void a_ready(const pg8::Unit& u) const {
        if constexpr (!TOKROWS) { unsigned* f = mflag + u.pm * MFLAG_STRIDE; unsigned spins = 0;
            while (__hip_atomic_load(f, __ATOMIC_RELAXED, __HIP_MEMORY_SCOPE_AGENT) < 8u && ++spins < (1u << 22)) __builtin_amdgcn_s_sleep(2);
            asm volatile("" ::: "memory"); } }
    __device__ __forceinline__ void done(const pg8::Unit& u) const {
        if constexpr (TOKROWS) { asm volatile("s_waitcnt vmcnt(0)" ::: "memory"); __builtin_amdgcn_s_barrier(); asm volatile("" ::: "memory");
            if (threadIdx.x == 0) __hip_atomic_fetch_add(mflag + u.pm * MFLAG_STRIDE, 1u, __ATOMIC_RELAXED, __HIP_MEMORY_SCOPE_AGENT); } }
    __device__ __forceinline__ bool next(int i, pg8::Unit& u) const { const long L = (long)i * G + vcu; if (L >= nunits) return false; const int pm = (int)(L / NN), pnl = (int)(L % NN);
        u.pm = pm; u.pn = tile2e[pm] * NN + pnl; return true; }
    __device__ __forceinline__ int row_slot(const pg8::Unit& u, int r) const { const int e = u.pn / NN, pos = (u.pm - tstart[e]) * 256 + r; return pos < cnt[e] ? elist[e * M + pos] : -1; }
    __device__ __forceinline__ int a_row(const pg8::Unit& u, int r, int slot) const { return TOKROWS ? (slot < 0 ? 0 : (slot >> 2)) : u.pm * 256 + r; }
    __device__ __forceinline__ const char* a_base(const pg8::Gemm& g, const pg8::Unit&, size_t) const { return (const char*)g.A; }
};
struct EpiUp {
    static constexpr bool PERM = true;
    __device__ __forceinline__ bool keep(const pg8::Unit&) const { return false; }
    unsigned char* ACT; const float* bup; const float* rs2;
    __device__ __forceinline__ void operator()(AccRef acc, const pg8::Unit& u, int wr, int wc, int fr, int fq, const LAS int* tab) const {
        const int e = u.pn >> 3, pnl = u.pn & 7, j0 = 128 * pnl + 32 * wc + 8 * fq;
        f32x4 bb[4];
#pragma unroll
        for (int q = 0; q < 4; ++q) bb[q] = *(const f32x4*)(bup + (size_t)e * UPW + 2 * j0 + 4 * q);
        int sl[2][4]; float rsv[2][4];
#pragma unroll
        for (int ai = 0; ai < 2; ++ai)
#pragma unroll
            for (int m = 0; m < 4; ++m) { sl[ai][m] = tab[ai * 128 + wr * 64 + m * 16 + fr]; rsv[ai][m] = rs2[sl[ai][m] < 0 ? 0 : (sl[ai][m] >> 2)] * 0.03125f; }
#pragma unroll
        for (int ai = 0; ai < 2; ++ai)
#pragma unroll
            for (int m = 0; m < 4; ++m) { const int r = ai * 128 + wr * 64 + m * 16 + fr, slot = sl[ai][m];
                if (slot >= 0) { const float rs = rsv[ai][m]; f32x4 o[2];
#pragma unroll
                    for (int n = 0; n < 2; ++n)
#pragma unroll
                        for (int e4 = 0; e4 < 4; ++e4) { const int j = 4 * n + e4;
                            float gl = acc[ai][0][m][n][e4] * rs + bb[(2 * j) >> 2][(2 * j) & 3], li = acc[ai][1][m][n][e4] * rs + bb[(2 * j + 1) >> 2][(2 * j + 1) & 3];
                            gl = fminf(gl, 7.0f); li = fminf(fmaxf(li, -7.0f), 7.0f);
                            o[n][e4] = gl * fsigmoid_fast(1.702f * gl) * (li + 1.0f) * 4.0f; }
                    const unsigned long long ov = (unsigned long long)pk4_fp8(o[0][0], o[0][1], o[0][2], o[0][3]) | ((unsigned long long)pk4_fp8(o[1][0], o[1][1], o[1][2], o[1][3]) << 32);
                    __hip_atomic_store((unsigned long long*)(ACT + (size_t)(u.pm * 256 + r) * DE + j0), ov, __ATOMIC_RELAXED, __HIP_MEMORY_SCOPE_AGENT); } }
    }
};
struct EpiDown {
    static constexpr bool PERM = true;
    __device__ __forceinline__ bool keep(const pg8::Unit&) const { return false; }
    unsigned char* YS2; const float* bdn; const float* wslot;
    __device__ __forceinline__ void operator()(AccRef acc, const pg8::Unit& u, int wr, int wc, int fr, int fq, const LAS int* tab) const {
        const int e = u.pn >> 2, pnl = u.pn & 3, c0 = 256 * pnl + 32 * wc + 8 * fq;
        f32x4 bb[2][2];
#pragma unroll
        for (int bj = 0; bj < 2; ++bj)
#pragma unroll
            for (int n = 0; n < 2; ++n) bb[bj][n] = *(const f32x4*)(bdn + (size_t)e * DM + c0 + bj * 128 + 4 * n);
        int sl[2][4]; float wv[2][4];
#pragma unroll
        for (int ai = 0; ai < 2; ++ai)
#pragma unroll
            for (int m = 0; m < 4; ++m) { sl[ai][m] = tab[ai * 128 + wr * 64 + m * 16 + fr]; wv[ai][m] = wslot[sl[ai][m] < 0 ? 0 : sl[ai][m]]; }
#pragma unroll
        for (int ai = 0; ai < 2; ++ai)
#pragma unroll
            for (int m = 0; m < 4; ++m) { const int slot = sl[ai][m];
                if (slot >= 0) { const float w = wv[ai][m] * 16.0f;
#pragma unroll
                    for (int bj = 0; bj < 2; ++bj) { const f32x4 ya = (acc[ai][bj][m][0] * 0.0078125f + bb[bj][0]) * w, yb = (acc[ai][bj][m][1] * 0.0078125f + bb[bj][1]) * w; v2u ov; ov.x = pk4_fp8(ya[0], ya[1], ya[2], ya[3]); ov.y = pk4_fp8(yb[0], yb[1], yb[2], yb[3]);
                        *(v2u*)(YS2 + (size_t)slot * DM + c0 + bj * 128) = ov; } } }
    }
};

constexpr int S5_UPITCH = 528, S5_SX_OFF = 128 * S5_UPITCH, S5_XPITCH = 132;
__device__ __forceinline__ void s5_unit(Frame& F, int b, int g) {
    LAS unsigned char* Uimg = F.lds + RING_OFF; LAS float* SX = (LAS float*)(F.lds + RING_OFF + S5_SX_OFF);
    const int tid = F.tid, lane = F.lane, w = F.wave, r32 = lane & 31, hi = lane >> 5;
    const bf16* Ug = (const bf16*)(F.ws + WS_U) + (size_t)(b * SSM_G + g) * SEQ * 16;
    const bf16* W1T = (const bf16*)(F.ws + WS_S5 + (size_t)g * 262144); const bf16* M2T = W1T + 128 * 256; const bf16* W3T = M2T + 256 * 256;
#pragma unroll
    for (int j = 0; j < 8; ++j) { const int q = tid + 512 * j; *(LAS v4u*)(Uimg + (q >> 5) * S5_UPITCH + (q & 31) * 16) = *(const v4u*)(Ug + (size_t)q * 8); }
    __syncthreads();
    { const int nt = w & 3, mt0 = 2 * (w >> 2);
      f32x16 s0 = {0}, s1 = {0};
#pragma unroll 4
      for (int ks = 0; ks < 16; ++ks) {
          const bf16x8 bf = *(const bf16x8*)(W1T + (size_t)(32 * nt + r32) * 256 + 16 * ks + 8 * hi);
          const bf16x8 a0 = *(const LAS bf16x8*)(Uimg + (32 * mt0 + r32) * S5_UPITCH + (16 * ks + 8 * hi) * 2);
          const bf16x8 a1 = *(const LAS bf16x8*)(Uimg + (32 * (mt0 + 1) + r32) * S5_UPITCH + (16 * ks + 8 * hi) * 2);
          s0 = __builtin_amdgcn_mfma_f32_32x32x16_bf16(a0, bf, s0, 0, 0, 0); s1 = __builtin_amdgcn_mfma_f32_32x32x16_bf16(a1, bf, s1, 0, 0, 0); }
#pragma unroll
      for (int r = 0; r < 16; ++r) { SX[(32 * mt0 + crow(r, hi)) * S5_XPITCH + 32 * nt + r32] = s0[r]; SX[(32 * (mt0 + 1) + crow(r, hi)) * S5_XPITCH + 32 * nt + r32] = s1[r]; } }
    __syncthreads();
    if (tid < 64) {
        const float* a16 = (const float*)(F.ws + WS_A16) + (g * 64 + tid) * 2; const float ar = a16[0], ai = a16[1]; float xr = 0.f, xi = 0.f;
#pragma unroll 8
        for (int c = 0; c < SSM_NC; ++c) { const float sr = SX[c * S5_XPITCH + tid], si = SX[c * S5_XPITCH + 64 + tid];
            SX[c * S5_XPITCH + tid] = xr; SX[c * S5_XPITCH + 64 + tid] = xi;
            const float nr = ar * xr - ai * xi + sr, ni = ar * xi + ai * xr + si; xr = nr; xi = ni; }
    }
    __syncthreads();
    { f32x16 y[4] = {{0}, {0}, {0}, {0}};
      const int nks = 2 * w + 2;
      for (int ks = 0; ks < nks; ++ks) {
          const bf16x8 bf = *(const bf16x8*)(M2T + (size_t)(32 * w + r32) * 256 + 16 * ks + 8 * hi);
#pragma unroll
          for (int mt = 0; mt < 4; ++mt) { const bf16x8 a = *(const LAS bf16x8*)(Uimg + (32 * mt + r32) * S5_UPITCH + (16 * ks + 8 * hi) * 2); y[mt] = __builtin_amdgcn_mfma_f32_32x32x16_bf16(a, bf, y[mt], 0, 0, 0); } }
#pragma unroll 2
      for (int ks = 0; ks < 8; ++ks) {
          const bf16x8 bf = *(const bf16x8*)(W3T + (size_t)(32 * w + r32) * 128 + 16 * ks + 8 * hi);
#pragma unroll
          for (int mt = 0; mt < 4; ++mt) { const LAS f32x4* xp = (const LAS f32x4*)(SX + (32 * mt + r32) * S5_XPITCH + 16 * ks + 8 * hi); const f32x4 x0 = xp[0], x1 = xp[1];
              const v4u pk = pack8(x0, x1); y[mt] = __builtin_amdgcn_mfma_f32_32x32x16_bf16(__builtin_bit_cast(bf16x8, pk), bf, y[mt], 0, 0, 0); } }
      bf16* YG = (bf16*)(F.ws + WS_YG); const int i = 2 * w + (r32 >> 4), ho = r32 & 15;
#pragma unroll
      for (int mt = 0; mt < 4; ++mt)
#pragma unroll
          for (int r = 0; r < 16; ++r) { const int c = 32 * mt + crow(r, hi); YG[(size_t)(b * SEQ + 16 * c + i) * SSM_W + g * 16 + ho] = (bf16)f2bf(gelu_tanh(y[mt][r])); } }
    __syncthreads();
}

constexpr int AT_KP = 272, AT_VP = 320, AT_KB = 64 * AT_KP, AT_VB = 64 * AT_VP, AT_BUF = AT_KB + AT_VB;
__device__ __forceinline__ s16x4 vtr(const LAS unsigned char* p) { typedef short v4i16_t __attribute__((ext_vector_type(4))); return __builtin_bit_cast(s16x4, __builtin_amdgcn_ds_read_tr16_b64_v4i16((LAS v4i16_t*)p)); }
__device__ __forceinline__ void attn_unit(Frame& F, int b, int h, int qb, float lam) {
    const int tid = F.tid, lane = F.lane, w = F.wave, rg = w >> 1, t = w & 1, r32 = lane & 31, hi = lane >> 5;
    const bf16* Q = (const bf16*)(F.ws + WS_Q); const bf16* K = (const bf16*)(F.ws + WS_K); const bf16* V = (const bf16*)(F.ws + WS_V); bf16* OB = (bf16*)(F.ws + WS_OB);
    LAS unsigned char* L = F.lds + RING_OFF;
    const int qrow = b * SEQ + qb * 128 + rg * 32 + r32;
    bf16x8 qf[4];
#pragma unroll
    for (int ks = 0; ks < 4; ++ks) qf[ks] = *(const bf16x8*)(Q + (size_t)qrow * QK_W + h * 128 + t * 64 + 16 * ks + 8 * hi);
    const int ntile = 2 * qb + 2, mylim = 2 * qb + (rg >> 1);
    const int kr0 = tid >> 4, cc = tid & 15;
    const size_t gbase = (size_t)(b * SEQ) * 512 + h * 128 + cc * 8;
    v4u kregA[2], vregA[2], kregB[2], vregB[2];
#define AT_LOAD(j, kreg, vreg) do { _Pragma("unroll") for (int i_ = 0; i_ < 2; ++i_) { const size_t o_ = gbase + (size_t)(64 * (j) + kr0 + 32 * i_) * 512; kreg[i_] = *(const v4u*)(K + o_); vreg[i_] = *(const v4u*)(V + o_); } } while (0)
#define AT_STORE(buf, kreg, vreg) do { _Pragma("unroll") for (int i_ = 0; i_ < 2; ++i_) { *(LAS v4u*)(L + (buf) * AT_BUF + (kr0 + 32 * i_) * AT_KP + cc * 16) = kreg[i_]; \
        *(LAS v4u*)(L + (buf) * AT_BUF + AT_KB + (kr0 + 32 * i_) * AT_VP + cc * 16) = vreg[i_]; } } while (0)
    AT_LOAD(0, kregB, vregB); AT_LOAD(1, kregA, vregA); AT_STORE(0, kregB, vregB);
    __syncthreads();
    f32x16 o[4] = {{0}, {0}, {0}, {0}};
    float mrun = -60.0f, lrun = 0.f;
    f32x16 negm;
#pragma unroll
    for (int r = 0; r < 16; ++r) negm[r] = 60.0f;
    const int g4 = lane >> 4, i16 = lane & 15;
    const int vlane = (4 * (g4 >> 1) + (i16 >> 2)) * AT_VP + (16 * (g4 & 1) + 4 * (i16 & 3)) * 2;
#define AT_COMPUTE(j, buf) do { \
        if (j <= mylim) { \
            const LAS unsigned char* Kb = L + buf * AT_BUF + t * 128 + hi * 16 + r32 * AT_KP; \
            const LAS unsigned char* Vb = L + buf * AT_BUF + AT_KB + vlane; \
            f32x16 s0, s1; \
            __builtin_amdgcn_s_setprio(1); \
        _Pragma("unroll") \
            for (int ks = 0; ks < 4; ++ks) { const bf16x8 k0 = *(const LAS bf16x8*)(Kb + ks * 32), k1 = *(const LAS bf16x8*)(Kb + 32 * AT_KP + ks * 32); \
                if (ks == 0) { s0 = __builtin_amdgcn_mfma_f32_32x32x16_bf16(k0, qf[0], negm, 0, 0, 0); s1 = __builtin_amdgcn_mfma_f32_32x32x16_bf16(k1, qf[0], negm, 0, 0, 0); } \
                else { s0 = __builtin_amdgcn_mfma_f32_32x32x16_bf16(k0, qf[ks], s0, 0, 0, 0); s1 = __builtin_amdgcn_mfma_f32_32x32x16_bf16(k1, qf[ks], s1, 0, 0, 0); } } \
            __builtin_amdgcn_s_setprio(0); \
            float mx = fmaxf(fmaxf(s0[0], s0[1]), s0[2]); \
        _Pragma("unroll") \
            for (int r = 3; r < 15; r += 2) mx = fmaxf(fmaxf(mx, s0[r]), s0[r + 1]); \
            mx = fmaxf(mx, s0[15]); \
        _Pragma("unroll") \
            for (int r = 0; r < 16; r += 2) mx = fmaxf(fmaxf(mx, s1[r]), s1[r + 1]); \
            mx = fmaxf(mx, __shfl_xor(mx, 32)); \
            if (__builtin_amdgcn_ballot_w64(mx > 8.0f) != 0ull) { \
                const float dm = (mx > 8.0f) ? mx : 0.0f, alpha = __builtin_amdgcn_exp2f(-dm); lrun *= alpha; mrun += dm; \
        _Pragma("unroll") \
                for (int dt = 0; dt < 4; ++dt) o[dt] *= alpha; \
        _Pragma("unroll") \
                for (int r = 0; r < 16; ++r) { s0[r] -= dm; s1[r] -= dm; negm[r] = -mrun; } } \
            float ps = 0.f; \
        _Pragma("unroll") \
            for (int r = 0; r < 16; ++r) { s0[r] = __builtin_amdgcn_exp2f(s0[r]); s1[r] = __builtin_amdgcn_exp2f(s1[r]); ps += s0[r] + s1[r]; } \
            lrun += ps; \
        _Pragma("unroll") \
            for (int s = 0; s < 4; ++s) { \
                v4u pk; const int rb = 8 * (s & 1); \
                if (s < 2) { pk.x = cvt_pk_bf16(s0[rb], s0[rb + 1]); pk.y = cvt_pk_bf16(s0[rb + 2], s0[rb + 3]); pk.z = cvt_pk_bf16(s0[rb + 4], s0[rb + 5]); pk.w = cvt_pk_bf16(s0[rb + 6], s0[rb + 7]); } \
                else       { pk.x = cvt_pk_bf16(s1[rb], s1[rb + 1]); pk.y = cvt_pk_bf16(s1[rb + 2], s1[rb + 3]); pk.z = cvt_pk_bf16(s1[rb + 4], s1[rb + 5]); pk.w = cvt_pk_bf16(s1[rb + 6], s1[rb + 7]); } \
                const bf16x8 pf = __builtin_bit_cast(bf16x8, pk); \
                __builtin_amdgcn_s_setprio(1); \
        _Pragma("unroll") \
                for (int dt = 0; dt < 4; ++dt) { const s16x4 lo = vtr(Vb + s * 16 * AT_VP + dt * 64), hh = vtr(Vb + s * 16 * AT_VP + dt * 64 + 8 * AT_VP); \
                    const bf16x8 vf = (bf16x8){lo[0], lo[1], lo[2], lo[3], hh[0], hh[1], hh[2], hh[3]}; \
                    o[dt] = __builtin_amdgcn_mfma_f32_32x32x16_bf16(vf, pf, o[dt], 0, 0, 0); } \
                __builtin_amdgcn_s_setprio(0); } \
        } \
    } while (0)
    for (int j = 0; j < ntile; j += 2) {
        { const int jn = (j + 2 < ntile) ? j + 2 : ntile - 1; AT_LOAD(jn, kregB, vregB); }
        AT_COMPUTE(j, 0);
        AT_STORE(1, kregA, vregA);
        __syncthreads();
        { const int jn = (j + 3 < ntile) ? j + 3 : ntile - 1; AT_LOAD(jn, kregA, vregA); }
        AT_COMPUTE(j + 1, 1);
        AT_STORE(0, kregB, vregB);
        __syncthreads();
    }
#undef AT_COMPUTE
#undef AT_LOAD
#undef AT_STORE
    const float ltot = lrun + __shfl_xor(lrun, 32), inv = 1.0f / ltot;
    LAS float* EX = (LAS float*)L + rg * 4096;
    if (t == 1) {
        const float sc = inv * lam;
#pragma unroll
        for (int dt = 0; dt < 4; ++dt)
#pragma unroll
            for (int r = 0; r < 16; ++r) EX[(dt * 16 + r) * 64 + lane] = o[dt][r] * sc;
    }
    __syncthreads();
    if (t == 0) {
        float ss = 0.f;
#pragma unroll
        for (int dt = 0; dt < 4; ++dt)
#pragma unroll
            for (int r = 0; r < 16; ++r) { const float y = o[dt][r] * inv - EX[(dt * 16 + r) * 64 + lane]; o[dt][r] = y; ss += y * y; }
        ss += __shfl_xor(ss, 32);
        const float rn = (1.0f - LAMBDA_INIT) / sqrtf(ss * (1.0f / 128.0f) + RMS_EPS);
        const float* sg = F.in[I_SUBLN];
        f32x4 ggv[4][4];
#pragma unroll
        for (int dt = 0; dt < 4; ++dt)
#pragma unroll
            for (int rq = 0; rq < 4; ++rq) ggv[dt][rq] = *(const f32x4*)(sg + 32 * dt + 8 * rq + 4 * hi);
#pragma unroll
        for (int dt = 0; dt < 4; ++dt)
#pragma unroll
            for (int rq = 0; rq < 4; ++rq) { const int d = 32 * dt + 8 * rq + 4 * hi; const f32x4 gg = ggv[dt][rq];
                v2u wv; wv.x = cvt_pk_bf16(o[dt][4 * rq] * rn * gg[0], o[dt][4 * rq + 1] * rn * gg[1]); wv.y = cvt_pk_bf16(o[dt][4 * rq + 2] * rn * gg[2], o[dt][4 * rq + 3] * rn * gg[3]);
                *(v2u*)(OB + (size_t)qrow * V_W + h * 128 + d) = wv; }
    }
    __syncthreads();
}

constexpr int CW_CNT_STRIDE = 64;
__device__ __forceinline__ void router_phase(Frame& F, const bool dummy = false) {
    const int lane = F.lane, tid = F.tid, w = F.wave, tt = w >> 1, kh = w & 1;
    LAS float* LG = (LAS float*)(F.lds + RING_OFF);
    LAS float* SS = LG + 4 * 2 * 16 * 33;
    LAS int* LC = (LAS int*)(SS + 128);
    const float* Hf = F.out; const float* wrT = (const float*)(F.ws + WS_WRT); const float* br = F.in[I_BR];
    float* rs2 = (float*)(F.ws + (dummy ? WS_YS2 : WS_RS2)); float* wslot = (float*)(F.ws + (dummy ? WS_YS2 + MiB : WS_WSLOT)); int* elist = (int*)(F.ws + (dummy ? WS_YS2 + 2 * MiB : WS_ELIST));
    unsigned* cnt = (unsigned*)(F.ctl + CW_CNT + (dummy ? 32 : 0));
    const int i16 = lane & 15, kq = lane >> 4;
    for (int tg = F.vcu; tg < M / 64; tg += F.G) {
        if (tid < 64) LC[tid] = 0;
        const int tok0 = tg * 64 + tt * 16;
        f32x4 a0 = {0.f, 0.f, 0.f, 0.f}, a1 = {0.f, 0.f, 0.f, 0.f}; float ssq = 0.f;
        const float* hp = Hf + (size_t)(tok0 + i16) * DM + kh * 512 + 4 * kq; const float* w0 = wrT + (size_t)i16 * DM + kh * 512 + 4 * kq; const float* w1 = w0 + 16 * DM;
#pragma unroll 8
        for (int s = 0; s < 32; ++s) { const f32x4 a = *(const f32x4*)(hp + 16 * s), b0 = *(const f32x4*)(w0 + 16 * s), b1 = *(const f32x4*)(w1 + 16 * s);
            ssq += (a[0] * a[0] + a[1] * a[1]) + (a[2] * a[2] + a[3] * a[3]);
#pragma unroll
            for (int q = 0; q < 4; ++q) { a0 = __builtin_amdgcn_mfma_f32_16x16x4f32(a[q], b0[q], a0, 0, 0, 0); a1 = __builtin_amdgcn_mfma_f32_16x16x4f32(a[q], b1[q], a1, 0, 0, 0); } }
        ssq += __shfl_xor(ssq, 16); ssq += __shfl_xor(ssq, 32);
        LAS float* lg = LG + (tt * 2 + kh) * 16 * 33;
#pragma unroll
        for (int r = 0; r < 4; ++r) { lg[(4 * kq + r) * 33 + i16] = a0[r]; lg[(4 * kq + r) * 33 + 16 + i16] = a1[r]; }
        if (kq == 0) SS[(tt * 2 + kh) * 16 + i16] = ssq;
        __syncthreads();
        int ti[4]; float wv[4]; int lpos[4]; float rsv = 0.f;
        if (tid < 64) {
            const int t4 = tid >> 4, t16 = tid & 15;
            rsv = 1.0f / sqrtf((SS[(t4 * 2) * 16 + t16] + SS[(t4 * 2 + 1) * 16 + t16]) * (1.0f / DM) + RMS_EPS);
            float lgv[32];
#pragma unroll
            for (int e = 0; e < 32; ++e) lgv[e] = (LG[((t4 * 2) * 16 + t16) * 33 + e] + LG[((t4 * 2 + 1) * 16 + t16) * 33 + e]) * rsv + br[e];
            float tv[4];
#pragma unroll
            for (int k = 0; k < 4; ++k) { float best = -3.0e38f; int bi = 0;
#pragma unroll
                for (int e = 0; e < 32; ++e) { const bool tk = lgv[e] > best; best = tk ? lgv[e] : best; bi = tk ? e : bi; }
                tv[k] = best; ti[k] = bi;
#pragma unroll
                for (int e = 0; e < 32; ++e) lgv[e] = (e == bi) ? -3.0e38f : lgv[e]; }
            const float e1 = __expf(tv[1] - tv[0]), e2 = __expf(tv[2] - tv[0]), e3 = __expf(tv[3] - tv[0]), den = 1.0f / (1.0f + e1 + e2 + e3);
            wv[0] = den; wv[1] = e1 * den; wv[2] = e2 * den; wv[3] = e3 * den;
#pragma unroll
            for (int k = 0; k < 4; ++k) lpos[k] = __hip_atomic_fetch_add(LC + ti[k], 1, __ATOMIC_RELAXED, __HIP_MEMORY_SCOPE_WORKGROUP);
        }
        __syncthreads();
        if (tid < 32) { const int c = LC[tid]; LC[32 + tid] = c ? (int)atomicAdd(cnt + tid * CW_CNT_STRIDE, (unsigned)c) : 0; }
        __syncthreads();
        if (tid < 64) {
            const int tok = tg * 64 + tid;
            rs2[tok] = rsv;
#pragma unroll
            for (int k = 0; k < 4; ++k) { elist[ti[k] * M + LC[32 + ti[k]] + lpos[k]] = tok * 4 + k; wslot[tok * 4 + k] = wv[k]; }
        }
        __syncthreads();
    }
}
__device__ __forceinline__ int moe_tables(Frame& F) {
    LAS int* T = (LAS int*)(F.lds + MOE_LDS_OFF); LAS int* cnt = T, *tstart = T + 32, *tile2e = T + 72;
    if (F.tid < 32) cnt[F.tid] = (int)__hip_atomic_load((unsigned*)(F.ctl + CW_CNT) + F.tid * CW_CNT_STRIDE, RLX_AGENT);
    __syncthreads();
    if (F.tid == 0) { int s = 0; for (int e = 0; e < 32; ++e) { tstart[e] = s; s += (cnt[e] + 255) >> 8; } tstart[32] = s; }
    __syncthreads();
    if (F.tid < 32) { for (int p = tstart[F.tid]; p < tstart[F.tid + 1]; ++p) tile2e[p] = F.tid; }
    __syncthreads();
    return tstart[32];
}
__device__ __forceinline__ void combine_phase(Frame& F, float* dst) {
    const int lane = F.lane, gw = F.vcu * NWAVES + F.wave, NGW = F.G * NWAVES;
    const unsigned char* YS2 = F.ws + WS_YS2;
    for (int tk = gw; tk < M; tk += NGW) {
        GAS f32x4* orow = (GAS f32x4*)(F.out + (size_t)tk * DM) + lane; GAS f32x4* drow = (GAS f32x4*)(dst + (size_t)tk * DM) + lane;
#pragma unroll
        for (int j = 0; j < 4; ++j) { f32x4 v = orow[64 * j];
#pragma unroll
            for (int k = 0; k < 4; ++k) { const unsigned y = *((const GAS unsigned*)(YS2 + (size_t)(tk * 4 + k) * DM) + lane + 64 * j);
                const f32x2 lo = __builtin_amdgcn_cvt_pk_f32_fp8(y, false), hi = __builtin_amdgcn_cvt_pk_f32_fp8(y, true); v += (f32x4){lo[0], lo[1], hi[0], hi[1]} * 0.0625f; }
            drow[64 * j] = v; }
    }
}

struct Args { const float* in[31]; float* out; unsigned char* ws; unsigned char* hi; int ph_lo, ph_hi; };
__global__ void __launch_bounds__(NWAVES * 64, 2) mk_fwd(Args args) {
    extern __shared__ __attribute__((aligned(16))) unsigned char lds[];
    Frame F;
    F.lds = (LAS unsigned char*)lds;
    F.MISC = (volatile LAS unsigned*)(F.lds + MISC_OFF);
    F.tid = threadIdx.x; F.lane = F.tid & 63; F.wave = __builtin_amdgcn_readfirstlane(F.tid >> 6);
    F.G = gridDim.x; { const int bx = blockIdx.x; F.vcu = (F.G % 8 == 0) ? (bx % 8) * (F.G / 8) + bx / 8 : bx; }
    F.ws = args.ws; F.hi = args.hi; F.ctl = (gu32*)(args.ws + WS_CTL); F.out = args.out;
#pragma unroll
    for (int i = 0; i < 31; ++i) F.in[i] = args.in[i];
    for (int u = F.tid; u < 64; u += NWAVES * 64) F.MISC[u] = 0u;
    __syncthreads();
    XcdBarrier bar; bar.bar = (unsigned*)(F.ctl + CW_BAR); bar.x = 0; bar.st = nullptr;
    if (N_LAUNCHES != PER_PHASE) bar = xcd_barrier_post((unsigned*)(F.ctl + CW_BAR), F.MISC + 8);
#define GRID_BAR() do { if (N_LAUNCHES != PER_PHASE) xcd_barrier(bar); } while (0)
    const int lo = args.ph_lo, hi = args.ph_hi;
#define IN(k) (lo <= (k) && (k) < hi)
#define BOTH(k) (IN(k) && IN((k) + 1))
    unsigned char* ws = args.ws; unsigned char* wsh = args.hi;

    if (IN(0)) { for (int rep = 0; rep < NREP(0); ++rep) { p0_prologue(F); if (BOTH(0)) GRID_BAR(); } }

    if (IN(1)) for (int rep = 0; rep < NREP(1); ++rep) {
        pg8::Gemm g{(const bf16*)(wsh + (WS_XN - HI)), (const bf16*)(wsh + (WS_WIN - HI)), M, IN_W, DM}; pg8::StaticOrder S; S.init(M, IN_W, F.G, (int)blockIdx.x);
        EpiInProj E{(bf16*)(ws + WS_U), (bf16*)(ws + WS_Q), (bf16*)(ws + WS_K), (bf16*)(ws + WS_V), (bf16*)(ws + WS_G1), (bf16*)(ws + WS_G2), F.in[I_BGATE], F.in[I_QG], F.in[I_KG]};
        pg8::gemm_phase<EpiInProj, pg8::StaticOrder, true>(F.lds + RING_OFF, g, S, E);
        if (BOTH(1)) GRID_BAR();
    }

    if (PROBE_REP == 30 && IN(1) && IN(2)) { GRID_BAR(); GRID_BAR(); GRID_BAR(); GRID_BAR(); }
    if (IN(2)) {
        for (int rep = 0; rep < NREP(20); ++rep) for (int u = F.vcu; u < BATCH * SSM_G; u += F.G) { const int g = (u >> 5) * 4 + ((u & 31) >> 3), b = u & 7; s5_unit(F, b, g); }
        float lam;
        { const float a = wave_sum(F.in[I_LQ1][F.lane] * F.in[I_LK1][F.lane]), c = wave_sum(F.in[I_LQ2][F.lane] * F.in[I_LK2][F.lane]); lam = __expf(a) - __expf(c) + LAMBDA_INIT; }
        for (int rep = 0; rep < NREP(21); ++rep) for (int u = F.vcu; u < BATCH * ATT_H * 8; u += F.G) { const int bh = u >> 3, qp = u & 7; attn_unit(F, bh >> 2, bh & 3, 15 - qp, lam); attn_unit(F, bh >> 2, bh & 3, qp, lam); }
        if (BOTH(2)) GRID_BAR();
    }

    if (IN(3)) for (int rep = 0; rep < NREP(3); ++rep) {
        { pg8::Gemm g{(const bf16*)(ws + WS_YG), (const bf16*)(ws + WS_WGLU), M, 512, 512}; pg8::StaticOrder S; S.init(M, 512, F.G, (int)blockIdx.x);
          EpiMix<0> E{(const bf16*)(ws + WS_YG), nullptr, (bf16*)(ws + WS_YS), F.in[I_BGLU], 512};
          pg8::gemm_phase<EpiMix<0>, pg8::StaticOrder, true>(F.lds + RING_OFF, g, S, E); }
        if (BOTH(3)) GRID_BAR();
    }

    if (IN(4)) for (int rep = 0; rep < NREP(4); ++rep) {
        pg8::Gemm g{(const bf16*)(ws + WS_OB), (const bf16*)(ws + WS_WPS), M, DM, 512};
        ChainOrder S; S.so.init(M, DM, F.G, (int)blockIdx.x); S.A_att = (const bf16*)(ws + WS_OB); S.A_ssm = (const bf16*)(ws + WS_YS);
        EpiChain E{(const bf16*)(ws + WS_G1), (const bf16*)(ws + WS_G2), (bf16*)(ws + WS_MX)};
        pg8::gemm_phase<EpiChain, ChainOrder, true>(F.lds + RING_OFF, g, S, E);
        if (BOTH(4)) GRID_BAR();
    }

    if (IN(5)) for (int rep = 0; rep < NREP(5); ++rep) {
        pg8::Gemm g{(const bf16*)(ws + WS_MX), (const bf16*)(ws + WS_WOUT), M, DM, DM}; pg8::StaticOrder S; S.init(M, DM, F.G, (int)blockIdx.x);
        EpiOut E{F.in[I_X], F.out, ws + WS_HB};
        pg8::gemm_phase<EpiOut, pg8::StaticOrder, true>(F.lds + RING_OFF, g, S, E);
        if (BOTH(5)) GRID_BAR();
    }

    if (IN(6)) { router_phase(F); if (BOTH(6)) GRID_BAR(); }

    if (IN(7)) for (int rep = 0; rep < NREP(7); ++rep) {
        const int nmt = moe_tables(F); LAS int* T = (LAS int*)(F.lds + MOE_LDS_OFF); unsigned* mflag = (unsigned*)(F.ctl + CW_MFLAG) + (rep ? 288 * MFLAG_STRIDE : 0);
        { pg8::Gemm g{(const bf16*)(ws + WS_HB), (const bf16*)(wsh + (WS_WUP - HI)), M, UPW, DM};
          MoeOrder<8, true> S{nmt * 8, F.G, F.vcu, T, T + 32, T + 72, (const int*)(ws + WS_ELIST), mflag};
          EpiUp E{ws + WS_ACT, F.in[I_BUP], (const float*)(ws + WS_RS2)};
          pg8::gemm_phase<EpiUp, MoeOrder<8, true>, true, true, true, true>(F.lds + RING_OFF, g, S, E, 0, 0); }
        { pg8::Gemm g{(const bf16*)(ws + WS_ACT), (const bf16*)(wsh + (WS_WDN - HI)), MOE_ROWS_MAX, DM, DE};
          MoeOrder<4, false> S{nmt * 4, F.G, F.G - 1 - F.vcu, T, T + 32, T + 72, (const int*)(ws + WS_ELIST), mflag};
          EpiDown E{ws + WS_YS2, F.in[I_BDN], (const float*)(ws + WS_WSLOT)};
          pg8::gemm_phase<EpiDown, MoeOrder<4, false>, true, true, true, true>(F.lds + RING_OFF, g, S, E, 0, 0); }
        if (BOTH(7)) GRID_BAR();
    }

    if (IN(9)) { combine_phase(F, F.out); }
    if (IN(16)) router_phase(F, true);
    if (IN(19)) combine_phase(F, (float*)(ws + WS_TA));
#undef IN
#undef BOTH
#undef GRID_BAR
}

extern "C" void kernel_launch(void* const* d_in, const int* in_sizes, int n_in, void* d_out, int out_size, void* d_ws, size_t ws_size, hipStream_t stream) {
    static int grid = 0;
    if (grid == 0) {
        if (n_in != 31 || in_sizes[0] != M * DM || out_size != M * DM || ws_size < WS_END) {
            fprintf(stderr, "kernel_launch: unexpected shapes (n_in %d, in0 %d, out %d, ws %zu < %zu); nothing launched\n", n_in, n_in > 0 ? in_sizes[0] : -1, out_size, ws_size, (size_t)WS_END); grid = -1; return; }
        int dev = 0, cus = 0;
        if (hipGetDevice(&dev) != hipSuccess || hipDeviceGetAttribute(&cus, hipDeviceAttributeMultiprocessorCount, dev) != hipSuccess) { grid = -1; return; }
        if (hipFuncSetAttribute((const void*)mk_fwd, hipFuncAttributeMaxDynamicSharedMemorySize, LDS_BYTES) != hipSuccess) { fprintf(stderr, "kernel_launch: hipFuncSetAttribute failed\n"); grid = -1; return; }
        int per_cu = 0;
        if (hipOccupancyMaxActiveBlocksPerMultiprocessor(&per_cu, (const void*)mk_fwd, NWAVES * 64, LDS_BYTES) != hipSuccess || per_cu < 1) fprintf(stderr, "kernel_launch: occupancy query reports %d\n", per_cu);
        (void)hipGetLastError();
        grid = cus;
    }
    if (grid < 0) return;
    (void)hipMemsetAsync((char*)d_ws + WS_CTL, 0, CTL_ZERO_BYTES, stream);
    Args a{};
    for (int i = 0; i < 31; ++i) a.in[i] = (const float*)d_in[i];
    a.out = (float*)d_out; a.ws = (unsigned char*)d_ws; a.hi = (unsigned char*)d_ws + ((ws_size - 256 * MiB) & ~(size_t)0xfffff);
    if (N_LAUNCHES == 1) { a.ph_lo = 0; a.ph_hi = PER_PHASE; hipLaunchKernelGGL(mk_fwd, dim3(grid), dim3(NWAVES * 64), LDS_BYTES, stream, a); }
    else for (int p = 0; p < PER_PHASE; ++p) { a.ph_lo = p; a.ph_hi = p + 1; if (PROBE_REP - 110 == p) { a.ph_lo = p + 10; a.ph_hi = p + 11; hipLaunchKernelGGL(mk_fwd, dim3(grid), dim3(NWAVES * 64), LDS_BYTES, stream, a); a.ph_lo = p; a.ph_hi = p + 1; }
        for (int rep = 0; rep < ((PROBE_REP - 100 == p) ? 2 : 1); ++rep) hipLaunchKernelGGL(mk_fwd, dim3(grid), dim3(NWAVES * 64), LDS_BYTES, stream, a); }
}
```

```cpp
#include <hip/hip_runtime.h>
#include <cstdio>
#include <cstdint>

#ifndef MK_N_LAUNCHES
#define MK_N_LAUNCHES 1
#endif
#ifndef PROBE_REP
#define PROBE_REP -1
#endif
#define NREP(k) ((PROBE_REP == (k)) ? 2 : 1)

namespace pg8 {
#define PG8_LAS __attribute__((address_space(3)))
typedef unsigned short bf16_t;
typedef short bf16x8 __attribute__((ext_vector_type(8)));
typedef float f32x4 __attribute__((ext_vector_type(4)));
typedef unsigned u32x4 __attribute__((ext_vector_type(4)));
typedef unsigned u32x2 __attribute__((ext_vector_type(2)));
constexpr int BM = 256, BK = 64, HALF = 128, HTB = HALF * BK * 2  , STAGE_BYTES = 8 * HTB, NXCD = 8, WGM = 8;

__host__ __device__ __forceinline__ int lds_byte(int r, int c) { const int st = (r >> 4) * 2 + (c >> 5), rr = r & 15, cc = c & 31, ob = rr * 64 + cc * 2; return st * 1024 + (ob ^ (((ob >> 9) & 1) * 48)); }
__host__ __device__ __forceinline__ void stage_rc(int b, int& R, int& C) { const int st = b / 1024, sb = b % 1024, swz = sb ^ (((sb >> 9) & 1) * 48); R = (st >> 1) * 16 + swz / 64; C = (st & 1) * 32 + (swz % 64) / 2; }
__host__ __device__ __forceinline__ int perm256(int R) { return 64 * ((R >> 5) & 3) + 16 * ((R >> 2) & 3) + 8 * (R >> 7) + 4 * ((R >> 4) & 1) + (R & 3); }
__host__ __device__ __forceinline__ int perm32(int rho) { const int n = rho >> 4, i = rho & 15; return 8 * (i >> 2) + 4 * n + (i & 3); }

struct Unit { int pm, pn; };
struct Gemm { const bf16_t* A; const bf16_t* Bt; int M, N, K; int bKT = 0; };

struct StaticOrder {
    int nM, nN, nwg, G, c;
    __host__ __device__ void init(int M, int N, int G_, int c_) { nM = M / BM; nN = N / BM; nwg = nM * nN; G = G_; c = c_; }
    __host__ __device__ __forceinline__ bool next(int i, Unit& u) const {
        const long L = (long)i * G + c; if (L >= nwg) return false;
        int wgid = (int)L; { const int q = nwg / NXCD, r = nwg % NXCD, xcd = wgid % NXCD, off = wgid / NXCD; wgid = (xcd < r ? xcd * (q + 1) : r * (q + 1) + (xcd - r) * q) + off; }
        const int nig = WGM * nN, gid = wgid / nig, fm = gid * WGM, gsz = (nM - fm) < WGM ? (nM - fm) : WGM;
        u.pm = fm + ((wgid % nig) % gsz); u.pn = (wgid % nig) / gsz; return true;
    }
    __device__ __forceinline__ int row_slot(const Unit&, int) const { return 0; }
    __device__ __forceinline__ const PG8_LAS int* slot_table() const { return nullptr; }
    __device__ __forceinline__ int a_row(const Unit& u, int r, int) const { return u.pm * BM + r; }
    __device__ __forceinline__ const char* a_base(const Gemm& g, const Unit& u, size_t tstep) const { return (const char*)g.A + (size_t)u.pm * tstep; }
    __device__ __forceinline__ void a_ready(const Unit&) const {}
    __device__ __forceinline__ void done(const Unit&) const {}
};

__device__ __forceinline__ unsigned cvt_pk_bf16(float lo, float hi) { unsigned r; asm volatile("v_cvt_pk_bf16_f32 %0, %1, %2" : "=v"(r) : "v"(lo), "v"(hi)); return r; }

typedef int v8i __attribute__((ext_vector_type(8)));
typedef int v4i __attribute__((ext_vector_type(4)));
template <class Epi, class Sched, bool ALIGN_EPI = false, bool ROWTAB = false, bool GATHER = false, bool FP8 = false>
__device__ __forceinline__ void gemm_phase(PG8_LAS unsigned char* lds, const Gemm g, const Sched& S, const Epi& E, const int sA8 = 0, const int sB8 = 0) {
    static_assert(!GATHER || ROWTAB, "GATHER needs ROWTAB");
    const int tid = threadIdx.x, wid = __builtin_amdgcn_readfirstlane(tid >> 6), lane = tid & 63, wr = wid >> 2, wc = wid & 3, fr = lane & 15, fq = lane >> 4;
    const int K = g.K, RB = FP8 ? K : 2 * K  , nt = RB / (2 * BK);
    unsigned voffA[2], voffB[2];
#pragma unroll
    for (int i = 0; i < 2; ++i) { int R, C; stage_rc(tid * 16 + i * 8192, R, C); const int Rb = (int)Epi::PERM == 2 ? perm256(R) : (int)Epi::PERM == 1 ? ((R & ~31) + perm32(R & 31)) : R;
        voffA[i] = (unsigned)(R * RB + 2 * C); voffB[i] = (unsigned)(Rb * (g.bKT ? 128 : RB) + 2 * C); }
    unsigned vA[2][2] = {{0u, 0u}, {0u, 0u}};
    const size_t kstep = (size_t)(BK * 2);
    const size_t hstep = (size_t)HALF * RB;
    const size_t tstep = 2 * hstep;
    const size_t kstepB = g.bKT ? (size_t)g.bKT * 128 : kstep, hstepB = (size_t)((int)Epi::PERM == 2 ? 8 : HALF) * (g.bKT ? (size_t)128 : (size_t)RB);
#define PG8_BBASE(u) (g.bKT ? (const char*)g.Bt + (size_t)((u).pn / (g.bKT / 256)) * ((size_t)g.bKT * RB) + (size_t)((u).pn % (g.bKT / 256)) * (256 * 128) : (const char*)g.Bt + (size_t)(u).pn * tstep)
    const unsigned ldsw = (unsigned)wid * 1024u;
    const int aoff = FP8 ? lds_byte(wr * 64 + fr, fq * 16) : lds_byte(wr * 64 + fr, fq * 8), boff = FP8 ? lds_byte(wc * 32 + fr, fq * 16) : lds_byte(wc * 32 + fr, fq * 8);
    const PG8_LAS int* tab = S.slot_table();
#define PG8_SA(b, h) (((b) * 2 + (h)) * HTB)
#define PG8_SB(b, h) ((4 + (b) * 2 + (h)) * HTB)
#define PG8_STAGE(bufoff, gbase, voff) do { _Pragma("unroll") for (int _i = 0; _i < 2; ++_i) \
        __builtin_amdgcn_global_load_lds((const unsigned*)((const char*)(gbase) + (voff)[_i]), (PG8_LAS unsigned*)(lds + (bufoff) + ldsw + _i * 8192), 16, 0, 0); } while (0)
#define PG8_STAGE_A(bufoff, kbase, h) do { if constexpr (GATHER) { PG8_STAGE(bufoff, kbase, vA[h]); } else { PG8_STAGE(bufoff, (kbase) + (h) * hstep, voffA); } } while (0)
#define PG8_LOAD_VA(sel, un) do { _Pragma("unroll") for (int _i = 0; _i < 2; ++_i) { int R_, C_; stage_rc(tid * 16 + _i * 8192, R_, C_); \
        _Pragma("unroll") for (int _h = 0; _h < 2; ++_h) { const int s_ = tab[(sel) * 256 + _h * HALF + R_]; vA[_h][_i] = (unsigned)(S.a_row(un, _h * HALF + R_, s_) * RB + 2 * C_); } } } while (0)
#define PG8_LDA(dst, b, h) do { _Pragma("unroll") for (int m = 0; m < 4; ++m) _Pragma("unroll") for (int k = 0; k < 2; ++k) dst[m][k] = *(const PG8_LAS bf16x8*)(lds + PG8_SA(b, h) + (FP8 ? (aoff ^ (16 * k)) : aoff + k * 1024) + m * 2048); } while (0)
#define PG8_LDB(dst, b, h) do { _Pragma("unroll") for (int n = 0; n < 2; ++n) _Pragma("unroll") for (int k = 0; k < 2; ++k) dst[n][k] = *(const PG8_LAS bf16x8*)(lds + PG8_SB(b, h) + (FP8 ? (boff ^ (16 * k)) : boff + k * 1024) + n * 2048); } while (0)
#define PG8_V8(x) __builtin_shufflevector(__builtin_bit_cast(v4i, (x)[0]), __builtin_bit_cast(v4i, (x)[1]), 0, 1, 2, 3, 4, 5, 6, 7)
#define PG8_MMA(ai, bj, At, Bt) do { __builtin_amdgcn_s_setprio(1); if constexpr (FP8) { _Pragma("unroll") for (int m = 0; m < 4; ++m) _Pragma("unroll") for (int n = 0; n < 2; ++n) \
        acc[ai][bj][m][n] = __builtin_amdgcn_mfma_scale_f32_16x16x128_f8f6f4(PG8_V8(Bt[n]), PG8_V8(At[m]), acc[ai][bj][m][n], 0, 0, 0, sB8, 0, sA8); } else { \
        _Pragma("unroll") for (int m = 0; m < 4; ++m) _Pragma("unroll") for (int n = 0; n < 2; ++n) _Pragma("unroll") for (int k = 0; k < 2; ++k) \
        acc[ai][bj][m][n] = __builtin_amdgcn_mfma_f32_16x16x32_bf16(Bt[n][k], At[m][k], acc[ai][bj][m][n], 0, 0, 0); } __builtin_amdgcn_s_setprio(0); } while (0)
#define PG8_WAIT_V(n) asm volatile("s_waitcnt vmcnt(" #n ")" ::: "memory")
#define PG8_WAIT_L(n) asm volatile("s_waitcnt lgkmcnt(" #n ")" ::: "memory")
#define PG8_BAR __builtin_amdgcn_s_barrier()
#define PG8_SCHED __builtin_amdgcn_sched_barrier(0)
    Unit cur, nxt; int ui = 0;
    if (!S.next(0, cur)) return;
    S.a_ready(cur);
    f32x4 acc[2][2][4][2];
#pragma unroll
    for (int a = 0; a < 2; ++a)
#pragma unroll
        for (int b = 0; b < 2; ++b)
#pragma unroll
            for (int m = 0; m < 4; ++m)
#pragma unroll
                for (int n = 0; n < 2; ++n) acc[a][b][m][n] = (f32x4){0.f, 0.f, 0.f, 0.f};
    bf16x8 At[4][2], B0[2][2], B1[2][2];
    if constexpr (GATHER) { PG8_LOAD_VA(0, cur); }
    const char* cA = GATHER ? (const char*)g.A : S.a_base(g, cur, tstep); const char* cB = PG8_BBASE(cur);
    PG8_STAGE(PG8_SB(0, 0), cB, voffB); PG8_STAGE(PG8_SB(0, 1), cB + hstepB, voffB); PG8_STAGE_A(PG8_SA(0, 0), cA, 0); PG8_STAGE_A(PG8_SA(0, 1), cA, 1);
    if (wr == 1) PG8_BAR;
    PG8_WAIT_V(2); PG8_BAR;
    PG8_STAGE(PG8_SB(1, 0), cB + kstepB, voffB); PG8_STAGE_A(PG8_SA(1, 0), cA + kstep, 0); PG8_STAGE(PG8_SB(1, 1), cB + hstepB + kstepB, voffB);
    PG8_WAIT_V(6); PG8_BAR;
    for (;;) {
        const bool has_next = S.next(ui + 1, nxt);
        const char* nA = has_next ? (GATHER ? (const char*)g.A : S.a_base(g, nxt, tstep)) : cA; const char* nB = has_next ? PG8_BBASE(nxt) : cB;
        for (int t = 0; t < nt; t += 2) {
            const bool last = (t == nt - 2);
            if (last && has_next) S.a_ready(nxt);
            const char* a1 = cA + (size_t)(t + 1) * kstep;
            const char* a2 = last ? nA : cA + (size_t)(t + 2) * kstep; const char* b2 = last ? nB : cB + (size_t)(t + 2) * kstepB;
            const char* a3 = a2 + kstep; const char* b3 = b2 + kstepB;
            PG8_LDB(B0, 0, 0); PG8_LDB(B1, 0, 1); PG8_SCHED; PG8_LDA(At, 0, 0); PG8_STAGE_A(PG8_SA(1, 1), a1, 1);
            if constexpr (GATHER) { if (last && has_next) { PG8_LOAD_VA(ui + 1, nxt); } }
            PG8_WAIT_V(8); PG8_WAIT_L(0); PG8_BAR; PG8_MMA(0, 0, At, B0); PG8_MMA(0, 1, At, B1); PG8_BAR; PG8_SCHED;
            PG8_LDA(At, 0, 1); PG8_STAGE(PG8_SB(0, 0), b2, voffB); PG8_STAGE(PG8_SB(0, 1), b2 + hstepB, voffB); PG8_STAGE_A(PG8_SA(0, 0), a2, 0);
            PG8_WAIT_V(8); PG8_WAIT_L(0); PG8_BAR; PG8_MMA(1, 0, At, B0); PG8_MMA(1, 1, At, B1); PG8_BAR; PG8_SCHED;
            PG8_LDB(B0, 1, 0); PG8_LDB(B1, 1, 1); PG8_SCHED; PG8_LDA(At, 1, 0); PG8_STAGE_A(PG8_SA(0, 1), a2, 1);
            PG8_WAIT_V(8); PG8_WAIT_L(0); PG8_BAR; PG8_MMA(0, 0, At, B0); PG8_MMA(0, 1, At, B1); PG8_BAR; PG8_SCHED;
            PG8_LDA(At, 1, 1); PG8_STAGE(PG8_SB(1, 0), b3, voffB); PG8_STAGE(PG8_SB(1, 1), b3 + hstepB, voffB); PG8_STAGE_A(PG8_SA(1, 0), a3, 0);
            PG8_WAIT_V(8); PG8_WAIT_L(0); PG8_BAR; PG8_MMA(1, 0, At, B0); PG8_MMA(1, 1, At, B1); PG8_BAR; PG8_SCHED;
        }
        if constexpr (ALIGN_EPI) { if (wr == 0) PG8_BAR; }
        E(acc, cur, wr, wc, fr, fq, ROWTAB ? tab + ui * 256 : tab);
        S.done(cur);
        if (!has_next) break;
        if (!E.keep(cur)) {
#pragma unroll
        for (int a = 0; a < 2; ++a)
#pragma unroll
            for (int b = 0; b < 2; ++b)
#pragma unroll
                for (int m = 0; m < 4; ++m)
#pragma unroll
                    for (int n = 0; n < 2; ++n) acc[a][b][m][n] = (f32x4){0.f, 0.f, 0.f, 0.f}; }
        cur = nxt; cA = nA; cB = nB; ++ui;
        if constexpr (ALIGN_EPI) { if (wr == 1) PG8_BAR; }
    }
    PG8_WAIT_V(0);
    if constexpr (!ALIGN_EPI) { if (wr == 0) PG8_BAR; }
    PG8_BAR;
#undef PG8_SA
#undef PG8_SB
#undef PG8_STAGE
#undef PG8_STAGE_A
#undef PG8_BBASE
#undef PG8_LOAD_VA
#undef PG8_LDA
#undef PG8_LDB
#undef PG8_MMA
#undef PG8_V8
#undef PG8_WAIT_V
#undef PG8_WAIT_L
#undef PG8_BAR
#undef PG8_SCHED
}
}

constexpr int NWAVES = 8;
constexpr int N_LAUNCHES = MK_N_LAUNCHES;
constexpr int PER_PHASE = 10;
constexpr int BATCH = 8, SEQ = 2048, DM = 1024, M = BATCH * SEQ;
constexpr int SSM_W = 512, SSM_G = 32, SSM_H = 16, SSM_P = 64, SSM_T = 16, SSM_NC = SEQ / SSM_T;
constexpr int ATT_H = 4, ATT_D = 64, ATT_V = 128, QK_W = 512, V_W = 512;
constexpr int IN_W = 4096;
constexpr int NE = 32, TOPK = 4, DE = 1024, UPW = 2048;
constexpr float RMS_EPS = 1e-6f;
constexpr float LAMBDA_INIT = 0.2f;
constexpr float QSCALE = 0.125f * 1.4426950408889634f;
constexpr int MOE_ROWS_MAX = M * TOPK + NE * 256;
constexpr int MOE_MT_MAX = MOE_ROWS_MAX / 256;

constexpr size_t MiB = 1u << 20;
constexpr size_t WS_CTL = 0, CTL_ZERO_BYTES = 256 * 1024;
constexpr size_t HI = (size_t)1 << 40;
constexpr size_t WS_WIN_OLD = 2 * MiB;
constexpr size_t WS_WGLU = 10 * MiB;
constexpr size_t WS_WPS = 11 * MiB;
constexpr size_t WS_WPA = 12 * MiB;
constexpr size_t WS_WOUT = 13 * MiB;
constexpr size_t WS_WRT = 15 * MiB;
constexpr size_t WS_S5 = 16 * MiB;
constexpr size_t WS_A16 = 24 * MiB;
constexpr size_t WS_WUP_OLD = 32 * MiB;
constexpr size_t WS_WDN_OLD = 160 * MiB;
constexpr size_t WS_XN_OLD = 224 * MiB;
constexpr size_t WS_U = 256 * MiB;
constexpr size_t WS_Q = 272 * MiB, WS_K = 288 * MiB, WS_V = 304 * MiB;
constexpr size_t WS_G1 = 320 * MiB, WS_G2 = 352 * MiB;
constexpr size_t WS_YG = 384 * MiB, WS_YS = 400 * MiB, WS_OB = 416 * MiB;
constexpr size_t WS_H16 = 432 * MiB;
constexpr size_t WS_TA = 432 * MiB, WS_MX = 464 * MiB;
constexpr size_t WS_HB = 496 * MiB;
constexpr size_t WS_RS2 = 528 * MiB;
constexpr size_t WS_WSLOT = 529 * MiB;
constexpr size_t WS_ELIST = 530 * MiB;
constexpr size_t WS_ACT = 544 * MiB;
constexpr size_t WS_YS2 = 32 * MiB;
constexpr size_t WS_YS2_OLD = 688 * MiB;
constexpr size_t WS_END = 1024 * MiB;
constexpr size_t WS_WUP = HI + 0 * MiB, WS_WDN = HI + 64 * MiB, WS_XN = HI + 96 * MiB, WS_WIN = HI + 128 * MiB;
constexpr int CW_BAR = 4096;
constexpr int CW_PANEL3 = 57344, CW_PANEL4 = 49152, CW_PANEL5 = 53248, PANEL_STRIDE = 16;
constexpr int CW_Q = 20480;
constexpr int CW_CNT = 16384;

constexpr int RING_OFF = 0, RING_BYTES = 139264;
constexpr int LDSCTL_OFF = RING_BYTES, MISC_OFF = LDSCTL_OFF;
constexpr int MOE_LDS_OFF = LDSCTL_OFF + 256;
constexpr int SLOT_OFF = 147456, SLOT_UNITS = 16;
constexpr int LDS_BYTES = 163840;

#define GAS __attribute__((address_space(1)))
#define LAS __attribute__((address_space(3)))
typedef unsigned short bf16;
typedef unsigned v4u __attribute__((ext_vector_type(4)));
typedef unsigned v2u __attribute__((ext_vector_type(2)));
typedef float f32x4 __attribute__((ext_vector_type(4)));
typedef float f32x16 __attribute__((ext_vector_type(16)));
typedef float f32x2 __attribute__((ext_vector_type(2)));
typedef short bf16x8 __attribute__((ext_vector_type(8)));
typedef short s16x4 __attribute__((ext_vector_type(4)));
typedef GAS unsigned gu32;
#define RLX_AGENT __ATOMIC_RELAXED, __HIP_MEMORY_SCOPE_AGENT
#define LDS_WAIT() asm volatile("s_waitcnt lgkmcnt(0)" ::: "memory")
#define VM_WAIT() asm volatile("s_waitcnt vmcnt(0)" ::: "memory")
using pg8::cvt_pk_bf16;
__device__ __forceinline__ unsigned f2bf(float f) { unsigned u = __builtin_bit_cast(unsigned, f); return (u + 0x7fffu + ((u >> 16) & 1u)) >> 16; }
__device__ __forceinline__ float xor32_max(float v) { const auto r = __builtin_amdgcn_permlane32_swap(__float_as_uint(v), __float_as_uint(v), false, false); return fmaxf(__uint_as_float(r[0]), __uint_as_float(r[1])); }
__device__ __forceinline__ float xor32_add(float v) { const auto r = __builtin_amdgcn_permlane32_swap(__float_as_uint(v), __float_as_uint(v), false, false); return __uint_as_float(r[0]) + __uint_as_float(r[1]); }
__device__ __forceinline__ float xor16_add(float v) { const auto r = __builtin_amdgcn_permlane16_swap(__float_as_uint(v), __float_as_uint(v), false, false); return __uint_as_float(r[0]) + __uint_as_float(r[1]); }
__device__ __forceinline__ unsigned pk4_fp8(float a, float b, float c, float d) { unsigned w = 0; w = __builtin_amdgcn_cvt_pk_fp8_f32(a, b, w, false); w = __builtin_amdgcn_cvt_pk_fp8_f32(c, d, w, true); return w; }
__device__ __forceinline__ float bf2f(unsigned b) { return __builtin_bit_cast(float, b << 16); }
__device__ __forceinline__ float bflo(unsigned w) { return __builtin_bit_cast(float, w << 16); }
__device__ __forceinline__ float bfhi(unsigned w) { return __builtin_bit_cast(float, w & 0xffff0000u); }
__device__ __forceinline__ float fsigmoid(float x) { return 1.0f / (1.0f + __expf(-x)); }
__device__ __forceinline__ float fsigmoid_fast(float x) { return __builtin_amdgcn_rcpf(1.0f + __builtin_amdgcn_exp2f(-1.4426950408889634f * x)); }
__device__ __forceinline__ float fsigmoid_asm(float x) { float r;
    asm volatile("v_mul_f32 %0, 0xbfb8aa3b, %1\n\ts_nop 0\n\tv_exp_f32 %0, %0\n\ts_nop 1\n\tv_add_f32 %0, 1.0, %0\n\ts_nop 0\n\tv_rcp_f32 %0, %0\n\ts_nop 1" : "=&v"(r) : "v"(x)); return r; }
__device__ __forceinline__ float gelu_tanh(float x) { const float z = 1.5957691216057308f * (x + 0.044715f * x * x * x); return x * fsigmoid_fast(z); }
__device__ __forceinline__ int crow(int r, int hi) { return (r & 3) + 8 * (r >> 2) + 4 * hi; }
__device__ __forceinline__ float wave_sum(float v) {
#pragma unroll
    for (int o = 1; o < 64; o <<= 1) v += __shfl_xor(v, o);
    return v;
}

#define XB_TMO      128
#define XB_XCNT(j)  (256  + 64 * (j))
#define XB_XSUB(j)  (1280 + 64 * (j))
#define XB_XGEN(j)  (2304 + 64 * (j))
#define XB_TOP      3328
#define XB_TOPGEN   3392
#define XCD_BAR_WORDS 3456
#define XB_SPIN_CAP (1u << 18)
__device__ __forceinline__ unsigned xb_ld(unsigned* p)              { return __hip_atomic_load(p, __ATOMIC_RELAXED, __HIP_MEMORY_SCOPE_AGENT); }
__device__ __forceinline__ unsigned xb_add(unsigned* p, unsigned v) { return __hip_atomic_fetch_add(p, v, __ATOMIC_RELAXED, __HIP_MEMORY_SCOPE_AGENT); }
__device__ __forceinline__ unsigned xb_xcc_id() { return (unsigned)__builtin_amdgcn_s_getreg((3 << 11) | 20) & 0xFu; }
#define XB_SPIN(cond, bar) do { unsigned _sp = 0; while (cond) { __builtin_amdgcn_s_sleep(1); \
    if ((++_sp & 255u) == 0u) { if (xb_ld(&(bar)[XB_TMO])) break; if (_sp > XB_SPIN_CAP) { atomicAdd(&(bar)[XB_TMO], 1u); break; } } } } while (0)
struct XcdBarrier { unsigned* bar; unsigned x; volatile LAS unsigned* st; };
__device__ __forceinline__ XcdBarrier xcd_barrier_post(unsigned* bar, volatile LAS unsigned* st) {
    XcdBarrier b; b.bar = bar; b.x = xb_xcc_id(); b.st = st;
    if (threadIdx.x == 0) (void)xb_add(&bar[XB_XCNT(b.x)], 1u);
    return b;
}
__device__ __forceinline__ void xcd_barrier_complete(unsigned* bar, unsigned x, unsigned& nloc, unsigned& nx) {
    const unsigned G = gridDim.x * gridDim.y * gridDim.z;
    unsigned sum, cnt, mine, sp = 0u;
    for (;;) {
        sum = 0u; cnt = 0u; mine = 0u;
#pragma unroll
        for (unsigned j = 0; j < 16; ++j) { const unsigned c = xb_ld(&bar[XB_XCNT(j)]); sum += c; cnt += (c > 0u) ? 1u : 0u; mine = (j == x) ? c : mine; }
        if (sum == G) break;
        __builtin_amdgcn_s_sleep(1);
        if ((++sp & 255u) == 0u) { if (xb_ld(&bar[XB_TMO])) break; if (sp > XB_SPIN_CAP) { atomicAdd(&bar[XB_TMO], 1u); break; } }
    }
    nloc = mine > 0u ? mine : 1u; nx = cnt > 0u ? cnt : 1u;
}
__device__ __forceinline__ void xcd_barrier(const XcdBarrier& b) {
    asm volatile("s_waitcnt vmcnt(0)" ::: "memory");
    __syncthreads();
    if (threadIdx.x == 0) {
        unsigned* bar = b.bar;
        __builtin_amdgcn_s_waitcnt(0);
        unsigned nloc = b.st[0], nx = b.st[1];
        if (nloc == 0u) { xcd_barrier_complete(bar, b.x, nloc, nx); b.st[0] = nloc; b.st[1] = nx; }
        const unsigned old = xb_add(&bar[XB_XSUB(b.x)], 1u);
        const unsigned gen = old / nloc;
        if (old + 1u == (gen + 1u) * nloc) {
            __builtin_amdgcn_fence(__ATOMIC_RELEASE, "agent");
            asm volatile("s_waitcnt vmcnt(0)" ::: "memory");
            const unsigned og = xb_add(&bar[XB_TOP], 1u);
            const unsigned tg = og / nx;
            if (og + 1u == (tg + 1u) * nx) xb_add(&bar[XB_TOPGEN], 1u);
            else XB_SPIN(xb_ld(&bar[XB_TOPGEN]) == tg, bar);
            __builtin_amdgcn_fence(__ATOMIC_ACQUIRE, "agent");
            xb_add(&bar[XB_XGEN(b.x)], 1u);
            asm volatile("s_waitcnt vmcnt(0)" ::: "memory");
        } else {
            XB_SPIN(xb_ld(&bar[XB_XGEN(b.x)]) == gen, bar);
            __builtin_amdgcn_fence(__ATOMIC_ACQUIRE, "agent");
            asm volatile("s_waitcnt vmcnt(0)" ::: "memory");
        }
    }
    __syncthreads();
}

struct Frame {
    LAS unsigned char* lds;
    volatile LAS unsigned* MISC;
    gu32* ctl;
    unsigned char* ws; unsigned char* hi;
    int tid, lane, wave;
    int vcu, G;
    const float* in[31];
    float* out;
};
enum { I_X = 0, I_N1G, I_WIN, I_BGATE, I_ARE, I_AIM, I_LOGDT, I_BRE, I_BIM, I_CRE, I_CIM, I_SSMD, I_WGLU, I_BGLU, I_QG, I_KG, I_LQ1, I_LK1, I_LQ2, I_LK2, I_SUBLN,
       I_WPS, I_WPA, I_WOUT, I_N2G, I_WR, I_BR, I_WUP, I_BUP, I_WDN, I_BDN };

template <int MODE>
__device__ __forceinline__ int physrow(int c) {
    if (MODE == 1) { const int w = c & 63; return (c & ~255) + 128 * (w >> 5) + 32 * ((c >> 6) & 3) + (w & 31); }
    if (MODE == 2) { const int j = c >> 1; return 256 * (j >> 7) + 128 * (c & 1) + (j & 127); }
    return c;
}
struct P0Item { const float* src; void* dst; const float* kscale; int N, K, mode, out8, k0, c0; };
__device__ __forceinline__ int physrow_rt(int mode, int c) { return mode == 1 ? physrow<1>(c) : (mode == 2 ? physrow<2>(c) : c); }
__device__ __forceinline__ void p0_item_load(const P0Item& d, f32x4 (&v)[16], int lane) {
    const int lr = lane >> 4, lc = lane & 15;
#pragma unroll
    for (int i = 0; i < 16; ++i) v[i] = __builtin_nontemporal_load((const f32x4*)(d.src + (size_t)(d.k0 + lr + 4 * i) * d.N + d.c0 + 4 * lc));
}
__device__ __forceinline__ void p0_item_finish(const P0Item& d, const f32x4 (&v)[16], LAS float* scr, int lane) {
    const int lr = lane >> 4, lc = lane & 15;
#pragma unroll
    for (int i = 0; i < 16; ++i) { const int k = lr + 4 * i; *(LAS f32x4*)(scr + k * 64 + 4 * (lc ^ ((k >> 3) & 7))) = v[i]; }
    LDS_WAIT(); asm volatile("" ::: "memory");
    const int a = lane & 7, bq = lane >> 3;
    float ks[8];
#pragma unroll
    for (int i = 0; i < 8; ++i) ks[i] = (d.kscale ? d.kscale[d.k0 + 8 * a + i] : 1.0f) * (d.out8 ? 32.0f : 1.0f);
#pragma unroll
    for (int j = 0; j < 8; ++j) { const int cl = bq + 8 * j; float x[8];
#pragma unroll
        for (int i = 0; i < 8; ++i) x[i] = scr[(8 * a + i) * 64 + 4 * ((cl >> 2) ^ a) + (cl & 3)] * ks[i];
        const size_t ro = (size_t)physrow_rt(d.mode, d.c0 + cl) * d.K + d.k0 + 8 * a;
        if (d.out8) { v2u o; o.x = pk4_fp8(x[0], x[1], x[2], x[3]); o.y = pk4_fp8(x[4], x[5], x[6], x[7]); __builtin_nontemporal_store(o, (GAS v2u*)((unsigned char*)d.dst + ro)); }
        else { v4u o; o.x = cvt_pk_bf16(x[0], x[1]); o.y = cvt_pk_bf16(x[2], x[3]); o.z = cvt_pk_bf16(x[4], x[5]); o.w = cvt_pk_bf16(x[6], x[7]); *(GAS v4u*)((bf16*)d.dst + ro) = o; } }
    LDS_WAIT(); asm volatile("" ::: "memory");
}
__device__ __forceinline__ void rms_row2_to_bf16(int lane, const float* xrow0, const float* xrow1, const float* g, bf16* orow0, bf16* orow1) {
    const GAS f32x4* xr0 = (const GAS f32x4*)xrow0 + lane; const GAS f32x4* xr1 = (const GAS f32x4*)xrow1 + lane; const GAS f32x4* gr = (const GAS f32x4*)g + lane;
    f32x4 v0[4], v1[4]; float s0 = 0.f, s1 = 0.f;
#pragma unroll
    for (int j = 0; j < 4; ++j) { v0[j] = xr0[64 * j]; v1[j] = xr1[64 * j]; }
#pragma unroll
    for (int j = 0; j < 4; ++j) { s0 += (v0[j].x * v0[j].x + v0[j].y * v0[j].y) + (v0[j].z * v0[j].z + v0[j].w * v0[j].w); s1 += (v1[j].x * v1[j].x + v1[j].y * v1[j].y) + (v1[j].z * v1[j].z + v1[j].w * v1[j].w); }
    const float rs0 = 1.0f / sqrtf(wave_sum(s0) * (1.f / DM) + RMS_EPS), rs1 = 1.0f / sqrtf(wave_sum(s1) * (1.f / DM) + RMS_EPS);
    GAS unsigned long long* o0 = (GAS unsigned long long*)orow0 + lane; GAS unsigned long long* o1 = (GAS unsigned long long*)orow1 + lane;
#pragma unroll
    for (int j = 0; j < 4; ++j) { const f32x4 gg = gr[64 * j];
        o0[64 * j] = (unsigned long long)cvt_pk_bf16(v0[j].x * rs0 * gg.x, v0[j].y * rs0 * gg.y) | ((unsigned long long)cvt_pk_bf16(v0[j].z * rs0 * gg.z, v0[j].w * rs0 * gg.w) << 32);
        o1[64 * j] = (unsigned long long)cvt_pk_bf16(v1[j].x * rs1 * gg.x, v1[j].y * rs1 * gg.y) | ((unsigned long long)cvt_pk_bf16(v1[j].z * rs1 * gg.z, v1[j].w * rs1 * gg.w) << 32); }
}
__device__ __forceinline__ void rms_row_to_bf16(int lane, const float* xrow, const float* g, bf16* orow) {
    const GAS f32x4* xr = (const GAS f32x4*)xrow + lane; const GAS f32x4* gr = (const GAS f32x4*)g + lane;
    f32x4 v[4]; float s = 0.f;
#pragma unroll
    for (int j = 0; j < 4; ++j) { v[j] = xr[64 * j]; s += (v[j].x * v[j].x + v[j].y * v[j].y) + (v[j].z * v[j].z + v[j].w * v[j].w); }
    const float rs = 1.0f / sqrtf(wave_sum(s) * (1.f / DM) + RMS_EPS);
    GAS unsigned long long* o8 = (GAS unsigned long long*)orow + lane;
#pragma unroll
    for (int j = 0; j < 4; ++j) { const f32x4 gg = gr[64 * j];
        o8[64 * j] = (unsigned long long)cvt_pk_bf16(v[j].x * rs * gg.x, v[j].y * rs * gg.y) | ((unsigned long long)cvt_pk_bf16(v[j].z * rs * gg.z, v[j].w * rs * gg.w) << 32); }
}
__device__ __forceinline__ void p0_s5_group(Frame& F, int g) {
    LAS float* AP = (LAS float*)(F.lds + RING_OFF);
    LAS float* BB = AP + 17 * 64 * 2;
    LAS float* CC = BB + 64 * 16 * 2;
    LAS float* KM = CC + 16 * 64 * 2;
    const float* are = F.in[I_ARE] + g * SSM_P; const float* aim = F.in[I_AIM] + g * SSM_P;
    const double dt = exp((double)F.in[I_LOGDT][g]);
    for (int e = F.tid; e < 17 * 64; e += NWAVES * 64) { const int m = e >> 6, p = e & 63; const double lr = are[p], li = aim[p];
        const double mag = exp(lr * dt * m), ang = li * dt * m; AP[e * 2] = (float)(mag * cos(ang)); AP[e * 2 + 1] = (float)(mag * sin(ang)); }
    for (int e = F.tid; e < 64 * 16; e += NWAVES * 64) { const int p = e >> 4, h = e & 15; const double lr = are[p], li = aim[p];
        const double mag = exp(lr * dt), ar = mag * cos(li * dt), ai = mag * sin(li * dt), den = lr * lr + li * li, nr = ar - 1.0, ni = ai;
        const double cr = (nr * lr + ni * li) / den, ci = (ni * lr - nr * li) / den;
        const double br = F.in[I_BRE][(size_t)(g * SSM_P + p) * SSM_H + h], bi = F.in[I_BIM][(size_t)(g * SSM_P + p) * SSM_H + h];
        BB[e * 2] = (float)(cr * br - ci * bi); BB[e * 2 + 1] = (float)(cr * bi + ci * br); }
    for (int e = F.tid; e < 16 * 64; e += NWAVES * 64) { CC[e * 2] = F.in[I_CRE][(size_t)g * 1024 + e]; CC[e * 2 + 1] = F.in[I_CIM][(size_t)g * 1024 + e]; }
    __syncthreads();
    if (F.tid < 64) { float* a16 = (float*)(F.ws + WS_A16) + (g * 64 + F.tid) * 2; a16[0] = AP[(16 * 64 + F.tid) * 2]; a16[1] = AP[(16 * 64 + F.tid) * 2 + 1]; }
    for (int e = F.tid; e < 16 * 256; e += NWAVES * 64) { const int m = e >> 8, ho = (e >> 4) & 15, hi = e & 15; float s = 0.f;
        for (int p = 0; p < 64; ++p) { const float cr = CC[(ho * 64 + p) * 2], ci = CC[(ho * 64 + p) * 2 + 1], ar = AP[(m * 64 + p) * 2], ai = AP[(m * 64 + p) * 2 + 1];
            const float tr = cr * ar - ci * ai, ti = cr * ai + ci * ar; s += tr * BB[(p * 16 + hi) * 2] - ti * BB[(p * 16 + hi) * 2 + 1]; }
        KM[e] = s; }
    __syncthreads();
    bf16* W1T = (bf16*)(F.ws + WS_S5 + (size_t)g * 262144); bf16* M2T = W1T + 128 * 256; bf16* W3T = M2T + 256 * 256;
    for (int e = F.tid; e < 128 * 256; e += NWAVES * 64) { const int n = e >> 8, k = e & 255, p = n & 63, j = k >> 4, hi = k & 15;
        const float ar = AP[((15 - j) * 64 + p) * 2], ai = AP[((15 - j) * 64 + p) * 2 + 1], br = BB[(p * 16 + hi) * 2], bi = BB[(p * 16 + hi) * 2 + 1];
        W1T[e] = (bf16)f2bf(n < 64 ? ar * br - ai * bi : ar * bi + ai * br); }
    for (int e = F.tid; e < 256 * 128; e += NWAVES * 64) { const int n = e >> 7, k = e & 127, i = n >> 4, ho = n & 15, p = k & 63;
        const float cr = CC[(ho * 64 + p) * 2], ci = CC[(ho * 64 + p) * 2 + 1], ar = AP[((i + 1) * 64 + p) * 2], ai = AP[((i + 1) * 64 + p) * 2 + 1];
        W3T[e] = (bf16)f2bf(k < 64 ? cr * ar - ci * ai : -(cr * ai + ci * ar)); }
    const float* dsk = F.in[I_SSMD] + g * 16;
    for (int e = F.tid; e < 256 * 256; e += NWAVES * 64) { const int n = e >> 8, k = e & 255, i = n >> 4, ho = n & 15, j = k >> 4, hi = k & 15;
        float v = 0.f; if (j <= i) { v = KM[((i - j) * 16 + ho) * 16 + hi]; if (i == j && ho == hi) v += dsk[ho]; }
        M2T[e] = (bf16)f2bf(v); }
    __syncthreads();
}
struct BigItem { const float* W; unsigned char* WT; const float* kscale; int N, K, mode, k0, c0; };
__device__ __forceinline__ void p0_big_load(const BigItem& d, f32x4 (&v)[16], int lane, int w) {
#pragma unroll
    for (int i = 0; i < 16; ++i) v[i] = __builtin_nontemporal_load((const f32x4*)(d.W + (size_t)(d.k0 + 16 * w + i) * d.N + d.c0 + 4 * lane));
}
__device__ __forceinline__ void p0_big_put(Frame& F, const f32x4 (&v)[16]) {
    LAS float* T = (LAS float*)(F.lds + RING_OFF); const int lane = F.lane, w = F.wave;
#pragma unroll
    for (int i = 0; i < 16; ++i) { const int k = 16 * w + i; *(LAS f32x4*)(T + k * 256 + 4 * (lane ^ (w & 7))) = v[i]; }
}
__device__ __forceinline__ void p0_big_emit(Frame& F, const BigItem& d) {
    LAS float* T = (LAS float*)(F.lds + RING_OFF); const int lane = F.lane, w = F.wave, r8 = lane >> 3, kc = lane & 7;
    float ksv[16];
#pragma unroll
    for (int i = 0; i < 16; ++i) ksv[i] = d.kscale ? d.kscale[d.k0 + 16 * kc + i] * 32.0f : 32.0f;
#pragma unroll
    for (int st = 0; st < 4; ++st) { const int cl = 32 * w + 8 * st + r8, chunk = cl >> 2, sub = cl & 3;
        float x[16];
#pragma unroll
        for (int i = 0; i < 16; ++i) x[i] = T[(16 * kc + i) * 256 + 4 * (chunk ^ kc) + sub] * ksv[i];
        v4u o; o.x = pk4_fp8(x[0], x[1], x[2], x[3]); o.y = pk4_fp8(x[4], x[5], x[6], x[7]); o.z = pk4_fp8(x[8], x[9], x[10], x[11]); o.w = pk4_fp8(x[12], x[13], x[14], x[15]);
        const int pr = d.mode == 2 ? physrow<2>(d.c0 + cl) : d.c0 + cl;
        __builtin_nontemporal_store(o, (GAS v4u*)(d.WT + ((size_t)(d.k0 >> 7) * d.N + pr) * 128 + 16 * kc)); }
}
constexpr int BI_UP1 = (DM / 128) * (UPW / 256), BI_DN1 = (DE / 128) * (DM / 256), NBIG = NE * (BI_UP1 + BI_DN1);
#ifndef BIG_SPLIT_AT
#define BIG_SPLIT_AT 2560
#endif
constexpr int BIG_SPLIT = BIG_SPLIT_AT;
__device__ __forceinline__ void convert_big(Frame& F, const int seg, const int lo, const int hi) {
        LAS int* qs = (LAS int*)(F.lds + MOE_LDS_OFF);
#define BIG_DRAW(it) do { if (F.tid == 0) qs[0] = lo + (int)atomicAdd((unsigned*)(F.ctl + CW_Q) + 64 + 64 * seg, 1u); __syncthreads(); it = qs[0]; __syncthreads(); } while (0)
#define BIG_DECODE(it, d) do { if ((it) < NE * BI_UP1) { const int e_ = (it) / BI_UP1, q_ = (it) % BI_UP1; d.W = F.in[I_WUP] + (size_t)e_ * DM * UPW; d.WT = F.hi + (WS_WUP - HI) + (size_t)e_ * UPW * DM; d.kscale = F.in[I_N2G]; \
            d.N = UPW; d.K = DM; d.mode = 2; d.k0 = 128 * (q_ / (UPW / 256)); d.c0 = 256 * (q_ % (UPW / 256)); } \
        else { const int r_ = (it) - NE * BI_UP1, e_ = r_ / BI_DN1, q_ = r_ % BI_DN1; d.W = F.in[I_WDN] + (size_t)e_ * DE * DM; d.WT = F.hi + (WS_WDN - HI) + (size_t)e_ * DM * DE; d.kscale = nullptr; \
            d.N = DM; d.K = DE; d.mode = 0; d.k0 = 128 * (q_ / (DM / 256)); d.c0 = 256 * (q_ % (DM / 256)); } } while (0)
        int it, itn; BigItem d, dn; f32x4 v[16];
        BIG_DRAW(it);
        if (it < hi) { BIG_DECODE(it, d); p0_big_load(d, v, F.lane, F.wave);
            for (;;) {
                p0_big_put(F, v);
                BIG_DRAW(itn);
                const bool hasn = itn < hi;
                if (hasn) { BIG_DECODE(itn, dn); p0_big_load(dn, v, F.lane, F.wave); }
                p0_big_emit(F, d);
                __syncthreads();
                if (!hasn) break;
                d = dn; } }
#undef BIG_DRAW
#undef BIG_DECODE
}


__device__ __forceinline__ void p0_prologue(Frame& F) {
    if (F.vcu < SSM_G) p0_s5_group(F, F.vcu);
    LAS float* scr = (LAS float*)(F.lds + RING_OFF + F.wave * 16384);
    const int gw = F.vcu * NWAVES + F.wave, NGW = F.G * NWAVES;
    { float* wrT = (float*)(F.ws + WS_WRT); const float* wr = F.in[I_WR]; const float* g2 = F.in[I_N2G];
      for (int e = gw * 64 + F.lane; e < NE * DM; e += NGW * 64) { const int ex = e >> 10, k = e & 1023; wrT[e] = g2[k] * wr[k * NE + ex]; } }
    { bf16* XN = (bf16*)(F.hi + (WS_XN - HI)); int m = gw;
      for (; m + NGW < M; m += 2 * NGW) rms_row2_to_bf16(F.lane, F.in[I_X] + (size_t)m * DM, F.in[I_X] + (size_t)(m + NGW) * DM, F.in[I_N1G], XN + (size_t)m * DM, XN + (size_t)(m + NGW) * DM);
      if (m < M) rms_row_to_bf16(F.lane, F.in[I_X] + (size_t)m * DM, F.in[I_N1G], XN + (size_t)m * DM); }
    constexpr int IT_IN = (DM / 64) * (IN_W / 64), IT_GLU = (512 / 64) * (512 / 64), IT_PS = (512 / 64) * (DM / 64), IT_OUT = (DM / 64) * (DM / 64);
    constexpr int IT_UP1 = (DM / 64) * (UPW / 64), IT_DN1 = (DE / 64) * (DM / 64);
    constexpr int NITEMS = IT_IN + IT_GLU + 2 * IT_PS + IT_OUT;
#define P0_DECODE(it, d) do { int r_ = (it); int nb_; \
        if (r_ < IT_IN) { d.src = F.in[I_WIN]; d.dst = F.hi + (WS_WIN - HI); d.kscale = nullptr; d.N = IN_W; d.K = DM; d.mode = 1; d.out8 = 0; } \
        else if ((r_ -= IT_IN) < IT_GLU) { d.src = F.in[I_WGLU]; d.dst = F.ws + WS_WGLU; d.kscale = nullptr; d.N = 512; d.K = 512; d.mode = 0; d.out8 = 0; } \
        else if ((r_ -= IT_GLU) < IT_PS) { d.src = F.in[I_WPS]; d.dst = F.ws + WS_WPS; d.kscale = nullptr; d.N = DM; d.K = 512; d.mode = 0; d.out8 = 0; } \
        else if ((r_ -= IT_PS) < IT_PS) { d.src = F.in[I_WPA]; d.dst = F.ws + WS_WPA; d.kscale = nullptr; d.N = DM; d.K = 512; d.mode = 0; d.out8 = 0; } \
        else if ((r_ -= IT_PS) < IT_OUT) { d.src = F.in[I_WOUT]; d.dst = F.ws + WS_WOUT; d.kscale = nullptr; d.N = DM; d.K = DM; d.mode = 0; d.out8 = 0; } \
        else if ((r_ -= IT_OUT) < NE * IT_UP1) { const int e_ = r_ / IT_UP1; r_ -= e_ * IT_UP1; d.src = F.in[I_WUP] + (size_t)e_ * DM * UPW; d.dst = F.hi + (WS_WUP - HI) + (size_t)e_ * UPW * DM; d.kscale = F.in[I_N2G]; d.N = UPW; d.K = DM; d.mode = 2; d.out8 = 1; } \
        else { r_ -= NE * IT_UP1; const int e_ = r_ / IT_DN1; r_ -= e_ * IT_DN1; d.src = F.in[I_WDN] + (size_t)e_ * DE * DM; d.dst = F.hi + (WS_WDN - HI) + (size_t)e_ * DM * DE; d.kscale = nullptr; d.N = DM; d.K = DE; d.mode = 0; d.out8 = 1; } \
        nb_ = d.N / 64; d.k0 = 64 * (r_ / nb_); d.c0 = 64 * (r_ % nb_); } while (0)
    int qcur = 0, qend = 0;
#define P0_DRAW(it) do { if (qcur == qend) { unsigned q_ = 0; if (F.lane == 0) q_ = atomicAdd((unsigned*)(F.ctl + CW_Q), 1u); qcur = 8 * (int)__builtin_amdgcn_readfirstlane(q_); qend = qcur + 8; } it = qcur++; } while (0)
    {
        P0Item dA, dB; f32x4 vA[16], vB[16]; int itA, itB;
        P0_DRAW(itA);
        if (itA < NITEMS) { P0_DECODE(itA, dA); p0_item_load(dA, vA, F.lane);
            for (;;) {
                P0_DRAW(itB); const bool hasB = itB < NITEMS;
                if (hasB) { P0_DECODE(itB, dB); p0_item_load(dB, vB, F.lane); }
                p0_item_finish(dA, vA, scr, F.lane);
                if (!hasB) break;
                P0_DRAW(itA); const bool hasA = itA < NITEMS;
                if (hasA) { P0_DECODE(itA, dA); p0_item_load(dA, vA, F.lane); }
                p0_item_finish(dB, vB, scr, F.lane);
                if (!hasA) break;
            } }
    }
#undef P0_DECODE
#undef P0_DRAW
    __syncthreads();
    convert_big(F, 0, 0, BIG_SPLIT);
}

typedef const pg8::f32x4 (&AccRef)[2][2][4][2];
__device__ __forceinline__ v4u pack8(const f32x4 a, const f32x4 b) { v4u w; w.x = cvt_pk_bf16(a[0], a[1]); w.y = cvt_pk_bf16(a[2], a[3]); w.z = cvt_pk_bf16(b[0], b[1]); w.w = cvt_pk_bf16(b[2], b[3]); return w; }
__device__ __forceinline__ void unpack8(const v4u w, f32x4& a, f32x4& b) { a = (f32x4){bflo(w.x), bfhi(w.x), bflo(w.y), bfhi(w.y)}; b = (f32x4){bflo(w.z), bfhi(w.z), bflo(w.w), bfhi(w.w)}; }

struct EpiInProj {
    static constexpr bool PERM = true;
    __device__ __forceinline__ bool keep(const pg8::Unit&) const { return false; }
    bf16 *U, *Q, *Kb, *V, *G1, *G2; const float *bgate, *qg, *kg;
    __device__ __forceinline__ void operator()(AccRef acc, const pg8::Unit& u, int wr, int wc, int fr, int fq, const LAS int*) const {
        const int pn = u.pn, row0 = u.pm * 256 + wr * 64 + fr;
        if (pn < 2) {
#pragma unroll
            for (int ai = 0; ai < 2; ++ai)
#pragma unroll
                for (int m = 0; m < 4; ++m) { const int row = row0 + ai * 128 + m * 16, b = row >> 11, t = row & 2047;
#pragma unroll
                    for (int bj = 0; bj < 2; ++bj) { const int lc = 256 * pn + 64 * wc + 32 * bj + 8 * fq, g = lc >> 4, ch = lc & 15;
                        *(v4u*)(U + ((size_t)(b * SSM_G + g) * SEQ + t) * 16 + ch) = pack8(acc[ai][bj][m][0], acc[ai][bj][m][1]); } }
        } else if (pn < 6) {
            const bool isq = pn < 4; const float* gv = isq ? qg : kg; const float sc = isq ? QSCALE : 1.0f;
            bf16* dst = (isq ? Q : Kb) + 256 * (pn - (isq ? 2 : 4)) + 64 * wc + 8 * fq;
            f32x4 gg[2][2];
#pragma unroll
            for (int bj = 0; bj < 2; ++bj)
#pragma unroll
                for (int n = 0; n < 2; ++n) gg[bj][n] = *(const f32x4*)(gv + 32 * bj + 8 * fq + 4 * n) * sc;
#pragma unroll
            for (int ai = 0; ai < 2; ++ai)
#pragma unroll
                for (int m = 0; m < 4; ++m) { const int row = row0 + ai * 128 + m * 16; float ss = 0.f;
#pragma unroll
                    for (int bj = 0; bj < 2; ++bj)
#pragma unroll
                        for (int n = 0; n < 2; ++n) { const f32x4 x = acc[ai][bj][m][n]; ss += (x[0] * x[0] + x[1] * x[1]) + (x[2] * x[2] + x[3] * x[3]); }
                    ss = xor16_add(ss); ss = xor32_add(ss);
                    const float rs = __builtin_amdgcn_rsqf(ss * (1.0f / 64.0f) + RMS_EPS);
#pragma unroll
                    for (int bj = 0; bj < 2; ++bj) *(v4u*)(dst + (size_t)row * 512 + 32 * bj) = pack8(acc[ai][bj][m][0] * rs * gg[bj][0], acc[ai][bj][m][1] * rs * gg[bj][1]); }
        } else if (pn < 8) {
            bf16* dst = V + 256 * (pn - 6) + 64 * wc + 8 * fq;
#pragma unroll
            for (int ai = 0; ai < 2; ++ai)
#pragma unroll
                for (int m = 0; m < 4; ++m) { const int row = row0 + ai * 128 + m * 16;
#pragma unroll
                    for (int bj = 0; bj < 2; ++bj) *(v4u*)(dst + (size_t)row * 512 + 32 * bj) = pack8(acc[ai][bj][m][0], acc[ai][bj][m][1]); }
        } else {
            const int gc = 256 * (pn - 8) + 64 * wc + 8 * fq;
            bf16* dst = (gc < 1024 ? G1 + gc : G2 + (gc - 1024));
            f32x4 bb[2][2];
#pragma unroll
            for (int bj = 0; bj < 2; ++bj)
#pragma unroll
                for (int n = 0; n < 2; ++n) bb[bj][n] = *(const f32x4*)(bgate + gc + 32 * bj + 4 * n);
#pragma unroll
            for (int ai = 0; ai < 2; ++ai)
#pragma unroll
                for (int m = 0; m < 4; ++m) { const int row = row0 + ai * 128 + m * 16;
#pragma unroll
                    for (int bj = 0; bj < 2; ++bj) { f32x4 a = acc[ai][bj][m][0] + bb[bj][0], b = acc[ai][bj][m][1] + bb[bj][1];
#pragma unroll
                        for (int e = 0; e < 4; ++e) { a[e] = fsigmoid_asm(a[e]); b[e] = fsigmoid_asm(b[e]); }
                        *(v4u*)(dst + (size_t)row * 1024 + 32 * bj) = pack8(a, b); } }
        }
    }
};
template <int MODE> struct EpiMix {
    static constexpr bool PERM = true;
    __device__ __forceinline__ bool keep(const pg8::Unit&) const { return false; }
    const bf16* P0; const bf16* P1; bf16* O; const float* bias; int ld;
    __device__ __forceinline__ void operator()(AccRef acc, const pg8::Unit& u, int wr, int wc, int fr, int fq, const LAS int*) const {
        const int row0 = u.pm * 256 + wr * 64 + fr, col0 = u.pn * 256 + wc * 32 + 8 * fq;
        f32x4 bb[2][2];
#pragma unroll
        for (int bj = 0; bj < 2; ++bj)
#pragma unroll
            for (int n = 0; n < 2; ++n) bb[bj][n] = (MODE == 0) ? *(const f32x4*)(bias + col0 + bj * 128 + 4 * n) : (f32x4){0.f, 0.f, 0.f, 0.f};
#pragma unroll
        for (int ai = 0; ai < 2; ++ai) {
            v4u q0[4][2], q1[4][2];
#pragma unroll
            for (int m = 0; m < 4; ++m)
#pragma unroll
                for (int bj = 0; bj < 2; ++bj) { const size_t off = (size_t)(row0 + ai * 128 + m * 16) * ld + col0 + bj * 128; q0[m][bj] = *(const v4u*)(P0 + off); if (MODE == 2) q1[m][bj] = *(const v4u*)(P1 + off); }
#pragma unroll
            for (int m = 0; m < 4; ++m) { const size_t off = (size_t)(row0 + ai * 128 + m * 16) * ld + col0;
#pragma unroll
                for (int bj = 0; bj < 2; ++bj) { f32x4 a = acc[ai][bj][m][0], b = acc[ai][bj][m][1], p0a, p0b;
                    unpack8(q0[m][bj], p0a, p0b);
                    if (MODE == 0) { a += bb[bj][0]; b += bb[bj][1];
#pragma unroll
                        for (int e = 0; e < 4; ++e) { a[e] = p0a[e] * fsigmoid_fast(a[e]); b[e] = p0b[e] * fsigmoid_fast(b[e]); } }
                    else if (MODE == 1) { a *= p0a; b *= p0b; }
                    else { f32x4 p1a, p1b; unpack8(q1[m][bj], p1a, p1b); a = p0a + p1a * a; b = p0b + p1b * b; }
                    if (MODE == 0) __builtin_amdgcn_raw_buffer_store_b128(pack8(a, b), __builtin_amdgcn_make_buffer_rsrc(O, 0, M * 512 * 2, 0x00020000), (int)((off + bj * 128) * 2), 0, 16);
                    else *(v4u*)(O + off + bj * 128) = pack8(a, b); } } }
    }
};
__device__ __forceinline__ void panel_publish(unsigned* flag) {
    asm volatile("s_waitcnt vmcnt(0)" ::: "memory"); __builtin_amdgcn_s_barrier(); asm volatile("" ::: "memory");
    if (threadIdx.x == 0) __hip_atomic_fetch_add(flag, 1u, __ATOMIC_RELAXED, __HIP_MEMORY_SCOPE_AGENT);
}
__device__ __forceinline__ void panel_wait(unsigned* flag, unsigned want) {
    unsigned spins = 0;
    while (__hip_atomic_load(flag, __ATOMIC_RELAXED, __HIP_MEMORY_SCOPE_AGENT) < want && ++spins < (1u << 22)) __builtin_amdgcn_s_sleep(2);
    asm volatile("" ::: "memory");
}
struct PanelOrder {
    pg8::StaticOrder so; unsigned* wflag; unsigned* pflag;
    __device__ __forceinline__ bool next(int i, pg8::Unit& u) const { return so.next(i, u); }
    __device__ __forceinline__ int row_slot(const pg8::Unit&, int) const { return 0; }
    __device__ __forceinline__ const LAS int* slot_table() const { return nullptr; }
    __device__ __forceinline__ int a_row(const pg8::Unit& u, int r, int) const { return u.pm * 256 + r; }
    __device__ __forceinline__ const char* a_base(const pg8::Gemm& g, const pg8::Unit& u, size_t tstep) const { return (const char*)g.A + (size_t)u.pm * tstep; }
    __device__ __forceinline__ void a_ready(const pg8::Unit& u) const { if (wflag) panel_wait(wflag + u.pm * PANEL_STRIDE, 4u); }
    __device__ __forceinline__ void done(const pg8::Unit& u) const { if (pflag) panel_publish(pflag + u.pm * PANEL_STRIDE); }
};
struct EpiOut {
    static constexpr bool PERM = true;
    static constexpr int PID = 5;
    __device__ __forceinline__ bool keep(const pg8::Unit&) const { return false; }
    const float* X; bf16* H; unsigned char* HB; bool wt;
    __device__ __forceinline__ void operator()(AccRef acc, const pg8::Unit& u, int wr, int wc, int fr, int fq, const LAS int*) const {
        const int row0 = u.pm * 256 + wr * 64 + fr, col0 = u.pn * 256 + wc * 32 + 8 * fq;
#pragma unroll
        for (int ai = 0; ai < 2; ++ai) {
            f32x4 xv[4][2][2];
#pragma unroll
            for (int m = 0; m < 4; ++m)
#pragma unroll
                for (int bj = 0; bj < 2; ++bj)
#pragma unroll
                    for (int n = 0; n < 2; ++n) xv[m][bj][n] = __builtin_nontemporal_load((const f32x4*)(X + (size_t)(row0 + ai * 128 + m * 16) * DM + col0 + bj * 128 + n * 4));
#pragma unroll
            for (int m = 0; m < 4; ++m) { const size_t off = (size_t)(row0 + ai * 128 + m * 16) * DM + col0;
#pragma unroll
                for (int bj = 0; bj < 2; ++bj) { const f32x4 ha = xv[m][bj][0] + acc[ai][bj][m][0], hb = xv[m][bj][1] + acc[ai][bj][m][1]; const v4u hw = pack8(ha, hb);
                    if (wt) __builtin_amdgcn_raw_buffer_store_b128(hw, __builtin_amdgcn_make_buffer_rsrc(H, 0, M * DM * 2, 0x00020000), (int)((off + bj * 128) * 2), 0, 16);
                    else *(v4u*)(H + off + bj * 128) = hw;
                    v2u fb; fb.x = pk4_fp8(ha[0], ha[1], ha[2], ha[3]); fb.y = pk4_fp8(hb[0], hb[1], hb[2], hb[3]); *(v2u*)(HB + off + bj * 128) = fb; } } }
    }
};
struct ChainOrder {
    pg8::StaticOrder so; const bf16* A_att; const bf16* A_ssm; unsigned* pflag; unsigned* wflag;
    __device__ __forceinline__ bool next(int i, pg8::Unit& u) const { pg8::Unit t; if (!so.next(i >> 1, t)) return false; u.pm = t.pm; u.pn = (i & 1) ? t.pn : 4 + t.pn; return true; }
    __device__ __forceinline__ int row_slot(const pg8::Unit&, int) const { return 0; }
    __device__ __forceinline__ const LAS int* slot_table() const { return nullptr; }
    __device__ __forceinline__ int a_row(const pg8::Unit& u, int r, int) const { return u.pm * 256 + r; }
    __device__ __forceinline__ const char* a_base(const pg8::Gemm&, const pg8::Unit& u, size_t tstep) const { return (const char*)(u.pn >= 4 ? A_att : A_ssm) + (size_t)u.pm * tstep; }
    __device__ __forceinline__ void a_ready(const pg8::Unit& u) const { if (wflag && u.pn < 4) panel_wait(wflag + u.pm * PANEL_STRIDE, 2u); }
    __device__ __forceinline__ void done(const pg8::Unit& u) const { if (pflag && u.pn < 4) panel_publish(pflag + u.pm * PANEL_STRIDE); }
};
struct EpiChain {
    static constexpr bool PERM = true;
    const bf16* G1; const bf16* G2; bf16* MX; bool wt;
    __device__ __forceinline__ bool keep(const pg8::Unit& u) const { return u.pn >= 4; }
    __device__ __forceinline__ void operator()(pg8::f32x4 (&acc)[2][2][4][2], const pg8::Unit& u, int wr, int wc, int fr, int fq, const LAS int*) const {
        const bool att = u.pn >= 4; const int row0 = u.pm * 256 + wr * 64 + fr, col0 = (u.pn & 3) * 256 + wc * 32 + 8 * fq;
#pragma unroll
        for (int ai = 0; ai < 2; ++ai) {
            v4u q1[4][2], q2[4][2];
#pragma unroll
            for (int m = 0; m < 4; ++m)
#pragma unroll
                for (int bj = 0; bj < 2; ++bj) { const size_t off = (size_t)(row0 + ai * 128 + m * 16) * DM + col0 + bj * 128; q1[m][bj] = *(const v4u*)(G1 + off); if (att) q2[m][bj] = *(const v4u*)(G2 + off); }
#pragma unroll
            for (int m = 0; m < 4; ++m)
#pragma unroll
                for (int bj = 0; bj < 2; ++bj) { f32x4 g1a, g1b; unpack8(q1[m][bj], g1a, g1b);
                    if (att) { f32x4 g2a, g2b; unpack8(q2[m][bj], g2a, g2b);
#pragma unroll
                        for (int e = 0; e < 4; ++e) { acc[ai][bj][m][0][e] *= g2a[e] * __builtin_amdgcn_rcpf(g1a[e]); acc[ai][bj][m][1][e] *= g2b[e] * __builtin_amdgcn_rcpf(g1b[e]); } }
                    else { const v4u o = pack8(acc[ai][bj][m][0] * g1a, acc[ai][bj][m][1] * g1b); const size_t eo = (size_t)(row0 + ai * 128 + m * 16) * DM + col0 + bj * 128;
                        if (wt) __builtin_amdgcn_raw_buffer_store_b128(o, __builtin_amdgcn_make_buffer_rsrc(MX, 0, M * DM * 2, 0x00020000), (int)(eo * 2), 0, 16); else *(v4u*)(MX + eo) = o; } } }
    }
};
constexpr int CW_MFLAG = 32768, MFLAG_STRIDE = 16;
static_assert((CW_MFLAG + 2 * 288 * MFLAG_STRIDE) * 4 <= (int)CTL_ZERO_BYTES && CW_MFLAG + 2 * 288 * MFLAG_STRIDE <= CW_PANEL4 && (CW_PANEL3 + 64 * PANEL_STRIDE) * 4 <= (int)CTL_ZERO_BYTES, "control words inside the per-call memset");
template <int NN, bool TOKROWS> struct MoeOrder {
    int nunits, G, vcu; const LAS int* cnt; const LAS int* tstart; const LAS int* tile2e; const int* elist; unsigned* mflag; LAS int* st;
    __device__ __forceinline__ const LAS int* slot_table() const { return st; }
    __device__ __forceinline__ void fill(int tid, const float* val) const {
        const int hi = tid >> 8, r = tid & 255;
#pragma unroll 1
        for (int j0 = 0; j0 < SLOT_UNITS / 2; j0 += 4) {
            int e0 = -2, e1 = -2, e2 = -2, e3 = -2; pg8::Unit u;
            if (next(2 * (j0 + 0) + hi, u)) e0 = row_slot(u, r);
            if (next(2 * (j0 + 1) + hi, u)) e1 = row_slot(u, r);
            if (next(2 * (j0 + 2) + hi, u)) e2 = row_slot(u, r);
            if (next(2 * (j0 + 3) + hi, u)) e3 = row_slot(u, r);
            const float v0 = e0 >= 0 ? val[TOKROWS ? (e0 >> 2) : e0] : 0.0f, v1 = e1 >= 0 ? val[TOKROWS ? (e1 >> 2) : e1] : 0.0f;
            const float v2 = e2 >= 0 ? val[TOKROWS ? (e2 >> 2) : e2] : 0.0f, v3 = e3 >= 0 ? val[TOKROWS ? (e3 >> 2) : e3] : 0.0f;
            if (e0 != -2) st[(2 * (j0 + 0) + hi) * 256 + r] = e0 < 0 ? -1 : (int)(((__float_as_uint(v0) + 0x8000u) & 0xFFFF0000u) | (unsigned)e0);
            if (e1 != -2) st[(2 * (j0 + 1) + hi) * 256 + r] = e1 < 0 ? -1 : (int)(((__float_as_uint(v1) + 0x8000u) & 0xFFFF0000u) | (unsigned)e1);
            if (e2 != -2) st[(2 * (j0 + 2) + hi) * 256 + r] = e2 < 0 ? -1 : (int)(((__float_as_uint(v2) + 0x8000u) & 0xFFFF0000u) | (unsigned)e2);
            if (e3 != -2) st[(2 * (j0 + 3) + hi) * 256 + r] = e3 < 0 ? -1 : (int)(((__float_as_uint(v3) + 0x8000u) & 0xFFFF0000u) | (unsigned)e3); } }
    __device__ __forceinline__ void a_ready(const pg8::Unit& u) const {
        if constexpr (!TOKROWS) { unsigned* f = mflag + u.pm * MFLAG_STRIDE; unsigned spins = 0;
            while (__hip_atomic_load(f, __ATOMIC_RELAXED, __HIP_MEMORY_SCOPE_AGENT) < 8u && ++spins < (1u << 22)) __builtin_amdgcn_s_sleep(2);
            asm volatile("" ::: "memory"); } }
    __device__ __forceinline__ void done(const pg8::Unit& u) const {
        if constexpr (TOKROWS) { asm volatile("s_waitcnt vmcnt(0)" ::: "memory"); __builtin_amdgcn_s_barrier(); asm volatile("" ::: "memory");
            if (threadIdx.x == 0) __hip_atomic_fetch_add(mflag + u.pm * MFLAG_STRIDE, 1u, __ATOMIC_RELAXED, __HIP_MEMORY_SCOPE_AGENT); } }
    __device__ __forceinline__ bool next(int i, pg8::Unit& u) const { const long L = (long)i * G + vcu; if (L >= nunits) return false; const int pm = (int)(L / NN), pnl = (int)(L % NN);
        u.pm = pm; u.pn = tile2e[pm] * NN + pnl; return true; }
    __device__ __forceinline__ int row_slot(const pg8::Unit& u, int r) const { const int e = u.pn / NN, pos = (u.pm - tstart[e]) * 256 + r; return pos < cnt[e] ? elist[e * M + pos] : -1; }
    __device__ __forceinline__ int a_row(const pg8::Unit& u, int r, int slot) const { return TOKROWS ? (slot < 0 ? 0 : ((slot & 0xFFFF) >> 2)) : u.pm * 256 + r; }
    __device__ __forceinline__ const char* a_base(const pg8::Gemm& g, const pg8::Unit&, size_t) const { return (const char*)g.A; }
};
struct EpiUp {
    static constexpr bool PERM = true;
    __device__ __forceinline__ bool keep(const pg8::Unit&) const { return false; }
    unsigned char* ACT; const float* bup; const float* rs2;
    __device__ __forceinline__ void operator()(AccRef acc, const pg8::Unit& u, int wr, int wc, int fr, int fq, const LAS int* tab) const {
        const int e = u.pn >> 3, pnl = u.pn & 7, j0 = 128 * pnl + 32 * wc + 8 * fq;
        f32x2 bG[2][2], bL[2][2];
#pragma unroll
        for (int q = 0; q < 4; ++q) { const f32x4 b4 = *(const f32x4*)(bup + (size_t)e * UPW + 2 * j0 + 4 * q); bG[q >> 1][q & 1] = (f32x2){b4[0], b4[2]}; bL[q >> 1][q & 1] = (f32x2){b4[1] * 4.0f + 4.0f, b4[3] * 4.0f + 4.0f}; }
        int sl[2][4];
#pragma unroll
        for (int ai = 0; ai < 2; ++ai)
#pragma unroll
            for (int m = 0; m < 4; ++m) sl[ai][m] = tab[ai * 128 + wr * 64 + m * 16 + fr];
#pragma unroll
        for (int ai = 0; ai < 2; ++ai)
#pragma unroll
            for (int m = 0; m < 4; ++m) { const int r = ai * 128 + wr * 64 + m * 16 + fr, en = sl[ai][m];
                if (en >= 0) { const float rs = __uint_as_float((unsigned)en & 0xFFFF0000u) * 0.03125f;
                    const f32x2 rsv = (f32x2){rs, rs}, rs4 = rsv * 4.0f; f32x2 o[2][2];
#pragma unroll
                    for (int n = 0; n < 2; ++n)
#pragma unroll
                        for (int p = 0; p < 2; ++p) {
                            f32x2 gl = (f32x2){acc[ai][0][m][n][2 * p], acc[ai][0][m][n][2 * p + 1]} * rsv + bG[n][p], li = (f32x2){acc[ai][1][m][n][2 * p], acc[ai][1][m][n][2 * p + 1]} * rs4 + bL[n][p];
                            gl.x = fminf(gl.x, 7.0f); gl.y = fminf(gl.y, 7.0f); li.x = __builtin_amdgcn_fmed3f(li.x, -24.0f, 32.0f); li.y = __builtin_amdgcn_fmed3f(li.y, -24.0f, 32.0f);
                            const f32x2 t = gl * (-1.702f * 1.4426950408889634f); f32x2 d = (f32x2){__builtin_amdgcn_exp2f(t.x), __builtin_amdgcn_exp2f(t.y)} + 1.0f;
                            d = (f32x2){__builtin_amdgcn_rcpf(d.x), __builtin_amdgcn_rcpf(d.y)};
                            o[n][p] = (gl * d) * li; }
                    const unsigned long long ov = (unsigned long long)pk4_fp8(o[0][0].x, o[0][0].y, o[0][1].x, o[0][1].y) | ((unsigned long long)pk4_fp8(o[1][0].x, o[1][0].y, o[1][1].x, o[1][1].y) << 32);
                    __hip_atomic_store((unsigned long long*)(ACT + (size_t)(u.pm * 256 + r) * DE + j0), ov, __ATOMIC_RELAXED, __HIP_MEMORY_SCOPE_AGENT); } }
    }
};
struct EpiDown {
    static constexpr int PERM = 2;
    __device__ __forceinline__ bool keep(const pg8::Unit&) const { return false; }
    unsigned char* YS2; const float* bdn; const float* wslot;
    __device__ __forceinline__ void operator()(AccRef acc, const pg8::Unit& u, int wr, int wc, int fr, int fq, const LAS int* tab) const {
        const int e = u.pn >> 2, pnl = u.pn & 3, c0 = 256 * pnl + 64 * wc + 16 * fq;
        f32x4 bb[2][2];
#pragma unroll
        for (int bj = 0; bj < 2; ++bj)
#pragma unroll
            for (int n = 0; n < 2; ++n) bb[bj][n] = *(const f32x4*)(bdn + (size_t)e * DM + c0 + bj * 8 + 4 * n);
        int sl[2][4]; float wv[2][4];
#pragma unroll
        for (int ai = 0; ai < 2; ++ai)
#pragma unroll
            for (int m = 0; m < 4; ++m) { const int en = tab[ai * 128 + wr * 64 + m * 16 + fr]; sl[ai][m] = en < 0 ? -1 : (en & 0xFFFF); wv[ai][m] = __uint_as_float((unsigned)en & 0xFFFF0000u); }
#pragma unroll
        for (int ai = 0; ai < 2; ++ai)
#pragma unroll
            for (int m = 0; m < 4; ++m) { const int slot = sl[ai][m];
                if (slot >= 0) { const float w = wv[ai][m] * 16.0f; v4u ov;
                    { const f32x4 ya = (acc[ai][0][m][0] * 0.0078125f + bb[0][0]) * w, yb = (acc[ai][0][m][1] * 0.0078125f + bb[0][1]) * w; ov.x = pk4_fp8(ya[0], ya[1], ya[2], ya[3]); ov.y = pk4_fp8(yb[0], yb[1], yb[2], yb[3]); }
                    { const f32x4 ya = (acc[ai][1][m][0] * 0.0078125f + bb[1][0]) * w, yb = (acc[ai][1][m][1] * 0.0078125f + bb[1][1]) * w; ov.z = pk4_fp8(ya[0], ya[1], ya[2], ya[3]); ov.w = pk4_fp8(yb[0], yb[1], yb[2], yb[3]); }
                    *(v4u*)(YS2 + (size_t)slot * DM + c0) = ov; } }
    }
};

constexpr int S5_UPITCH = 528, S5_SX_OFF = 128 * S5_UPITCH, S5_XPITCH = 132;
__device__ __forceinline__ void s5_unit(Frame& F, int b, int g) {
    LAS unsigned char* Uimg = F.lds + RING_OFF; LAS float* SX = (LAS float*)(F.lds + RING_OFF + S5_SX_OFF);
    const int tid = F.tid, lane = F.lane, w = F.wave, r32 = lane & 31, hi = lane >> 5;
    const bf16* Ug = (const bf16*)(F.ws + WS_U) + (size_t)(b * SSM_G + g) * SEQ * 16;
    const bf16* W1T = (const bf16*)(F.ws + WS_S5 + (size_t)g * 262144); const bf16* M2T = W1T + 128 * 256; const bf16* W3T = M2T + 256 * 256;
    bf16x8 bw1[16];
    { const int nt = w & 3;
#pragma unroll
      for (int ks = 0; ks < 16; ++ks) bw1[ks] = *(const bf16x8*)(W1T + (size_t)(32 * nt + r32) * 256 + 16 * ks + 8 * hi); }
#pragma unroll
    for (int j = 0; j < 8; ++j) { const int q = tid + 512 * j; *(LAS v4u*)(Uimg + (q >> 5) * S5_UPITCH + (q & 31) * 16) = *(const v4u*)(Ug + (size_t)q * 8); }
    __syncthreads();
    { const int nt = w & 3, mt0 = 2 * (w >> 2);
      f32x16 s0 = {0}, s1 = {0};
#pragma unroll
      for (int ks = 0; ks < 16; ++ks) {
          const bf16x8 bf = bw1[ks];
          const bf16x8 a0 = *(const LAS bf16x8*)(Uimg + (32 * mt0 + r32) * S5_UPITCH + (16 * ks + 8 * hi) * 2);
          const bf16x8 a1 = *(const LAS bf16x8*)(Uimg + (32 * (mt0 + 1) + r32) * S5_UPITCH + (16 * ks + 8 * hi) * 2);
          s0 = __builtin_amdgcn_mfma_f32_32x32x16_bf16(a0, bf, s0, 0, 0, 0); s1 = __builtin_amdgcn_mfma_f32_32x32x16_bf16(a1, bf, s1, 0, 0, 0); }
#pragma unroll
      for (int r = 0; r < 16; ++r) { SX[(32 * mt0 + crow(r, hi)) * S5_XPITCH + 32 * nt + r32] = s0[r]; SX[(32 * (mt0 + 1) + crow(r, hi)) * S5_XPITCH + 32 * nt + r32] = s1[r]; } }
    bf16x8 bm2[16], bw3[8];
#pragma unroll
    for (int ks = 0; ks < 16; ++ks) bm2[ks] = *(const bf16x8*)(M2T + (size_t)(32 * w + r32) * 256 + 16 * ks + 8 * hi);
#pragma unroll
    for (int ks = 0; ks < 8; ++ks) bw3[ks] = *(const bf16x8*)(W3T + (size_t)(32 * w + r32) * 128 + 16 * ks + 8 * hi);
    __syncthreads();
    if (tid < 64) {
        const float* a16 = (const float*)(F.ws + WS_A16) + (g * 64 + tid) * 2; const float ar = a16[0], ai = a16[1]; float xr = 0.f, xi = 0.f;
#pragma unroll 8
        for (int c = 0; c < SSM_NC; ++c) { const float sr = SX[c * S5_XPITCH + tid], si = SX[c * S5_XPITCH + 64 + tid];
            SX[c * S5_XPITCH + tid] = xr; SX[c * S5_XPITCH + 64 + tid] = xi;
            const float nr = ar * xr - ai * xi + sr, ni = ar * xi + ai * xr + si; xr = nr; xi = ni; }
    }
    __syncthreads();
    { f32x16 y[4] = {{0}, {0}, {0}, {0}};
#pragma unroll
      for (int ks = 0; ks < 16; ++ks) {
          const bf16x8 bf = bm2[ks];
#pragma unroll
          for (int mt = 0; mt < 4; ++mt) { const bf16x8 a = *(const LAS bf16x8*)(Uimg + (32 * mt + r32) * S5_UPITCH + (16 * ks + 8 * hi) * 2); y[mt] = __builtin_amdgcn_mfma_f32_32x32x16_bf16(a, bf, y[mt], 0, 0, 0); }
          }
#pragma unroll
      for (int ks = 0; ks < 8; ++ks) {
          const bf16x8 bf = bw3[ks];
#pragma unroll
          for (int mt = 0; mt < 4; ++mt) { const LAS f32x4* xp = (const LAS f32x4*)(SX + (32 * mt + r32) * S5_XPITCH + 16 * ks + 8 * hi); const f32x4 x0 = xp[0], x1 = xp[1];
              const v4u pk = pack8(x0, x1); y[mt] = __builtin_amdgcn_mfma_f32_32x32x16_bf16(__builtin_bit_cast(bf16x8, pk), bf, y[mt], 0, 0, 0); } }
      bf16* YG = (bf16*)(F.ws + WS_YG); const int i = 2 * w + (r32 >> 4), ho = r32 & 15;
#pragma unroll
      for (int mt = 0; mt < 4; ++mt)
#pragma unroll
          for (int r = 0; r < 16; ++r) { const int c = 32 * mt + crow(r, hi); YG[(size_t)(b * SEQ + 16 * c + i) * SSM_W + g * 16 + ho] = (bf16)f2bf(gelu_tanh(y[mt][r])); } }
    __syncthreads();
}

constexpr int AT_KP = 272, AT_VP = 320, AT_KB = 64 * AT_KP, AT_VB = 64 * AT_VP, AT_BUF = AT_KB + AT_VB;
__device__ __forceinline__ s16x4 vtr(const LAS unsigned char* p) { typedef short v4i16_t __attribute__((ext_vector_type(4))); return __builtin_bit_cast(s16x4, __builtin_amdgcn_ds_read_tr16_b64_v4i16((LAS v4i16_t*)p)); }
__device__ __forceinline__ void attn_unit(Frame& F, int b, int h, int qb, float lam) {
    const int tid = F.tid, lane = F.lane, w = F.wave, rg = w >> 1, t = w & 1, r32 = lane & 31, hi = lane >> 5;
    const bf16* Q = (const bf16*)(F.ws + WS_Q); const bf16* K = (const bf16*)(F.ws + WS_K); const bf16* V = (const bf16*)(F.ws + WS_V); bf16* OB = (bf16*)(F.ws + WS_OB);
    LAS unsigned char* L = F.lds + RING_OFF;
    const int qrow = b * SEQ + qb * 128 + rg * 32 + r32;
    bf16x8 qf[4];
#pragma unroll
    for (int ks = 0; ks < 4; ++ks) qf[ks] = *(const bf16x8*)(Q + (size_t)qrow * QK_W + h * 128 + t * 64 + 16 * ks + 8 * hi);
    const int ntile = 2 * qb + 2, mylim = 2 * qb + (rg >> 1);
    const int kr0 = tid >> 4, cc = tid & 15;
    const size_t gbase = (size_t)(b * SEQ) * 512 + h * 128 + cc * 8;
    v4u kregA[2], vregA[2], kregB[2], vregB[2];
#define AT_LOAD(j, kreg, vreg) do { _Pragma("unroll") for (int i_ = 0; i_ < 2; ++i_) { const size_t o_ = gbase + (size_t)(64 * (j) + kr0 + 32 * i_) * 512; kreg[i_] = *(const v4u*)(K + o_); vreg[i_] = *(const v4u*)(V + o_); } } while (0)
#define AT_STORE(buf, kreg, vreg) do { _Pragma("unroll") for (int i_ = 0; i_ < 2; ++i_) { *(LAS v4u*)(L + (buf) * AT_BUF + (kr0 + 32 * i_) * AT_KP + cc * 16) = kreg[i_]; \
        *(LAS v4u*)(L + (buf) * AT_BUF + AT_KB + (kr0 + 32 * i_) * AT_VP + cc * 16) = vreg[i_]; } } while (0)
    AT_LOAD(0, kregB, vregB); AT_LOAD(1, kregA, vregA); AT_STORE(0, kregB, vregB);
    __syncthreads();
    f32x16 o[4] = {{0}, {0}, {0}, {0}};
    float mrun = -60.0f, lrun = 0.f;
    f32x16 negm;
#pragma unroll
    for (int r = 0; r < 16; ++r) negm[r] = 60.0f;
    const int g4 = lane >> 4, i16 = lane & 15;
    const int vlane = (4 * (g4 >> 1) + (i16 >> 2)) * AT_VP + (16 * (g4 & 1) + 4 * (i16 & 3)) * 2;
#define AT_VREAD(s_, set) do { _Pragma("unroll") for (int dt_ = 0; dt_ < 4; ++dt_) { vlo[set][dt_] = vtr(Vb + (s_) * 16 * AT_VP + dt_ * 64); vhh[set][dt_] = vtr(Vb + (s_) * 16 * AT_VP + dt_ * 64 + 8 * AT_VP); } } while (0)
#define AT_EXPCHUNK(S, rb, dst) do { _Pragma("unroll") for (int r_ = 0; r_ < 8; ++r_) S[(rb) + r_] = __builtin_amdgcn_exp2f(S[(rb) + r_]); \
        ps += ((S[(rb)] + S[(rb) + 1]) + (S[(rb) + 2] + S[(rb) + 3])) + ((S[(rb) + 4] + S[(rb) + 5]) + (S[(rb) + 6] + S[(rb) + 7])); \
        dst.x = cvt_pk_bf16(S[(rb)], S[(rb) + 1]); dst.y = cvt_pk_bf16(S[(rb) + 2], S[(rb) + 3]); dst.z = cvt_pk_bf16(S[(rb) + 4], S[(rb) + 5]); dst.w = cvt_pk_bf16(S[(rb) + 6], S[(rb) + 7]); } while (0)
#define AT_COMPUTE(j, buf) do { \
        if (j <= mylim) { \
            const LAS unsigned char* Kb = L + buf * AT_BUF + t * 128 + hi * 16 + r32 * AT_KP; \
            const LAS unsigned char* Vb = L + buf * AT_BUF + AT_KB + vlane; \
            f32x16 s0, s1; bf16x8 kf0[4], kf1[4];        \
        _Pragma("unroll") \
            for (int ks = 0; ks < 4; ++ks) { kf0[ks] = *(const LAS bf16x8*)(Kb + ks * 32); kf1[ks] = *(const LAS bf16x8*)(Kb + 32 * AT_KP + ks * 32); } \
            __builtin_amdgcn_s_setprio(1); \
        _Pragma("unroll") \
            for (int ks = 0; ks < 4; ++ks) { \
                if (ks == 0) { s0 = __builtin_amdgcn_mfma_f32_32x32x16_bf16(kf0[0], qf[0], negm, 0, 0, 0); s1 = __builtin_amdgcn_mfma_f32_32x32x16_bf16(kf1[0], qf[0], negm, 0, 0, 0); } \
                else { s0 = __builtin_amdgcn_mfma_f32_32x32x16_bf16(kf0[ks], qf[ks], s0, 0, 0, 0); s1 = __builtin_amdgcn_mfma_f32_32x32x16_bf16(kf1[ks], qf[ks], s1, 0, 0, 0); } } \
            __builtin_amdgcn_s_setprio(0); \
            float mx = fmaxf(fmaxf(s0[0], s0[1]), s0[2]); \
        _Pragma("unroll") \
            for (int r = 3; r < 15; r += 2) mx = fmaxf(fmaxf(mx, s0[r]), s0[r + 1]); \
            mx = fmaxf(mx, s0[15]); \
        _Pragma("unroll") \
            for (int r = 0; r < 16; r += 2) mx = fmaxf(fmaxf(mx, s1[r]), s1[r + 1]); \
            mx = xor32_max(mx); \
            if (__builtin_amdgcn_ballot_w64(mx > 8.0f) != 0ull) { \
                const float dm = (mx > 8.0f) ? mx : 0.0f, alpha = __builtin_amdgcn_exp2f(-dm); lrun *= alpha; mrun += dm; \
        _Pragma("unroll") \
                for (int dt = 0; dt < 4; ++dt) o[dt] *= alpha; \
        _Pragma("unroll") \
                for (int r = 0; r < 16; ++r) { s0[r] -= dm; s1[r] -= dm; negm[r] = -mrun; } } \
            float ps = 0.f; v4u pkA, pkB; \
              \
            s16x4 vlo[2][4], vhh[2][4]; \
            AT_VREAD(0, 0); AT_EXPCHUNK(s0, 0, pkA); \
        _Pragma("unroll") \
            for (int s = 0; s < 4; ++s) { \
                const bf16x8 pf = __builtin_bit_cast(bf16x8, (s & 1) ? pkB : pkA); \
                __builtin_amdgcn_s_setprio(1); \
        _Pragma("unroll") \
                for (int dt = 0; dt < 4; ++dt) { const bf16x8 vf = (bf16x8){vlo[s & 1][dt][0], vlo[s & 1][dt][1], vlo[s & 1][dt][2], vlo[s & 1][dt][3], vhh[s & 1][dt][0], vhh[s & 1][dt][1], vhh[s & 1][dt][2], vhh[s & 1][dt][3]}; \
                    o[dt] = __builtin_amdgcn_mfma_f32_32x32x16_bf16(vf, pf, o[dt], 0, 0, 0); } \
                __builtin_amdgcn_s_setprio(0); \
                __builtin_amdgcn_sched_barrier(0); \
                if (s == 0) { AT_VREAD(1, 1); AT_EXPCHUNK(s0, 8, pkB); } else if (s == 1) { AT_VREAD(2, 0); AT_EXPCHUNK(s1, 0, pkA); } else if (s == 2) { AT_VREAD(3, 1); AT_EXPCHUNK(s1, 8, pkB); } \
                __builtin_amdgcn_sched_barrier(0); } \
            lrun += ps; \
        } \
    } while (0)
    for (int j = 0; j < ntile; j += 2) {
        { const int jn = (j + 2 < ntile) ? j + 2 : ntile - 1; AT_LOAD(jn, kregB, vregB); }
        AT_COMPUTE(j, 0);
        AT_STORE(1, kregA, vregA);
        __syncthreads();
        { const int jn = (j + 3 < ntile) ? j + 3 : ntile - 1; AT_LOAD(jn, kregA, vregA); }
        AT_COMPUTE(j + 1, 1);
        AT_STORE(0, kregB, vregB);
        __syncthreads();
    }
#undef AT_COMPUTE
#undef AT_EXPCHUNK
#undef AT_VREAD
#undef AT_LOAD
#undef AT_STORE
    const float ltot = lrun + __shfl_xor(lrun, 32), inv = 1.0f / ltot;
    LAS float* EX = (LAS float*)L + rg * 4096;
    if (t == 1) {
        const float sc = inv * lam;
#pragma unroll
        for (int dt = 0; dt < 4; ++dt)
#pragma unroll
            for (int r = 0; r < 16; ++r) EX[(dt * 16 + r) * 64 + lane] = o[dt][r] * sc;
    }
    __syncthreads();
    if (t == 0) {
        float ss = 0.f;
#pragma unroll
        for (int dt = 0; dt < 4; ++dt)
#pragma unroll
            for (int r = 0; r < 16; ++r) { const float y = o[dt][r] * inv - EX[(dt * 16 + r) * 64 + lane]; o[dt][r] = y; ss += y * y; }
        ss += __shfl_xor(ss, 32);
        const float rn = (1.0f - LAMBDA_INIT) / sqrtf(ss * (1.0f / 128.0f) + RMS_EPS);
        const float* sg = F.in[I_SUBLN];
        f32x4 ggv[4][4];
#pragma unroll
        for (int dt = 0; dt < 4; ++dt)
#pragma unroll
            for (int rq = 0; rq < 4; ++rq) ggv[dt][rq] = *(const f32x4*)(sg + 32 * dt + 8 * rq + 4 * hi);
#pragma unroll
        for (int dt = 0; dt < 4; ++dt)
#pragma unroll
            for (int rq = 0; rq < 4; ++rq) { const int d = 32 * dt + 8 * rq + 4 * hi; const f32x4 gg = ggv[dt][rq];
                v2u wv; wv.x = cvt_pk_bf16(o[dt][4 * rq] * rn * gg[0], o[dt][4 * rq + 1] * rn * gg[1]); wv.y = cvt_pk_bf16(o[dt][4 * rq + 2] * rn * gg[2], o[dt][4 * rq + 3] * rn * gg[3]);
                *(v2u*)(OB + (size_t)qrow * V_W + h * 128 + d) = wv; }
    }
    __syncthreads();
}

constexpr int CW_CNT_STRIDE = 64;
__device__ __forceinline__ void router_phase(Frame& F, const bool dummy = false, const int tg_only = -1, unsigned* wflag = nullptr) {
    const int lane = F.lane, tid = F.tid, w = F.wave, tt = w >> 1, kh = w & 1;
    LAS unsigned char* WL = F.lds + RING_OFF; constexpr int WLP = 4112;
    LAS float* LG = (LAS float*)(F.lds + LDSCTL_OFF + 2048);
    LAS float* SS = LG + 4 * 2 * 16 * 33;
    LAS int* LC = (LAS int*)(SS + 128);
    const bf16* Hf = (const bf16*)(F.ws + WS_H16); const float* br = F.in[I_BR];
    float* rs2 = (float*)(F.ws + (dummy ? WS_YS2 : WS_RS2)); float* wslot = (float*)(F.ws + (dummy ? WS_YS2 + MiB : WS_WSLOT)); int* elist = (int*)(F.ws + (dummy ? WS_YS2 + 2 * MiB : WS_ELIST));
    unsigned* cnt = (unsigned*)(F.ctl + CW_CNT + (dummy ? 32 : 0));
    const int i16 = lane & 15, kq = lane >> 4;
    { const float* wrT = (const float*)(F.ws + WS_WRT);
#pragma unroll
      for (int i = 0; i < 16; ++i) { const int q = tid + 512 * i; *(LAS f32x4*)(WL + (q >> 8) * WLP + (q & 255) * 16) = *(const f32x4*)(wrT + (size_t)q * 4); } }
    if (wflag) panel_wait(wflag, 4u);
    __syncthreads();
    for (int tg = tg_only >= 0 ? tg_only : F.vcu; tg < M / 64; tg += tg_only >= 0 ? M : F.G) {
        if (tid < 64) LC[tid] = 0;
        const int tok0 = tg * 64 + tt * 16;
        f32x4 a0 = {0.f, 0.f, 0.f, 0.f}, a1 = {0.f, 0.f, 0.f, 0.f}; float ssq = 0.f;
        const bf16* hp = Hf + (size_t)(tok0 + i16) * DM + kh * 512 + 8 * kq; const LAS unsigned char* w0 = WL + i16 * WLP + (kh * 512 + 8 * kq) * 4; const LAS unsigned char* w1 = w0 + 16 * WLP;
#pragma unroll 8
        for (int s = 0; s < 16; ++s) { const v4u hv = *(const v4u*)(hp + 32 * s);
            const f32x4 b0l = *(const LAS f32x4*)(w0 + 128 * s), b0h = *(const LAS f32x4*)(w0 + 128 * s + 16), b1l = *(const LAS f32x4*)(w1 + 128 * s), b1h = *(const LAS f32x4*)(w1 + 128 * s + 16);
            const f32x4 al = (f32x4){bflo(hv.x), bfhi(hv.x), bflo(hv.y), bfhi(hv.y)}, ah = (f32x4){bflo(hv.z), bfhi(hv.z), bflo(hv.w), bfhi(hv.w)};
            ssq += ((al[0] * al[0] + al[1] * al[1]) + (al[2] * al[2] + al[3] * al[3])) + ((ah[0] * ah[0] + ah[1] * ah[1]) + (ah[2] * ah[2] + ah[3] * ah[3]));
#pragma unroll
            for (int q = 0; q < 4; ++q) { a0 = __builtin_amdgcn_mfma_f32_16x16x4f32(al[q], b0l[q], a0, 0, 0, 0); a1 = __builtin_amdgcn_mfma_f32_16x16x4f32(al[q], b1l[q], a1, 0, 0, 0); }
#pragma unroll
            for (int q = 0; q < 4; ++q) { a0 = __builtin_amdgcn_mfma_f32_16x16x4f32(ah[q], b0h[q], a0, 0, 0, 0); a1 = __builtin_amdgcn_mfma_f32_16x16x4f32(ah[q], b1h[q], a1, 0, 0, 0); } }
        ssq += __shfl_xor(ssq, 16); ssq += __shfl_xor(ssq, 32);
        LAS float* lg = LG + (tt * 2 + kh) * 16 * 33;
#pragma unroll
        for (int r = 0; r < 4; ++r) { lg[(4 * kq + r) * 33 + i16] = a0[r]; lg[(4 * kq + r) * 33 + 16 + i16] = a1[r]; }
        if (kq == 0) SS[(tt * 2 + kh) * 16 + i16] = ssq;
        __syncthreads();
        int ti[4]; float wv[4]; int lpos[4]; float rsv = 0.f;
        if (tid < 64) {
            const int t4 = tid >> 4, t16 = tid & 15;
            rsv = 1.0f / sqrtf((SS[(t4 * 2) * 16 + t16] + SS[(t4 * 2 + 1) * 16 + t16]) * (1.0f / DM) + RMS_EPS);
            float lgv[32];
#pragma unroll
            for (int e = 0; e < 32; ++e) lgv[e] = (LG[((t4 * 2) * 16 + t16) * 33 + e] + LG[((t4 * 2 + 1) * 16 + t16) * 33 + e]) * rsv + br[e];
            float tv[4];
#pragma unroll
            for (int k = 0; k < 4; ++k) { float best = -3.0e38f; int bi = 0;
#pragma unroll
                for (int e = 0; e < 32; ++e) { const bool tk = lgv[e] > best; best = tk ? lgv[e] : best; bi = tk ? e : bi; }
                tv[k] = best; ti[k] = bi;
#pragma unroll
                for (int e = 0; e < 32; ++e) lgv[e] = (e == bi) ? -3.0e38f : lgv[e]; }
            const float e1 = __expf(tv[1] - tv[0]), e2 = __expf(tv[2] - tv[0]), e3 = __expf(tv[3] - tv[0]), den = 1.0f / (1.0f + e1 + e2 + e3);
            wv[0] = den; wv[1] = e1 * den; wv[2] = e2 * den; wv[3] = e3 * den;
#pragma unroll
            for (int k = 0; k < 4; ++k) lpos[k] = __hip_atomic_fetch_add(LC + ti[k], 1, __ATOMIC_RELAXED, __HIP_MEMORY_SCOPE_WORKGROUP);
        }
        __syncthreads();
        if (tid < 32) { const int c = LC[tid]; LC[32 + tid] = c ? (int)atomicAdd(cnt + tid * CW_CNT_STRIDE, (unsigned)c) : 0; }
        __syncthreads();
        if (tid < 64) {
            const int tok = tg * 64 + tid;
            rs2[tok] = rsv;
#pragma unroll
            for (int k = 0; k < 4; ++k) { elist[ti[k] * M + LC[32 + ti[k]] + lpos[k]] = tok * 4 + k; wslot[tok * 4 + k] = wv[k]; }
        }
        __syncthreads();
    }
}
__device__ __forceinline__ int moe_tables(Frame& F) {
    LAS int* T = (LAS int*)(F.lds + MOE_LDS_OFF); LAS int* cnt = T, *tstart = T + 32, *tile2e = T + 72;
    if (F.tid < 32) cnt[F.tid] = (int)__hip_atomic_load((unsigned*)(F.ctl + CW_CNT) + F.tid * CW_CNT_STRIDE, RLX_AGENT);
    __syncthreads();
    if (F.tid == 0) { int s = 0; for (int e = 0; e < 32; ++e) { tstart[e] = s; s += (cnt[e] + 255) >> 8; } tstart[32] = s; }
    __syncthreads();
    if (F.tid < 32) { for (int p = tstart[F.tid]; p < tstart[F.tid + 1]; ++p) tile2e[p] = F.tid; }
    __syncthreads();
    return tstart[32];
}
__device__ __forceinline__ void combine_phase(Frame& F, float* dst) {
    const int lane = F.lane, gw = F.vcu * NWAVES + F.wave, NGW = F.G * NWAVES;
    const unsigned char* YS2 = F.ws + WS_YS2;
    for (int tk = gw; tk < M; tk += NGW) {
        const GAS v2u* hrow = (const GAS v2u*)((const bf16*)(F.ws + WS_H16) + (size_t)tk * DM) + lane; GAS f32x4* drow = (GAS f32x4*)(dst + (size_t)tk * DM) + lane;
#pragma unroll
        for (int j = 0; j < 4; ++j) { const v2u hw = hrow[64 * j]; f32x4 v = (f32x4){bflo(hw.x), bfhi(hw.x), bflo(hw.y), bfhi(hw.y)};
#pragma unroll
            for (int k = 0; k < 4; ++k) { const unsigned y = *((const GAS unsigned*)(YS2 + (size_t)(tk * 4 + k) * DM) + lane + 64 * j);
                const f32x2 lo = __builtin_amdgcn_cvt_pk_f32_fp8(y, false), hi = __builtin_amdgcn_cvt_pk_f32_fp8(y, true); v += (f32x4){lo[0], lo[1], hi[0], hi[1]} * 0.0625f; }
            drow[64 * j] = v; }
    }
}

struct Args { const float* in[31]; float* out; unsigned char* ws; unsigned char* hi; int ph_lo, ph_hi; };
__global__ void __launch_bounds__(NWAVES * 64, 2) mk_fwd(Args args) {
    extern __shared__ __attribute__((aligned(16))) unsigned char lds[];
    Frame F;
    F.lds = (LAS unsigned char*)lds;
    F.MISC = (volatile LAS unsigned*)(F.lds + MISC_OFF);
    F.tid = threadIdx.x; F.lane = F.tid & 63; F.wave = __builtin_amdgcn_readfirstlane(F.tid >> 6);
    F.G = gridDim.x; { const int bx = blockIdx.x; F.vcu = (F.G % 8 == 0) ? (bx % 8) * (F.G / 8) + bx / 8 : bx; }
    F.ws = args.ws; F.hi = args.hi; F.ctl = (gu32*)(args.ws + WS_CTL); F.out = args.out;
#pragma unroll
    for (int i = 0; i < 31; ++i) F.in[i] = args.in[i];
    for (int u = F.tid; u < 64; u += NWAVES * 64) F.MISC[u] = 0u;
    __syncthreads();
    XcdBarrier bar; bar.bar = (unsigned*)(F.ctl + CW_BAR); bar.x = 0; bar.st = nullptr;
    if (N_LAUNCHES != PER_PHASE) bar = xcd_barrier_post((unsigned*)(F.ctl + CW_BAR), F.MISC + 8);
#define GRID_BAR() do { if (N_LAUNCHES != PER_PHASE) xcd_barrier(bar); } while (0)
    const int lo = args.ph_lo, hi = args.ph_hi;
    unsigned long long tpA = 0, tpB = 0;
#define TP_BEGIN(k) do { if (PROBE_REP == 60 + (k)) tpA = __builtin_amdgcn_s_memrealtime(); } while (0)
#define TP_END(k) do { if (PROBE_REP == 60 + (k)) tpB = __builtin_amdgcn_s_memrealtime(); } while (0)
#define IN(k) (lo <= (k) && (k) < hi)
#define BOTH(k) (IN(k) && IN((k) + 1))
    unsigned char* ws = args.ws; unsigned char* wsh = args.hi;

    TP_BEGIN(0);
    if (PROBE_REP == 80) tpA = __builtin_amdgcn_s_memrealtime();
    if (IN(0)) { for (int rep = 0; rep < NREP(0); ++rep) { p0_prologue(F); if (BOTH(0)) GRID_BAR(); } }

    TP_END(0);
    TP_BEGIN(1);
    if (IN(1)) for (int rep = 0; rep < NREP(1); ++rep) {
        pg8::Gemm g{(const bf16*)(wsh + (WS_XN - HI)), (const bf16*)(wsh + (WS_WIN - HI)), M, IN_W, DM}; pg8::StaticOrder S; S.init(M, IN_W, F.G, (int)blockIdx.x);
        EpiInProj E{(bf16*)(ws + WS_U), (bf16*)(ws + WS_Q), (bf16*)(ws + WS_K), (bf16*)(ws + WS_V), (bf16*)(ws + WS_G1), (bf16*)(ws + WS_G2), F.in[I_BGATE], F.in[I_QG], F.in[I_KG]};
        pg8::gemm_phase<EpiInProj, pg8::StaticOrder, true>(F.lds + RING_OFF, g, S, E);
        if (BOTH(1)) GRID_BAR();
    }

    if (PROBE_REP == 30 && IN(1) && IN(2)) { GRID_BAR(); GRID_BAR(); GRID_BAR(); GRID_BAR(); }
    TP_END(1);
    TP_BEGIN(2);
    if (IN(2)) {
        for (int rep = 0; rep < NREP(20); ++rep) for (int u = F.vcu; u < BATCH * SSM_G; u += F.G) { const int g = (u >> 5) * 4 + ((u & 31) >> 3), b = u & 7; s5_unit(F, b, g); }
        float lam;
        { const float a = wave_sum(F.in[I_LQ1][F.lane] * F.in[I_LK1][F.lane]), c = wave_sum(F.in[I_LQ2][F.lane] * F.in[I_LK2][F.lane]); lam = __expf(a) - __expf(c) + LAMBDA_INIT; }
        for (int rep = 0; rep < NREP(21); ++rep) for (int u = F.vcu; u < BATCH * ATT_H * 8; u += F.G) { const int bh = u >> 3, qp = u & 7; attn_unit(F, bh >> 2, bh & 3, 15 - qp, lam); attn_unit(F, bh >> 2, bh & 3, qp, lam); }
        if (BOTH(2)) GRID_BAR();
    }

    TP_END(2);
    TP_BEGIN(3);
    const bool pf3 = (F.G == M / 64) && IN(3) && IN(4) && (PROBE_REP < 0 || PROBE_REP >= 60);
    unsigned* const panel3 = (unsigned*)(F.ctl + CW_PANEL3);
    if (IN(3)) for (int rep = 0; rep < NREP(3); ++rep) {
        { pg8::Gemm g{(const bf16*)(ws + WS_YG), (const bf16*)(ws + WS_WGLU), M, 512, 512}; PanelOrder S; S.so.init(M, 512, F.G, (int)blockIdx.x); S.wflag = nullptr; S.pflag = pf3 ? panel3 : nullptr;
          EpiMix<0> E{(const bf16*)(ws + WS_YG), nullptr, (bf16*)(ws + WS_YS), F.in[I_BGLU], 512};
          pg8::gemm_phase<EpiMix<0>, PanelOrder, true>(F.lds + RING_OFF, g, S, E); }
        if ((int)blockIdx.x >= (M / 256) * 2 && rep == 0) convert_big(F, 1, BIG_SPLIT, NBIG);
        if (BOTH(3) && !pf3) GRID_BAR();
    }

    TP_END(3);
    TP_BEGIN(4);
    const bool pf = (F.G == M / 64) && IN(4) && IN(5) && IN(6) && (PROBE_REP < 0 || PROBE_REP >= 60);
    unsigned* const panel4 = (unsigned*)(F.ctl + CW_PANEL4); unsigned* const panel5 = (unsigned*)(F.ctl + CW_PANEL5);
    if (IN(4)) for (int rep = 0; rep < NREP(4); ++rep) {
        pg8::Gemm g{(const bf16*)(ws + WS_OB), (const bf16*)(ws + WS_WPS), M, DM, 512};
        ChainOrder S; S.so.init(M, DM, F.G, (int)blockIdx.x); S.A_att = (const bf16*)(ws + WS_OB); S.A_ssm = (const bf16*)(ws + WS_YS); S.pflag = pf ? panel4 : nullptr; S.wflag = pf3 ? panel3 : nullptr;
        EpiChain E{(const bf16*)(ws + WS_G1), (const bf16*)(ws + WS_G2), (bf16*)(ws + WS_MX), pf};
        pg8::gemm_phase<EpiChain, ChainOrder, true>(F.lds + RING_OFF, g, S, E);
        if (BOTH(4) && !pf) GRID_BAR();
    }

    TP_END(4);
    TP_BEGIN(5);
    if (IN(5)) for (int rep = 0; rep < NREP(5); ++rep) {
        pg8::Gemm g{(const bf16*)(ws + WS_MX), (const bf16*)(ws + WS_WOUT), M, DM, DM}; PanelOrder S; S.so.init(M, DM, F.G, (int)blockIdx.x); S.wflag = pf ? panel4 : nullptr; S.pflag = pf ? panel5 : nullptr;
        EpiOut E{F.in[I_X], (bf16*)(ws + WS_H16), ws + WS_HB, pf};
        pg8::gemm_phase<EpiOut, PanelOrder, true>(F.lds + RING_OFF, g, S, E);
        if (BOTH(5) && !pf) GRID_BAR();
    }

    TP_END(5);
    TP_BEGIN(6);
    if (IN(6)) {
        if (pf) { pg8::StaticOrder so; so.init(M, DM, F.G, (int)blockIdx.x); pg8::Unit u; so.next(0, u);
                  router_phase(F, false, 4 * u.pm + u.pn, panel5 + u.pm * PANEL_STRIDE); }
        else router_phase(F);
        if (BOTH(6)) GRID_BAR(); }

    TP_END(6);
    TP_BEGIN(7);
    if (IN(7)) for (int rep = 0; rep < NREP(7); ++rep) {
        const int nmt = moe_tables(F); LAS int* T = (LAS int*)(F.lds + MOE_LDS_OFF); unsigned* mflag = (unsigned*)(F.ctl + CW_MFLAG) + (rep ? 288 * MFLAG_STRIDE : 0);
        { pg8::Gemm g{(const bf16*)(ws + WS_HB), (const bf16*)(wsh + (WS_WUP - HI)), M, UPW, DM, UPW};
          MoeOrder<8, true> S{nmt * 8, F.G, F.vcu, T, T + 32, T + 72, (const int*)(ws + WS_ELIST), mflag, (LAS int*)(F.lds + SLOT_OFF)}; S.fill(F.tid, (const float*)(ws + WS_RS2)); __syncthreads();
          EpiUp E{ws + WS_ACT, F.in[I_BUP], (const float*)(ws + WS_RS2)};
          pg8::gemm_phase<EpiUp, MoeOrder<8, true>, true, true, true, true>(F.lds + RING_OFF, g, S, E, 0, 0); }
        { pg8::Gemm g{(const bf16*)(ws + WS_ACT), (const bf16*)(wsh + (WS_WDN - HI)), MOE_ROWS_MAX, DM, DE, DM};
          MoeOrder<4, false> S{nmt * 4, F.G, F.G - 1 - F.vcu, T, T + 32, T + 72, (const int*)(ws + WS_ELIST), mflag, (LAS int*)(F.lds + SLOT_OFF)}; S.fill(F.tid, (const float*)(ws + WS_WSLOT)); __syncthreads();
          EpiDown E{ws + WS_YS2, F.in[I_BDN], (const float*)(ws + WS_WSLOT)};
          pg8::gemm_phase<EpiDown, MoeOrder<4, false>, true, true, true, true>(F.lds + RING_OFF, g, S, E, 0, 0); }
        if (BOTH(7)) GRID_BAR();
    }

    TP_END(7);
    TP_BEGIN(9);
    if (IN(9)) { combine_phase(F, F.out); }
    if (IN(16)) router_phase(F, true);
    if (IN(19)) combine_phase(F, (float*)(ws + WS_TA));
    TP_END(9);
    if (PROBE_REP == 80) tpB = __builtin_amdgcn_s_memrealtime();
    if (PROBE_REP >= 60 && blockIdx.x == 0) { const unsigned long long t0 = __builtin_amdgcn_s_memrealtime(); while (__builtin_amdgcn_s_memrealtime() - t0 < tpB - tpA) __builtin_amdgcn_s_sleep(8); }
#undef IN
#undef BOTH
#undef GRID_BAR
}

extern "C" void kernel_launch(void* const* d_in, const int* in_sizes, int n_in, void* d_out, int out_size, void* d_ws, size_t ws_size, hipStream_t stream) {
    static int grid = 0;
    if (grid == 0) {
        if (n_in != 31 || in_sizes[0] != M * DM || out_size != M * DM || ws_size < WS_END) {
            fprintf(stderr, "kernel_launch: unexpected shapes (n_in %d, in0 %d, out %d, ws %zu < %zu); nothing launched\n", n_in, n_in > 0 ? in_sizes[0] : -1, out_size, ws_size, (size_t)WS_END); grid = -1; return; }
        int dev = 0, cus = 0;
        if (hipGetDevice(&dev) != hipSuccess || hipDeviceGetAttribute(&cus, hipDeviceAttributeMultiprocessorCount, dev) != hipSuccess) { grid = -1; return; }
        if (hipFuncSetAttribute((const void*)mk_fwd, hipFuncAttributeMaxDynamicSharedMemorySize, LDS_BYTES) != hipSuccess) { fprintf(stderr, "kernel_launch: hipFuncSetAttribute failed\n"); grid = -1; return; }
        int per_cu = 0;
        if (hipOccupancyMaxActiveBlocksPerMultiprocessor(&per_cu, (const void*)mk_fwd, NWAVES * 64, LDS_BYTES) != hipSuccess || per_cu < 1) fprintf(stderr, "kernel_launch: occupancy query reports %d\n", per_cu);
        (void)hipGetLastError();
        grid = cus;
    }
    if (grid < 0) return;
    (void)hipMemsetAsync((char*)d_ws + WS_CTL, 0, CTL_ZERO_BYTES, stream);
    Args a{};
    for (int i = 0; i < 31; ++i) a.in[i] = (const float*)d_in[i];
    a.out = (float*)d_out; a.ws = (unsigned char*)d_ws; a.hi = (unsigned char*)d_ws + ((ws_size - 256 * MiB) & ~(size_t)0xfffff);
    if (N_LAUNCHES == 1) { a.ph_lo = 0; a.ph_hi = PER_PHASE; hipLaunchKernelGGL(mk_fwd, dim3(grid), dim3(NWAVES * 64), LDS_BYTES, stream, a); }
    else for (int p = 0; p < PER_PHASE; ++p) { a.ph_lo = p; a.ph_hi = p + 1; if (PROBE_REP - 110 == p) { a.ph_lo = p + 10; a.ph_hi = p + 11; hipLaunchKernelGGL(mk_fwd, dim3(grid), dim3(NWAVES * 64), LDS_BYTES, stream, a); a.ph_lo = p; a.ph_hi = p + 1; }
        for (int rep = 0; rep < ((PROBE_REP - 100 == p) ? 2 : 1); ++rep) hipLaunchKernelGGL(mk_fwd, dim3(grid), dim3(NWAVES * 64), LDS_BYTES, stream, a); }
}
```

```cpp
#include <hip/hip_runtime.h>
#include <cstdio>
#include <cstdint>

#ifndef MK_N_LAUNCHES
#define MK_N_LAUNCHES 1
#endif
#ifndef PROBE_REP
#define PROBE_REP -1
#endif
#define NREP(k) ((PROBE_REP == (k)) ? 2 : 1)

namespace pg8 {
#define PG8_LAS __attribute__((address_space(3)))
typedef unsigned short bf16_t;
typedef short bf16x8 __attribute__((ext_vector_type(8)));
typedef float f32x4 __attribute__((ext_vector_type(4)));
typedef unsigned u32x4 __attribute__((ext_vector_type(4)));
typedef unsigned u32x2 __attribute__((ext_vector_type(2)));
constexpr int BM = 256, BK = 64, HALF = 128, HTB = HALF * BK * 2  , STAGE_BYTES = 8 * HTB, NXCD = 8, WGM = 8;

__host__ __device__ __forceinline__ int lds_byte(int r, int c) { const int st = (r >> 4) * 2 + (c >> 5), rr = r & 15, cc = c & 31, ob = rr * 64 + cc * 2; return st * 1024 + (ob ^ (((ob >> 9) & 1) * 48)); }
__host__ __device__ __forceinline__ void stage_rc(int b, int& R, int& C) { const int st = b / 1024, sb = b % 1024, swz = sb ^ (((sb >> 9) & 1) * 48); R = (st >> 1) * 16 + swz / 64; C = (st & 1) * 32 + (swz % 64) / 2; }
__host__ __device__ __forceinline__ int perm256(int R) { return 64 * ((R >> 5) & 3) + 16 * ((R >> 2) & 3) + 8 * (R >> 7) + 4 * ((R >> 4) & 1) + (R & 3); }
__host__ __device__ __forceinline__ int perm32(int rho) { const int n = rho >> 4, i = rho & 15; return 8 * (i >> 2) + 4 * n + (i & 3); }

struct Unit { int pm, pn; };
struct Gemm { const bf16_t* A; const bf16_t* Bt; int M, N, K; int bKT = 0; };

struct StaticOrder {
    int nM, nN, nwg, G, c;
    __host__ __device__ void init(int M, int N, int G_, int c_) { nM = M / BM; nN = N / BM; nwg = nM * nN; G = G_; c = c_; }
    __host__ __device__ __forceinline__ bool next(int i, Unit& u) const {
        const long L = (long)i * G + c; if (L >= nwg) return false;
        int wgid = (int)L; { const int q = nwg / NXCD, r = nwg % NXCD, xcd = wgid % NXCD, off = wgid / NXCD; wgid = (xcd < r ? xcd * (q + 1) : r * (q + 1) + (xcd - r) * q) + off; }
        const int nig = WGM * nN, gid = wgid / nig, fm = gid * WGM, gsz = (nM - fm) < WGM ? (nM - fm) : WGM;
        u.pm = fm + ((wgid % nig) % gsz); u.pn = (wgid % nig) / gsz; return true;
    }
    __device__ __forceinline__ int row_slot(const Unit&, int) const { return 0; }
    __device__ __forceinline__ const PG8_LAS int* slot_table() const { return nullptr; }
    __device__ __forceinline__ int a_row(const Unit& u, int r, int) const { return u.pm * BM + r; }
    __device__ __forceinline__ const char* a_base(const Gemm& g, const Unit& u, size_t tstep) const { return (const char*)g.A + (size_t)u.pm * tstep; }
    __device__ __forceinline__ void a_ready(const Unit&) const {}
    __device__ __forceinline__ void done(const Unit&) const {}
};

__device__ __forceinline__ unsigned cvt_pk_bf16(float lo, float hi) { unsigned r; asm volatile("v_cvt_pk_bf16_f32 %0, %1, %2" : "=v"(r) : "v"(lo), "v"(hi)); return r; }

typedef int v8i __attribute__((ext_vector_type(8)));
typedef int v4i __attribute__((ext_vector_type(4)));
template <class Epi, class Sched, bool ALIGN_EPI = false, bool ROWTAB = false, bool GATHER = false, bool FP8 = false>
__device__ __forceinline__ void gemm_phase(PG8_LAS unsigned char* lds, const Gemm g, const Sched& S, const Epi& E, const int sA8 = 0, const int sB8 = 0) {
    static_assert(!GATHER || ROWTAB, "GATHER needs ROWTAB");
    const int tid = threadIdx.x, wid = __builtin_amdgcn_readfirstlane(tid >> 6), lane = tid & 63, wr = wid >> 2, wc = wid & 3, fr = lane & 15, fq = lane >> 4;
    const int K = g.K, RB = FP8 ? K : 2 * K  , nt = RB / (2 * BK);
    unsigned voffA[2], voffB[2];
#pragma unroll
    for (int i = 0; i < 2; ++i) { int R, C; stage_rc(tid * 16 + i * 8192, R, C); const int Rb = (int)Epi::PERM == 2 ? perm256(R) : (int)Epi::PERM == 1 ? ((R & ~31) + perm32(R & 31)) : R;
        voffA[i] = (unsigned)(R * RB + 2 * C); voffB[i] = (unsigned)(Rb * (g.bKT ? 128 : RB) + 2 * C); }
    unsigned vA[2][2] = {{0u, 0u}, {0u, 0u}};
    const size_t kstep = (size_t)(BK * 2);
    const size_t hstep = (size_t)HALF * RB;
    const size_t tstep = 2 * hstep;
    const size_t kstepB = g.bKT ? (size_t)g.bKT * 128 : kstep, hstepB = (size_t)((int)Epi::PERM == 2 ? 8 : HALF) * (g.bKT ? (size_t)128 : (size_t)RB);
#define PG8_BBASE(u) (g.bKT ? (const char*)g.Bt + (size_t)((u).pn / (g.bKT / 256)) * ((size_t)g.bKT * RB) + (size_t)((u).pn % (g.bKT / 256)) * (256 * 128) : (const char*)g.Bt + (size_t)(u).pn * tstep)
    const unsigned ldsw = (unsigned)wid * 1024u;
    const int aoff = FP8 ? lds_byte(wr * 64 + fr, fq * 16) : lds_byte(wr * 64 + fr, fq * 8), boff = FP8 ? lds_byte(wc * 32 + fr, fq * 16) : lds_byte(wc * 32 + fr, fq * 8);
    const PG8_LAS int* tab = S.slot_table();
#define PG8_SA(b, h) (((b) * 2 + (h)) * HTB)
#define PG8_SB(b, h) ((4 + (b) * 2 + (h)) * HTB)
#define PG8_STAGE(bufoff, gbase, voff) do { _Pragma("unroll") for (int _i = 0; _i < 2; ++_i) \
        __builtin_amdgcn_global_load_lds((const unsigned*)((const char*)(gbase) + (voff)[_i]), (PG8_LAS unsigned*)(lds + (bufoff) + ldsw + _i * 8192), 16, 0, 0); } while (0)
#define PG8_STAGE_A(bufoff, kbase, h) do { if constexpr (GATHER) { PG8_STAGE(bufoff, kbase, vA[h]); } else { PG8_STAGE(bufoff, (kbase) + (h) * hstep, voffA); } } while (0)
#define PG8_LOAD_VA(sel, un) do { _Pragma("unroll") for (int _i = 0; _i < 2; ++_i) { int R_, C_; stage_rc(tid * 16 + _i * 8192, R_, C_); \
        _Pragma("unroll") for (int _h = 0; _h < 2; ++_h) { const int s_ = tab[(sel) * 256 + _h * HALF + R_]; vA[_h][_i] = (unsigned)(S.a_row(un, _h * HALF + R_, s_) * RB + 2 * C_); } } } while (0)
#define PG8_LDA(dst, b, h) do { _Pragma("unroll") for (int m = 0; m < 4; ++m) _Pragma("unroll") for (int k = 0; k < 2; ++k) dst[m][k] = *(const PG8_LAS bf16x8*)(lds + PG8_SA(b, h) + (FP8 ? (aoff ^ (16 * k)) : aoff + k * 1024) + m * 2048); } while (0)
#define PG8_LDB(dst, b, h) do { _Pragma("unroll") for (int n = 0; n < 2; ++n) _Pragma("unroll") for (int k = 0; k < 2; ++k) dst[n][k] = *(const PG8_LAS bf16x8*)(lds + PG8_SB(b, h) + (FP8 ? (boff ^ (16 * k)) : boff + k * 1024) + n * 2048); } while (0)
#define PG8_V8(x) __builtin_shufflevector(__builtin_bit_cast(v4i, (x)[0]), __builtin_bit_cast(v4i, (x)[1]), 0, 1, 2, 3, 4, 5, 6, 7)
#define PG8_MMA(ai, bj, At, Bt) do { __builtin_amdgcn_s_setprio(1); if constexpr (FP8) { _Pragma("unroll") for (int m = 0; m < 4; ++m) _Pragma("unroll") for (int n = 0; n < 2; ++n) \
        acc[ai][bj][m][n] = __builtin_amdgcn_mfma_scale_f32_16x16x128_f8f6f4(PG8_V8(Bt[n]), PG8_V8(At[m]), acc[ai][bj][m][n], 0, 0, 0, sB8, 0, sA8); } else { \
        _Pragma("unroll") for (int m = 0; m < 4; ++m) _Pragma("unroll") for (int n = 0; n < 2; ++n) _Pragma("unroll") for (int k = 0; k < 2; ++k) \
        acc[ai][bj][m][n] = __builtin_amdgcn_mfma_f32_16x16x32_bf16(Bt[n][k], At[m][k], acc[ai][bj][m][n], 0, 0, 0); } __builtin_amdgcn_s_setprio(0); } while (0)
#define PG8_WAIT_V(n) asm volatile("s_waitcnt vmcnt(" #n ")" ::: "memory")
#define PG8_WAIT_L(n) asm volatile("s_waitcnt lgkmcnt(" #n ")" ::: "memory")
#define PG8_BAR __builtin_amdgcn_s_barrier()
#define PG8_SCHED __builtin_amdgcn_sched_barrier(0)
    Unit cur, nxt; int ui = 0;
    if (!S.next(0, cur)) return;
    S.a_ready(cur);
    f32x4 acc[2][2][4][2];
#pragma unroll
    for (int a = 0; a < 2; ++a)
#pragma unroll
        for (int b = 0; b < 2; ++b)
#pragma unroll
            for (int m = 0; m < 4; ++m)
#pragma unroll
                for (int n = 0; n < 2; ++n) acc[a][b][m][n] = (f32x4){0.f, 0.f, 0.f, 0.f};
    bf16x8 At[4][2], B0[2][2], B1[2][2];
    if constexpr (GATHER) { PG8_LOAD_VA(0, cur); }
    const char* cA = GATHER ? (const char*)g.A : S.a_base(g, cur, tstep); const char* cB = PG8_BBASE(cur);
    PG8_STAGE(PG8_SB(0, 0), cB, voffB); PG8_STAGE(PG8_SB(0, 1), cB + hstepB, voffB); PG8_STAGE_A(PG8_SA(0, 0), cA, 0); PG8_STAGE_A(PG8_SA(0, 1), cA, 1);
    if (wr == 1) PG8_BAR;
    PG8_WAIT_V(2); PG8_BAR;
    PG8_STAGE(PG8_SB(1, 0), cB + kstepB, voffB); PG8_STAGE_A(PG8_SA(1, 0), cA + kstep, 0); PG8_STAGE(PG8_SB(1, 1), cB + hstepB + kstepB, voffB);
    PG8_WAIT_V(6); PG8_BAR;
    for (;;) {
        const bool has_next = S.next(ui + 1, nxt);
        const char* nA = has_next ? (GATHER ? (const char*)g.A : S.a_base(g, nxt, tstep)) : cA; const char* nB = has_next ? PG8_BBASE(nxt) : cB;
        for (int t = 0; t < nt; t += 2) {
            const bool last = (t == nt - 2);
            if (last && has_next) S.a_ready(nxt);
            const char* a1 = cA + (size_t)(t + 1) * kstep;
            const char* a2 = last ? nA : cA + (size_t)(t + 2) * kstep; const char* b2 = last ? nB : cB + (size_t)(t + 2) * kstepB;
            const char* a3 = a2 + kstep; const char* b3 = b2 + kstepB;
            PG8_LDB(B0, 0, 0); PG8_LDB(B1, 0, 1); PG8_SCHED; PG8_LDA(At, 0, 0); PG8_STAGE_A(PG8_SA(1, 1), a1, 1);
            if constexpr (GATHER) { if (last && has_next) { PG8_LOAD_VA(ui + 1, nxt); } }
            PG8_WAIT_V(8); PG8_WAIT_L(0); PG8_BAR; PG8_MMA(0, 0, At, B0); PG8_MMA(0, 1, At, B1); PG8_BAR; PG8_SCHED;
            PG8_LDA(At, 0, 1); PG8_STAGE(PG8_SB(0, 0), b2, voffB); PG8_STAGE(PG8_SB(0, 1), b2 + hstepB, voffB); PG8_STAGE_A(PG8_SA(0, 0), a2, 0);
            PG8_WAIT_V(8); PG8_WAIT_L(0); PG8_BAR; PG8_MMA(1, 0, At, B0); PG8_MMA(1, 1, At, B1); PG8_BAR; PG8_SCHED;
            PG8_LDB(B0, 1, 0); PG8_LDB(B1, 1, 1); PG8_SCHED; PG8_LDA(At, 1, 0); PG8_STAGE_A(PG8_SA(0, 1), a2, 1);
            PG8_WAIT_V(8); PG8_WAIT_L(0); PG8_BAR; PG8_MMA(0, 0, At, B0); PG8_MMA(0, 1, At, B1); PG8_BAR; PG8_SCHED;
            PG8_LDA(At, 1, 1); PG8_STAGE(PG8_SB(1, 0), b3, voffB); PG8_STAGE(PG8_SB(1, 1), b3 + hstepB, voffB); PG8_STAGE_A(PG8_SA(1, 0), a3, 0);
            PG8_WAIT_V(8); PG8_WAIT_L(0); PG8_BAR; PG8_MMA(1, 0, At, B0); PG8_MMA(1, 1, At, B1); PG8_BAR; PG8_SCHED;
        }
        if constexpr (ALIGN_EPI) { if (wr == 0) PG8_BAR; }
        E(acc, cur, wr, wc, fr, fq, ROWTAB ? tab + ui * 256 : tab);
        S.done(cur);
        if (!has_next) break;
        if (!E.keep(cur)) {
#pragma unroll
        for (int a = 0; a < 2; ++a)
#pragma unroll
            for (int b = 0; b < 2; ++b)
#pragma unroll
                for (int m = 0; m < 4; ++m)
#pragma unroll
                    for (int n = 0; n < 2; ++n) acc[a][b][m][n] = (f32x4){0.f, 0.f, 0.f, 0.f}; }
        cur = nxt; cA = nA; cB = nB; ++ui;
        if constexpr (ALIGN_EPI) { if (wr == 1) PG8_BAR; }
    }
    PG8_WAIT_V(0);
    if constexpr (!ALIGN_EPI) { if (wr == 0) PG8_BAR; }
    PG8_BAR;
#undef PG8_SA
#undef PG8_SB
#undef PG8_STAGE
#undef PG8_STAGE_A
#undef PG8_BBASE
#undef PG8_LOAD_VA
#undef PG8_LDA
#undef PG8_LDB
#undef PG8_MMA
#undef PG8_V8
#undef PG8_WAIT_V
#undef PG8_WAIT_L
#undef PG8_BAR
#undef PG8_SCHED
}
}

constexpr int NWAVES = 8;
constexpr int N_LAUNCHES = MK_N_LAUNCHES;
constexpr int PER_PHASE = 10;
constexpr int BATCH = 8, SEQ = 2048, DM = 1024, M = BATCH * SEQ;
constexpr int SSM_W = 512, SSM_G = 32, SSM_H = 16, SSM_P = 64, SSM_T = 16, SSM_NC = SEQ / SSM_T;
constexpr int ATT_H = 4, ATT_D = 64, ATT_V = 128, QK_W = 512, V_W = 512;
constexpr int IN_W = 4096;
constexpr int NE = 32, TOPK = 4, DE = 1024, UPW = 2048;
constexpr float RMS_EPS = 1e-6f;
constexpr float LAMBDA_INIT = 0.2f;
constexpr float QSCALE = 0.125f * 1.4426950408889634f;
constexpr int MOE_ROWS_MAX = M * TOPK + NE * 256;
constexpr int MOE_MT_MAX = MOE_ROWS_MAX / 256;

constexpr size_t MiB = 1u << 20;
constexpr size_t WS_CTL = 0, CTL_ZERO_BYTES = 256 * 1024;
constexpr size_t HI = (size_t)1 << 40;
constexpr size_t WS_WIN_OLD = 2 * MiB;
constexpr size_t WS_WGLU = 10 * MiB;
constexpr size_t WS_WPS = 11 * MiB;
constexpr size_t WS_WPA = 12 * MiB;
constexpr size_t WS_WOUT = 13 * MiB;
constexpr size_t WS_WRT = 15 * MiB;
constexpr size_t WS_S5 = 16 * MiB;
constexpr size_t WS_A16 = 24 * MiB;
constexpr size_t WS_WUP_OLD = 32 * MiB;
constexpr size_t WS_WDN_OLD = 160 * MiB;
constexpr size_t WS_XN_OLD = 224 * MiB;
constexpr size_t WS_U = 256 * MiB;
constexpr size_t WS_Q = 272 * MiB, WS_K = 288 * MiB, WS_V = 304 * MiB;
constexpr size_t WS_G1 = 320 * MiB, WS_G2 = 352 * MiB;
constexpr size_t WS_YG = 384 * MiB, WS_YS = 400 * MiB, WS_OB = 416 * MiB;
constexpr size_t WS_H16 = 432 * MiB;
constexpr size_t WS_TA = 432 * MiB, WS_MX = 464 * MiB;
constexpr size_t WS_HB = 496 * MiB;
constexpr size_t WS_RS2 = 528 * MiB;
constexpr size_t WS_WSLOT = 529 * MiB;
constexpr size_t WS_ELIST = 530 * MiB;
constexpr size_t WS_ACT = 544 * MiB;
constexpr size_t WS_YS2 = 32 * MiB;
constexpr size_t WS_YS2_OLD = 688 * MiB;
constexpr size_t WS_END = 1024 * MiB;
constexpr size_t WS_WUP = HI + 0 * MiB, WS_WDN = HI + 64 * MiB, WS_XN = HI + 96 * MiB, WS_WIN = HI + 128 * MiB;
constexpr int CW_BAR = 4096;
constexpr int CW_PANEL3 = 57344, CW_PANEL4 = 49152, CW_PANEL5 = 53248, PANEL_STRIDE = 16;
constexpr int CW_Q = 20480;
constexpr int CW_CNT = 16384;

constexpr int RING_OFF = 0, RING_BYTES = 139264;
constexpr int LDSCTL_OFF = RING_BYTES, MISC_OFF = LDSCTL_OFF;
constexpr int MOE_LDS_OFF = LDSCTL_OFF + 256;
constexpr int SLOT_OFF = 147456, SLOT_UNITS = 16;
constexpr int LDS_BYTES = 163840;

#define GAS __attribute__((address_space(1)))
#define LAS __attribute__((address_space(3)))
typedef unsigned short bf16;
typedef unsigned v4u __attribute__((ext_vector_type(4)));
typedef unsigned v2u __attribute__((ext_vector_type(2)));
typedef float f32x4 __attribute__((ext_vector_type(4)));
typedef float f32x16 __attribute__((ext_vector_type(16)));
typedef float f32x2 __attribute__((ext_vector_type(2)));
typedef short bf16x8 __attribute__((ext_vector_type(8)));
typedef short s16x4 __attribute__((ext_vector_type(4)));
typedef GAS unsigned gu32;
#define RLX_AGENT __ATOMIC_RELAXED, __HIP_MEMORY_SCOPE_AGENT
#define LDS_WAIT() asm volatile("s_waitcnt lgkmcnt(0)" ::: "memory")
#define VM_WAIT() asm volatile("s_waitcnt vmcnt(0)" ::: "memory")
using pg8::cvt_pk_bf16;
__device__ __forceinline__ unsigned f2bf(float f) { unsigned u = __builtin_bit_cast(unsigned, f); return (u + 0x7fffu + ((u >> 16) & 1u)) >> 16; }
__device__ __forceinline__ float xor32_max(float v) { const auto r = __builtin_amdgcn_permlane32_swap(__float_as_uint(v), __float_as_uint(v), false, false); return fmaxf(__uint_as_float(r[0]), __uint_as_float(r[1])); }
__device__ __forceinline__ float xor32_add(float v) { const auto r = __builtin_amdgcn_permlane32_swap(__float_as_uint(v), __float_as_uint(v), false, false); return __uint_as_float(r[0]) + __uint_as_float(r[1]); }
__device__ __forceinline__ float xor16_add(float v) { const auto r = __builtin_amdgcn_permlane16_swap(__float_as_uint(v), __float_as_uint(v), false, false); return __uint_as_float(r[0]) + __uint_as_float(r[1]); }
__device__ __forceinline__ unsigned pk4_fp8(float a, float b, float c, float d) { unsigned w = 0; w = __builtin_amdgcn_cvt_pk_fp8_f32(a, b, w, false); w = __builtin_amdgcn_cvt_pk_fp8_f32(c, d, w, true); return w; }
__device__ __forceinline__ float bf2f(unsigned b) { return __builtin_bit_cast(float, b << 16); }
__device__ __forceinline__ float bflo(unsigned w) { return __builtin_bit_cast(float, w << 16); }
__device__ __forceinline__ float bfhi(unsigned w) { return __builtin_bit_cast(float, w & 0xffff0000u); }
__device__ __forceinline__ float fsigmoid(float x) { return 1.0f / (1.0f + __expf(-x)); }
__device__ __forceinline__ float fsigmoid_fast(float x) { return __builtin_amdgcn_rcpf(1.0f + __builtin_amdgcn_exp2f(-1.4426950408889634f * x)); }
__device__ __forceinline__ float fsigmoid_asm(float x) { float r;
    asm volatile("v_mul_f32 %0, 0xbfb8aa3b, %1\n\ts_nop 0\n\tv_exp_f32 %0, %0\n\ts_nop 1\n\tv_add_f32 %0, 1.0, %0\n\ts_nop 0\n\tv_rcp_f32 %0, %0\n\ts_nop 1" : "=&v"(r) : "v"(x)); return r; }
__device__ __forceinline__ float gelu_tanh(float x) { const float z = 1.5957691216057308f * (x + 0.044715f * x * x * x); return x * fsigmoid_fast(z); }
__device__ __forceinline__ int crow(int r, int hi) { return (r & 3) + 8 * (r >> 2) + 4 * hi; }
__device__ __forceinline__ float wave_sum(float v) {
#pragma unroll
    for (int o = 1; o < 64; o <<= 1) v += __shfl_xor(v, o);
    return v;
}

#define XB_TMO      128
#define XB_XCNT(j)  (256  + 64 * (j))
#define XB_XSUB(j)  (1280 + 64 * (j))
#define XB_XGEN(j)  (2304 + 64 * (j))
#define XB_TOP      3328
#define XB_TOPGEN   3392
#define XCD_BAR_WORDS 3456
#define XB_SPIN_CAP (1u << 18)
__device__ __forceinline__ unsigned xb_ld(unsigned* p)              { return __hip_atomic_load(p, __ATOMIC_RELAXED, __HIP_MEMORY_SCOPE_AGENT); }
__device__ __forceinline__ unsigned xb_add(unsigned* p, unsigned v) { return __hip_atomic_fetch_add(p, v, __ATOMIC_RELAXED, __HIP_MEMORY_SCOPE_AGENT); }
__device__ __forceinline__ unsigned xb_xcc_id() { return (unsigned)__builtin_amdgcn_s_getreg((3 << 11) | 20) & 0xFu; }
#define XB_SPIN(cond, bar) do { unsigned _sp = 0; while (cond) { __builtin_amdgcn_s_sleep(1); \
    if ((++_sp & 255u) == 0u) { if (xb_ld(&(bar)[XB_TMO])) break; if (_sp > XB_SPIN_CAP) { atomicAdd(&(bar)[XB_TMO], 1u); break; } } } } while (0)
struct XcdBarrier { unsigned* bar; unsigned x; volatile LAS unsigned* st; };
__device__ __forceinline__ XcdBarrier xcd_barrier_post(unsigned* bar, volatile LAS unsigned* st) {
    XcdBarrier b; b.bar = bar; b.x = xb_xcc_id(); b.st = st;
    if (threadIdx.x == 0) (void)xb_add(&bar[XB_XCNT(b.x)], 1u);
    return b;
}
__device__ __forceinline__ void xcd_barrier_complete(unsigned* bar, unsigned x, unsigned& nloc, unsigned& nx) {
    const unsigned G = gridDim.x * gridDim.y * gridDim.z;
    unsigned sum, cnt, mine, sp = 0u;
    for (;;) {
        sum = 0u; cnt = 0u; mine = 0u;
#pragma unroll
        for (unsigned j = 0; j < 16; ++j) { const unsigned c = xb_ld(&bar[XB_XCNT(j)]); sum += c; cnt += (c > 0u) ? 1u : 0u; mine = (j == x) ? c : mine; }
        if (sum == G) break;
        __builtin_amdgcn_s_sleep(1);
        if ((++sp & 255u) == 0u) { if (xb_ld(&bar[XB_TMO])) break; if (sp > XB_SPIN_CAP) { atomicAdd(&bar[XB_TMO], 1u); break; } }
    }
    nloc = mine > 0u ? mine : 1u; nx = cnt > 0u ? cnt : 1u;
}
__device__ __forceinline__ void xcd_barrier(const XcdBarrier& b) {
    asm volatile("s_waitcnt vmcnt(0)" ::: "memory");
    __syncthreads();
    if (threadIdx.x == 0) {
        unsigned* bar = b.bar;
        __builtin_amdgcn_s_waitcnt(0);
        unsigned nloc = b.st[0], nx = b.st[1];
        if (nloc == 0u) { xcd_barrier_complete(bar, b.x, nloc, nx); b.st[0] = nloc; b.st[1] = nx; }
        const unsigned old = xb_add(&bar[XB_XSUB(b.x)], 1u);
        const unsigned gen = old / nloc;
        if (old + 1u == (gen + 1u) * nloc) {
            __builtin_amdgcn_fence(__ATOMIC_RELEASE, "agent");
            asm volatile("s_waitcnt vmcnt(0)" ::: "memory");
            const unsigned og = xb_add(&bar[XB_TOP], 1u);
            const unsigned tg = og / nx;
            if (og + 1u == (tg + 1u) * nx) xb_add(&bar[XB_TOPGEN], 1u);
            else XB_SPIN(xb_ld(&bar[XB_TOPGEN]) == tg, bar);
            __builtin_amdgcn_fence(__ATOMIC_ACQUIRE, "agent");
            xb_add(&bar[XB_XGEN(b.x)], 1u);
            asm volatile("s_waitcnt vmcnt(0)" ::: "memory");
        } else {
            XB_SPIN(xb_ld(&bar[XB_XGEN(b.x)]) == gen, bar);
            __builtin_amdgcn_fence(__ATOMIC_ACQUIRE, "agent");
            asm volatile("s_waitcnt vmcnt(0)" ::: "memory");
        }
    }
    __syncthreads();
}

struct Frame {
    LAS unsigned char* lds;
    volatile LAS unsigned* MISC;
    gu32* ctl;
    unsigned char* ws; unsigned char* hi;
    int tid, lane, wave;
    int vcu, G;
    const float* in[31];
    float* out;
};
enum { I_X = 0, I_N1G, I_WIN, I_BGATE, I_ARE, I_AIM, I_LOGDT, I_BRE, I_BIM, I_CRE, I_CIM, I_SSMD, I_WGLU, I_BGLU, I_QG, I_KG, I_LQ1, I_LK1, I_LQ2, I_LK2, I_SUBLN,
       I_WPS, I_WPA, I_WOUT, I_N2G, I_WR, I_BR, I_WUP, I_BUP, I_WDN, I_BDN };

template <int MODE>
__device__ __forceinline__ int physrow(int c) {
    if (MODE == 1) { const int w = c & 63; return (c & ~255) + 128 * (w >> 5) + 32 * ((c >> 6) & 3) + (w & 31); }
    if (MODE == 2) { const int j = c >> 1; return 256 * (j >> 7) + 128 * (c & 1) + (j & 127); }
    return c;
}
struct P0Item { const float* src; void* dst; const float* kscale; int N, K, mode, out8, k0, c0; };
__device__ __forceinline__ int physrow_rt(int mode, int c) { return mode == 1 ? physrow<1>(c) : (mode == 2 ? physrow<2>(c) : c); }
__device__ __forceinline__ void p0_item_load(const P0Item& d, f32x4 (&v)[16], int lane) {
    const int lr = lane >> 4, lc = lane & 15;
#pragma unroll
    for (int i = 0; i < 16; ++i) v[i] = __builtin_nontemporal_load((const f32x4*)(d.src + (size_t)(d.k0 + lr + 4 * i) * d.N + d.c0 + 4 * lc));
}
__device__ __forceinline__ void p0_item_finish(const P0Item& d, const f32x4 (&v)[16], LAS float* scr, int lane) {
    const int lr = lane >> 4, lc = lane & 15;
#pragma unroll
    for (int i = 0; i < 16; ++i) { const int k = lr + 4 * i; *(LAS f32x4*)(scr + k * 64 + 4 * (lc ^ ((k >> 3) & 7))) = v[i]; }
    LDS_WAIT(); asm volatile("" ::: "memory");
    const int a = lane & 7, bq = lane >> 3;
    float ks[8];
#pragma unroll
    for (int i = 0; i < 8; ++i) ks[i] = (d.kscale ? d.kscale[d.k0 + 8 * a + i] : 1.0f) * (d.out8 ? 32.0f : 1.0f);
#pragma unroll
    for (int j = 0; j < 8; ++j) { const int cl = bq + 8 * j; float x[8];
#pragma unroll
        for (int i = 0; i < 8; ++i) x[i] = scr[(8 * a + i) * 64 + 4 * ((cl >> 2) ^ a) + (cl & 3)] * ks[i];
        const size_t ro = (size_t)physrow_rt(d.mode, d.c0 + cl) * d.K + d.k0 + 8 * a;
        if (d.out8) { v2u o; o.x = pk4_fp8(x[0], x[1], x[2], x[3]); o.y = pk4_fp8(x[4], x[5], x[6], x[7]); __builtin_nontemporal_store(o, (GAS v2u*)((unsigned char*)d.dst + ro)); }
        else { v4u o; o.x = cvt_pk_bf16(x[0], x[1]); o.y = cvt_pk_bf16(x[2], x[3]); o.z = cvt_pk_bf16(x[4], x[5]); o.w = cvt_pk_bf16(x[6], x[7]); *(GAS v4u*)((bf16*)d.dst + ro) = o; } }
    LDS_WAIT(); asm volatile("" ::: "memory");
}
__device__ __forceinline__ void rms_row2_to_bf16(int lane, const float* xrow0, const float* xrow1, const float* g, bf16* orow0, bf16* orow1) {
    const GAS f32x4* xr0 = (const GAS f32x4*)xrow0 + lane; const GAS f32x4* xr1 = (const GAS f32x4*)xrow1 + lane; const GAS f32x4* gr = (const GAS f32x4*)g + lane;
    f32x4 v0[4], v1[4]; float s0 = 0.f, s1 = 0.f;
#pragma unroll
    for (int j = 0; j < 4; ++j) { v0[j] = xr0[64 * j]; v1[j] = xr1[64 * j]; }
#pragma unroll
    for (int j = 0; j < 4; ++j) { s0 += (v0[j].x * v0[j].x + v0[j].y * v0[j].y) + (v0[j].z * v0[j].z + v0[j].w * v0[j].w); s1 += (v1[j].x * v1[j].x + v1[j].y * v1[j].y) + (v1[j].z * v1[j].z + v1[j].w * v1[j].w); }
    const float rs0 = 1.0f / sqrtf(wave_sum(s0) * (1.f / DM) + RMS_EPS), rs1 = 1.0f / sqrtf(wave_sum(s1) * (1.f / DM) + RMS_EPS);
    GAS unsigned long long* o0 = (GAS unsigned long long*)orow0 + lane; GAS unsigned long long* o1 = (GAS unsigned long long*)orow1 + lane;
#pragma unroll
    for (int j = 0; j < 4; ++j) { const f32x4 gg = gr[64 * j];
        o0[64 * j] = (unsigned long long)cvt_pk_bf16(v0[j].x * rs0 * gg.x, v0[j].y * rs0 * gg.y) | ((unsigned long long)cvt_pk_bf16(v0[j].z * rs0 * gg.z, v0[j].w * rs0 * gg.w) << 32);
        o1[64 * j] = (unsigned long long)cvt_pk_bf16(v1[j].x * rs1 * gg.x, v1[j].y * rs1 * gg.y) | ((unsigned long long)cvt_pk_bf16(v1[j].z * rs1 * gg.z, v1[j].w * rs1 * gg.w) << 32); }
}
__device__ __forceinline__ void rms_row_to_bf16(int lane, const float* xrow, const float* g, bf16* orow) {
    const GAS f32x4* xr = (const GAS f32x4*)xrow + lane; const GAS f32x4* gr = (const GAS f32x4*)g + lane;
    f32x4 v[4]; float s = 0.f;
#pragma unroll
    for (int j = 0; j < 4; ++j) { v[j] = xr[64 * j]; s += (v[j].x * v[j].x + v[j].y * v[j].y) + (v[j].z * v[j].z + v[j].w * v[j].w); }
    const float rs = 1.0f / sqrtf(wave_sum(s) * (1.f / DM) + RMS_EPS);
    GAS unsigned long long* o8 = (GAS unsigned long long*)orow + lane;
#pragma unroll
    for (int j = 0; j < 4; ++j) { const f32x4 gg = gr[64 * j];
        o8[64 * j] = (unsigned long long)cvt_pk_bf16(v[j].x * rs * gg.x, v[j].y * rs * gg.y) | ((unsigned long long)cvt_pk_bf16(v[j].z * rs * gg.z, v[j].w * rs * gg.w) << 32); }
}
__device__ __forceinline__ void p0_s5_group(Frame& F, int g) {
    LAS float* AP = (LAS float*)(F.lds + RING_OFF);
    LAS float* BB = AP + 17 * 64 * 2;
    LAS float* CC = BB + 64 * 16 * 2;
    LAS float* KM = CC + 16 * 64 * 2;
    const float* are = F.in[I_ARE] + g * SSM_P; const float* aim = F.in[I_AIM] + g * SSM_P;
    const double dt = exp((double)F.in[I_LOGDT][g]);
    for (int e = F.tid; e < 17 * 64; e += NWAVES * 64) { const int m = e >> 6, p = e & 63; const double lr = are[p], li = aim[p];
        const double mag = exp(lr * dt * m), ang = li * dt * m; AP[e * 2] = (float)(mag * cos(ang)); AP[e * 2 + 1] = (float)(mag * sin(ang)); }
    for (int e = F.tid; e < 64 * 16; e += NWAVES * 64) { const int p = e >> 4, h = e & 15; const double lr = are[p], li = aim[p];
        const double mag = exp(lr * dt), ar = mag * cos(li * dt), ai = mag * sin(li * dt), den = lr * lr + li * li, nr = ar - 1.0, ni = ai;
        const double cr = (nr * lr + ni * li) / den, ci = (ni * lr - nr * li) / den;
        const double br = F.in[I_BRE][(size_t)(g * SSM_P + p) * SSM_H + h], bi = F.in[I_BIM][(size_t)(g * SSM_P + p) * SSM_H + h];
        BB[e * 2] = (float)(cr * br - ci * bi); BB[e * 2 + 1] = (float)(cr * bi + ci * br); }
    for (int e = F.tid; e < 16 * 64; e += NWAVES * 64) { CC[e * 2] = F.in[I_CRE][(size_t)g * 1024 + e]; CC[e * 2 + 1] = F.in[I_CIM][(size_t)g * 1024 + e]; }
    __syncthreads();
    if (F.tid < 64) { float* a16 = (float*)(F.ws + WS_A16) + (g * 64 + F.tid) * 2; a16[0] = AP[(16 * 64 + F.tid) * 2]; a16[1] = AP[(16 * 64 + F.tid) * 2 + 1]; }
    for (int e = F.tid; e < 16 * 256; e += NWAVES * 64) { const int m = e >> 8, ho = (e >> 4) & 15, hi = e & 15; float s = 0.f;
        for (int p = 0; p < 64; ++p) { const float cr = CC[(ho * 64 + p) * 2], ci = CC[(ho * 64 + p) * 2 + 1], ar = AP[(m * 64 + p) * 2], ai = AP[(m * 64 + p) * 2 + 1];
            const float tr = cr * ar - ci * ai, ti = cr * ai + ci * ar; s += tr * BB[(p * 16 + hi) * 2] - ti * BB[(p * 16 + hi) * 2 + 1]; }
        KM[e] = s; }
    __syncthreads();
    bf16* W1T = (bf16*)(F.ws + WS_S5 + (size_t)g * 262144); bf16* M2T = W1T + 128 * 256; bf16* W3T = M2T + 256 * 256;
    for (int e = F.tid; e < 128 * 256; e += NWAVES * 64) { const int n = e >> 8, k = e & 255, p = n & 63, j = k >> 4, hi = k & 15;
        const float ar = AP[((15 - j) * 64 + p) * 2], ai = AP[((15 - j) * 64 + p) * 2 + 1], br = BB[(p * 16 + hi) * 2], bi = BB[(p * 16 + hi) * 2 + 1];
        W1T[e] = (bf16)f2bf(n < 64 ? ar * br - ai * bi : ar * bi + ai * br); }
    for (int e = F.tid; e < 256 * 128; e += NWAVES * 64) { const int n = e >> 7, k = e & 127, i = n >> 4, ho = n & 15, p = k & 63;
        const float cr = CC[(ho * 64 + p) * 2], ci = CC[(ho * 64 + p) * 2 + 1], ar = AP[((i + 1) * 64 + p) * 2], ai = AP[((i + 1) * 64 + p) * 2 + 1];
        W3T[e] = (bf16)f2bf(k < 64 ? cr * ar - ci * ai : -(cr * ai + ci * ar)); }
    const float* dsk = F.in[I_SSMD] + g * 16;
    for (int e = F.tid; e < 256 * 256; e += NWAVES * 64) { const int n = e >> 8, k = e & 255, i = n >> 4, ho = n & 15, j = k >> 4, hi = k & 15;
        float v = 0.f; if (j <= i) { v = KM[((i - j) * 16 + ho) * 16 + hi]; if (i == j && ho == hi) v += dsk[ho]; }
        M2T[e] = (bf16)f2bf(v); }
    __syncthreads();
}
struct BigItem { const float* W; unsigned char* WT; const float* kscale; int N, K, mode, k0, c0; };
__device__ __forceinline__ void p0_big_load(const BigItem& d, f32x4 (&v)[16], int lane, int w) {
#pragma unroll
    for (int i = 0; i < 16; ++i) v[i] = __builtin_nontemporal_load((const f32x4*)(d.W + (size_t)(d.k0 + 16 * w + i) * d.N + d.c0 + 4 * lane));
}
__device__ __forceinline__ void p0_big_put(Frame& F, const f32x4 (&v)[16]) {
    LAS float* T = (LAS float*)(F.lds + RING_OFF); const int lane = F.lane, w = F.wave;
#pragma unroll
    for (int i = 0; i < 16; ++i) { const int k = 16 * w + i; *(LAS f32x4*)(T + k * 256 + 4 * (lane ^ (w & 7))) = v[i]; }
}
__device__ __forceinline__ void p0_big_emit(Frame& F, const BigItem& d) {
    LAS float* T = (LAS float*)(F.lds + RING_OFF); const int lane = F.lane, w = F.wave, r8 = lane >> 3, kc = lane & 7;
    float ksv[16];
#pragma unroll
    for (int i = 0; i < 16; ++i) ksv[i] = d.kscale ? d.kscale[d.k0 + 16 * kc + i] * 32.0f : 32.0f;
#pragma unroll
    for (int st = 0; st < 4; ++st) { const int cl = 32 * w + 8 * st + r8, chunk = cl >> 2, sub = cl & 3;
        float x[16];
#pragma unroll
        for (int i = 0; i < 16; ++i) x[i] = T[(16 * kc + i) * 256 + 4 * (chunk ^ kc) + sub] * ksv[i];
        v4u o; o.x = pk4_fp8(x[0], x[1], x[2], x[3]); o.y = pk4_fp8(x[4], x[5], x[6], x[7]); o.z = pk4_fp8(x[8], x[9], x[10], x[11]); o.w = pk4_fp8(x[12], x[13], x[14], x[15]);
        const int pr = d.mode == 2 ? physrow<2>(d.c0 + cl) : d.c0 + cl;
        __builtin_nontemporal_store(o, (GAS v4u*)(d.WT + ((size_t)(d.k0 >> 7) * d.N + pr) * 128 + 16 * kc)); }
}
constexpr int BI_UP1 = (DM / 128) * (UPW / 256), BI_DN1 = (DE / 128) * (DM / 256), NBIG = NE * (BI_UP1 + BI_DN1);
#ifndef BIG_SPLIT_AT
#define BIG_SPLIT_AT 2560
#endif
constexpr int BIG_SPLIT = BIG_SPLIT_AT;
__device__ __forceinline__ void convert_big(Frame& F, const int seg, const int lo, const int hi) {
        LAS int* qs = (LAS int*)(F.lds + MOE_LDS_OFF);
#define BIG_DRAW(it) do { if (F.tid == 0) qs[0] = lo + (int)atomicAdd((unsigned*)(F.ctl + CW_Q) + 64 + 64 * seg, 1u); __syncthreads(); it = qs[0]; __syncthreads(); } while (0)
#define BIG_DECODE(it, d) do { if ((it) < NE * BI_UP1) { const int e_ = (it) / BI_UP1, q_ = (it) % BI_UP1; d.W = F.in[I_WUP] + (size_t)e_ * DM * UPW; d.WT = F.hi + (WS_WUP - HI) + (size_t)e_ * UPW * DM; d.kscale = F.in[I_N2G]; \
            d.N = UPW; d.K = DM; d.mode = 2; d.k0 = 128 * (q_ / (UPW / 256)); d.c0 = 256 * (q_ % (UPW / 256)); } \
        else { const int r_ = (it) - NE * BI_UP1, e_ = r_ / BI_DN1, q_ = r_ % BI_DN1; d.W = F.in[I_WDN] + (size_t)e_ * DE * DM; d.WT = F.hi + (WS_WDN - HI) + (size_t)e_ * DM * DE; d.kscale = nullptr; \
            d.N = DM; d.K = DE; d.mode = 0; d.k0 = 128 * (q_ / (DM / 256)); d.c0 = 256 * (q_ % (DM / 256)); } } while (0)
        int it, itn; BigItem d, dn; f32x4 v[16];
        BIG_DRAW(it);
        if (it < hi) { BIG_DECODE(it, d); p0_big_load(d, v, F.lane, F.wave);
            for (;;) {
                p0_big_put(F, v);
                BIG_DRAW(itn);
                const bool hasn = itn < hi;
                if (hasn) { BIG_DECODE(itn, dn); p0_big_load(dn, v, F.lane, F.wave); }
                p0_big_emit(F, d);
                __syncthreads();
                if (!hasn) break;
                d = dn; } }
#undef BIG_DRAW
#undef BIG_DECODE
}


__device__ __forceinline__ void p0_prologue(Frame& F) {
    if (F.vcu < SSM_G) p0_s5_group(F, F.vcu);
    LAS float* scr = (LAS float*)(F.lds + RING_OFF + F.wave * 16384);
    const int gw = F.vcu * NWAVES + F.wave, NGW = F.G * NWAVES;
    { float* wrT = (float*)(F.ws + WS_WRT); const float* wr = F.in[I_WR]; const float* g2 = F.in[I_N2G];
      for (int e = gw * 64 + F.lane; e < NE * DM; e += NGW * 64) { const int ex = e >> 10, k = e & 1023; wrT[e] = g2[k] * wr[k * NE + ex]; } }
    { bf16* XN = (bf16*)(F.hi + (WS_XN - HI)); int m = gw;
      for (; m + NGW < M; m += 2 * NGW) rms_row2_to_bf16(F.lane, F.in[I_X] + (size_t)m * DM, F.in[I_X] + (size_t)(m + NGW) * DM, F.in[I_N1G], XN + (size_t)m * DM, XN + (size_t)(m + NGW) * DM);
      if (m < M) rms_row_to_bf16(F.lane, F.in[I_X] + (size_t)m * DM, F.in[I_N1G], XN + (size_t)m * DM); }
    constexpr int IT_IN = (DM / 64) * (IN_W / 64), IT_GLU = (512 / 64) * (512 / 64), IT_PS = (512 / 64) * (DM / 64), IT_OUT = (DM / 64) * (DM / 64);
    constexpr int IT_UP1 = (DM / 64) * (UPW / 64), IT_DN1 = (DE / 64) * (DM / 64);
    constexpr int NITEMS = IT_IN + IT_GLU + 2 * IT_PS + IT_OUT;
#define P0_DECODE(it, d) do { int r_ = (it); int nb_; \
        if (r_ < IT_IN) { d.src = F.in[I_WIN]; d.dst = F.hi + (WS_WIN - HI); d.kscale = nullptr; d.N = IN_W; d.K = DM; d.mode = 1; d.out8 = 0; } \
        else if ((r_ -= IT_IN) < IT_GLU) { d.src = F.in[I_WGLU]; d.dst = F.ws + WS_WGLU; d.kscale = nullptr; d.N = 512; d.K = 512; d.mode = 0; d.out8 = 0; } \
        else if ((r_ -= IT_GLU) < IT_PS) { d.src = F.in[I_WPS]; d.dst = F.ws + WS_WPS; d.kscale = nullptr; d.N = DM; d.K = 512; d.mode = 0; d.out8 = 0; } \
        else if ((r_ -= IT_PS) < IT_PS) { d.src = F.in[I_WPA]; d.dst = F.ws + WS_WPA; d.kscale = nullptr; d.N = DM; d.K = 512; d.mode = 0; d.out8 = 0; } \
        else if ((r_ -= IT_PS) < IT_OUT) { d.src = F.in[I_WOUT]; d.dst = F.ws + WS_WOUT; d.kscale = nullptr; d.N = DM; d.K = DM; d.mode = 0; d.out8 = 0; } \
        else if ((r_ -= IT_OUT) < NE * IT_UP1) { const int e_ = r_ / IT_UP1; r_ -= e_ * IT_UP1; d.src = F.in[I_WUP] + (size_t)e_ * DM * UPW; d.dst = F.hi + (WS_WUP - HI) + (size_t)e_ * UPW * DM; d.kscale = F.in[I_N2G]; d.N = UPW; d.K = DM; d.mode = 2; d.out8 = 1; } \
        else { r_ -= NE * IT_UP1; const int e_ = r_ / IT_DN1; r_ -= e_ * IT_DN1; d.src = F.in[I_WDN] + (size_t)e_ * DE * DM; d.dst = F.hi + (WS_WDN - HI) + (size_t)e_ * DM * DE; d.kscale = nullptr; d.N = DM; d.K = DE; d.mode = 0; d.out8 = 1; } \
        nb_ = d.N / 64; d.k0 = 64 * (r_ / nb_); d.c0 = 64 * (r_ % nb_); } while (0)
    int qcur = 0, qend = 0;
#define P0_DRAW(it) do { if (qcur == qend) { unsigned q_ = 0; if (F.lane == 0) q_ = atomicAdd((unsigned*)(F.ctl + CW_Q), 1u); qcur = 8 * (int)__builtin_amdgcn_readfirstlane(q_); qend = qcur + 8; } it = qcur++; } while (0)
    {
        P0Item dA, dB; f32x4 vA[16], vB[16]; int itA, itB;
        P0_DRAW(itA);
        if (itA < NITEMS) { P0_DECODE(itA, dA); p0_item_load(dA, vA, F.lane);
            for (;;) {
                P0_DRAW(itB); const bool hasB = itB < NITEMS;
                if (hasB) { P0_DECODE(itB, dB); p0_item_load(dB, vB, F.lane); }
                p0_item_finish(dA, vA, scr, F.lane);
                if (!hasB) break;
                P0_DRAW(itA); const bool hasA = itA < NITEMS;
                if (hasA) { P0_DECODE(itA, dA); p0_item_load(dA, vA, F.lane); }
                p0_item_finish(dB, vB, scr, F.lane);
                if (!hasA) break;
            } }
    }
#undef P0_DECODE
#undef P0_DRAW
    __syncthreads();
    convert_big(F, 0, 0, BIG_SPLIT);
}

typedef const pg8::f32x4 (&AccRef)[2][2][4][2];
__device__ __forceinline__ v4u pack8(const f32x4 a, const f32x4 b) { v4u w; w.x = cvt_pk_bf16(a[0], a[1]); w.y = cvt_pk_bf16(a[2], a[3]); w.z = cvt_pk_bf16(b[0], b[1]); w.w = cvt_pk_bf16(b[2], b[3]); return w; }
__device__ __forceinline__ void unpack8(const v4u w, f32x4& a, f32x4& b) { a = (f32x4){bflo(w.x), bfhi(w.x), bflo(w.y), bfhi(w.y)}; b = (f32x4){bflo(w.z), bfhi(w.z), bflo(w.w), bfhi(w.w)}; }

struct EpiInProj {
    static constexpr bool PERM = true;
    __device__ __forceinline__ bool keep(const pg8::Unit&) const { return false; }
    bf16 *U, *Q, *Kb, *V, *G1, *G2; const float *bgate, *qg, *kg;
    __device__ __forceinline__ void operator()(AccRef acc, const pg8::Unit& u, int wr, int wc, int fr, int fq, const LAS int*) const {
        const int pn = u.pn, row0 = u.pm * 256 + wr * 64 + fr;
        if (pn < 2) {
#pragma unroll
            for (int ai = 0; ai < 2; ++ai)
#pragma unroll
                for (int m = 0; m < 4; ++m) { const int row = row0 + ai * 128 + m * 16, b = row >> 11, t = row & 2047;
#pragma unroll
                    for (int bj = 0; bj < 2; ++bj) { const int lc = 256 * pn + 64 * wc + 32 * bj + 8 * fq, g = lc >> 4, ch = lc & 15;
                        *(v4u*)(U + ((size_t)(b * SSM_G + g) * SEQ + t) * 16 + ch) = pack8(acc[ai][bj][m][0], acc[ai][bj][m][1]); } }
        } else if (pn < 6) {
            const bool isq = pn < 4; const float* gv = isq ? qg : kg; const float sc = isq ? QSCALE : 1.0f;
            bf16* dst = (isq ? Q : Kb) + 256 * (pn - (isq ? 2 : 4)) + 64 * wc + 8 * fq;
            f32x4 gg[2][2];
#pragma unroll
            for (int bj = 0; bj < 2; ++bj)
#pragma unroll
                for (int n = 0; n < 2; ++n) gg[bj][n] = *(const f32x4*)(gv + 32 * bj + 8 * fq + 4 * n) * sc;
#pragma unroll
            for (int ai = 0; ai < 2; ++ai)
#pragma unroll
                for (int m = 0; m < 4; ++m) { const int row = row0 + ai * 128 + m * 16; float ss = 0.f;
#pragma unroll
                    for (int bj = 0; bj < 2; ++bj)
#pragma unroll
                        for (int n = 0; n < 2; ++n) { const f32x4 x = acc[ai][bj][m][n]; ss += (x[0] * x[0] + x[1] * x[1]) + (x[2] * x[2] + x[3] * x[3]); }
                    ss = xor16_add(ss); ss = xor32_add(ss);
                    const float rs = __builtin_amdgcn_rsqf(ss * (1.0f / 64.0f) + RMS_EPS);
#pragma unroll
                    for (int bj = 0; bj < 2; ++bj) *(v4u*)(dst + (size_t)row * 512 + 32 * bj) = pack8(acc[ai][bj][m][0] * rs * gg[bj][0], acc[ai][bj][m][1] * rs * gg[bj][1]); }
        } else if (pn < 8) {
            bf16* dst = V + 256 * (pn - 6) + 64 * wc + 8 * fq;
#pragma unroll
            for (int ai = 0; ai < 2; ++ai)
#pragma unroll
                for (int m = 0; m < 4; ++m) { const int row = row0 + ai * 128 + m * 16;
#pragma unroll
                    for (int bj = 0; bj < 2; ++bj) *(v4u*)(dst + (size_t)row * 512 + 32 * bj) = pack8(acc[ai][bj][m][0], acc[ai][bj][m][1]); }
        } else {
            const int gc = 256 * (pn - 8) + 64 * wc + 8 * fq;
            bf16* dst = (gc < 1024 ? G1 + gc : G2 + (gc - 1024));
            f32x4 bb[2][2];
#pragma unroll
            for (int bj = 0; bj < 2; ++bj)
#pragma unroll
                for (int n = 0; n < 2; ++n) bb[bj][n] = *(const f32x4*)(bgate + gc + 32 * bj + 4 * n);
#pragma unroll
            for (int ai = 0; ai < 2; ++ai)
#pragma unroll
                for (int m = 0; m < 4; ++m) { const int row = row0 + ai * 128 + m * 16;
#pragma unroll
                    for (int bj = 0; bj < 2; ++bj) { f32x4 a = acc[ai][bj][m][0] + bb[bj][0], b = acc[ai][bj][m][1] + bb[bj][1];
#pragma unroll
                        for (int e = 0; e < 4; ++e) { a[e] = fsigmoid_asm(a[e]); b[e] = fsigmoid_asm(b[e]); }
                        *(v4u*)(dst + (size_t)row * 1024 + 32 * bj) = pack8(a, b); } }
        }
    }
};
template <int MODE> struct EpiMix {
    static constexpr bool PERM = true;
    __device__ __forceinline__ bool keep(const pg8::Unit&) const { return false; }
    const bf16* P0; const bf16* P1; bf16* O; const float* bias; int ld;
    __device__ __forceinline__ void operator()(AccRef acc, const pg8::Unit& u, int wr, int wc, int fr, int fq, const LAS int*) const {
        const int row0 = u.pm * 256 + wr * 64 + fr, col0 = u.pn * 256 + wc * 32 + 8 * fq;
        f32x4 bb[2][2];
#pragma unroll
        for (int bj = 0; bj < 2; ++bj)
#pragma unroll
            for (int n = 0; n < 2; ++n) bb[bj][n] = (MODE == 0) ? *(const f32x4*)(bias + col0 + bj * 128 + 4 * n) : (f32x4){0.f, 0.f, 0.f, 0.f};
#pragma unroll
        for (int ai = 0; ai < 2; ++ai) {
            v4u q0[4][2], q1[4][2];
#pragma unroll
            for (int m = 0; m < 4; ++m)
#pragma unroll
                for (int bj = 0; bj < 2; ++bj) { const size_t off = (size_t)(row0 + ai * 128 + m * 16) * ld + col0 + bj * 128; q0[m][bj] = *(const v4u*)(P0 + off); if (MODE == 2) q1[m][bj] = *(const v4u*)(P1 + off); }
#pragma unroll
            for (int m = 0; m < 4; ++m) { const size_t off = (size_t)(row0 + ai * 128 + m * 16) * ld + col0;
#pragma unroll
                for (int bj = 0; bj < 2; ++bj) { f32x4 a = acc[ai][bj][m][0], b = acc[ai][bj][m][1], p0a, p0b;
                    unpack8(q0[m][bj], p0a, p0b);
                    if (MODE == 0) { a += bb[bj][0]; b += bb[bj][1];
#pragma unroll
                        for (int e = 0; e < 4; ++e) { a[e] = p0a[e] * fsigmoid_fast(a[e]); b[e] = p0b[e] * fsigmoid_fast(b[e]); } }
                    else if (MODE == 1) { a *= p0a; b *= p0b; }
                    else { f32x4 p1a, p1b; unpack8(q1[m][bj], p1a, p1b); a = p0a + p1a * a; b = p0b + p1b * b; }
                    if (MODE == 0) __builtin_amdgcn_raw_buffer_store_b128(pack8(a, b), __builtin_amdgcn_make_buffer_rsrc(O, 0, M * 512 * 2, 0x00020000), (int)((off + bj * 128) * 2), 0, 16);
                    else *(v4u*)(O + off + bj * 128) = pack8(a, b); } } }
    }
};
__device__ __forceinline__ void panel_publish(unsigned* flag) {
    asm volatile("s_waitcnt vmcnt(0)" ::: "memory"); __builtin_amdgcn_s_barrier(); asm volatile("" ::: "memory");
    if (threadIdx.x == 0) __hip_atomic_fetch_add(flag, 1u, __ATOMIC_RELAXED, __HIP_MEMORY_SCOPE_AGENT);
}
__device__ __forceinline__ void panel_wait(unsigned* flag, unsigned want) {
    unsigned spins = 0;
    while (__hip_atomic_load(flag, __ATOMIC_RELAXED, __HIP_MEMORY_SCOPE_AGENT) < want && ++spins < (1u << 22)) __builtin_amdgcn_s_sleep(2);
    asm volatile("" ::: "memory");
}
struct PanelOrder {
    pg8::StaticOrder so; unsigned* wflag; unsigned* pflag;
    __device__ __forceinline__ bool next(int i, pg8::Unit& u) const { return so.next(i, u); }
    __device__ __forceinline__ int row_slot(const pg8::Unit&, int) const { return 0; }
    __device__ __forceinline__ const LAS int* slot_table() const { return nullptr; }
    __device__ __forceinline__ int a_row(const pg8::Unit& u, int r, int) const { return u.pm * 256 + r; }
    __device__ __forceinline__ const char* a_base(const pg8::Gemm& g, const pg8::Unit& u, size_t tstep) const { return (const char*)g.A + (size_t)u.pm * tstep; }
    __device__ __forceinline__ void a_ready(const pg8::Unit& u) const { if (wflag) panel_wait(wflag + u.pm * PANEL_STRIDE, 4u); }
    __device__ __forceinline__ void done(const pg8::Unit& u) const { if (pflag) panel_publish(pflag + u.pm * PANEL_STRIDE); }
};
struct EpiOut {
    static constexpr bool PERM = true;
    static constexpr int PID = 5;
    __device__ __forceinline__ bool keep(const pg8::Unit&) const { return false; }
    const float* X; bf16* H; unsigned char* HB; bool wt;
    __device__ __forceinline__ void operator()(AccRef acc, const pg8::Unit& u, int wr, int wc, int fr, int fq, const LAS int*) const {
        const int row0 = u.pm * 256 + wr * 64 + fr, col0 = u.pn * 256 + wc * 32 + 8 * fq;
#pragma unroll
        for (int ai = 0; ai < 2; ++ai) {
            f32x4 xv[4][2][2];
#pragma unroll
            for (int m = 0; m < 4; ++m)
#pragma unroll
                for (int bj = 0; bj < 2; ++bj)
#pragma unroll
                    for (int n = 0; n < 2; ++n) xv[m][bj][n] = __builtin_nontemporal_load((const f32x4*)(X + (size_t)(row0 + ai * 128 + m * 16) * DM + col0 + bj * 128 + n * 4));
#pragma unroll
            for (int m = 0; m < 4; ++m) { const size_t off = (size_t)(row0 + ai * 128 + m * 16) * DM + col0;
#pragma unroll
                for (int bj = 0; bj < 2; ++bj) { const f32x4 ha = xv[m][bj][0] + acc[ai][bj][m][0], hb = xv[m][bj][1] + acc[ai][bj][m][1]; const v4u hw = pack8(ha, hb);
                    if (wt) __builtin_amdgcn_raw_buffer_store_b128(hw, __builtin_amdgcn_make_buffer_rsrc(H, 0, M * DM * 2, 0x00020000), (int)((off + bj * 128) * 2), 0, 16);
                    else *(v4u*)(H + off + bj * 128) = hw;
                    v2u fb; fb.x = pk4_fp8(ha[0], ha[1], ha[2], ha[3]); fb.y = pk4_fp8(hb[0], hb[1], hb[2], hb[3]); *(v2u*)(HB + off + bj * 128) = fb; } } }
    }
};
struct ChainOrder {
    pg8::StaticOrder so; const bf16* A_att; const bf16* A_ssm; unsigned* pflag; unsigned* wflag;
    __device__ __forceinline__ bool next(int i, pg8::Unit& u) const { pg8::Unit t; if (!so.next(i >> 1, t)) return false; u.pm = t.pm; u.pn = (i & 1) ? t.pn : 4 + t.pn; return true; }
    __device__ __forceinline__ int row_slot(const pg8::Unit&, int) const { return 0; }
    __device__ __forceinline__ const LAS int* slot_table() const { return nullptr; }
    __device__ __forceinline__ int a_row(const pg8::Unit& u, int r, int) const { return u.pm * 256 + r; }
    __device__ __forceinline__ const char* a_base(const pg8::Gemm&, const pg8::Unit& u, size_t tstep) const { return (const char*)(u.pn >= 4 ? A_att : A_ssm) + (size_t)u.pm * tstep; }
    __device__ __forceinline__ void a_ready(const pg8::Unit& u) const { if (wflag && u.pn < 4) panel_wait(wflag + u.pm * PANEL_STRIDE, 2u); }
    __device__ __forceinline__ void done(const pg8::Unit& u) const { if (pflag && u.pn < 4) panel_publish(pflag + u.pm * PANEL_STRIDE); }
};
struct EpiChain {
    static constexpr bool PERM = true;
    const bf16* G1; const bf16* G2; bf16* MX; bool wt;
    __device__ __forceinline__ bool keep(const pg8::Unit& u) const { return u.pn >= 4; }
    __device__ __forceinline__ void operator()(pg8::f32x4 (&acc)[2][2][4][2], const pg8::Unit& u, int wr, int wc, int fr, int fq, const LAS int*) const {
        const bool att = u.pn >= 4; const int row0 = u.pm * 256 + wr * 64 + fr, col0 = (u.pn & 3) * 256 + wc * 32 + 8 * fq;
#pragma unroll
        for (int ai = 0; ai < 2; ++ai) {
            v4u q1[4][2], q2[4][2];
#pragma unroll
            for (int m = 0; m < 4; ++m)
#pragma unroll
                for (int bj = 0; bj < 2; ++bj) { const size_t off = (size_t)(row0 + ai * 128 + m * 16) * DM + col0 + bj * 128; q1[m][bj] = *(const v4u*)(G1 + off); if (att) q2[m][bj] = *(const v4u*)(G2 + off); }
#pragma unroll
            for (int m = 0; m < 4; ++m)
#pragma unroll
                for (int bj = 0; bj < 2; ++bj) { f32x4 g1a, g1b; unpack8(q1[m][bj], g1a, g1b);
                    if (att) { f32x4 g2a, g2b; unpack8(q2[m][bj], g2a, g2b);
#pragma unroll
                        for (int e = 0; e < 4; ++e) { acc[ai][bj][m][0][e] *= g2a[e] * __builtin_amdgcn_rcpf(g1a[e]); acc[ai][bj][m][1][e] *= g2b[e] * __builtin_amdgcn_rcpf(g1b[e]); } }
                    else { const v4u o = pack8(acc[ai][bj][m][0] * g1a, acc[ai][bj][m][1] * g1b); const size_t eo = (size_t)(row0 + ai * 128 + m * 16) * DM + col0 + bj * 128;
                        if (wt) __builtin_amdgcn_raw_buffer_store_b128(o, __builtin_amdgcn_make_buffer_rsrc(MX, 0, M * DM * 2, 0x00020000), (int)(eo * 2), 0, 16); else *(v4u*)(MX + eo) = o; } } }
    }
};
constexpr int CW_MFLAG = 32768, MFLAG_STRIDE = 16;
static_assert((CW_MFLAG + 2 * 288 * MFLAG_STRIDE) * 4 <= (int)CTL_ZERO_BYTES && CW_MFLAG + 2 * 288 * MFLAG_STRIDE <= CW_PANEL4 && (CW_PANEL3 + 64 * PANEL_STRIDE) * 4 <= (int)CTL_ZERO_BYTES, "control words inside the per-call memset");
template <int NN, bool TOKROWS> struct MoeOrder {
    int nunits, G, vcu; const LAS int* cnt; const LAS int* tstart; const LAS int* tile2e; const int* elist; unsigned* mflag; LAS int* st;
    __device__ __forceinline__ const LAS int* slot_table() const { return st; }
    __device__ __forceinline__ void fill(int tid, const float* val) const {
        const int hi = tid >> 8, r = tid & 255;
#pragma unroll 1
        for (int j0 = 0; j0 < SLOT_UNITS / 2; j0 += 4) {
            int e0 = -2, e1 = -2, e2 = -2, e3 = -2; pg8::Unit u;
            if (next(2 * (j0 + 0) + hi, u)) e0 = row_slot(u, r);
            if (next(2 * (j0 + 1) + hi, u)) e1 = row_slot(u, r);
            if (next(2 * (j0 + 2) + hi, u)) e2 = row_slot(u, r);
            if (next(2 * (j0 + 3) + hi, u)) e3 = row_slot(u, r);
            const float v0 = e0 >= 0 ? val[TOKROWS ? (e0 >> 2) : e0] : 0.0f, v1 = e1 >= 0 ? val[TOKROWS ? (e1 >> 2) : e1] : 0.0f;
            const float v2 = e2 >= 0 ? val[TOKROWS ? (e2 >> 2) : e2] : 0.0f, v3 = e3 >= 0 ? val[TOKROWS ? (e3 >> 2) : e3] : 0.0f;
            if (e0 != -2) st[(2 * (j0 + 0) + hi) * 256 + r] = e0 < 0 ? -1 : (int)(((__float_as_uint(v0) + 0x8000u) & 0xFFFF0000u) | (unsigned)e0);
            if (e1 != -2) st[(2 * (j0 + 1) + hi) * 256 + r] = e1 < 0 ? -1 : (int)(((__float_as_uint(v1) + 0x8000u) & 0xFFFF0000u) | (unsigned)e1);
            if (e2 != -2) st[(2 * (j0 + 2) + hi) * 256 + r] = e2 < 0 ? -1 : (int)(((__float_as_uint(v2) + 0x8000u) & 0xFFFF0000u) | (unsigned)e2);
            if (e3 != -2) st[(2 * (j0 + 3) + hi) * 256 + r] = e3 < 0 ? -1 : (int)(((__float_as_uint(v3) + 0x8000u) & 0xFFFF0000u) | (unsigned)e3); } }
    __device__ __forceinline__ void a_ready(const pg8::Unit& u) const {
        if constexpr (!TOKROWS) { unsigned* f = mflag + u.pm * MFLAG_STRIDE; unsigned spins = 0;
            while (__hip_atomic_load(f, __ATOMIC_RELAXED, __HIP_MEMORY_SCOPE_AGENT) < 8u && ++spins < (1u << 22)) __builtin_amdgcn_s_sleep(2);
            asm volatile("" ::: "memory"); } }
    __device__ __forceinline__ void done(const pg8::Unit& u) const {
        if constexpr (TOKROWS) { asm volatile("s_waitcnt vmcnt(0)" ::: "memory"); __builtin_amdgcn_s_barrier(); asm volatile("" ::: "memory");
            if (threadIdx.x == 0) __hip_atomic_fetch_add(mflag + u.pm * MFLAG_STRIDE, 1u, __ATOMIC_RELAXED, __HIP_MEMORY_SCOPE_AGENT); } }
    __device__ __forceinline__ bool next(int i, pg8::Unit& u) const { const long L = (long)i * G + vcu; if (L >= nunits) return false; const int pm = (int)(L / NN), pnl = (int)(L % NN);
        u.pm = pm; u.pn = tile2e[pm] * NN + pnl; return true; }
    __device__ __forceinline__ int row_slot(const pg8::Unit& u, int r) const { const int e = u.pn / NN, pos = (u.pm - tstart[e]) * 256 + r; return pos < cnt[e] ? elist[e * M + pos] : -1; }
    __device__ __forceinline__ int a_row(const pg8::Unit& u, int r, int slot) const { return TOKROWS ? (slot < 0 ? 0 : ((slot & 0xFFFF) >> 2)) : u.pm * 256 + r; }
    __device__ __forceinline__ const char* a_base(const pg8::Gemm& g, const pg8::Unit&, size_t) const { return (const char*)g.A; }
};
struct EpiUp {
    static constexpr bool PERM = true;
    __device__ __forceinline__ bool keep(const pg8::Unit&) const { return false; }
    unsigned char* ACT; const float* bup; const float* rs2;
    __device__ __forceinline__ void operator()(AccRef acc, const pg8::Unit& u, int wr, int wc, int fr, int fq, const LAS int* tab) const {
        const int e = u.pn >> 3, pnl = u.pn & 7, j0 = 128 * pnl + 32 * wc + 8 * fq;
        f32x2 bG[2][2], bL[2][2];
#pragma unroll
        for (int q = 0; q < 4; ++q) { const f32x4 b4 = *(const f32x4*)(bup + (size_t)e * UPW + 2 * j0 + 4 * q); bG[q >> 1][q & 1] = (f32x2){b4[0], b4[2]}; bL[q >> 1][q & 1] = (f32x2){b4[1] * 4.0f + 4.0f, b4[3] * 4.0f + 4.0f}; }
        int sl[2][4];
#pragma unroll
        for (int ai = 0; ai < 2; ++ai)
#pragma unroll
            for (int m = 0; m < 4; ++m) sl[ai][m] = tab[ai * 128 + wr * 64 + m * 16 + fr];
#pragma unroll
        for (int ai = 0; ai < 2; ++ai)
#pragma unroll
            for (int m = 0; m < 4; ++m) { const int r = ai * 128 + wr * 64 + m * 16 + fr, en = sl[ai][m];
                if (en >= 0) { const float rs = __uint_as_float((unsigned)en & 0xFFFF0000u) * 0.03125f;
                    const f32x2 rsv = (f32x2){rs, rs}, rs4 = rsv * 4.0f; f32x2 o[2][2];
#pragma unroll
                    for (int n = 0; n < 2; ++n)
#pragma unroll
                        for (int p = 0; p < 2; ++p) {
                            f32x2 gl = (f32x2){acc[ai][0][m][n][2 * p], acc[ai][0][m][n][2 * p + 1]} * rsv + bG[n][p], li = (f32x2){acc[ai][1][m][n][2 * p], acc[ai][1][m][n][2 * p + 1]} * rs4 + bL[n][p];
                            gl.x = fminf(gl.x, 7.0f); gl.y = fminf(gl.y, 7.0f); li.x = __builtin_amdgcn_fmed3f(li.x, -24.0f, 32.0f); li.y = __builtin_amdgcn_fmed3f(li.y, -24.0f, 32.0f);
                            const f32x2 t = gl * (-1.702f * 1.4426950408889634f); f32x2 d = (f32x2){__builtin_amdgcn_exp2f(t.x), __builtin_amdgcn_exp2f(t.y)} + 1.0f;
                            d = (f32x2){__builtin_amdgcn_rcpf(d.x), __builtin_amdgcn_rcpf(d.y)};
                            o[n][p] = (gl * d) * li; }
                    const unsigned long long ov = (unsigned long long)pk4_fp8(o[0][0].x, o[0][0].y, o[0][1].x, o[0][1].y) | ((unsigned long long)pk4_fp8(o[1][0].x, o[1][0].y, o[1][1].x, o[1][1].y) << 32);
                    __hip_atomic_store((unsigned long long*)(ACT + (size_t)(u.pm * 256 + r) * DE + j0), ov, __ATOMIC_RELAXED, __HIP_MEMORY_SCOPE_AGENT); } }
    }
};
struct EpiDown {
    static constexpr int PERM = 2;
    __device__ __forceinline__ bool keep(const pg8::Unit&) const { return false; }
    unsigned char* YS2; const float* bdn; const float* wslot;
    __device__ __forceinline__ void operator()(AccRef acc, const pg8::Unit& u, int wr, int wc, int fr, int fq, const LAS int* tab) const {
        const int e = u.pn >> 2, pnl = u.pn & 3, c0 = 256 * pnl + 64 * wc + 16 * fq;
        f32x4 bb[2][2];
#pragma unroll
        for (int bj = 0; bj < 2; ++bj)
#pragma unroll
            for (int n = 0; n < 2; ++n) bb[bj][n] = *(const f32x4*)(bdn + (size_t)e * DM + c0 + bj * 8 + 4 * n);
        int sl[2][4]; float wv[2][4];
#pragma unroll
        for (int ai = 0; ai < 2; ++ai)
#pragma unroll
            for (int m = 0; m < 4; ++m) { const int en = tab[ai * 128 + wr * 64 + m * 16 + fr]; sl[ai][m] = en < 0 ? -1 : (en & 0xFFFF); wv[ai][m] = __uint_as_float((unsigned)en & 0xFFFF0000u); }
#pragma unroll
        for (int ai = 0; ai < 2; ++ai)
#pragma unroll
            for (int m = 0; m < 4; ++m) { const int slot = sl[ai][m];
                if (slot >= 0) { const float w = wv[ai][m] * 16.0f; v4u ov;
                    { const f32x4 ya = (acc[ai][0][m][0] * 0.0078125f + bb[0][0]) * w, yb = (acc[ai][0][m][1] * 0.0078125f + bb[0][1]) * w; ov.x = pk4_fp8(ya[0], ya[1], ya[2], ya[3]); ov.y = pk4_fp8(yb[0], yb[1], yb[2], yb[3]); }
                    { const f32x4 ya = (acc[ai][1][m][0] * 0.0078125f + bb[1][0]) * w, yb = (acc[ai][1][m][1] * 0.0078125f + bb[1][1]) * w; ov.z = pk4_fp8(ya[0], ya[1], ya[2], ya[3]); ov.w = pk4_fp8(yb[0], yb[1], yb[2], yb[3]); }
                    *(v4u*)(YS2 + (size_t)slot * DM + c0) = ov; } }
    }
};

constexpr int S5_UPITCH = 528, S5_SX_OFF = 128 * S5_UPITCH, S5_XPITCH = 132;
__device__ __forceinline__ void s5_unit(Frame& F, int b, int g) {
    LAS unsigned char* Uimg = F.lds + RING_OFF; LAS float* SX = (LAS float*)(F.lds + RING_OFF + S5_SX_OFF);
    const int tid = F.tid, lane = F.lane, w = F.wave, r32 = lane & 31, hi = lane >> 5;
    const bf16* Ug = (const bf16*)(F.ws + WS_U) + (size_t)(b * SSM_G + g) * SEQ * 16;
    const bf16* W1T = (const bf16*)(F.ws + WS_S5 + (size_t)g * 262144); const bf16* M2T = W1T + 128 * 256; const bf16* W3T = M2T + 256 * 256;
    bf16x8 bw1[16];
    { const int nt = w & 3;
#pragma unroll
      for (int ks = 0; ks < 16; ++ks) bw1[ks] = *(const bf16x8*)(W1T + (size_t)(32 * nt + r32) * 256 + 16 * ks + 8 * hi); }
#pragma unroll
    for (int j = 0; j < 8; ++j) { const int q = tid + 512 * j; *(LAS v4u*)(Uimg + (q >> 5) * S5_UPITCH + (q & 31) * 16) = *(const v4u*)(Ug + (size_t)q * 8); }
    __syncthreads();
    { const int nt = w & 3, mt0 = 2 * (w >> 2);
      f32x16 s0 = {0}, s1 = {0};
#pragma unroll
      for (int ks = 0; ks < 16; ++ks) {
          const bf16x8 bf = bw1[ks];
          const bf16x8 a0 = *(const LAS bf16x8*)(Uimg + (32 * mt0 + r32) * S5_UPITCH + (16 * ks + 8 * hi) * 2);
          const bf16x8 a1 = *(const LAS bf16x8*)(Uimg + (32 * (mt0 + 1) + r32) * S5_UPITCH + (16 * ks + 8 * hi) * 2);
          s0 = __builtin_amdgcn_mfma_f32_32x32x16_bf16(a0, bf, s0, 0, 0, 0); s1 = __builtin_amdgcn_mfma_f32_32x32x16_bf16(a1, bf, s1, 0, 0, 0); }
#pragma unroll
      for (int r = 0; r < 16; ++r) { SX[(32 * mt0 + crow(r, hi)) * S5_XPITCH + 32 * nt + r32] = s0[r]; SX[(32 * (mt0 + 1) + crow(r, hi)) * S5_XPITCH + 32 * nt + r32] = s1[r]; } }
    bf16x8 bm2[16], bw3[8];
#pragma unroll
    for (int ks = 0; ks < 16; ++ks) bm2[ks] = *(const bf16x8*)(M2T + (size_t)(32 * w + r32) * 256 + 16 * ks + 8 * hi);
#pragma unroll
    for (int ks = 0; ks < 8; ++ks) bw3[ks] = *(const bf16x8*)(W3T + (size_t)(32 * w + r32) * 128 + 16 * ks + 8 * hi);
    __syncthreads();
    if (tid < 64) {
        const float* a16 = (const float*)(F.ws + WS_A16) + (g * 64 + tid) * 2; const float ar = a16[0], ai = a16[1]; float xr = 0.f, xi = 0.f;
#pragma unroll 8
        for (int c = 0; c < SSM_NC; ++c) { const float sr = SX[c * S5_XPITCH + tid], si = SX[c * S5_XPITCH + 64 + tid];
            SX[c * S5_XPITCH + tid] = xr; SX[c * S5_XPITCH + 64 + tid] = xi;
            const float nr = ar * xr - ai * xi + sr, ni = ar * xi + ai * xr + si; xr = nr; xi = ni; }
    }
    __syncthreads();
    { f32x16 y[4] = {{0}, {0}, {0}, {0}};
#pragma unroll
      for (int ks = 0; ks < 16; ++ks) {
          const bf16x8 bf = bm2[ks];
#pragma unroll
          for (int mt = 0; mt < 4; ++mt) { const bf16x8 a = *(const LAS bf16x8*)(Uimg + (32 * mt + r32) * S5_UPITCH + (16 * ks + 8 * hi) * 2); y[mt] = __builtin_amdgcn_mfma_f32_32x32x16_bf16(a, bf, y[mt], 0, 0, 0); }
          }
#pragma unroll
      for (int ks = 0; ks < 8; ++ks) {
          const bf16x8 bf = bw3[ks];
#pragma unroll
          for (int mt = 0; mt < 4; ++mt) { const LAS f32x4* xp = (const LAS f32x4*)(SX + (32 * mt + r32) * S5_XPITCH + 16 * ks + 8 * hi); const f32x4 x0 = xp[0], x1 = xp[1];
              const v4u pk = pack8(x0, x1); y[mt] = __builtin_amdgcn_mfma_f32_32x32x16_bf16(__builtin_bit_cast(bf16x8, pk), bf, y[mt], 0, 0, 0); } }
      bf16* YG = (bf16*)(F.ws + WS_YG); const int i = 2 * w + (r32 >> 4), ho = r32 & 15;
#pragma unroll
      for (int mt = 0; mt < 4; ++mt)
#pragma unroll
          for (int r = 0; r < 16; r += 2) {
              const f32x2 x = (f32x2){y[mt][r], y[mt][r + 1]}, x2 = x * x, pz = x2 * (-1.4426950408889634f * 1.5957691216057308f * 0.044715f) + (-1.4426950408889634f * 1.5957691216057308f), tz = x * pz;
              f32x2 d = (f32x2){__builtin_amdgcn_exp2f(tz.x), __builtin_amdgcn_exp2f(tz.y)} + 1.0f; d = (f32x2){__builtin_amdgcn_rcpf(d.x), __builtin_amdgcn_rcpf(d.y)};
              const f32x2 o = x * d; const unsigned pk = cvt_pk_bf16(o.x, o.y);
              const int c0 = 32 * mt + crow(r, hi), c1 = 32 * mt + crow(r + 1, hi);
              ((unsigned short*)YG)[(size_t)(b * SEQ + 16 * c0 + i) * SSM_W + g * 16 + ho] = (unsigned short)(pk & 0xFFFFu); ((unsigned short*)YG)[(size_t)(b * SEQ + 16 * c1 + i) * SSM_W + g * 16 + ho] = (unsigned short)(pk >> 16); } }
    __syncthreads();
}

constexpr int AT_KP = 272, AT_VP = 320, AT_KB = 64 * AT_KP, AT_VB = 64 * AT_VP, AT_BUF = AT_KB + AT_VB;
__device__ __forceinline__ s16x4 vtr(const LAS unsigned char* p) { typedef short v4i16_t __attribute__((ext_vector_type(4))); return __builtin_bit_cast(s16x4, __builtin_amdgcn_ds_read_tr16_b64_v4i16((LAS v4i16_t*)p)); }
__device__ __forceinline__ void attn_unit(Frame& F, int b, int h, int qb, float lam) {
    const int tid = F.tid, lane = F.lane, w = F.wave, rg = w >> 1, t = w & 1, r32 = lane & 31, hi = lane >> 5;
    const bf16* Q = (const bf16*)(F.ws + WS_Q); const bf16* K = (const bf16*)(F.ws + WS_K); const bf16* V = (const bf16*)(F.ws + WS_V); bf16* OB = (bf16*)(F.ws + WS_OB);
    LAS unsigned char* L = F.lds + RING_OFF;
    const int qrow = b * SEQ + qb * 128 + rg * 32 + r32;
    bf16x8 qf[4];
#pragma unroll
    for (int ks = 0; ks < 4; ++ks) qf[ks] = *(const bf16x8*)(Q + (size_t)qrow * QK_W + h * 128 + t * 64 + 16 * ks + 8 * hi);
    const int ntile = 2 * qb + 2, mylim = 2 * qb + (rg >> 1);
    const int kr0 = tid >> 4, cc = tid & 15;
    const size_t gbase = (size_t)(b * SEQ) * 512 + h * 128 + cc * 8;
    v4u kregA[2], vregA[2], kregB[2], vregB[2];
#define AT_LOAD(j, kreg, vreg) do { _Pragma("unroll") for (int i_ = 0; i_ < 2; ++i_) { const size_t o_ = gbase + (size_t)(64 * (j) + kr0 + 32 * i_) * 512; kreg[i_] = *(const v4u*)(K + o_); vreg[i_] = *(const v4u*)(V + o_); } } while (0)
#define AT_STORE(buf, kreg, vreg) do { _Pragma("unroll") for (int i_ = 0; i_ < 2; ++i_) { *(LAS v4u*)(L + (buf) * AT_BUF + (kr0 + 32 * i_) * AT_KP + cc * 16) = kreg[i_]; \
        *(LAS v4u*)(L + (buf) * AT_BUF + AT_KB + (kr0 + 32 * i_) * AT_VP + cc * 16) = vreg[i_]; } } while (0)
    AT_LOAD(0, kregB, vregB); AT_LOAD(1, kregA, vregA); AT_STORE(0, kregB, vregB);
    __syncthreads();
    f32x16 o[4] = {{0}, {0}, {0}, {0}};
    float mrun = -60.0f, lrun = 0.f;
    f32x16 negm;
#pragma unroll
    for (int r = 0; r < 16; ++r) negm[r] = 60.0f;
    const int g4 = lane >> 4, i16 = lane & 15;
    const int vlane = (4 * (g4 >> 1) + (i16 >> 2)) * AT_VP + (16 * (g4 & 1) + 4 * (i16 & 3)) * 2;
#define AT_VREAD(s_, set) do { _Pragma("unroll") for (int dt_ = 0; dt_ < 4; ++dt_) { vlo[set][dt_] = vtr(Vb + (s_) * 16 * AT_VP + dt_ * 64); vhh[set][dt_] = vtr(Vb + (s_) * 16 * AT_VP + dt_ * 64 + 8 * AT_VP); } } while (0)
#define AT_EXPCHUNK(S, rb, dst) do { _Pragma("unroll") for (int r_ = 0; r_ < 8; ++r_) S[(rb) + r_] = __builtin_amdgcn_exp2f(S[(rb) + r_]); \
        ps += ((S[(rb)] + S[(rb) + 1]) + (S[(rb) + 2] + S[(rb) + 3])) + ((S[(rb) + 4] + S[(rb) + 5]) + (S[(rb) + 6] + S[(rb) + 7])); \
        dst.x = cvt_pk_bf16(S[(rb)], S[(rb) + 1]); dst.y = cvt_pk_bf16(S[(rb) + 2], S[(rb) + 3]); dst.z = cvt_pk_bf16(S[(rb) + 4], S[(rb) + 5]); dst.w = cvt_pk_bf16(S[(rb) + 6], S[(rb) + 7]); } while (0)
#define AT_COMPUTE(j, buf) do { \
        if (j <= mylim) { \
            const LAS unsigned char* Kb = L + buf * AT_BUF + t * 128 + hi * 16 + r32 * AT_KP; \
            const LAS unsigned char* Vb = L + buf * AT_BUF + AT_KB + vlane; \
            f32x16 s0, s1; \
            __builtin_amdgcn_s_setprio(1); \
        _Pragma("unroll") \
            for (int ks = 0; ks < 4; ++ks) { const bf16x8 k0 = *(const LAS bf16x8*)(Kb + ks * 32); \
                s0 = __builtin_amdgcn_mfma_f32_32x32x16_bf16(k0, qf[ks], ks == 0 ? negm : s0, 0, 0, 0); } \
        _Pragma("unroll") \
            for (int ks = 0; ks < 4; ++ks) { const bf16x8 k1 = *(const LAS bf16x8*)(Kb + 32 * AT_KP + ks * 32);        \
                s1 = __builtin_amdgcn_mfma_f32_32x32x16_bf16(k1, qf[ks], ks == 0 ? negm : s1, 0, 0, 0); } \
            __builtin_amdgcn_s_setprio(0); \
            float mx = fmaxf(fmaxf(s0[0], s0[1]), s0[2]); \
        _Pragma("unroll") \
            for (int r = 3; r < 15; r += 2) mx = fmaxf(fmaxf(mx, s0[r]), s0[r + 1]); \
            mx = fmaxf(mx, s0[15]); \
        _Pragma("unroll") \
            for (int r = 0; r < 16; r += 2) mx = fmaxf(fmaxf(mx, s1[r]), s1[r + 1]); \
            mx = xor32_max(mx); \
            if (__builtin_amdgcn_ballot_w64(mx > 8.0f) != 0ull) { \
                const float dm = (mx > 8.0f) ? mx : 0.0f, alpha = __builtin_amdgcn_exp2f(-dm); lrun *= alpha; mrun += dm; \
        _Pragma("unroll") \
                for (int dt = 0; dt < 4; ++dt) o[dt] *= alpha; \
        _Pragma("unroll") \
                for (int r = 0; r < 16; ++r) { s0[r] -= dm; s1[r] -= dm; negm[r] = -mrun; } } \
            float ps = 0.f; v4u pkA, pkB; \
              \
            s16x4 vlo[2][4], vhh[2][4]; \
            AT_VREAD(0, 0); AT_EXPCHUNK(s0, 0, pkA); \
        _Pragma("unroll") \
            for (int s = 0; s < 4; ++s) { \
                const bf16x8 pf = __builtin_bit_cast(bf16x8, (s & 1) ? pkB : pkA); \
                __builtin_amdgcn_s_setprio(1); \
        _Pragma("unroll") \
                for (int dt = 0; dt < 4; ++dt) { const bf16x8 vf = (bf16x8){vlo[s & 1][dt][0], vlo[s & 1][dt][1], vlo[s & 1][dt][2], vlo[s & 1][dt][3], vhh[s & 1][dt][0], vhh[s & 1][dt][1], vhh[s & 1][dt][2], vhh[s & 1][dt][3]}; \
                    o[dt] = __builtin_amdgcn_mfma_f32_32x32x16_bf16(vf, pf, o[dt], 0, 0, 0); } \
                __builtin_amdgcn_s_setprio(0); \
                __builtin_amdgcn_sched_barrier(0); \
                if (s == 0) { AT_VREAD(1, 1); AT_EXPCHUNK(s0, 8, pkB); } else if (s == 1) { AT_VREAD(2, 0); AT_EXPCHUNK(s1, 0, pkA); } else if (s == 2) { AT_VREAD(3, 1); AT_EXPCHUNK(s1, 8, pkB); } \
                __builtin_amdgcn_sched_barrier(0); } \
            lrun += ps; \
            if (PROBE_REP == 30) { float d_[8] = {0.f, 0.f, 0.f, 0.f, 0.f, 0.f, 0.f, 0.f}; _Pragma("unroll") for (int r_ = 0; r_ < 16; ++r_) { asm volatile("v_exp_f32 %0, %1" : "+v"(d_[r_ & 7]) : "v"(s0[r_])); } \
                _Pragma("unroll") for (int r_ = 0; r_ < 16; ++r_) { asm volatile("v_exp_f32 %0, %1" : "+v"(d_[r_ & 7]) : "v"(s1[r_])); } \
                asm volatile("s_nop 1" :: "v"(d_[0]), "v"(d_[1]), "v"(d_[2]), "v"(d_[3]), "v"(d_[4]), "v"(d_[5]), "v"(d_[6]), "v"(d_[7])); } \
            if (PROBE_REP == 32) { float d_[8] = {0.f, 0.f, 0.f, 0.f, 0.f, 0.f, 0.f, 0.f}; _Pragma("unroll") for (int r_ = 0; r_ < 16; ++r_) { asm volatile("v_mul_f32 %0, %1, %1" : "+v"(d_[r_ & 7]) : "v"(s0[r_])); } \
                _Pragma("unroll") for (int r_ = 0; r_ < 16; ++r_) { asm volatile("v_mul_f32 %0, %1, %1" : "+v"(d_[r_ & 7]) : "v"(s1[r_])); } \
                asm volatile("s_nop 1" :: "v"(d_[0]), "v"(d_[1]), "v"(d_[2]), "v"(d_[3]), "v"(d_[4]), "v"(d_[5]), "v"(d_[6]), "v"(d_[7])); } \
            if (PROBE_REP == 31) { unsigned zz_; asm volatile("v_mov_b32 %0, 0" : "=v"(zz_)); const bf16x8 zp_ = __builtin_bit_cast(bf16x8, (v4u){zz_, zz_, zz_, zz_}); \
                _Pragma("unroll") for (int q_ = 0; q_ < 4; ++q_) _Pragma("unroll") for (int dt = 0; dt < 4; ++dt) { const bf16x8 vf = (bf16x8){vlo[1][dt][0], vlo[1][dt][1], vlo[1][dt][2], vlo[1][dt][3], vhh[1][dt][0], vhh[1][dt][1], vhh[1][dt][2], vhh[1][dt][3]}; \
                    o[dt] = __builtin_amdgcn_mfma_f32_32x32x16_bf16(vf, zp_, o[dt], 0, 0, 0); } } \
        } \
    } while (0)
    for (int j = 0; j < ntile; j += 2) {
        { const int jn = (j + 2 < ntile) ? j + 2 : ntile - 1; AT_LOAD(jn, kregB, vregB); }
        AT_COMPUTE(j, 0);
        AT_STORE(1, kregA, vregA);
        __syncthreads();
        { const int jn = (j + 3 < ntile) ? j + 3 : ntile - 1; AT_LOAD(jn, kregA, vregA); }
        AT_COMPUTE(j + 1, 1);
        AT_STORE(0, kregB, vregB);
        __syncthreads();
    }
#undef AT_COMPUTE
#undef AT_EXPCHUNK
#undef AT_VREAD
#undef AT_LOAD
#undef AT_STORE
    const float ltot = lrun + __shfl_xor(lrun, 32), inv = 1.0f / ltot;
    LAS float* EX = (LAS float*)L + rg * 4096;
    if (t == 1) {
        const float sc = inv * lam;
#pragma unroll
        for (int dt = 0; dt < 4; ++dt)
#pragma unroll
            for (int r = 0; r < 16; ++r) EX[(dt * 16 + r) * 64 + lane] = o[dt][r] * sc;
    }
    __syncthreads();
    if (t == 0) {
        float ss = 0.f;
#pragma unroll
        for (int dt = 0; dt < 4; ++dt)
#pragma unroll
            for (int r = 0; r < 16; ++r) { const float y = o[dt][r] * inv - EX[(dt * 16 + r) * 64 + lane]; o[dt][r] = y; ss += y * y; }
        ss += __shfl_xor(ss, 32);
        const float rn = (1.0f - LAMBDA_INIT) / sqrtf(ss * (1.0f / 128.0f) + RMS_EPS);
        const float* sg = F.in[I_SUBLN];
        f32x4 ggv[4][4];
#pragma unroll
        for (int dt = 0; dt < 4; ++dt)
#pragma unroll
            for (int rq = 0; rq < 4; ++rq) ggv[dt][rq] = *(const f32x4*)(sg + 32 * dt + 8 * rq + 4 * hi);
#pragma unroll
        for (int dt = 0; dt < 4; ++dt)
#pragma unroll
            for (int rq = 0; rq < 4; ++rq) { const int d = 32 * dt + 8 * rq + 4 * hi; const f32x4 gg = ggv[dt][rq];
                v2u wv; wv.x = cvt_pk_bf16(o[dt][4 * rq] * rn * gg[0], o[dt][4 * rq + 1] * rn * gg[1]); wv.y = cvt_pk_bf16(o[dt][4 * rq + 2] * rn * gg[2], o[dt][4 * rq + 3] * rn * gg[3]);
                *(v2u*)(OB + (size_t)qrow * V_W + h * 128 + d) = wv; }
    }
    __syncthreads();
}

constexpr int CW_CNT_STRIDE = 64;
__device__ __forceinline__ void router_phase(Frame& F, const bool dummy = false, const int tg_only = -1, unsigned* wflag = nullptr) {
    const int lane = F.lane, tid = F.tid, w = F.wave, tt = w >> 1, kh = w & 1;
    LAS unsigned char* WL = F.lds + RING_OFF; constexpr int WLP = 4112;
    LAS float* LG = (LAS float*)(F.lds + LDSCTL_OFF + 2048);
    LAS float* SS = LG + 4 * 2 * 16 * 33;
    LAS int* LC = (LAS int*)(SS + 128);
    const bf16* Hf = (const bf16*)(F.ws + WS_H16); const float* br = F.in[I_BR];
    float* rs2 = (float*)(F.ws + (dummy ? WS_YS2 : WS_RS2)); float* wslot = (float*)(F.ws + (dummy ? WS_YS2 + MiB : WS_WSLOT)); int* elist = (int*)(F.ws + (dummy ? WS_YS2 + 2 * MiB : WS_ELIST));
    unsigned* cnt = (unsigned*)(F.ctl + CW_CNT + (dummy ? 32 : 0));
    const int i16 = lane & 15, kq = lane >> 4;
    { const float* wrT = (const float*)(F.ws + WS_WRT);
#pragma unroll
      for (int i = 0; i < 16; ++i) { const int q = tid + 512 * i; *(LAS f32x4*)(WL + (q >> 8) * WLP + (q & 255) * 16) = *(const f32x4*)(wrT + (size_t)q * 4); } }
    if (wflag) panel_wait(wflag, 4u);
    __syncthreads();
    for (int tg = tg_only >= 0 ? tg_only : F.vcu; tg < M / 64; tg += tg_only >= 0 ? M : F.G) {
        if (tid < 64) LC[tid] = 0;
        const int tok0 = tg * 64 + tt * 16;
        f32x4 a0 = {0.f, 0.f, 0.f, 0.f}, a1 = {0.f, 0.f, 0.f, 0.f}; float ssq = 0.f;
        const bf16* hp = Hf + (size_t)(tok0 + i16) * DM + kh * 512 + 8 * kq; const LAS unsigned char* w0 = WL + i16 * WLP + (kh * 512 + 8 * kq) * 4; const LAS unsigned char* w1 = w0 + 16 * WLP;
#pragma unroll 8
        for (int s = 0; s < 16; ++s) { const v4u hv = *(const v4u*)(hp + 32 * s);
            const f32x4 b0l = *(const LAS f32x4*)(w0 + 128 * s), b0h = *(const LAS f32x4*)(w0 + 128 * s + 16), b1l = *(const LAS f32x4*)(w1 + 128 * s), b1h = *(const LAS f32x4*)(w1 + 128 * s + 16);
            const f32x4 al = (f32x4){bflo(hv.x), bfhi(hv.x), bflo(hv.y), bfhi(hv.y)}, ah = (f32x4){bflo(hv.z), bfhi(hv.z), bflo(hv.w), bfhi(hv.w)};
            ssq += ((al[0] * al[0] + al[1] * al[1]) + (al[2] * al[2] + al[3] * al[3])) + ((ah[0] * ah[0] + ah[1] * ah[1]) + (ah[2] * ah[2] + ah[3] * ah[3]));
#pragma unroll
            for (int q = 0; q < 4; ++q) { a0 = __builtin_amdgcn_mfma_f32_16x16x4f32(al[q], b0l[q], a0, 0, 0, 0); a1 = __builtin_amdgcn_mfma_f32_16x16x4f32(al[q], b1l[q], a1, 0, 0, 0); }
#pragma unroll
            for (int q = 0; q < 4; ++q) { a0 = __builtin_amdgcn_mfma_f32_16x16x4f32(ah[q], b0h[q], a0, 0, 0, 0); a1 = __builtin_amdgcn_mfma_f32_16x16x4f32(ah[q], b1h[q], a1, 0, 0, 0); } }
        ssq += __shfl_xor(ssq, 16); ssq += __shfl_xor(ssq, 32);
        LAS float* lg = LG + (tt * 2 + kh) * 16 * 33;
#pragma unroll
        for (int r = 0; r < 4; ++r) { lg[(4 * kq + r) * 33 + i16] = a0[r]; lg[(4 * kq + r) * 33 + 16 + i16] = a1[r]; }
        if (kq == 0) SS[(tt * 2 + kh) * 16 + i16] = ssq;
        __syncthreads();
        int ti[4]; float wv[4]; int lpos[4]; float rsv = 0.f;
        if (tid < 64) {
            const int t4 = tid >> 4, t16 = tid & 15;
            rsv = 1.0f / sqrtf((SS[(t4 * 2) * 16 + t16] + SS[(t4 * 2 + 1) * 16 + t16]) * (1.0f / DM) + RMS_EPS);
            float lgv[32];
#pragma unroll
            for (int e = 0; e < 32; ++e) lgv[e] = (LG[((t4 * 2) * 16 + t16) * 33 + e] + LG[((t4 * 2 + 1) * 16 + t16) * 33 + e]) * rsv + br[e];
            float tv[4];
#pragma unroll
            for (int k = 0; k < 4; ++k) { float best = -3.0e38f; int bi = 0;
#pragma unroll
                for (int e = 0; e < 32; ++e) { const bool tk = lgv[e] > best; best = tk ? lgv[e] : best; bi = tk ? e : bi; }
                tv[k] = best; ti[k] = bi;
#pragma unroll
                for (int e = 0; e < 32; ++e) lgv[e] = (e == bi) ? -3.0e38f : lgv[e]; }
            const float e1 = __expf(tv[1] - tv[0]), e2 = __expf(tv[2] - tv[0]), e3 = __expf(tv[3] - tv[0]), den = 1.0f / (1.0f + e1 + e2 + e3);
            wv[0] = den; wv[1] = e1 * den; wv[2] = e2 * den; wv[3] = e3 * den;
#pragma unroll
            for (int k = 0; k < 4; ++k) lpos[k] = __hip_atomic_fetch_add(LC + ti[k], 1, __ATOMIC_RELAXED, __HIP_MEMORY_SCOPE_WORKGROUP);
        }
        __syncthreads();
        if (tid < 32) { const int c = LC[tid]; LC[32 + tid] = c ? (int)atomicAdd(cnt + tid * CW_CNT_STRIDE, (unsigned)c) : 0; }
        __syncthreads();
        if (tid < 64) {
            const int tok = tg * 64 + tid;
            rs2[tok] = rsv;
#pragma unroll
            for (int k = 0; k < 4; ++k) { elist[ti[k] * M + LC[32 + ti[k]] + lpos[k]] = tok * 4 + k; wslot[tok * 4 + k] = wv[k]; }
        }
        __syncthreads();
    }
}
__device__ __forceinline__ int moe_tables(Frame& F) {
    LAS int* T = (LAS int*)(F.lds + MOE_LDS_OFF); LAS int* cnt = T, *tstart = T + 32, *tile2e = T + 72;
    if (F.tid < 32) cnt[F.tid] = (int)__hip_atomic_load((unsigned*)(F.ctl + CW_CNT) + F.tid * CW_CNT_STRIDE, RLX_AGENT);
    __syncthreads();
    if (F.tid == 0) { int s = 0; for (int e = 0; e < 32; ++e) { tstart[e] = s; s += (cnt[e] + 255) >> 8; } tstart[32] = s; }
    __syncthreads();
    if (F.tid < 32) { for (int p = tstart[F.tid]; p < tstart[F.tid + 1]; ++p) tile2e[p] = F.tid; }
    __syncthreads();
    return tstart[32];
}
__device__ __forceinline__ void combine_phase(Frame& F, float* dst) {
    const int lane = F.lane, gw = F.vcu * NWAVES + F.wave, NGW = F.G * NWAVES;
    const unsigned char* YS2 = F.ws + WS_YS2;
    for (int tk = gw; tk < M; tk += NGW) {
        const GAS v2u* hrow = (const GAS v2u*)((const bf16*)(F.ws + WS_H16) + (size_t)tk * DM) + lane; GAS f32x4* drow = (GAS f32x4*)(dst + (size_t)tk * DM) + lane;
#pragma unroll
        for (int j = 0; j < 4; ++j) { const v2u hw = hrow[64 * j]; f32x4 v = (f32x4){bflo(hw.x), bfhi(hw.x), bflo(hw.y), bfhi(hw.y)};
#pragma unroll
            for (int k = 0; k < 4; ++k) { const unsigned y = *((const GAS unsigned*)(YS2 + (size_t)(tk * 4 + k) * DM) + lane + 64 * j);
                const f32x2 lo = __builtin_amdgcn_cvt_pk_f32_fp8(y, false), hi = __builtin_amdgcn_cvt_pk_f32_fp8(y, true); v += (f32x4){lo[0], lo[1], hi[0], hi[1]} * 0.0625f; }
            drow[64 * j] = v; }
    }
}

struct Args { const float* in[31]; float* out; unsigned char* ws; unsigned char* hi; int ph_lo, ph_hi; };
__global__ void __launch_bounds__(NWAVES * 64, 2) mk_fwd(Args args) {
    extern __shared__ __attribute__((aligned(16))) unsigned char lds[];
    Frame F;
    F.lds = (LAS unsigned char*)lds;
    F.MISC = (volatile LAS unsigned*)(F.lds + MISC_OFF);
    F.tid = threadIdx.x; F.lane = F.tid & 63; F.wave = __builtin_amdgcn_readfirstlane(F.tid >> 6);
    F.G = gridDim.x; { const int bx = blockIdx.x; F.vcu = (F.G % 8 == 0) ? (bx % 8) * (F.G / 8) + bx / 8 : bx; }
    F.ws = args.ws; F.hi = args.hi; F.ctl = (gu32*)(args.ws + WS_CTL); F.out = args.out;
#pragma unroll
    for (int i = 0; i < 31; ++i) F.in[i] = args.in[i];
    for (int u = F.tid; u < 64; u += NWAVES * 64) F.MISC[u] = 0u;
    __syncthreads();
    XcdBarrier bar; bar.bar = (unsigned*)(F.ctl + CW_BAR); bar.x = 0; bar.st = nullptr;
    if (N_LAUNCHES != PER_PHASE) bar = xcd_barrier_post((unsigned*)(F.ctl + CW_BAR), F.MISC + 8);
#define GRID_BAR() do { if (N_LAUNCHES != PER_PHASE) xcd_barrier(bar); } while (0)
    const int lo = args.ph_lo, hi = args.ph_hi;
    unsigned long long tpA = 0, tpB = 0;
#define TP_BEGIN(k) do { if (PROBE_REP == 60 + (k)) tpA = __builtin_amdgcn_s_memrealtime(); } while (0)
#define TP_END(k) do { if (PROBE_REP == 60 + (k)) tpB = __builtin_amdgcn_s_memrealtime(); } while (0)
#define IN(k) (lo <= (k) && (k) < hi)
#define BOTH(k) (IN(k) && IN((k) + 1))
    unsigned char* ws = args.ws; unsigned char* wsh = args.hi;

    TP_BEGIN(0);
    if (PROBE_REP == 80) tpA = __builtin_amdgcn_s_memrealtime();
    if (IN(0)) { for (int rep = 0; rep < NREP(0); ++rep) { p0_prologue(F); if (BOTH(0)) GRID_BAR(); } }

    TP_END(0);
    TP_BEGIN(1);
    if (IN(1)) for (int rep = 0; rep < NREP(1); ++rep) {
        pg8::Gemm g{(const bf16*)(wsh + (WS_XN - HI)), (const bf16*)(wsh + (WS_WIN - HI)), M, IN_W, DM}; pg8::StaticOrder S; S.init(M, IN_W, F.G, (int)blockIdx.x);
        EpiInProj E{(bf16*)(ws + WS_U), (bf16*)(ws + WS_Q), (bf16*)(ws + WS_K), (bf16*)(ws + WS_V), (bf16*)(ws + WS_G1), (bf16*)(ws + WS_G2), F.in[I_BGATE], F.in[I_QG], F.in[I_KG]};
        pg8::gemm_phase<EpiInProj, pg8::StaticOrder, true>(F.lds + RING_OFF, g, S, E);
        if (BOTH(1)) GRID_BAR();
    }

    if (PROBE_REP == 30 && IN(1) && IN(2)) { GRID_BAR(); GRID_BAR(); GRID_BAR(); GRID_BAR(); }
    TP_END(1);
    TP_BEGIN(2);
    if (IN(2)) {
        for (int rep = 0; rep < NREP(20); ++rep) for (int u = F.vcu; u < BATCH * SSM_G; u += F.G) { const int g = (u >> 5) * 4 + ((u & 31) >> 3), b = u & 7; s5_unit(F, b, g); }
        float lam;
        { const float a = wave_sum(F.in[I_LQ1][F.lane] * F.in[I_LK1][F.lane]), c = wave_sum(F.in[I_LQ2][F.lane] * F.in[I_LK2][F.lane]); lam = __expf(a) - __expf(c) + LAMBDA_INIT; }
        for (int rep = 0; rep < NREP(21); ++rep) for (int u = F.vcu; u < BATCH * ATT_H * 8; u += F.G) { const int bh = u >> 3, qp = u & 7; attn_unit(F, bh >> 2, bh & 3, 15 - qp, lam); attn_unit(F, bh >> 2, bh & 3, qp, lam); }
        if (BOTH(2)) GRID_BAR();
    }

    TP_END(2);
    TP_BEGIN(3);
    const bool pf3 = (F.G == M / 64) && IN(3) && IN(4) && (PROBE_REP < 0 || PROBE_REP >= 60);
    unsigned* const panel3 = (unsigned*)(F.ctl + CW_PANEL3);
    if (IN(3)) for (int rep = 0; rep < NREP(3); ++rep) {
        { pg8::Gemm g{(const bf16*)(ws + WS_YG), (const bf16*)(ws + WS_WGLU), M, 512, 512}; PanelOrder S; S.so.init(M, 512, F.G, (int)blockIdx.x); S.wflag = nullptr; S.pflag = pf3 ? panel3 : nullptr;
          EpiMix<0> E{(const bf16*)(ws + WS_YG), nullptr, (bf16*)(ws + WS_YS), F.in[I_BGLU], 512};
          pg8::gemm_phase<EpiMix<0>, PanelOrder, true>(F.lds + RING_OFF, g, S, E); }
        if ((int)blockIdx.x >= (M / 256) * 2 && rep == 0) convert_big(F, 1, BIG_SPLIT, NBIG);
        if (BOTH(3) && !pf3) GRID_BAR();
    }

    TP_END(3);
    TP_BEGIN(4);
    const bool pf = (F.G == M / 64) && IN(4) && IN(5) && IN(6) && (PROBE_REP < 0 || PROBE_REP >= 60);
    unsigned* const panel4 = (unsigned*)(F.ctl + CW_PANEL4); unsigned* const panel5 = (unsigned*)(F.ctl + CW_PANEL5);
    if (IN(4)) for (int rep = 0; rep < NREP(4); ++rep) {
        pg8::Gemm g{(const bf16*)(ws + WS_OB), (const bf16*)(ws + WS_WPS), M, DM, 512};
        ChainOrder S; S.so.init(M, DM, F.G, (int)blockIdx.x); S.A_att = (const bf16*)(ws + WS_OB); S.A_ssm = (const bf16*)(ws + WS_YS); S.pflag = pf ? panel4 : nullptr; S.wflag = pf3 ? panel3 : nullptr;
        EpiChain E{(const bf16*)(ws + WS_G1), (const bf16*)(ws + WS_G2), (bf16*)(ws + WS_MX), pf};
        pg8::gemm_phase<EpiChain, ChainOrder, true>(F.lds + RING_OFF, g, S, E);
        if (BOTH(4) && !pf) GRID_BAR();
    }

    TP_END(4);
    TP_BEGIN(5);
    if (IN(5)) for (int rep = 0; rep < NREP(5); ++rep) {
        pg8::Gemm g{(const bf16*)(ws + WS_MX), (const bf16*)(ws + WS_WOUT), M, DM, DM}; PanelOrder S; S.so.init(M, DM, F.G, (int)blockIdx.x); S.wflag = pf ? panel4 : nullptr; S.pflag = pf ? panel5 : nullptr;
        EpiOut E{F.in[I_X], (bf16*)(ws + WS_H16), ws + WS_HB, pf};
        pg8::gemm_phase<EpiOut, PanelOrder, true>(F.lds + RING_OFF, g, S, E);
        if (BOTH(5) && !pf) GRID_BAR();
    }

    TP_END(5);
    TP_BEGIN(6);
    if (IN(6)) {
        if (pf) { pg8::StaticOrder so; so.init(M, DM, F.G, (int)blockIdx.x); pg8::Unit u; so.next(0, u);
                  router_phase(F, false, 4 * u.pm + u.pn, panel5 + u.pm * PANEL_STRIDE); }
        else router_phase(F);
        if (BOTH(6)) GRID_BAR(); }

    TP_END(6);
    TP_BEGIN(7);
    if (IN(7)) for (int rep = 0; rep < NREP(7); ++rep) {
        const int nmt = moe_tables(F); LAS int* T = (LAS int*)(F.lds + MOE_LDS_OFF); unsigned* mflag = (unsigned*)(F.ctl + CW_MFLAG) + (rep ? 288 * MFLAG_STRIDE : 0);
        { pg8::Gemm g{(const bf16*)(ws + WS_HB), (const bf16*)(wsh + (WS_WUP - HI)), M, UPW, DM, UPW};
          MoeOrder<8, true> S{nmt * 8, F.G, F.vcu, T, T + 32, T + 72, (const int*)(ws + WS_ELIST), mflag, (LAS int*)(F.lds + SLOT_OFF)}; S.fill(F.tid, (const float*)(ws + WS_RS2)); __syncthreads();
          EpiUp E{ws + WS_ACT, F.in[I_BUP], (const float*)(ws + WS_RS2)};
          pg8::gemm_phase<EpiUp, MoeOrder<8, true>, true, true, true, true>(F.lds + RING_OFF, g, S, E, 0, 0); }
        { pg8::Gemm g{(const bf16*)(ws + WS_ACT), (const bf16*)(wsh + (WS_WDN - HI)), MOE_ROWS_MAX, DM, DE, DM};
          MoeOrder<4, false> S{nmt * 4, F.G, F.G - 1 - F.vcu, T, T + 32, T + 72, (const int*)(ws + WS_ELIST), mflag, (LAS int*)(F.lds + SLOT_OFF)}; S.fill(F.tid, (const float*)(ws + WS_WSLOT)); __syncthreads();
          EpiDown E{ws + WS_YS2, F.in[I_BDN], (const float*)(ws + WS_WSLOT)};
          pg8::gemm_phase<EpiDown, MoeOrder<4, false>, true, true, true, true>(F.lds + RING_OFF, g, S, E, 0, 0); }
        if (BOTH(7)) GRID_BAR();
    }

    TP_END(7);
    TP_BEGIN(9);
    if (IN(9)) { combine_phase(F, F.out); }
    if (IN(16)) router_phase(F, true);
    if (IN(19)) combine_phase(F, (float*)(ws + WS_TA));
    TP_END(9);
    if (PROBE_REP == 80) tpB = __builtin_amdgcn_s_memrealtime();
    if (PROBE_REP >= 60 && blockIdx.x == 0) { const unsigned long long t0 = __builtin_amdgcn_s_memrealtime(); while (__builtin_amdgcn_s_memrealtime() - t0 < tpB - tpA) __builtin_amdgcn_s_sleep(8); }
#undef IN
#undef BOTH
#undef GRID_BAR
}

extern "C" void kernel_launch(void* const* d_in, const int* in_sizes, int n_in, void* d_out, int out_size, void* d_ws, size_t ws_size, hipStream_t stream) {
    static int grid = 0;
    if (grid == 0) {
        if (n_in != 31 || in_sizes[0] != M * DM || out_size != M * DM || ws_size < WS_END) {
            fprintf(stderr, "kernel_launch: unexpected shapes (n_in %d, in0 %d, out %d, ws %zu < %zu); nothing launched\n", n_in, n_in > 0 ? in_sizes[0] : -1, out_size, ws_size, (size_t)WS_END); grid = -1; return; }
        int dev = 0, cus = 0;
        if (hipGetDevice(&dev) != hipSuccess || hipDeviceGetAttribute(&cus, hipDeviceAttributeMultiprocessorCount, dev) != hipSuccess) { grid = -1; return; }
        if (hipFuncSetAttribute((const void*)mk_fwd, hipFuncAttributeMaxDynamicSharedMemorySize, LDS_BYTES) != hipSuccess) { fprintf(stderr, "kernel_launch: hipFuncSetAttribute failed\n"); grid = -1; return; }
        int per_cu = 0;
        if (hipOccupancyMaxActiveBlocksPerMultiprocessor(&per_cu, (const void*)mk_fwd, NWAVES * 64, LDS_BYTES) != hipSuccess || per_cu < 1) fprintf(stderr, "kernel_launch: occupancy query reports %d\n", per_cu);
        (void)hipGetLastError();
        grid = cus;
    }
    if (grid < 0) return;
    (void)hipMemsetAsync((char*)d_ws + WS_CTL, 0, CTL_ZERO_BYTES, stream);
    Args a{};
    for (int i = 0; i < 31; ++i) a.in[i] = (const float*)d_in[i];
    a.out = (float*)d_out; a.ws = (unsigned char*)d_ws; a.hi = (unsigned char*)d_ws + ((ws_size - 256 * MiB) & ~(size_t)0xfffff);
    if (N_LAUNCHES == 1) { a.ph_lo = 0; a.ph_hi = PER_PHASE; hipLaunchKernelGGL(mk_fwd, dim3(grid), dim3(NWAVES * 64), LDS_BYTES, stream, a); }
    else for (int p = 0; p < PER_PHASE; ++p) { a.ph_lo = p; a.ph_hi = p + 1; if (PROBE_REP - 110 == p) { a.ph_lo = p + 10; a.ph_hi = p + 11; hipLaunchKernelGGL(mk_fwd, dim3(grid), dim3(NWAVES * 64), LDS_BYTES, stream, a); a.ph_lo = p; a.ph_hi = p + 1; }
        for (int rep = 0; rep < ((PROBE_REP - 100 == p) ? 2 : 1); ++rep) hipLaunchKernelGGL(mk_fwd, dim3(grid), dim3(NWAVES * 64), LDS_BYTES, stream, a); }
}
```

```cpp
#include <hip/hip_runtime.h>
#include <cstdio>
#include <cstdint>

#ifndef MK_N_LAUNCHES
#define MK_N_LAUNCHES 1
#endif
#ifndef PROBE_REP
#define PROBE_REP -1
#endif
#define NREP(k) ((PROBE_REP == (k)) ? 2 : 1)

namespace pg8 {
#define PG8_LAS __attribute__((address_space(3)))
typedef unsigned short bf16_t;
typedef short bf16x8 __attribute__((ext_vector_type(8)));
typedef float f32x4 __attribute__((ext_vector_type(4)));
typedef unsigned u32x4 __attribute__((ext_vector_type(4)));
typedef unsigned u32x2 __attribute__((ext_vector_type(2)));
constexpr int BM = 256, BK = 64, HALF = 128, HTB = HALF * BK * 2  , STAGE_BYTES = 8 * HTB, NXCD = 8, WGM = 8;

__host__ __device__ __forceinline__ int lds_byte(int r, int c) { const int st = (r >> 4) * 2 + (c >> 5), rr = r & 15, cc = c & 31, ob = rr * 64 + cc * 2; return st * 1024 + (ob ^ (((ob >> 9) & 1) * 48)); }
__host__ __device__ __forceinline__ void stage_rc(int b, int& R, int& C) { const int st = b / 1024, sb = b % 1024, swz = sb ^ (((sb >> 9) & 1) * 48); R = (st >> 1) * 16 + swz / 64; C = (st & 1) * 32 + (swz % 64) / 2; }
__host__ __device__ __forceinline__ int perm256(int R) { return 64 * ((R >> 5) & 3) + 16 * ((R >> 2) & 3) + 8 * (R >> 7) + 4 * ((R >> 4) & 1) + (R & 3); }
__host__ __device__ __forceinline__ int perm32(int rho) { const int n = rho >> 4, i = rho & 15; return 8 * (i >> 2) + 4 * n + (i & 3); }

struct Unit { int pm, pn; };
struct Gemm { const bf16_t* A; const bf16_t* Bt; int M, N, K; int bKT = 0; };

struct StaticOrder {
    int nM, nN, nwg, G, c;
    __host__ __device__ void init(int M, int N, int G_, int c_) { nM = M / BM; nN = N / BM; nwg = nM * nN; G = G_; c = c_; }
    __host__ __device__ __forceinline__ bool next(int i, Unit& u) const {
        const long L = (long)i * G + c; if (L >= nwg) return false;
        int wgid = (int)L; { const int q = nwg / NXCD, r = nwg % NXCD, xcd = wgid % NXCD, off = wgid / NXCD; wgid = (xcd < r ? xcd * (q + 1) : r * (q + 1) + (xcd - r) * q) + off; }
        const int nig = WGM * nN, gid = wgid / nig, fm = gid * WGM, gsz = (nM - fm) < WGM ? (nM - fm) : WGM;
        u.pm = fm + ((wgid % nig) % gsz); u.pn = (wgid % nig) / gsz; return true;
    }
    __device__ __forceinline__ int row_slot(const Unit&, int) const { return 0; }
    __device__ __forceinline__ const PG8_LAS int* slot_table() const { return nullptr; }
    __device__ __forceinline__ int a_row(const Unit& u, int r, int) const { return u.pm * BM + r; }
    __device__ __forceinline__ const char* a_base(const Gemm& g, const Unit& u, size_t tstep) const { return (const char*)g.A + (size_t)u.pm * tstep; }
    __device__ __forceinline__ void a_ready(const Unit&) const {}
    __device__ __forceinline__ void done(const Unit&) const {}
};

__device__ __forceinline__ unsigned cvt_pk_bf16(float lo, float hi) { unsigned r; asm volatile("v_cvt_pk_bf16_f32 %0, %1, %2" : "=v"(r) : "v"(lo), "v"(hi)); return r; }

typedef int v8i __attribute__((ext_vector_type(8)));
typedef int v4i __attribute__((ext_vector_type(4)));
template <class Epi, class Sched, bool ALIGN_EPI = false, bool ROWTAB = false, bool GATHER = false, bool FP8 = false>
__device__ __forceinline__ void gemm_phase(PG8_LAS unsigned char* lds, const Gemm g, const Sched& S, const Epi& E, const int sA8 = 0, const int sB8 = 0) {
    static_assert(!GATHER || ROWTAB, "GATHER needs ROWTAB");
    int tid = threadIdx.x; asm volatile("" : "+v"(tid));
    const int wid = __builtin_amdgcn_readfirstlane(tid >> 6), lane = tid & 63, wr = wid >> 2, wc = wid & 3, fr = lane & 15, fq = lane >> 4;
    const int K = g.K, RB = FP8 ? K : 2 * K  , nt = RB / (2 * BK);
    unsigned voffA[2], voffB[2];
#pragma unroll
    for (int i = 0; i < 2; ++i) { int R, C; stage_rc(tid * 16 + i * 8192, R, C); const int Rb = (int)Epi::PERM == 2 ? perm256(R) : (int)Epi::PERM == 1 ? ((R & ~31) + perm32(R & 31)) : R;
        voffA[i] = (unsigned)(R * RB + 2 * C); voffB[i] = (unsigned)(Rb * (g.bKT ? 128 : RB) + 2 * C); }
    unsigned vA[2][2] = {{0u, 0u}, {0u, 0u}};
    const size_t kstep = (size_t)(BK * 2);
    const size_t hstep = (size_t)HALF * RB;
    const size_t tstep = 2 * hstep;
    const size_t kstepB = g.bKT ? (size_t)g.bKT * 128 : kstep, hstepB = (size_t)((int)Epi::PERM == 2 ? 8 : HALF) * (g.bKT ? (size_t)128 : (size_t)RB);
#define PG8_BBASE(u) (g.bKT ? (const char*)g.Bt + (size_t)((u).pn / (g.bKT / 256)) * ((size_t)g.bKT * RB) + (size_t)((u).pn % (g.bKT / 256)) * (256 * 128) : (const char*)g.Bt + (size_t)(u).pn * tstep)
    const unsigned ldsw = (unsigned)wid * 1024u;
    const int aoff = FP8 ? lds_byte(wr * 64 + fr, fq * 16) : lds_byte(wr * 64 + fr, fq * 8), boff = FP8 ? lds_byte(wc * 32 + fr, fq * 16) : lds_byte(wc * 32 + fr, fq * 8);
    const PG8_LAS int* tab = S.slot_table();
#define PG8_SA(b, h) (((b) * 2 + (h)) * HTB)
#define PG8_SB(b, h) ((4 + (b) * 2 + (h)) * HTB)
#define PG8_STAGE(bufoff, gbase, voff) do { _Pragma("unroll") for (int _i = 0; _i < 2; ++_i) \
        __builtin_amdgcn_global_load_lds((const unsigned*)((const char*)(gbase) + (voff)[_i]), (PG8_LAS unsigned*)(lds + (bufoff) + ldsw + _i * 8192), 16, 0, 0); } while (0)
#define PG8_STAGE_A(bufoff, kbase, h) do { if constexpr (GATHER) { PG8_STAGE(bufoff, kbase, vA[h]); } else { PG8_STAGE(bufoff, (kbase) + (h) * hstep, voffA); } } while (0)
#define PG8_LOAD_VA(sel, un) do { _Pragma("unroll") for (int _i = 0; _i < 2; ++_i) { int R_, C_; stage_rc(tid * 16 + _i * 8192, R_, C_); \
        _Pragma("unroll") for (int _h = 0; _h < 2; ++_h) { const int s_ = tab[(sel) * 256 + _h * HALF + R_]; vA[_h][_i] = (unsigned)(S.a_row(un, _h * HALF + R_, s_) * RB + 2 * C_); } } } while (0)
#define PG8_LDA(dst, b, h) do { _Pragma("unroll") for (int m = 0; m < 4; ++m) _Pragma("unroll") for (int k = 0; k < 2; ++k) dst[m][k] = *(const PG8_LAS bf16x8*)(lds + PG8_SA(b, h) + (FP8 ? (aoff ^ (16 * k)) : aoff + k * 1024) + m * 2048); } while (0)
#define PG8_LDB(dst, b, h) do { _Pragma("unroll") for (int n = 0; n < 2; ++n) _Pragma("unroll") for (int k = 0; k < 2; ++k) dst[n][k] = *(const PG8_LAS bf16x8*)(lds + PG8_SB(b, h) + (FP8 ? (boff ^ (16 * k)) : boff + k * 1024) + n * 2048); } while (0)
#define PG8_V8(x) __builtin_shufflevector(__builtin_bit_cast(v4i, (x)[0]), __builtin_bit_cast(v4i, (x)[1]), 0, 1, 2, 3, 4, 5, 6, 7)
#define PG8_MMA(ai, bj, At, Bt) do { __builtin_amdgcn_s_setprio(1); if constexpr (FP8) { _Pragma("unroll") for (int m = 0; m < 4; ++m) _Pragma("unroll") for (int n = 0; n < 2; ++n) \
        acc[ai][bj][m][n] = __builtin_amdgcn_mfma_scale_f32_16x16x128_f8f6f4(PG8_V8(Bt[n]), PG8_V8(At[m]), acc[ai][bj][m][n], 0, 0, 0, sB8, 0, sA8); } else { \
        _Pragma("unroll") for (int m = 0; m < 4; ++m) _Pragma("unroll") for (int n = 0; n < 2; ++n) _Pragma("unroll") for (int k = 0; k < 2; ++k) \
        acc[ai][bj][m][n] = __builtin_amdgcn_mfma_f32_16x16x32_bf16(Bt[n][k], At[m][k], acc[ai][bj][m][n], 0, 0, 0); } __builtin_amdgcn_s_setprio(0); } while (0)
#define PG8_WAIT_V(n) asm volatile("s_waitcnt vmcnt(" #n ")" ::: "memory")
#define PG8_WAIT_L(n) asm volatile("s_waitcnt lgkmcnt(" #n ")" ::: "memory")
#define PG8_BAR __builtin_amdgcn_s_barrier()
#define PG8_SCHED __builtin_amdgcn_sched_barrier(0)
    Unit cur, nxt; int ui = 0;
    if (!S.next(0, cur)) return;
    S.a_ready(cur);
    f32x4 acc[2][2][4][2];
#pragma unroll
    for (int a = 0; a < 2; ++a)
#pragma unroll
        for (int b = 0; b < 2; ++b)
#pragma unroll
            for (int m = 0; m < 4; ++m)
#pragma unroll
                for (int n = 0; n < 2; ++n) acc[a][b][m][n] = (f32x4){0.f, 0.f, 0.f, 0.f};
    bf16x8 At[4][2], B0[2][2], B1[2][2];
    if constexpr (GATHER) { PG8_LOAD_VA(0, cur); }
    const char* cA = GATHER ? (const char*)g.A : S.a_base(g, cur, tstep); const char* cB = PG8_BBASE(cur);
    PG8_STAGE(PG8_SB(0, 0), cB, voffB); PG8_STAGE(PG8_SB(0, 1), cB + hstepB, voffB); PG8_STAGE_A(PG8_SA(0, 0), cA, 0); PG8_STAGE_A(PG8_SA(0, 1), cA, 1);
    if (wr == 1) PG8_BAR;
    PG8_WAIT_V(2); PG8_BAR;
    PG8_STAGE(PG8_SB(1, 0), cB + kstepB, voffB); PG8_STAGE_A(PG8_SA(1, 0), cA + kstep, 0); PG8_STAGE(PG8_SB(1, 1), cB + hstepB + kstepB, voffB);
    PG8_WAIT_V(6); PG8_BAR;
    for (;;) {
        const bool has_next = S.next(ui + 1, nxt);
        const char* nA = has_next ? (GATHER ? (const char*)g.A : S.a_base(g, nxt, tstep)) : cA; const char* nB = has_next ? PG8_BBASE(nxt) : cB;
        for (int t = 0; t < nt; t += 2) {
            const bool last = (t == nt - 2);
            if (last && has_next) S.a_ready(nxt);
            const char* a1 = cA + (size_t)(t + 1) * kstep;
            const char* a2 = last ? nA : cA + (size_t)(t + 2) * kstep; const char* b2 = last ? nB : cB + (size_t)(t + 2) * kstepB;
            const char* a3 = a2 + kstep; const char* b3 = b2 + kstepB;
            PG8_LDB(B0, 0, 0); PG8_LDB(B1, 0, 1); PG8_SCHED; PG8_LDA(At, 0, 0); PG8_STAGE_A(PG8_SA(1, 1), a1, 1);
            if constexpr (GATHER) { if (last && has_next) { PG8_LOAD_VA(ui + 1, nxt); } }
            PG8_WAIT_V(8); PG8_WAIT_L(0); PG8_BAR; PG8_MMA(0, 0, At, B0); PG8_MMA(0, 1, At, B1); PG8_BAR; PG8_SCHED;
            PG8_LDA(At, 0, 1); PG8_STAGE(PG8_SB(0, 0), b2, voffB); PG8_STAGE(PG8_SB(0, 1), b2 + hstepB, voffB); PG8_STAGE_A(PG8_SA(0, 0), a2, 0);
            PG8_WAIT_V(8); PG8_WAIT_L(0); PG8_BAR; PG8_MMA(1, 0, At, B0); PG8_MMA(1, 1, At, B1); PG8_BAR; PG8_SCHED;
            PG8_LDB(B0, 1, 0); PG8_LDB(B1, 1, 1); PG8_SCHED; PG8_LDA(At, 1, 0); PG8_STAGE_A(PG8_SA(0, 1), a2, 1);
            PG8_WAIT_V(8); PG8_WAIT_L(0); PG8_BAR; PG8_MMA(0, 0, At, B0); PG8_MMA(0, 1, At, B1); PG8_BAR; PG8_SCHED;
            PG8_LDA(At, 1, 1); PG8_STAGE(PG8_SB(1, 0), b3, voffB); PG8_STAGE(PG8_SB(1, 1), b3 + hstepB, voffB); PG8_STAGE_A(PG8_SA(1, 0), a3, 0);
            PG8_WAIT_V(8); PG8_WAIT_L(0); PG8_BAR; PG8_MMA(1, 0, At, B0); PG8_MMA(1, 1, At, B1); PG8_BAR; PG8_SCHED;
        }
        if constexpr (ALIGN_EPI) { if (wr == 0) PG8_BAR; }
        E(acc, cur, wr, wc, fr, fq, ROWTAB ? tab + ui * 256 : tab);
        S.done(cur);
        if (!has_next) break;
        if (!E.keep(cur)) {
#pragma unroll
        for (int a = 0; a < 2; ++a)
#pragma unroll
            for (int b = 0; b < 2; ++b)
#pragma unroll
                for (int m = 0; m < 4; ++m)
#pragma unroll
                    for (int n = 0; n < 2; ++n) acc[a][b][m][n] = (f32x4){0.f, 0.f, 0.f, 0.f}; }
        cur = nxt; cA = nA; cB = nB; ++ui;
        if constexpr (ALIGN_EPI) { if (wr == 1) PG8_BAR; }
    }
    PG8_WAIT_V(0);
    if constexpr (!ALIGN_EPI) { if (wr == 0) PG8_BAR; }
    PG8_BAR;
#undef PG8_SA
#undef PG8_SB
#undef PG8_STAGE
#undef PG8_STAGE_A
#undef PG8_BBASE
#undef PG8_LOAD_VA
#undef PG8_LDA
#undef PG8_LDB
#undef PG8_MMA
#undef PG8_V8
#undef PG8_WAIT_V
#undef PG8_WAIT_L
#undef PG8_BAR
#undef PG8_SCHED
}
}

constexpr int NWAVES = 8;
constexpr int N_LAUNCHES = MK_N_LAUNCHES;
constexpr int PER_PHASE = 10;
constexpr int BATCH = 8, SEQ = 2048, DM = 1024, M = BATCH * SEQ;
constexpr int SSM_W = 512, SSM_G = 32, SSM_H = 16, SSM_P = 64, SSM_T = 16, SSM_NC = SEQ / SSM_T;
constexpr int ATT_H = 4, ATT_D = 64, ATT_V = 128, QK_W = 512, V_W = 512;
constexpr int IN_W = 4096;
constexpr int NE = 32, TOPK = 4, DE = 1024, UPW = 2048;
constexpr float RMS_EPS = 1e-6f;
constexpr float LAMBDA_INIT = 0.2f;
constexpr float QSCALE = 0.125f * 1.4426950408889634f;
constexpr int MOE_ROWS_MAX = M * TOPK + NE * 256;
constexpr int MOE_MT_MAX = MOE_ROWS_MAX / 256;

constexpr size_t MiB = 1u << 20;
constexpr size_t WS_CTL = 0, CTL_ZERO_BYTES = 256 * 1024;
constexpr size_t HI = (size_t)1 << 40;
constexpr size_t WS_WIN_OLD = 2 * MiB;
constexpr size_t WS_WGLU = 10 * MiB;
constexpr size_t WS_WPS = 11 * MiB;
constexpr size_t WS_WPA = 12 * MiB;
constexpr size_t WS_WOUT = 13 * MiB;
constexpr size_t WS_WRT = 15 * MiB;
constexpr size_t WS_S5 = 16 * MiB;
constexpr size_t WS_A16 = 24 * MiB;
constexpr size_t WS_WUP_OLD = 32 * MiB;
constexpr size_t WS_WDN_OLD = 160 * MiB;
constexpr size_t WS_XN_OLD = 224 * MiB;
constexpr size_t WS_U = 256 * MiB;
constexpr size_t WS_Q = 272 * MiB, WS_K = 288 * MiB, WS_V = 304 * MiB;
constexpr size_t WS_G1 = 320 * MiB, WS_G2 = 352 * MiB;
constexpr size_t WS_YG = 384 * MiB, WS_YS = 400 * MiB, WS_OB = 416 * MiB;
constexpr size_t WS_H16 = 432 * MiB;
constexpr size_t WS_TA = 432 * MiB, WS_MX = 464 * MiB;
constexpr size_t WS_HB = 496 * MiB;
constexpr size_t WS_RS2 = 528 * MiB;
constexpr size_t WS_WSLOT = 529 * MiB;
constexpr size_t WS_ELIST = 530 * MiB;
constexpr size_t WS_ACT = 544 * MiB;
constexpr size_t WS_YS2 = 32 * MiB;
constexpr size_t WS_YS2_OLD = 688 * MiB;
constexpr size_t WS_END = 1024 * MiB;
constexpr size_t WS_WUP = HI + 0 * MiB, WS_WDN = HI + 64 * MiB, WS_XN = HI + 96 * MiB, WS_WIN = HI + 128 * MiB;
constexpr size_t WS_XN8 = HI + 144 * MiB, WS_WIN8 = HI + 160 * MiB;
constexpr int CW_BAR = 4096;
constexpr int CW_PANEL3 = 57344, CW_PANEL4 = 49152, CW_PANEL5 = 53248, PANEL_STRIDE = 16;
constexpr int CW_Q = 20480;
constexpr int CW_CNT = 16384;

constexpr int RING_OFF = 0, RING_BYTES = 139264;
constexpr int LDSCTL_OFF = RING_BYTES, MISC_OFF = LDSCTL_OFF;
constexpr int MOE_LDS_OFF = LDSCTL_OFF + 256;
constexpr int SLOT_OFF = 147456, SLOT_UNITS = 16;
constexpr int LDS_BYTES = 163840;

#define GAS __attribute__((address_space(1)))
#define LAS __attribute__((address_space(3)))
typedef unsigned short bf16;
typedef unsigned v4u __attribute__((ext_vector_type(4)));
typedef unsigned v2u __attribute__((ext_vector_type(2)));
typedef float f32x4 __attribute__((ext_vector_type(4)));
typedef float f32x16 __attribute__((ext_vector_type(16)));
typedef float f32x2 __attribute__((ext_vector_type(2)));
typedef short bf16x8 __attribute__((ext_vector_type(8)));
typedef short s16x4 __attribute__((ext_vector_type(4)));
typedef GAS unsigned gu32;
#define RLX_AGENT __ATOMIC_RELAXED, __HIP_MEMORY_SCOPE_AGENT
#define LDS_WAIT() asm volatile("s_waitcnt lgkmcnt(0)" ::: "memory")
#define VM_WAIT() asm volatile("s_waitcnt vmcnt(0)" ::: "memory")
using pg8::cvt_pk_bf16;
__device__ __forceinline__ unsigned f2bf(float f) { unsigned u = __builtin_bit_cast(unsigned, f); return (u + 0x7fffu + ((u >> 16) & 1u)) >> 16; }
__device__ __forceinline__ float xor32_max(float v) { const auto r = __builtin_amdgcn_permlane32_swap(__float_as_uint(v), __float_as_uint(v), false, false); return fmaxf(__uint_as_float(r[0]), __uint_as_float(r[1])); }
__device__ __forceinline__ float xor32_add(float v) { const auto r = __builtin_amdgcn_permlane32_swap(__float_as_uint(v), __float_as_uint(v), false, false); return __uint_as_float(r[0]) + __uint_as_float(r[1]); }
__device__ __forceinline__ float xor16_add(float v) { const auto r = __builtin_amdgcn_permlane16_swap(__float_as_uint(v), __float_as_uint(v), false, false); return __uint_as_float(r[0]) + __uint_as_float(r[1]); }
__device__ __forceinline__ unsigned pk4_fp8(float a, float b, float c, float d) { unsigned w = 0; w = __builtin_amdgcn_cvt_pk_fp8_f32(a, b, w, false); w = __builtin_amdgcn_cvt_pk_fp8_f32(c, d, w, true); return w; }
__device__ __forceinline__ float bf2f(unsigned b) { return __builtin_bit_cast(float, b << 16); }
__device__ __forceinline__ float bflo(unsigned w) { return __builtin_bit_cast(float, w << 16); }
__device__ __forceinline__ float bfhi(unsigned w) { return __builtin_bit_cast(float, w & 0xffff0000u); }
__device__ __forceinline__ float fsigmoid(float x) { return 1.0f / (1.0f + __expf(-x)); }
__device__ __forceinline__ float fsigmoid_fast(float x) { return __builtin_amdgcn_rcpf(1.0f + __builtin_amdgcn_exp2f(-1.4426950408889634f * x)); }
__device__ __forceinline__ float fsigmoid_asm(float x) { float r;
    asm volatile("v_mul_f32 %0, 0xbfb8aa3b, %1\n\ts_nop 0\n\tv_exp_f32 %0, %0\n\ts_nop 1\n\tv_add_f32 %0, 1.0, %0\n\ts_nop 0\n\tv_rcp_f32 %0, %0\n\ts_nop 1" : "=&v"(r) : "v"(x)); return r; }
__device__ __forceinline__ float gelu_tanh(float x) { const float z = 1.5957691216057308f * (x + 0.044715f * x * x * x); return x * fsigmoid_fast(z); }
__device__ __forceinline__ int crow(int r, int hi) { return (r & 3) + 8 * (r >> 2) + 4 * hi; }
__device__ __forceinline__ float wave_sum(float v) {
#pragma unroll
    for (int o = 1; o < 64; o <<= 1) v += __shfl_xor(v, o);
    return v;
}

#define XB_TMO      128
#define XB_XCNT(j)  (256  + 64 * (j))
#define XB_XSUB(j)  (1280 + 64 * (j))
#define XB_XGEN(j)  (2304 + 64 * (j))
#define XB_TOP      3328
#define XB_TOPGEN   3392
#define XCD_BAR_WORDS 3456
#define XB_SPIN_CAP (1u << 18)
__device__ __forceinline__ unsigned xb_ld(unsigned* p)              { return __hip_atomic_load(p, __ATOMIC_RELAXED, __HIP_MEMORY_SCOPE_AGENT); }
__device__ __forceinline__ unsigned xb_add(unsigned* p, unsigned v) { return __hip_atomic_fetch_add(p, v, __ATOMIC_RELAXED, __HIP_MEMORY_SCOPE_AGENT); }
__device__ __forceinline__ unsigned xb_xcc_id() { return (unsigned)__builtin_amdgcn_s_getreg((3 << 11) | 20) & 0xFu; }
#define XB_SPIN(cond, bar) do { unsigned _sp = 0; while (cond) { __builtin_amdgcn_s_sleep(1); \
    if ((++_sp & 255u) == 0u) { if (xb_ld(&(bar)[XB_TMO])) break; if (_sp > XB_SPIN_CAP) { atomicAdd(&(bar)[XB_TMO], 1u); break; } } } } while (0)
struct XcdBarrier { unsigned* bar; unsigned x; volatile LAS unsigned* st; };
__device__ __forceinline__ XcdBarrier xcd_barrier_post(unsigned* bar, volatile LAS unsigned* st) {
    XcdBarrier b; b.bar = bar; b.x = xb_xcc_id(); b.st = st;
    if (threadIdx.x == 0) (void)xb_add(&bar[XB_XCNT(b.x)], 1u);
    return b;
}
__device__ __forceinline__ void xcd_barrier_complete(unsigned* bar, unsigned x, unsigned& nloc, unsigned& nx) {
    const unsigned G = gridDim.x * gridDim.y * gridDim.z;
    unsigned sum, cnt, mine, sp = 0u;
    for (;;) {
        sum = 0u; cnt = 0u; mine = 0u;
#pragma unroll
        for (unsigned j = 0; j < 16; ++j) { const unsigned c = xb_ld(&bar[XB_XCNT(j)]); sum += c; cnt += (c > 0u) ? 1u : 0u; mine = (j == x) ? c : mine; }
        if (sum == G) break;
        __builtin_amdgcn_s_sleep(1);
        if ((++sp & 255u) == 0u) { if (xb_ld(&bar[XB_TMO])) break; if (sp > XB_SPIN_CAP) { atomicAdd(&bar[XB_TMO], 1u); break; } }
    }
    nloc = mine > 0u ? mine : 1u; nx = cnt > 0u ? cnt : 1u;
}
__device__ __forceinline__ void xcd_barrier(const XcdBarrier& b) {
    asm volatile("s_waitcnt vmcnt(0)" ::: "memory");
    __syncthreads();
    if (threadIdx.x == 0) {
        unsigned* bar = b.bar;
        __builtin_amdgcn_s_waitcnt(0);
        unsigned nloc = b.st[0], nx = b.st[1];
        if (nloc == 0u) { xcd_barrier_complete(bar, b.x, nloc, nx); b.st[0] = nloc; b.st[1] = nx; }
        const unsigned old = xb_add(&bar[XB_XSUB(b.x)], 1u);
        const unsigned gen = old / nloc;
        if (old + 1u == (gen + 1u) * nloc) {
            __builtin_amdgcn_fence(__ATOMIC_RELEASE, "agent");
            asm volatile("s_waitcnt vmcnt(0)" ::: "memory");
            const unsigned og = xb_add(&bar[XB_TOP], 1u);
            const unsigned tg = og / nx;
            if (og + 1u == (tg + 1u) * nx) xb_add(&bar[XB_TOPGEN], 1u);
            else XB_SPIN(xb_ld(&bar[XB_TOPGEN]) == tg, bar);
            __builtin_amdgcn_fence(__ATOMIC_ACQUIRE, "agent");
            xb_add(&bar[XB_XGEN(b.x)], 1u);
            asm volatile("s_waitcnt vmcnt(0)" ::: "memory");
        } else {
            XB_SPIN(xb_ld(&bar[XB_XGEN(b.x)]) == gen, bar);
            __builtin_amdgcn_fence(__ATOMIC_ACQUIRE, "agent");
            asm volatile("s_waitcnt vmcnt(0)" ::: "memory");
        }
    }
    __syncthreads();
}

struct Frame {
    LAS unsigned char* lds;
    volatile LAS unsigned* MISC;
    gu32* ctl;
    unsigned char* ws; unsigned char* hi;
    int tid, lane, wave;
    int vcu, G;
    const float* in[31];
    float* out;
};
enum { I_X = 0, I_N1G, I_WIN, I_BGATE, I_ARE, I_AIM, I_LOGDT, I_BRE, I_BIM, I_CRE, I_CIM, I_SSMD, I_WGLU, I_BGLU, I_QG, I_KG, I_LQ1, I_LK1, I_LQ2, I_LK2, I_SUBLN,
       I_WPS, I_WPA, I_WOUT, I_N2G, I_WR, I_BR, I_WUP, I_BUP, I_WDN, I_BDN };

template <int MODE>
__device__ __forceinline__ int physrow(int c) {
    if (MODE == 1) { const int w = c & 63; return (c & ~255) + 128 * (w >> 5) + 32 * ((c >> 6) & 3) + (w & 31); }
    if (MODE == 2) { const int j = c >> 1; return 256 * (j >> 7) + 128 * (c & 1) + (j & 127); }
    return c;
}
struct P0Item { const float* src; void* dst; const float* kscale; int N, K, mode, out8, k0, c0; };
__device__ __forceinline__ int physrow_rt(int mode, int c) { return mode == 1 ? physrow<1>(c) : (mode == 2 ? physrow<2>(c) : c); }
__device__ __forceinline__ void p0_item_load(const P0Item& d, f32x4 (&v)[16], int lane) {
    const int lr = lane >> 4, lc = lane & 15;
#pragma unroll
    for (int i = 0; i < 16; ++i) v[i] = __builtin_nontemporal_load((const f32x4*)(d.src + (size_t)(d.k0 + lr + 4 * i) * d.N + d.c0 + 4 * lc));
}
__device__ __forceinline__ void p0_item_finish(const P0Item& d, const f32x4 (&v)[16], LAS float* scr, int lane) {
    const int lr = lane >> 4, lc = lane & 15;
#pragma unroll
    for (int i = 0; i < 16; ++i) { const int k = lr + 4 * i; *(LAS f32x4*)(scr + k * 64 + 4 * (lc ^ ((k >> 3) & 7))) = v[i]; }
    LDS_WAIT(); asm volatile("" ::: "memory");
    const int a = lane & 7, bq = lane >> 3;
    float ks[8];
#pragma unroll
    for (int i = 0; i < 8; ++i) ks[i] = (d.kscale ? d.kscale[d.k0 + 8 * a + i] : 1.0f) * (d.out8 ? 32.0f : 1.0f);
#pragma unroll
    for (int j = 0; j < 8; ++j) { const int cl = bq + 8 * j; float x[8];
#pragma unroll
        for (int i = 0; i < 8; ++i) x[i] = scr[(8 * a + i) * 64 + 4 * ((cl >> 2) ^ a) + (cl & 3)] * ks[i];
        const size_t ro = (size_t)physrow_rt(d.mode, d.c0 + cl) * d.K + d.k0 + 8 * a;
        if (d.out8) { v2u o; o.x = pk4_fp8(x[0], x[1], x[2], x[3]); o.y = pk4_fp8(x[4], x[5], x[6], x[7]); __builtin_nontemporal_store(o, (GAS v2u*)((unsigned char*)d.dst + ro)); }
        else { v4u o; o.x = cvt_pk_bf16(x[0], x[1]); o.y = cvt_pk_bf16(x[2], x[3]); o.z = cvt_pk_bf16(x[4], x[5]); o.w = cvt_pk_bf16(x[6], x[7]); *(GAS v4u*)((bf16*)d.dst + ro) = o; } }
    LDS_WAIT(); asm volatile("" ::: "memory");
}
__device__ __forceinline__ void rms_row2_to_bf16(int lane, const float* xrow0, const float* xrow1, const float* g, bf16* orow0, bf16* orow1) {
    const GAS f32x4* xr0 = (const GAS f32x4*)xrow0 + lane; const GAS f32x4* xr1 = (const GAS f32x4*)xrow1 + lane; const GAS f32x4* gr = (const GAS f32x4*)g + lane;
    f32x4 v0[4], v1[4]; float s0 = 0.f, s1 = 0.f;
#pragma unroll
    for (int j = 0; j < 4; ++j) { v0[j] = xr0[64 * j]; v1[j] = xr1[64 * j]; }
#pragma unroll
    for (int j = 0; j < 4; ++j) { s0 += (v0[j].x * v0[j].x + v0[j].y * v0[j].y) + (v0[j].z * v0[j].z + v0[j].w * v0[j].w); s1 += (v1[j].x * v1[j].x + v1[j].y * v1[j].y) + (v1[j].z * v1[j].z + v1[j].w * v1[j].w); }
    const float rs0 = 1.0f / sqrtf(wave_sum(s0) * (1.f / DM) + RMS_EPS), rs1 = 1.0f / sqrtf(wave_sum(s1) * (1.f / DM) + RMS_EPS);
    GAS unsigned long long* o0 = (GAS unsigned long long*)orow0 + lane; GAS unsigned long long* o1 = (GAS unsigned long long*)orow1 + lane;
#pragma unroll
    for (int j = 0; j < 4; ++j) { const f32x4 gg = gr[64 * j];
        o0[64 * j] = (unsigned long long)cvt_pk_bf16(v0[j].x * rs0 * gg.x, v0[j].y * rs0 * gg.y) | ((unsigned long long)cvt_pk_bf16(v0[j].z * rs0 * gg.z, v0[j].w * rs0 * gg.w) << 32);
        o1[64 * j] = (unsigned long long)cvt_pk_bf16(v1[j].x * rs1 * gg.x, v1[j].y * rs1 * gg.y) | ((unsigned long long)cvt_pk_bf16(v1[j].z * rs1 * gg.z, v1[j].w * rs1 * gg.w) << 32); }
}
template <int NR>
__device__ __forceinline__ void rms_rows_to_bf16(int lane, const float* x0, const size_t xstride, const float* g, bf16* o0, const size_t ostride, unsigned char* o8) {
    const GAS f32x4* gr = (const GAS f32x4*)g + lane;
    f32x4 v[NR][4]; float ss[NR];
#pragma unroll
    for (int r = 0; r < NR; ++r) { const GAS f32x4* xr = (const GAS f32x4*)(x0 + r * xstride) + lane;
#pragma unroll
        for (int j = 0; j < 4; ++j) v[r][j] = __builtin_nontemporal_load(xr + 64 * j); }
    f32x4 gg[4];
#pragma unroll
    for (int j = 0; j < 4; ++j) gg[j] = gr[64 * j];
#pragma unroll
    for (int r = 0; r < NR; ++r) { float s = 0.f;
#pragma unroll
        for (int j = 0; j < 4; ++j) s += (v[r][j].x * v[r][j].x + v[r][j].y * v[r][j].y) + (v[r][j].z * v[r][j].z + v[r][j].w * v[r][j].w);
        ss[r] = s; }
#pragma unroll
    for (int r = 0; r < NR; ++r) { const float rs = 1.0f / sqrtf(wave_sum(ss[r]) * (1.f / DM) + RMS_EPS);
        GAS unsigned long long* o = (GAS unsigned long long*)(o0 + r * ostride) + lane;
#pragma unroll
        for (int j = 0; j < 4; ++j) { const float y0 = v[r][j].x * rs * gg[j].x, y1 = v[r][j].y * rs * gg[j].y, y2 = v[r][j].z * rs * gg[j].z, y3 = v[r][j].w * rs * gg[j].w;
            o[64 * j] = (unsigned long long)cvt_pk_bf16(y0, y1) | ((unsigned long long)cvt_pk_bf16(y2, y3) << 32);
            ((GAS unsigned*)(o8 + r * ostride) + lane)[64 * j] = pk4_fp8(y0 * 4.0f, y1 * 4.0f, y2 * 4.0f, y3 * 4.0f); } }
}
__device__ __forceinline__ void rms_row_to_bf16(int lane, const float* xrow, const float* g, bf16* orow) {
    const GAS f32x4* xr = (const GAS f32x4*)xrow + lane; const GAS f32x4* gr = (const GAS f32x4*)g + lane;
    f32x4 v[4]; float s = 0.f;
#pragma unroll
    for (int j = 0; j < 4; ++j) { v[j] = xr[64 * j]; s += (v[j].x * v[j].x + v[j].y * v[j].y) + (v[j].z * v[j].z + v[j].w * v[j].w); }
    const float rs = 1.0f / sqrtf(wave_sum(s) * (1.f / DM) + RMS_EPS);
    GAS unsigned long long* o8 = (GAS unsigned long long*)orow + lane;
#pragma unroll
    for (int j = 0; j < 4; ++j) { const f32x4 gg = gr[64 * j];
        o8[64 * j] = (unsigned long long)cvt_pk_bf16(v[j].x * rs * gg.x, v[j].y * rs * gg.y) | ((unsigned long long)cvt_pk_bf16(v[j].z * rs * gg.z, v[j].w * rs * gg.w) << 32); }
}
__device__ __forceinline__ void p0_s5_group(Frame& F, int g) {
    LAS float* AP = (LAS float*)(F.lds + RING_OFF);
    LAS float* BB = AP + 17 * 64 * 2;
    LAS float* CC = BB + 64 * 16 * 2;
    LAS float* KM = CC + 16 * 64 * 2;
    const float* are = F.in[I_ARE] + g * SSM_P; const float* aim = F.in[I_AIM] + g * SSM_P;
    const double dt = exp((double)F.in[I_LOGDT][g]);
    for (int e = F.tid; e < 17 * 64; e += NWAVES * 64) { const int m = e >> 6, p = e & 63; const double lr = are[p], li = aim[p];
        const double mag = exp(lr * dt * m), ang = li * dt * m; AP[e * 2] = (float)(mag * cos(ang)); AP[e * 2 + 1] = (float)(mag * sin(ang)); }
    for (int e = F.tid; e < 64 * 16; e += NWAVES * 64) { const int p = e >> 4, h = e & 15; const double lr = are[p], li = aim[p];
        const double mag = exp(lr * dt), ar = mag * cos(li * dt), ai = mag * sin(li * dt), den = lr * lr + li * li, nr = ar - 1.0, ni = ai;
        const double cr = (nr * lr + ni * li) / den, ci = (ni * lr - nr * li) / den;
        const double br = F.in[I_BRE][(size_t)(g * SSM_P + p) * SSM_H + h], bi = F.in[I_BIM][(size_t)(g * SSM_P + p) * SSM_H + h];
        BB[e * 2] = (float)(cr * br - ci * bi); BB[e * 2 + 1] = (float)(cr * bi + ci * br); }
    for (int e = F.tid; e < 16 * 64; e += NWAVES * 64) { CC[e * 2] = F.in[I_CRE][(size_t)g * 1024 + e]; CC[e * 2 + 1] = F.in[I_CIM][(size_t)g * 1024 + e]; }
    __syncthreads();
    if (F.tid < 64) { float* a16 = (float*)(F.ws + WS_A16) + (g * 64 + F.tid) * 2; a16[0] = AP[(16 * 64 + F.tid) * 2]; a16[1] = AP[(16 * 64 + F.tid) * 2 + 1]; }
    { const int ho = (F.tid >> 4) & 15, hi = F.tid & 15, m0 = F.tid >> 8; float acc[8] = {0.f, 0.f, 0.f, 0.f, 0.f, 0.f, 0.f, 0.f};
      for (int p = 0; p < 64; ++p) { const f32x2 c = *(const LAS f32x2*)(CC + (ho * 64 + p) * 2), bb = *(const LAS f32x2*)(BB + (p * 16 + hi) * 2);
          const float tr = c.x * bb.x - c.y * bb.y, ti = c.x * bb.y + c.y * bb.x;
#pragma unroll
          for (int i = 0; i < 8; ++i) { const f32x2 a = *(const LAS f32x2*)(AP + ((m0 + 2 * i) * 64 + p) * 2); acc[i] += tr * a.x - ti * a.y; } }
#pragma unroll
      for (int i = 0; i < 8; ++i) KM[(m0 + 2 * i) * 256 + ho * 16 + hi] = acc[i]; }
    __syncthreads();
    bf16* W1T = (bf16*)(F.ws + WS_S5 + (size_t)g * 262144); bf16* M2T = W1T + 128 * 256; bf16* W3T = M2T + 256 * 256;
    for (int q = F.tid; q < 128 * 16; q += NWAVES * 64) { const int n = q >> 4, j = q & 15, pp = n & 63;
        const f32x2 a = *(const LAS f32x2*)(AP + ((15 - j) * 64 + pp) * 2); const LAS f32x4* bp = (const LAS f32x4*)(BB + pp * 32); float o[16];
#pragma unroll
        for (int h2 = 0; h2 < 8; ++h2) { const f32x4 b4 = bp[h2];
            o[2 * h2] = n < 64 ? a.x * b4.x - a.y * b4.y : a.x * b4.y + a.y * b4.x; o[2 * h2 + 1] = n < 64 ? a.x * b4.z - a.y * b4.w : a.x * b4.w + a.y * b4.z; }
        v4u w0, w1; w0.x = cvt_pk_bf16(o[0], o[1]); w0.y = cvt_pk_bf16(o[2], o[3]); w0.z = cvt_pk_bf16(o[4], o[5]); w0.w = cvt_pk_bf16(o[6], o[7]);
        w1.x = cvt_pk_bf16(o[8], o[9]); w1.y = cvt_pk_bf16(o[10], o[11]); w1.z = cvt_pk_bf16(o[12], o[13]); w1.w = cvt_pk_bf16(o[14], o[15]);
        *(v4u*)(W1T + n * 256 + 16 * j) = w0; *(v4u*)(W1T + n * 256 + 16 * j + 8) = w1; }
    for (int q = F.tid; q < 256 * 8; q += NWAVES * 64) { const int n = q >> 3, p8 = (q & 7) * 8, i = n >> 4, ho = n & 15;
        const LAS f32x4* cp = (const LAS f32x4*)(CC + (ho * 64 + p8) * 2); const LAS f32x4* ap = (const LAS f32x4*)(AP + ((i + 1) * 64 + p8) * 2); float re[8], im[8];
#pragma unroll
        for (int h2 = 0; h2 < 4; ++h2) { const f32x4 c4 = cp[h2], a4 = ap[h2];
            re[2 * h2] = c4.x * a4.x - c4.y * a4.y; im[2 * h2] = -(c4.x * a4.y + c4.y * a4.x); re[2 * h2 + 1] = c4.z * a4.z - c4.w * a4.w; im[2 * h2 + 1] = -(c4.z * a4.w + c4.w * a4.z); }
        v4u w0, w1; w0.x = cvt_pk_bf16(re[0], re[1]); w0.y = cvt_pk_bf16(re[2], re[3]); w0.z = cvt_pk_bf16(re[4], re[5]); w0.w = cvt_pk_bf16(re[6], re[7]);
        w1.x = cvt_pk_bf16(im[0], im[1]); w1.y = cvt_pk_bf16(im[2], im[3]); w1.z = cvt_pk_bf16(im[4], im[5]); w1.w = cvt_pk_bf16(im[6], im[7]);
        *(v4u*)(W3T + n * 128 + p8) = w0; *(v4u*)(W3T + n * 128 + 64 + p8) = w1; }
    const float* dsk = F.in[I_SSMD] + g * 16;
    for (int q = F.tid; q < 256 * 16; q += NWAVES * 64) { const int n = q >> 4, j = q & 15, i = n >> 4, ho = n & 15;
        float o[16];
        if (j <= i) { const LAS f32x4* kp = (const LAS f32x4*)(KM + ((i - j) * 16 + ho) * 16);
#pragma unroll
            for (int h4 = 0; h4 < 4; ++h4) { const f32x4 k4 = kp[h4]; o[4 * h4] = k4.x; o[4 * h4 + 1] = k4.y; o[4 * h4 + 2] = k4.z; o[4 * h4 + 3] = k4.w; }
            if (i == j) { const float dd = dsk[ho];
#pragma unroll
                for (int hh = 0; hh < 16; ++hh) if (hh == ho) o[hh] += dd; } }
        else {
#pragma unroll
            for (int hh = 0; hh < 16; ++hh) o[hh] = 0.f; }
        v4u w0, w1; w0.x = cvt_pk_bf16(o[0], o[1]); w0.y = cvt_pk_bf16(o[2], o[3]); w0.z = cvt_pk_bf16(o[4], o[5]); w0.w = cvt_pk_bf16(o[6], o[7]);
        w1.x = cvt_pk_bf16(o[8], o[9]); w1.y = cvt_pk_bf16(o[10], o[11]); w1.z = cvt_pk_bf16(o[12], o[13]); w1.w = cvt_pk_bf16(o[14], o[15]);
        *(v4u*)(M2T + n * 256 + 16 * j) = w0; *(v4u*)(M2T + n * 256 + 16 * j + 8) = w1; }
    __syncthreads();
}
struct BigItem { const float* W; unsigned char* WT; const float* kscale; int N, K, mode, k0, c0; };
__device__ __forceinline__ void p0_big_load(const BigItem& d, f32x4 (&v)[16], int lane, int w) {
#pragma unroll
    for (int i = 0; i < 16; ++i) v[i] = __builtin_nontemporal_load((const f32x4*)(d.W + (size_t)(d.k0 + 16 * w + i) * d.N + d.c0 + 4 * lane));
}
__device__ __forceinline__ void p0_big_put(Frame& F, const f32x4 (&v)[16]) {
    LAS float* T = (LAS float*)(F.lds + RING_OFF); const int lane = F.lane, w = F.wave;
#pragma unroll
    for (int i = 0; i < 16; ++i) { const int k = 16 * w + i; *(LAS f32x4*)(T + k * 256 + 4 * (lane ^ (w & 7))) = v[i]; }
}
__device__ __forceinline__ void p0_big_emit(Frame& F, const BigItem& d) {
    LAS float* T = (LAS float*)(F.lds + RING_OFF); const int lane = F.lane, w = F.wave, r8 = lane >> 3, kc = lane & 7;
    float ksv[16];
#pragma unroll
    for (int i = 0; i < 16; ++i) ksv[i] = d.kscale ? d.kscale[d.k0 + 16 * kc + i] * 32.0f : 32.0f;
#pragma unroll
    for (int st = 0; st < 4; ++st) { const int cl = 32 * w + 8 * st + r8, chunk = cl >> 2, sub = cl & 3;
        float x[16];
#pragma unroll
        for (int i = 0; i < 16; ++i) x[i] = T[(16 * kc + i) * 256 + 4 * (chunk ^ kc) + sub] * ksv[i];
        v4u o; o.x = pk4_fp8(x[0], x[1], x[2], x[3]); o.y = pk4_fp8(x[4], x[5], x[6], x[7]); o.z = pk4_fp8(x[8], x[9], x[10], x[11]); o.w = pk4_fp8(x[12], x[13], x[14], x[15]);
        const int pr = d.mode == 2 ? physrow<2>(d.c0 + cl) : d.c0 + cl;
        __builtin_nontemporal_store(o, (GAS v4u*)(d.WT + ((size_t)(d.k0 >> 7) * d.N + pr) * 128 + 16 * kc)); }
}
constexpr int BI_UP1 = (DM / 128) * (UPW / 256), BI_DN1 = (DE / 128) * (DM / 256), NBIG = NE * (BI_UP1 + BI_DN1);
#ifndef BIG_SPLIT_AT
#define BIG_SPLIT_AT 2560
#endif
constexpr int BIG_SPLIT = BIG_SPLIT_AT;
__device__ __forceinline__ void convert_big(Frame& F, const int seg, const int lo, const int hi) {
        LAS int* qs = (LAS int*)(F.lds + MOE_LDS_OFF);
#define BIG_DRAW(it) do { if (F.tid == 0) qs[0] = lo + (int)atomicAdd((unsigned*)(F.ctl + CW_Q) + 64 + 64 * seg, 1u); __syncthreads(); it = qs[0]; __syncthreads(); } while (0)
#define BIG_DECODE(it, d) do { if ((it) < NE * BI_UP1) { const int e_ = (it) / BI_UP1, q_ = (it) % BI_UP1; d.W = F.in[I_WUP] + (size_t)e_ * DM * UPW; d.WT = F.hi + (WS_WUP - HI) + (size_t)e_ * UPW * DM; d.kscale = F.in[I_N2G]; \
            d.N = UPW; d.K = DM; d.mode = 2; d.k0 = 128 * (q_ / (UPW / 256)); d.c0 = 256 * (q_ % (UPW / 256)); } \
        else { const int r_ = (it) - NE * BI_UP1, e_ = r_ / BI_DN1, q_ = r_ % BI_DN1; d.W = F.in[I_WDN] + (size_t)e_ * DE * DM; d.WT = F.hi + (WS_WDN - HI) + (size_t)e_ * DM * DE; d.kscale = nullptr; \
            d.N = DM; d.K = DE; d.mode = 0; d.k0 = 128 * (q_ / (DM / 256)); d.c0 = 256 * (q_ % (DM / 256)); } } while (0)
        int it, itn; BigItem d, dn; f32x4 v[16];
        BIG_DRAW(it);
        if (it < hi) { BIG_DECODE(it, d); p0_big_load(d, v, F.lane, F.wave);
            for (;;) {
                p0_big_put(F, v);
                BIG_DRAW(itn);
                const bool hasn = itn < hi;
                if (hasn) { BIG_DECODE(itn, dn); p0_big_load(dn, v, F.lane, F.wave); }
                p0_big_emit(F, d);
                __syncthreads();
                if (!hasn) break;
                d = dn; } }
#undef BIG_DRAW
#undef BIG_DECODE
}


__device__ __forceinline__ void p0_prologue(Frame& F) {
    if (F.vcu < SSM_G) p0_s5_group(F, F.vcu);
    LAS float* scr = (LAS float*)(F.lds + RING_OFF + F.wave * 16384);
    const int gw = F.vcu * NWAVES + F.wave, NGW = F.G * NWAVES;
    { unsigned short* wrH = (unsigned short*)(F.ws + WS_WRT); unsigned short* wrL = wrH + NE * DM; const float* wr = F.in[I_WR]; const float* g2 = F.in[I_N2G];
      for (int e = gw * 64 + F.lane; e < NE * DM; e += NGW * 64) { const int ex = e >> 10, k = e & 1023; const float v = g2[k] * wr[k * NE + ex];
          const unsigned hb = f2bf(v); const float hf = __uint_as_float(hb << 16); wrH[e] = (unsigned short)hb; wrL[e] = (unsigned short)f2bf(v - hf); } }
    { bf16* XN = (bf16*)(F.hi + (WS_XN - HI)); int m = gw;
      for (; m + 7 * NGW < M; m += 8 * NGW) rms_rows_to_bf16<8>(F.lane, F.in[I_X] + (size_t)m * DM, (size_t)NGW * DM, F.in[I_N1G], XN + (size_t)m * DM, (size_t)NGW * DM, F.hi + (WS_XN8 - HI) + (size_t)m * DM);
      for (; m < M; m += NGW) rms_row_to_bf16(F.lane, F.in[I_X] + (size_t)m * DM, F.in[I_N1G], XN + (size_t)m * DM); }
    constexpr int IT_IN = (DM / 64) * (IN_W / 64), IT_GLU = (512 / 64) * (512 / 64), IT_PS = (512 / 64) * (DM / 64), IT_OUT = (DM / 64) * (DM / 64);
    constexpr int IT_UP1 = (DM / 64) * (UPW / 64), IT_DN1 = (DE / 64) * (DM / 64);
    constexpr int NITEMS = IT_IN + IT_GLU + 2 * IT_PS + IT_OUT;
#define P0_DECODE(it, d) do { int r_ = (it); int nb_; \
        if (r_ < IT_IN) { d.src = F.in[I_WIN]; d.kscale = nullptr; d.N = IN_W; d.K = DM; d.mode = 1; nb_ = IN_W / 64; d.out8 = (r_ % nb_) >= 32; d.dst = d.out8 ? (void*)(F.hi + (WS_WIN8 - HI) - (size_t)2048 * DM) : (void*)(F.hi + (WS_WIN - HI)); } \
        else if ((r_ -= IT_IN) < IT_GLU) { d.src = F.in[I_WGLU]; d.dst = F.ws + WS_WGLU; d.kscale = nullptr; d.N = 512; d.K = 512; d.mode = 0; d.out8 = 0; } \
        else if ((r_ -= IT_GLU) < IT_PS) { d.src = F.in[I_WPS]; d.dst = F.ws + WS_WPS; d.kscale = nullptr; d.N = DM; d.K = 512; d.mode = 0; d.out8 = 0; } \
        else if ((r_ -= IT_PS) < IT_PS) { d.src = F.in[I_WPA]; d.dst = F.ws + WS_WPA; d.kscale = nullptr; d.N = DM; d.K = 512; d.mode = 0; d.out8 = 0; } \
        else if ((r_ -= IT_PS) < IT_OUT) { d.src = F.in[I_WOUT]; d.dst = F.ws + WS_WOUT; d.kscale = nullptr; d.N = DM; d.K = DM; d.mode = 0; d.out8 = 0; } \
        else if ((r_ -= IT_OUT) < NE * IT_UP1) { const int e_ = r_ / IT_UP1; r_ -= e_ * IT_UP1; d.src = F.in[I_WUP] + (size_t)e_ * DM * UPW; d.dst = F.hi + (WS_WUP - HI) + (size_t)e_ * UPW * DM; d.kscale = F.in[I_N2G]; d.N = UPW; d.K = DM; d.mode = 2; d.out8 = 1; } \
        else { r_ -= NE * IT_UP1; const int e_ = r_ / IT_DN1; r_ -= e_ * IT_DN1; d.src = F.in[I_WDN] + (size_t)e_ * DE * DM; d.dst = F.hi + (WS_WDN - HI) + (size_t)e_ * DM * DE; d.kscale = nullptr; d.N = DM; d.K = DE; d.mode = 0; d.out8 = 1; } \
        nb_ = d.N / 64; d.k0 = 64 * (r_ / nb_); d.c0 = 64 * (r_ % nb_); } while (0)
    { P0Item dA; f32x4 vA[16];
      for (int it = gw; it < NITEMS; it += NGW) { P0_DECODE(it, dA); p0_item_load(dA, vA, F.lane); p0_item_finish(dA, vA, scr, F.lane); } }
#undef P0_DECODE
    __syncthreads();
    convert_big(F, 0, 0, BIG_SPLIT);
}

typedef const pg8::f32x4 (&AccRef)[2][2][4][2];
__device__ __forceinline__ v4u pack8(const f32x4 a, const f32x4 b) { v4u w; w.x = cvt_pk_bf16(a[0], a[1]); w.y = cvt_pk_bf16(a[2], a[3]); w.z = cvt_pk_bf16(b[0], b[1]); w.w = cvt_pk_bf16(b[2], b[3]); return w; }
__device__ __forceinline__ void unpack8(const v4u w, f32x4& a, f32x4& b) { a = (f32x4){bflo(w.x), bfhi(w.x), bflo(w.y), bfhi(w.y)}; b = (f32x4){bflo(w.z), bfhi(w.z), bflo(w.w), bfhi(w.w)}; }

struct Fp8Dense {
    pg8::StaticOrder so; const LAS int* st;
    __device__ __forceinline__ bool next(int i, pg8::Unit& u) const { return so.next(i, u); }
    __device__ __forceinline__ int row_slot(const pg8::Unit&, int) const { return 0; }
    __device__ __forceinline__ const LAS int* slot_table() const { return st; }
    __device__ __forceinline__ int a_row(const pg8::Unit& u, int r, int) const { return u.pm * 256 + r; }
    __device__ __forceinline__ const char* a_base(const pg8::Gemm& g, const pg8::Unit&, size_t) const { return (const char*)g.A; }
    __device__ __forceinline__ void a_ready(const pg8::Unit&) const {}
    __device__ __forceinline__ void done(const pg8::Unit&) const {}
};
struct EpiInProj {
    static constexpr bool PERM = true;
    __device__ __forceinline__ bool keep(const pg8::Unit&) const { return false; }
    bf16 *U, *Q, *Kb, *V, *G1, *G2; const float *bgate, *qg, *kg; int pn_off; float sA;
    __device__ __forceinline__ void operator()(AccRef acc, const pg8::Unit& u, int wr, int wc, int fr, int fq, const LAS int*) const {
        const int pn = u.pn + pn_off, row0 = u.pm * 256 + wr * 64 + fr;
        if (pn < 2) {
#pragma unroll
            for (int ai = 0; ai < 2; ++ai)
#pragma unroll
                for (int m = 0; m < 4; ++m) { const int row = row0 + ai * 128 + m * 16, b = row >> 11, t = row & 2047;
#pragma unroll
                    for (int bj = 0; bj < 2; ++bj) { const int lc = 256 * pn + 64 * wc + 32 * bj + 8 * fq, g = lc >> 4, ch = lc & 15;
                        *(v4u*)(U + ((size_t)(b * SSM_G + g) * SEQ + t) * 16 + ch) = pack8(acc[ai][bj][m][0], acc[ai][bj][m][1]); } }
        } else if (pn < 6) {
            const bool isq = pn < 4; const float* gv = isq ? qg : kg; const float sc = isq ? QSCALE : 1.0f;
            bf16* dst = (isq ? Q : Kb) + 256 * (pn - (isq ? 2 : 4)) + 64 * wc + 8 * fq;
            f32x4 gg[2][2];
#pragma unroll
            for (int bj = 0; bj < 2; ++bj)
#pragma unroll
                for (int n = 0; n < 2; ++n) gg[bj][n] = *(const f32x4*)(gv + 32 * bj + 8 * fq + 4 * n) * sc;
#pragma unroll
            for (int ai = 0; ai < 2; ++ai)
#pragma unroll
                for (int m = 0; m < 4; ++m) { const int row = row0 + ai * 128 + m * 16; float ss = 0.f;
#pragma unroll
                    for (int bj = 0; bj < 2; ++bj)
#pragma unroll
                        for (int n = 0; n < 2; ++n) { const f32x4 x = acc[ai][bj][m][n]; ss += (x[0] * x[0] + x[1] * x[1]) + (x[2] * x[2] + x[3] * x[3]); }
                    ss = xor16_add(ss); ss = xor32_add(ss);
                    const float rs = __builtin_amdgcn_rsqf(ss * (1.0f / 64.0f) + RMS_EPS);
#pragma unroll
                    for (int bj = 0; bj < 2; ++bj) *(v4u*)(dst + (size_t)row * 512 + 32 * bj) = pack8(acc[ai][bj][m][0] * rs * gg[bj][0], acc[ai][bj][m][1] * rs * gg[bj][1]); }
        } else if (pn < 8) {
            bf16* dst = V + 256 * (pn - 6) + 64 * wc + 8 * fq;
#pragma unroll
            for (int ai = 0; ai < 2; ++ai)
#pragma unroll
                for (int m = 0; m < 4; ++m) { const int row = row0 + ai * 128 + m * 16;
#pragma unroll
                    for (int bj = 0; bj < 2; ++bj) *(v4u*)(dst + (size_t)row * 512 + 32 * bj) = pack8(acc[ai][bj][m][0], acc[ai][bj][m][1]); }
        } else {
            const int gc = 256 * (pn - 8) + 64 * wc + 8 * fq;
            bf16* dst = (gc < 1024 ? G1 + gc : G2 + (gc - 1024));
            f32x4 bb[2][2];
#pragma unroll
            for (int bj = 0; bj < 2; ++bj)
#pragma unroll
                for (int n = 0; n < 2; ++n) bb[bj][n] = *(const f32x4*)(bgate + gc + 32 * bj + 4 * n);
#pragma unroll
            for (int ai = 0; ai < 2; ++ai)
#pragma unroll
                for (int m = 0; m < 4; ++m) { const int row = row0 + ai * 128 + m * 16;
#pragma unroll
                    for (int bj = 0; bj < 2; ++bj) { f32x4 a = acc[ai][bj][m][0] * sA + bb[bj][0], b = acc[ai][bj][m][1] * sA + bb[bj][1];
#pragma unroll
                        for (int e = 0; e < 4; ++e) { a[e] = fsigmoid_asm(a[e]); b[e] = fsigmoid_asm(b[e]); }
                        *(v4u*)(dst + (size_t)row * 1024 + 32 * bj) = pack8(a, b); } }
        }
    }
};
template <int MODE> struct EpiMix {
    static constexpr bool PERM = true;
    __device__ __forceinline__ bool keep(const pg8::Unit&) const { return false; }
    const bf16* P0; const bf16* P1; bf16* O; const float* bias; int ld;
    __device__ __forceinline__ void operator()(AccRef acc, const pg8::Unit& u, int wr, int wc, int fr, int fq, const LAS int*) const {
        const int row0 = u.pm * 256 + wr * 64 + fr, col0 = u.pn * 256 + wc * 32 + 8 * fq;
        f32x4 bb[2][2];
#pragma unroll
        for (int bj = 0; bj < 2; ++bj)
#pragma unroll
            for (int n = 0; n < 2; ++n) bb[bj][n] = (MODE == 0) ? *(const f32x4*)(bias + col0 + bj * 128 + 4 * n) : (f32x4){0.f, 0.f, 0.f, 0.f};
#pragma unroll
        for (int ai = 0; ai < 2; ++ai) {
            v4u q0[4][2], q1[4][2];
#pragma unroll
            for (int m = 0; m < 4; ++m)
#pragma unroll
                for (int bj = 0; bj < 2; ++bj) { const size_t off = (size_t)(row0 + ai * 128 + m * 16) * ld + col0 + bj * 128; q0[m][bj] = *(const v4u*)(P0 + off); if (MODE == 2) q1[m][bj] = *(const v4u*)(P1 + off); }
#pragma unroll
            for (int m = 0; m < 4; ++m) { const size_t off = (size_t)(row0 + ai * 128 + m * 16) * ld + col0;
#pragma unroll
                for (int bj = 0; bj < 2; ++bj) { f32x4 a = acc[ai][bj][m][0], b = acc[ai][bj][m][1], p0a, p0b;
                    unpack8(q0[m][bj], p0a, p0b);
                    if (MODE == 0) { a += bb[bj][0]; b += bb[bj][1];
#pragma unroll
                        for (int e = 0; e < 4; ++e) { a[e] = p0a[e] * fsigmoid_fast(a[e]); b[e] = p0b[e] * fsigmoid_fast(b[e]); } }
                    else if (MODE == 1) { a *= p0a; b *= p0b; }
                    else { f32x4 p1a, p1b; unpack8(q1[m][bj], p1a, p1b); a = p0a + p1a * a; b = p0b + p1b * b; }
                    if (MODE == 0) __builtin_amdgcn_raw_buffer_store_b128(pack8(a, b), __builtin_amdgcn_make_buffer_rsrc(O, 0, M * 512 * 2, 0x00020000), (int)((off + bj * 128) * 2), 0, 16);
                    else *(v4u*)(O + off + bj * 128) = pack8(a, b); } } }
    }
};
__device__ __forceinline__ void panel_publish(unsigned* flag) {
    asm volatile("s_waitcnt vmcnt(0)" ::: "memory"); __builtin_amdgcn_s_barrier(); asm volatile("" ::: "memory");
    if (threadIdx.x == 0) __hip_atomic_fetch_add(flag, 1u, __ATOMIC_RELAXED, __HIP_MEMORY_SCOPE_AGENT);
}
__device__ __forceinline__ void panel_wait(unsigned* flag, unsigned want) {
    unsigned spins = 0;
    while (__hip_atomic_load(flag, __ATOMIC_RELAXED, __HIP_MEMORY_SCOPE_AGENT) < want && ++spins < (1u << 22)) __builtin_amdgcn_s_sleep(2);
    asm volatile("" ::: "memory");
}
struct PanelOrder {
    pg8::StaticOrder so; unsigned* wflag; unsigned* pflag;
    __device__ __forceinline__ bool next(int i, pg8::Unit& u) const { return so.next(i, u); }
    __device__ __forceinline__ int row_slot(const pg8::Unit&, int) const { return 0; }
    __device__ __forceinline__ const LAS int* slot_table() const { return nullptr; }
    __device__ __forceinline__ int a_row(const pg8::Unit& u, int r, int) const { return u.pm * 256 + r; }
    __device__ __forceinline__ const char* a_base(const pg8::Gemm& g, const pg8::Unit& u, size_t tstep) const { return (const char*)g.A + (size_t)u.pm * tstep; }
    __device__ __forceinline__ void a_ready(const pg8::Unit& u) const { if (wflag) panel_wait(wflag + u.pm * PANEL_STRIDE, 4u); }
    __device__ __forceinline__ void done(const pg8::Unit& u) const { if (pflag) panel_publish(pflag + u.pm * PANEL_STRIDE); }
};
struct EpiOut {
    static constexpr bool PERM = true;
    static constexpr int PID = 5;
    __device__ __forceinline__ bool keep(const pg8::Unit&) const { return false; }
    const float* X; bf16* H; unsigned char* HB; bool wt;
    __device__ __forceinline__ void operator()(AccRef acc, const pg8::Unit& u, int wr, int wc, int fr, int fq, const LAS int*) const {
        const int row0 = u.pm * 256 + wr * 64 + fr, col0 = u.pn * 256 + wc * 32 + 8 * fq;
#pragma unroll
        for (int ai = 0; ai < 2; ++ai) {
            f32x4 xv[4][2][2];
#pragma unroll
            for (int m = 0; m < 4; ++m)
#pragma unroll
                for (int bj = 0; bj < 2; ++bj)
#pragma unroll
                    for (int n = 0; n < 2; ++n) xv[m][bj][n] = __builtin_nontemporal_load((const f32x4*)(X + (size_t)(row0 + ai * 128 + m * 16) * DM + col0 + bj * 128 + n * 4));
#pragma unroll
            for (int m = 0; m < 4; ++m) { const size_t off = (size_t)(row0 + ai * 128 + m * 16) * DM + col0;
#pragma unroll
                for (int bj = 0; bj < 2; ++bj) { const f32x4 ha = xv[m][bj][0] + acc[ai][bj][m][0], hb = xv[m][bj][1] + acc[ai][bj][m][1]; const v4u hw = pack8(ha, hb);
                    if (wt) __builtin_amdgcn_raw_buffer_store_b128(hw, __builtin_amdgcn_make_buffer_rsrc(H, 0, M * DM * 2, 0x00020000), (int)((off + bj * 128) * 2), 0, 16);
                    else *(v4u*)(H + off + bj * 128) = hw;
                    v2u fb; fb.x = pk4_fp8(ha[0], ha[1], ha[2], ha[3]); fb.y = pk4_fp8(hb[0], hb[1], hb[2], hb[3]); *(v2u*)(HB + off + bj * 128) = fb; } } }
    }
};
struct ChainOrder {
    pg8::StaticOrder so; const bf16* A_att; const bf16* A_ssm; unsigned* pflag; unsigned* wflag;
    __device__ __forceinline__ bool next(int i, pg8::Unit& u) const { pg8::Unit t; if (!so.next(i >> 1, t)) return false; u.pm = t.pm; u.pn = (i & 1) ? t.pn : 4 + t.pn; return true; }
    __device__ __forceinline__ int row_slot(const pg8::Unit&, int) const { return 0; }
    __device__ __forceinline__ const LAS int* slot_table() const { return nullptr; }
    __device__ __forceinline__ int a_row(const pg8::Unit& u, int r, int) const { return u.pm * 256 + r; }
    __device__ __forceinline__ const char* a_base(const pg8::Gemm&, const pg8::Unit& u, size_t tstep) const { return (const char*)(u.pn >= 4 ? A_att : A_ssm) + (size_t)u.pm * tstep; }
    __device__ __forceinline__ void a_ready(const pg8::Unit& u) const { if (wflag && u.pn < 4) panel_wait(wflag + u.pm * PANEL_STRIDE, 2u); }
    __device__ __forceinline__ void done(const pg8::Unit& u) const { if (pflag && u.pn < 4) panel_publish(pflag + u.pm * PANEL_STRIDE); }
};
struct EpiChain {
    static constexpr bool PERM = true;
    const bf16* G1; const bf16* G2; bf16* MX; bool wt;
    __device__ __forceinline__ bool keep(const pg8::Unit& u) const { return u.pn >= 4; }
    __device__ __forceinline__ void operator()(pg8::f32x4 (&acc)[2][2][4][2], const pg8::Unit& u, int wr, int wc, int fr, int fq, const LAS int*) const {
        const bool att = u.pn >= 4; const int row0 = u.pm * 256 + wr * 64 + fr, col0 = (u.pn & 3) * 256 + wc * 32 + 8 * fq;
#pragma unroll
        for (int ai = 0; ai < 2; ++ai) {
            v4u q1[4][2], q2[4][2];
#pragma unroll
            for (int m = 0; m < 4; ++m)
#pragma unroll
                for (int bj = 0; bj < 2; ++bj) { const size_t off = (size_t)(row0 + ai * 128 + m * 16) * DM + col0 + bj * 128; q1[m][bj] = *(const v4u*)(G1 + off); if (att) q2[m][bj] = *(const v4u*)(G2 + off); }
#pragma unroll
            for (int m = 0; m < 4; ++m)
#pragma unroll
                for (int bj = 0; bj < 2; ++bj) { f32x4 g1a, g1b; unpack8(q1[m][bj], g1a, g1b);
                    if (att) { f32x4 g2a, g2b; unpack8(q2[m][bj], g2a, g2b);
#pragma unroll
                        for (int e = 0; e < 4; ++e) { acc[ai][bj][m][0][e] *= g2a[e] * __builtin_amdgcn_rcpf(g1a[e]); acc[ai][bj][m][1][e] *= g2b[e] * __builtin_amdgcn_rcpf(g1b[e]); } }
                    else { const v4u o = pack8(acc[ai][bj][m][0] * g1a, acc[ai][bj][m][1] * g1b); const size_t eo = (size_t)(row0 + ai * 128 + m * 16) * DM + col0 + bj * 128;
                        if (wt) __builtin_amdgcn_raw_buffer_store_b128(o, __builtin_amdgcn_make_buffer_rsrc(MX, 0, M * DM * 2, 0x00020000), (int)(eo * 2), 0, 16); else *(v4u*)(MX + eo) = o; } } }
    }
};
constexpr int CW_MFLAG = 32768, MFLAG_STRIDE = 16;
static_assert((CW_MFLAG + 2 * 288 * MFLAG_STRIDE) * 4 <= (int)CTL_ZERO_BYTES && CW_MFLAG + 2 * 288 * MFLAG_STRIDE <= CW_PANEL4 && (CW_PANEL3 + 64 * PANEL_STRIDE) * 4 <= (int)CTL_ZERO_BYTES, "control words inside the per-call memset");
template <int NN, bool TOKROWS> struct MoeOrder {
    int nunits, G, vcu; const LAS int* cnt; const LAS int* tstart; const LAS int* tile2e; const int* elist; unsigned* mflag; LAS int* st;
    __device__ __forceinline__ const LAS int* slot_table() const { return st; }
    __device__ __forceinline__ void fill(int tid, const float* val) const {
        const int hi = tid >> 8, r = tid & 255;
#pragma unroll 1
        for (int j0 = 0; j0 < SLOT_UNITS / 2; j0 += 4) {
            int e0 = -2, e1 = -2, e2 = -2, e3 = -2; pg8::Unit u;
            if (next(2 * (j0 + 0) + hi, u)) e0 = row_slot(u, r);
            if (next(2 * (j0 + 1) + hi, u)) e1 = row_slot(u, r);
            if (next(2 * (j0 + 2) + hi, u)) e2 = row_slot(u, r);
            if (next(2 * (j0 + 3) + hi, u)) e3 = row_slot(u, r);
            const float v0 = e0 >= 0 ? val[TOKROWS ? (e0 >> 2) : e0] : 0.0f, v1 = e1 >= 0 ? val[TOKROWS ? (e1 >> 2) : e1] : 0.0f;
            const float v2 = e2 >= 0 ? val[TOKROWS ? (e2 >> 2) : e2] : 0.0f, v3 = e3 >= 0 ? val[TOKROWS ? (e3 >> 2) : e3] : 0.0f;
            if (e0 != -2) st[(2 * (j0 + 0) + hi) * 256 + r] = e0 < 0 ? -1 : (int)(((__float_as_uint(v0) + 0x8000u) & 0xFFFF0000u) | (unsigned)e0);
            if (e1 != -2) st[(2 * (j0 + 1) + hi) * 256 + r] = e1 < 0 ? -1 : (int)(((__float_as_uint(v1) + 0x8000u) & 0xFFFF0000u) | (unsigned)e1);
            if (e2 != -2) st[(2 * (j0 + 2) + hi) * 256 + r] = e2 < 0 ? -1 : (int)(((__float_as_uint(v2) + 0x8000u) & 0xFFFF0000u) | (unsigned)e2);
            if (e3 != -2) st[(2 * (j0 + 3) + hi) * 256 + r] = e3 < 0 ? -1 : (int)(((__float_as_uint(v3) + 0x8000u) & 0xFFFF0000u) | (unsigned)e3); } }
    __device__ __forceinline__ void a_ready(const pg8::Unit& u) const {
        if constexpr (!TOKROWS) { unsigned* f = mflag + u.pm * MFLAG_STRIDE; unsigned spins = 0;
            while (__hip_atomic_load(f, __ATOMIC_RELAXED, __HIP_MEMORY_SCOPE_AGENT) < 8u && ++spins < (1u << 22)) __builtin_amdgcn_s_sleep(2);
            asm volatile("" ::: "memory"); } }
    __device__ __forceinline__ void done(const pg8::Unit& u) const {
        if constexpr (TOKROWS) { asm volatile("s_waitcnt vmcnt(0)" ::: "memory"); __builtin_amdgcn_s_barrier(); asm volatile("" ::: "memory");
            if (threadIdx.x == 0) __hip_atomic_fetch_add(mflag + u.pm * MFLAG_STRIDE, 1u, __ATOMIC_RELAXED, __HIP_MEMORY_SCOPE_AGENT); } }
    __device__ __forceinline__ bool next(int i, pg8::Unit& u) const { const long L = (long)i * G + vcu; if (L >= nunits) return false; const int pm = (int)(L / NN), pnl = (int)(L % NN);
        u.pm = pm; u.pn = tile2e[pm] * NN + pnl; return true; }
    __device__ __forceinline__ int row_slot(const pg8::Unit& u, int r) const { const int e = u.pn / NN, pos = (u.pm - tstart[e]) * 256 + r; return pos < cnt[e] ? elist[e * M + pos] : -1; }
    __device__ __forceinline__ int a_row(const pg8::Unit& u, int r, int slot) const { return TOKROWS ? (slot < 0 ? 0 : ((slot & 0xFFFF) >> 2)) : u.pm * 256 + r; }
    __device__ __forceinline__ const char* a_base(const pg8::Gemm& g, const pg8::Unit&, size_t) const { return (const char*)g.A; }
};
struct EpiUp {
    static constexpr bool PERM = true;
    __device__ __forceinline__ bool keep(const pg8::Unit&) const { return false; }
    unsigned char* ACT; const float* bup; const float* rs2;
    __device__ __forceinline__ void operator()(AccRef acc, const pg8::Unit& u, int wr, int wc, int fr, int fq, const LAS int* tab) const {
        const int e = u.pn >> 3, pnl = u.pn & 7, j0 = 128 * pnl + 32 * wc + 8 * fq;
        f32x2 bG[2][2], bL[2][2];
#pragma unroll
        for (int q = 0; q < 4; ++q) { const f32x4 b4 = *(const f32x4*)(bup + (size_t)e * UPW + 2 * j0 + 4 * q); bG[q >> 1][q & 1] = (f32x2){b4[0], b4[2]}; bL[q >> 1][q & 1] = (f32x2){b4[1] * 4.0f + 4.0f, b4[3] * 4.0f + 4.0f}; }
        int sl[2][4];
#pragma unroll
        for (int ai = 0; ai < 2; ++ai)
#pragma unroll
            for (int m = 0; m < 4; ++m) sl[ai][m] = tab[ai * 128 + wr * 64 + m * 16 + fr];
#pragma unroll
        for (int ai = 0; ai < 2; ++ai)
#pragma unroll
            for (int m = 0; m < 4; ++m) { const int r = ai * 128 + wr * 64 + m * 16 + fr, en = sl[ai][m];
                if (en >= 0) { const float rs = __uint_as_float((unsigned)en & 0xFFFF0000u) * 0.03125f;
                    const f32x2 rsv = (f32x2){rs, rs}, rs4 = rsv * 4.0f; f32x2 o[2][2];
#pragma unroll
                    for (int n = 0; n < 2; ++n)
#pragma unroll
                        for (int p = 0; p < 2; ++p) {
                            f32x2 gl = (f32x2){acc[ai][0][m][n][2 * p], acc[ai][0][m][n][2 * p + 1]} * rsv + bG[n][p], li = (f32x2){acc[ai][1][m][n][2 * p], acc[ai][1][m][n][2 * p + 1]} * rs4 + bL[n][p];
                            gl.x = fminf(gl.x, 7.0f); gl.y = fminf(gl.y, 7.0f); li.x = __builtin_amdgcn_fmed3f(li.x, -24.0f, 32.0f); li.y = __builtin_amdgcn_fmed3f(li.y, -24.0f, 32.0f);
                            const f32x2 t = gl * (-1.702f * 1.4426950408889634f); f32x2 d = (f32x2){__builtin_amdgcn_exp2f(t.x), __builtin_amdgcn_exp2f(t.y)} + 1.0f;
                            d = (f32x2){__builtin_amdgcn_rcpf(d.x), __builtin_amdgcn_rcpf(d.y)};
                            o[n][p] = (gl * d) * li; }
                    const unsigned long long ov = (unsigned long long)pk4_fp8(o[0][0].x, o[0][0].y, o[0][1].x, o[0][1].y) | ((unsigned long long)pk4_fp8(o[1][0].x, o[1][0].y, o[1][1].x, o[1][1].y) << 32);
                    __hip_atomic_store((unsigned long long*)(ACT + (size_t)(u.pm * 256 + r) * DE + j0), ov, __ATOMIC_RELAXED, __HIP_MEMORY_SCOPE_AGENT); } }
    }
};
struct EpiDown {
    static constexpr int PERM = 2;
    __device__ __forceinline__ bool keep(const pg8::Unit&) const { return false; }
    unsigned char* YS2; const float* bdn; const float* wslot;
    __device__ __forceinline__ void operator()(AccRef acc, const pg8::Unit& u, int wr, int wc, int fr, int fq, const LAS int* tab) const {
        const int e = u.pn >> 2, pnl = u.pn & 3, c0 = 256 * pnl + 64 * wc + 16 * fq;
        f32x4 bb[2][2];
#pragma unroll
        for (int bj = 0; bj < 2; ++bj)
#pragma unroll
            for (int n = 0; n < 2; ++n) bb[bj][n] = *(const f32x4*)(bdn + (size_t)e * DM + c0 + bj * 8 + 4 * n);
        int sl[2][4]; float wv[2][4];
#pragma unroll
        for (int ai = 0; ai < 2; ++ai)
#pragma unroll
            for (int m = 0; m < 4; ++m) { const int en = tab[ai * 128 + wr * 64 + m * 16 + fr]; sl[ai][m] = en < 0 ? -1 : (en & 0xFFFF); wv[ai][m] = __uint_as_float((unsigned)en & 0xFFFF0000u); }
#pragma unroll
        for (int ai = 0; ai < 2; ++ai)
#pragma unroll
            for (int m = 0; m < 4; ++m) { const int slot = sl[ai][m];
                if (slot >= 0) { const float w = wv[ai][m] * 16.0f; v4u ov;
                    { const f32x4 ya = (acc[ai][0][m][0] * 0.0078125f + bb[0][0]) * w, yb = (acc[ai][0][m][1] * 0.0078125f + bb[0][1]) * w; ov.x = pk4_fp8(ya[0], ya[1], ya[2], ya[3]); ov.y = pk4_fp8(yb[0], yb[1], yb[2], yb[3]); }
                    { const f32x4 ya = (acc[ai][1][m][0] * 0.0078125f + bb[1][0]) * w, yb = (acc[ai][1][m][1] * 0.0078125f + bb[1][1]) * w; ov.z = pk4_fp8(ya[0], ya[1], ya[2], ya[3]); ov.w = pk4_fp8(yb[0], yb[1], yb[2], yb[3]); }
                    *(v4u*)(YS2 + (size_t)slot * DM + c0) = ov; } }
    }
};

constexpr int S5_UPITCH = 528, S5_SX_OFF = 128 * S5_UPITCH, S5_XPITCH = 132;
__device__ __forceinline__ void s5_unit(Frame& F, int b, int g) {
    LAS unsigned char* Uimg = F.lds + RING_OFF; LAS float* SX = (LAS float*)(F.lds + RING_OFF + S5_SX_OFF);
    const int tid = F.tid, lane = F.lane, w = F.wave, r32 = lane & 31, hi = lane >> 5;
    const bf16* Ug = (const bf16*)(F.ws + WS_U) + (size_t)(b * SSM_G + g) * SEQ * 16;
    const bf16* W1T = (const bf16*)(F.ws + WS_S5 + (size_t)g * 262144); const bf16* M2T = W1T + 128 * 256; const bf16* W3T = M2T + 256 * 256;
    bf16x8 bw1[16];
    { const int nt = w & 3;
#pragma unroll
      for (int ks = 0; ks < 16; ++ks) bw1[ks] = *(const bf16x8*)(W1T + (size_t)(32 * nt + r32) * 256 + 16 * ks + 8 * hi); }
#pragma unroll
    for (int j = 0; j < 8; ++j) { const int q = tid + 512 * j; *(LAS v4u*)(Uimg + (q >> 5) * S5_UPITCH + (q & 31) * 16) = *(const v4u*)(Ug + (size_t)q * 8); }
    __syncthreads();
    { const int nt = w & 3, mt0 = 2 * (w >> 2);
      f32x16 s0 = {0}, s1 = {0};
#pragma unroll
      for (int ks = 0; ks < 16; ++ks) {
          const bf16x8 bf = bw1[ks];
          const bf16x8 a0 = *(const LAS bf16x8*)(Uimg + (32 * mt0 + r32) * S5_UPITCH + (16 * ks + 8 * hi) * 2);
          const bf16x8 a1 = *(const LAS bf16x8*)(Uimg + (32 * (mt0 + 1) + r32) * S5_UPITCH + (16 * ks + 8 * hi) * 2);
          s0 = __builtin_amdgcn_mfma_f32_32x32x16_bf16(a0, bf, s0, 0, 0, 0); s1 = __builtin_amdgcn_mfma_f32_32x32x16_bf16(a1, bf, s1, 0, 0, 0); }
#pragma unroll
      for (int r = 0; r < 16; ++r) { SX[(32 * mt0 + crow(r, hi)) * S5_XPITCH + 32 * nt + r32] = s0[r]; SX[(32 * (mt0 + 1) + crow(r, hi)) * S5_XPITCH + 32 * nt + r32] = s1[r]; } }
    bf16x8 bm2[16], bw3[8];
#pragma unroll
    for (int ks = 0; ks < 16; ++ks) bm2[ks] = *(const bf16x8*)(M2T + (size_t)(32 * w + r32) * 256 + 16 * ks + 8 * hi);
#pragma unroll
    for (int ks = 0; ks < 8; ++ks) bw3[ks] = *(const bf16x8*)(W3T + (size_t)(32 * w + r32) * 128 + 16 * ks + 8 * hi);
    __syncthreads();
    { const int p = lane, c0 = 16 * w; LAS float* ES = (LAS float*)(F.lds + RING_OFF + 2 * S5_SX_OFF);
      static_assert(2 * S5_SX_OFF + 8 * 64 * 2 * 4 <= 139264, "S5 segment states fit above the images");
      const float* a16 = (const float*)(F.ws + WS_A16) + (g * 64 + p) * 2; const float ar = a16[0], ai = a16[1];
      float xr = 0.f, xi = 0.f;
#pragma unroll
      for (int c = 0; c < 16; ++c) { const float sr = SX[(c0 + c) * S5_XPITCH + p], si = SX[(c0 + c) * S5_XPITCH + 64 + p];
          const float nr = ar * xr - ai * xi + sr, ni = ar * xi + ai * xr + si; xr = nr; xi = ni; }
      ES[(w * 64 + p) * 2] = xr; ES[(w * 64 + p) * 2 + 1] = xi;
      float Ar = ar, Ai = ai;
#pragma unroll
      for (int q = 0; q < 4; ++q) { const float tr = Ar * Ar - Ai * Ai, ti = 2.0f * Ar * Ai; Ar = tr; Ai = ti; }
      __syncthreads();
      xr = 0.f; xi = 0.f;
      for (int k = 0; k < w; ++k) { const float er = ES[(k * 64 + p) * 2], ei = ES[(k * 64 + p) * 2 + 1]; const float nr = Ar * xr - Ai * xi + er, ni = Ar * xi + Ai * xr + ei; xr = nr; xi = ni; }
#pragma unroll
      for (int c = 0; c < 16; ++c) { const float sr = SX[(c0 + c) * S5_XPITCH + p], si = SX[(c0 + c) * S5_XPITCH + 64 + p];
          SX[(c0 + c) * S5_XPITCH + p] = xr; SX[(c0 + c) * S5_XPITCH + 64 + p] = xi;
          const float nr = ar * xr - ai * xi + sr, ni = ar * xi + ai * xr + si; xr = nr; xi = ni; }
    }
    __syncthreads();
    { f32x16 y[4] = {{0}, {0}, {0}, {0}};
#pragma unroll
      for (int ks = 0; ks < 16; ++ks) {
          const bf16x8 bf = bm2[ks];
#pragma unroll
          for (int mt = 0; mt < 4; ++mt) { const bf16x8 a = *(const LAS bf16x8*)(Uimg + (32 * mt + r32) * S5_UPITCH + (16 * ks + 8 * hi) * 2); y[mt] = __builtin_amdgcn_mfma_f32_32x32x16_bf16(bf, a, y[mt], 0, 0, 0); }
          }
#pragma unroll
      for (int ks = 0; ks < 8; ++ks) {
          const bf16x8 bf = bw3[ks];
#pragma unroll
          for (int mt = 0; mt < 4; ++mt) { const LAS f32x4* xp = (const LAS f32x4*)(SX + (32 * mt + r32) * S5_XPITCH + 16 * ks + 8 * hi); const f32x4 x0 = xp[0], x1 = xp[1];
              const v4u pk = pack8(x0, x1); y[mt] = __builtin_amdgcn_mfma_f32_32x32x16_bf16(bf, __builtin_bit_cast(bf16x8, pk), y[mt], 0, 0, 0); } }
      bf16* YG = (bf16*)(F.ws + WS_YG);
#pragma unroll
      for (int mt = 0; mt < 4; ++mt) { const int c = 32 * mt + r32;
#pragma unroll
          for (int q = 0; q < 4; ++q) { unsigned pk[2];
#pragma unroll
              for (int hh = 0; hh < 2; ++hh) { const f32x2 x = (f32x2){y[mt][4 * q + 2 * hh], y[mt][4 * q + 2 * hh + 1]}, x2 = x * x,
                      pz = x2 * (-1.4426950408889634f * 1.5957691216057308f * 0.044715f) + (-1.4426950408889634f * 1.5957691216057308f), tz = x * pz;
                  f32x2 d = (f32x2){__builtin_amdgcn_exp2f(tz.x), __builtin_amdgcn_exp2f(tz.y)} + 1.0f; d = (f32x2){__builtin_amdgcn_rcpf(d.x), __builtin_amdgcn_rcpf(d.y)};
                  const f32x2 o = x * d; pk[hh] = cvt_pk_bf16(o.x, o.y); }
              v2u ov; ov.x = pk[0]; ov.y = pk[1];
              *(v2u*)(YG + (size_t)(b * SEQ + 16 * c + 2 * w + (q >> 1)) * SSM_W + g * 16 + 8 * (q & 1) + 4 * hi) = ov; } } }
    __syncthreads();
}

constexpr int AT_KP = 272, AT_VP = 320, AT_KB = 64 * AT_KP, AT_VB = 64 * AT_VP, AT_BUF = AT_KB + AT_VB;
__device__ __forceinline__ s16x4 vtr(const LAS unsigned char* p) { typedef short v4i16_t __attribute__((ext_vector_type(4))); return __builtin_bit_cast(s16x4, __builtin_amdgcn_ds_read_tr16_b64_v4i16((LAS v4i16_t*)p)); }
__device__ __forceinline__ void attn_unit(Frame& F, int b, int h, int qb, float lam) {
    const int tid = F.tid, lane = F.lane, w = F.wave, rg = w >> 1, t = w & 1, r32 = lane & 31, hi = lane >> 5;
    const bf16* Q = (const bf16*)(F.ws + WS_Q); const bf16* K = (const bf16*)(F.ws + WS_K); const bf16* V = (const bf16*)(F.ws + WS_V); bf16* OB = (bf16*)(F.ws + WS_OB);
    LAS unsigned char* L = F.lds + RING_OFF;
    const int qrow = b * SEQ + qb * 128 + rg * 32 + r32;
    bf16x8 qf[4];
#pragma unroll
    for (int ks = 0; ks < 4; ++ks) qf[ks] = *(const bf16x8*)(Q + (size_t)qrow * QK_W + h * 128 + t * 64 + 16 * ks + 8 * hi);
    const int ntile = 2 * qb + 2, mylim = 2 * qb + (rg >> 1);
    const int kr0 = tid >> 4, cc = tid & 15;
    const size_t gbase = (size_t)(b * SEQ) * 512 + h * 128 + cc * 8;
    v4u kregA[2], vregA[2], kregB[2], vregB[2];
#define AT_LOAD(j, kreg, vreg) do { _Pragma("unroll") for (int i_ = 0; i_ < 2; ++i_) { const size_t o_ = gbase + (size_t)(64 * (j) + kr0 + 32 * i_) * 512; kreg[i_] = *(const v4u*)(K + o_); vreg[i_] = *(const v4u*)(V + o_); } } while (0)
#define AT_STORE(buf, kreg, vreg) do { _Pragma("unroll") for (int i_ = 0; i_ < 2; ++i_) { *(LAS v4u*)(L + (buf) * AT_BUF + (kr0 + 32 * i_) * AT_KP + cc * 16) = kreg[i_]; \
        *(LAS v4u*)(L + (buf) * AT_BUF + AT_KB + (kr0 + 32 * i_) * AT_VP + cc * 16) = vreg[i_]; } } while (0)
    AT_LOAD(0, kregB, vregB); AT_LOAD(1, kregA, vregA); AT_STORE(0, kregB, vregB);
    __syncthreads();
    f32x16 o[4] = {{0}, {0}, {0}, {0}};
    float mrun = -60.0f, lrun = 0.f;
    f32x16 negm;
#pragma unroll
    for (int r = 0; r < 16; ++r) negm[r] = 60.0f;
    const int g4 = lane >> 4, i16 = lane & 15;
    const int vlane = (4 * (g4 >> 1) + (i16 >> 2)) * AT_VP + (16 * (g4 & 1) + 4 * (i16 & 3)) * 2;
#define AT_VREAD(s_, set) do { _Pragma("unroll") for (int dt_ = 0; dt_ < 4; ++dt_) { vlo[set][dt_] = vtr(Vb + (s_) * 16 * AT_VP + dt_ * 64); vhh[set][dt_] = vtr(Vb + (s_) * 16 * AT_VP + dt_ * 64 + 8 * AT_VP); } } while (0)
#define AT_EXPCHUNK(S, rb, dst) do { _Pragma("unroll") for (int r_ = 0; r_ < 8; ++r_) S[(rb) + r_] = __builtin_amdgcn_exp2f(S[(rb) + r_]); \
        ps += ((S[(rb)] + S[(rb) + 1]) + (S[(rb) + 2] + S[(rb) + 3])) + ((S[(rb) + 4] + S[(rb) + 5]) + (S[(rb) + 6] + S[(rb) + 7])); \
        dst.x = cvt_pk_bf16(S[(rb)], S[(rb) + 1]); dst.y = cvt_pk_bf16(S[(rb) + 2], S[(rb) + 3]); dst.z = cvt_pk_bf16(S[(rb) + 4], S[(rb) + 5]); dst.w = cvt_pk_bf16(S[(rb) + 6], S[(rb) + 7]); } while (0)
#define AT_COMPUTE(j, buf) do { \
        if (j <= mylim) { \
            const LAS unsigned char* Kb = L + buf * AT_BUF + t * 128 + hi * 16 + r32 * AT_KP; \
            const LAS unsigned char* Vb = L + buf * AT_BUF + AT_KB + vlane; \
            f32x16 s0, s1; \
            __builtin_amdgcn_s_setprio(1); \
        _Pragma("unroll") \
            for (int ks = 0; ks < 4; ++ks) { const bf16x8 k0 = *(const LAS bf16x8*)(Kb + ks * 32), k1 = *(const LAS bf16x8*)(Kb + 32 * AT_KP + ks * 32); \
                if (ks == 0) { s0 = __builtin_amdgcn_mfma_f32_32x32x16_bf16(k0, qf[0], negm, 0, 0, 0); s1 = __builtin_amdgcn_mfma_f32_32x32x16_bf16(k1, qf[0], negm, 0, 0, 0); } \
                else { s0 = __builtin_amdgcn_mfma_f32_32x32x16_bf16(k0, qf[ks], s0, 0, 0, 0); s1 = __builtin_amdgcn_mfma_f32_32x32x16_bf16(k1, qf[ks], s1, 0, 0, 0); } } \
            __builtin_amdgcn_s_setprio(0); \
            float mx = fmaxf(fmaxf(s0[0], s0[1]), s0[2]); \
        _Pragma("unroll") \
            for (int r = 3; r < 15; r += 2) mx = fmaxf(fmaxf(mx, s0[r]), s0[r + 1]); \
            mx = fmaxf(mx, s0[15]); \
        _Pragma("unroll") \
            for (int r = 0; r < 16; r += 2) mx = fmaxf(fmaxf(mx, s1[r]), s1[r + 1]); \
            mx = xor32_max(mx); \
            if (__builtin_amdgcn_ballot_w64(mx > 8.0f) != 0ull) { \
                const float dm = (mx > 8.0f) ? mx : 0.0f, alpha = __builtin_amdgcn_exp2f(-dm); lrun *= alpha; mrun += dm; \
        _Pragma("unroll") \
                for (int dt = 0; dt < 4; ++dt) o[dt] *= alpha; \
        _Pragma("unroll") \
                for (int r = 0; r < 16; ++r) { s0[r] -= dm; s1[r] -= dm; negm[r] = -mrun; } } \
            float ps = 0.f; v4u pkA, pkB; \
              \
            s16x4 vlo[2][4], vhh[2][4]; \
            AT_VREAD(0, 0); AT_EXPCHUNK(s0, 0, pkA); \
        _Pragma("unroll") \
            for (int s = 0; s < 4; ++s) { \
                const bf16x8 pf = __builtin_bit_cast(bf16x8, (s & 1) ? pkB : pkA); \
                __builtin_amdgcn_s_setprio(1); \
        _Pragma("unroll") \
                for (int dt = 0; dt < 4; ++dt) { const bf16x8 vf = (bf16x8){vlo[s & 1][dt][0], vlo[s & 1][dt][1], vlo[s & 1][dt][2], vlo[s & 1][dt][3], vhh[s & 1][dt][0], vhh[s & 1][dt][1], vhh[s & 1][dt][2], vhh[s & 1][dt][3]}; \
                    o[dt] = __builtin_amdgcn_mfma_f32_32x32x16_bf16(vf, pf, o[dt], 0, 0, 0); } \
                __builtin_amdgcn_s_setprio(0); \
                __builtin_amdgcn_sched_barrier(0); \
                if (s == 0) { AT_VREAD(1, 1); AT_EXPCHUNK(s0, 8, pkB); } else if (s == 1) { AT_VREAD(2, 0); AT_EXPCHUNK(s1, 0, pkA); } else if (s == 2) { AT_VREAD(3, 1); AT_EXPCHUNK(s1, 8, pkB); } \
                __builtin_amdgcn_sched_barrier(0); } \
            lrun += ps; \
        } \
    } while (0)
    for (int j = 0; j < ntile; j += 2) {
        { const int jn = (j + 2 < ntile) ? j + 2 : ntile - 1; AT_LOAD(jn, kregB, vregB); }
        AT_COMPUTE(j, 0);
        AT_STORE(1, kregA, vregA);
        __syncthreads();
        { const int jn = (j + 3 < ntile) ? j + 3 : ntile - 1; AT_LOAD(jn, kregA, vregA); }
        AT_COMPUTE(j + 1, 1);
        AT_STORE(0, kregB, vregB);
        __syncthreads();
    }
#undef AT_COMPUTE
#undef AT_EXPCHUNK
#undef AT_VREAD
#undef AT_LOAD
#undef AT_STORE
    const float ltot = lrun + __shfl_xor(lrun, 32), inv = 1.0f / ltot;
    LAS float* EX = (LAS float*)L + rg * 4096;
    if (t == 1) {
        const float sc = inv * lam;
#pragma unroll
        for (int dt = 0; dt < 4; ++dt)
#pragma unroll
            for (int r = 0; r < 16; ++r) EX[(dt * 16 + r) * 64 + lane] = o[dt][r] * sc;
    }
    __syncthreads();
    if (t == 0) {
        float ss = 0.f;
#pragma unroll
        for (int dt = 0; dt < 4; ++dt)
#pragma unroll
            for (int r = 0; r < 16; ++r) { const float y = o[dt][r] * inv - EX[(dt * 16 + r) * 64 + lane]; o[dt][r] = y; ss += y * y; }
        ss += __shfl_xor(ss, 32);
        const float rn = (1.0f - LAMBDA_INIT) / sqrtf(ss * (1.0f / 128.0f) + RMS_EPS);
        const float* sg = F.in[I_SUBLN];
        f32x4 ggv[4][4];
#pragma unroll
        for (int dt = 0; dt < 4; ++dt)
#pragma unroll
            for (int rq = 0; rq < 4; ++rq) ggv[dt][rq] = *(const f32x4*)(sg + 32 * dt + 8 * rq + 4 * hi);
#pragma unroll
        for (int dt = 0; dt < 4; ++dt)
#pragma unroll
            for (int rq = 0; rq < 4; ++rq) { const int d = 32 * dt + 8 * rq + 4 * hi; const f32x4 gg = ggv[dt][rq];
                v2u wv; wv.x = cvt_pk_bf16(o[dt][4 * rq] * rn * gg[0], o[dt][4 * rq + 1] * rn * gg[1]); wv.y = cvt_pk_bf16(o[dt][4 * rq + 2] * rn * gg[2], o[dt][4 * rq + 3] * rn * gg[3]);
                *(v2u*)(OB + (size_t)qrow * V_W + h * 128 + d) = wv; }
    }
    __syncthreads();
}

constexpr int CW_CNT_STRIDE = 64;
__device__ __forceinline__ void router_phase(Frame& F, const bool dummy = false, const int tg_only = -1, unsigned* wflag = nullptr) {
    const int lane = F.lane, tid = F.tid, w = F.wave, tt = w >> 1, kh = w & 1;
    LAS unsigned char* WL = F.lds + RING_OFF; constexpr int WLP = 2064;
    LAS float* LG = (LAS float*)(F.lds + LDSCTL_OFF + 2048);
    LAS float* SS = LG + 4 * 2 * 16 * 33;
    LAS int* LC = (LAS int*)(SS + 128);
    const bf16* Hf = (const bf16*)(F.ws + WS_H16); const float* br = F.in[I_BR];
    float* rs2 = (float*)(F.ws + (dummy ? WS_YS2 : WS_RS2)); float* wslot = (float*)(F.ws + (dummy ? WS_YS2 + MiB : WS_WSLOT)); int* elist = (int*)(F.ws + (dummy ? WS_YS2 + 2 * MiB : WS_ELIST));
    unsigned* cnt = (unsigned*)(F.ctl + CW_CNT + (dummy ? 32 : 0));
    const int i16 = lane & 15, kq = lane >> 4;
    { const v4u* wrT = (const v4u*)(F.ws + WS_WRT);
#pragma unroll
      for (int i = 0; i < 16; ++i) { const int q = tid + 512 * i; *(LAS v4u*)(WL + (q >> 7) * WLP + (q & 127) * 16) = wrT[q]; } }
    if (wflag) panel_wait(wflag, 4u);
    __syncthreads();
    for (int tg = tg_only >= 0 ? tg_only : F.vcu; tg < M / 64; tg += tg_only >= 0 ? M : F.G) {
        if (tid < 64) LC[tid] = 0;
        const int tok0 = tg * 64 + tt * 16;
        f32x4 a0 = {0.f, 0.f, 0.f, 0.f}, a1 = {0.f, 0.f, 0.f, 0.f}; float ssq = 0.f;
        const bf16* hp = Hf + (size_t)(tok0 + i16) * DM + kh * 512 + 8 * kq; const LAS unsigned char* w0 = WL + i16 * WLP + (kh * 512 + 8 * kq) * 2;
#pragma unroll 8
        for (int s = 0; s < 16; ++s) { const v4u hv = *(const v4u*)(hp + 32 * s);
            const bf16x8 bh0 = *(const LAS bf16x8*)(w0 + 64 * s), bh1 = *(const LAS bf16x8*)(w0 + 16 * WLP + 64 * s), bl0 = *(const LAS bf16x8*)(w0 + 32 * WLP + 64 * s), bl1 = *(const LAS bf16x8*)(w0 + 48 * WLP + 64 * s);
            const f32x4 al = (f32x4){bflo(hv.x), bfhi(hv.x), bflo(hv.y), bfhi(hv.y)}, ah = (f32x4){bflo(hv.z), bfhi(hv.z), bflo(hv.w), bfhi(hv.w)};
            ssq += ((al[0] * al[0] + al[1] * al[1]) + (al[2] * al[2] + al[3] * al[3])) + ((ah[0] * ah[0] + ah[1] * ah[1]) + (ah[2] * ah[2] + ah[3] * ah[3]));
            const bf16x8 af = __builtin_bit_cast(bf16x8, hv);
            a0 = __builtin_amdgcn_mfma_f32_16x16x32_bf16(af, bh0, a0, 0, 0, 0); a1 = __builtin_amdgcn_mfma_f32_16x16x32_bf16(af, bh1, a1, 0, 0, 0);
            a0 = __builtin_amdgcn_mfma_f32_16x16x32_bf16(af, bl0, a0, 0, 0, 0); a1 = __builtin_amdgcn_mfma_f32_16x16x32_bf16(af, bl1, a1, 0, 0, 0); }
        ssq += __shfl_xor(ssq, 16); ssq += __shfl_xor(ssq, 32);
        LAS float* lg = LG + (tt * 2 + kh) * 16 * 33;
#pragma unroll
        for (int r = 0; r < 4; ++r) { lg[(4 * kq + r) * 33 + i16] = a0[r]; lg[(4 * kq + r) * 33 + 16 + i16] = a1[r]; }
        if (kq == 0) SS[(tt * 2 + kh) * 16 + i16] = ssq;
        __syncthreads();
        int ti[4]; float wv[4]; int lpos[4]; float rsv = 0.f;
        if (tid < 64) {
            const int t4 = tid >> 4, t16 = tid & 15;
            rsv = 1.0f / sqrtf((SS[(t4 * 2) * 16 + t16] + SS[(t4 * 2 + 1) * 16 + t16]) * (1.0f / DM) + RMS_EPS);
            float lgv[32];
#pragma unroll
            for (int e = 0; e < 32; ++e) lgv[e] = (LG[((t4 * 2) * 16 + t16) * 33 + e] + LG[((t4 * 2 + 1) * 16 + t16) * 33 + e]) * rsv + br[e];
            float tv[4];
#pragma unroll
            for (int k = 0; k < 4; ++k) { float best = -3.0e38f; int bi = 0;
#pragma unroll
                for (int e = 0; e < 32; ++e) { const bool tk = lgv[e] > best; best = tk ? lgv[e] : best; bi = tk ? e : bi; }
                tv[k] = best; ti[k] = bi;
#pragma unroll
                for (int e = 0; e < 32; ++e) lgv[e] = (e == bi) ? -3.0e38f : lgv[e]; }
            const float e1 = __expf(tv[1] - tv[0]), e2 = __expf(tv[2] - tv[0]), e3 = __expf(tv[3] - tv[0]), den = 1.0f / (1.0f + e1 + e2 + e3);
            wv[0] = den; wv[1] = e1 * den; wv[2] = e2 * den; wv[3] = e3 * den;
#pragma unroll
            for (int k = 0; k < 4; ++k) lpos[k] = __hip_atomic_fetch_add(LC + ti[k], 1, __ATOMIC_RELAXED, __HIP_MEMORY_SCOPE_WORKGROUP);
        }
        __syncthreads();
        if (tid < 32) { const int c = LC[tid]; LC[32 + tid] = c ? (int)atomicAdd(cnt + tid * CW_CNT_STRIDE, (unsigned)c) : 0; }
        __syncthreads();
        if (tid < 64) {
            const int tok = tg * 64 + tid;
            rs2[tok] = rsv;
#pragma unroll
            for (int k = 0; k < 4; ++k) { elist[ti[k] * M + LC[32 + ti[k]] + lpos[k]] = tok * 4 + k; wslot[tok * 4 + k] = wv[k]; }
        }
        __syncthreads();
    }
}
__device__ __forceinline__ int moe_tables(Frame& F) {
    LAS int* T = (LAS int*)(F.lds + MOE_LDS_OFF); LAS int* cnt = T, *tstart = T + 32, *tile2e = T + 72;
    if (F.tid < 32) cnt[F.tid] = (int)__hip_atomic_load((unsigned*)(F.ctl + CW_CNT) + F.tid * CW_CNT_STRIDE, RLX_AGENT);
    __syncthreads();
    if (F.tid == 0) { int s = 0; for (int e = 0; e < 32; ++e) { tstart[e] = s; s += (cnt[e] + 255) >> 8; } tstart[32] = s; }
    __syncthreads();
    if (F.tid < 32) { for (int p = tstart[F.tid]; p < tstart[F.tid + 1]; ++p) tile2e[p] = F.tid; }
    __syncthreads();
    return tstart[32];
}
__device__ __forceinline__ void combine_phase(Frame& F, float* dst) {
    const int lane = F.lane, gw = F.vcu * NWAVES + F.wave, NGW = F.G * NWAVES;
    const unsigned char* YS2 = F.ws + WS_YS2;
    for (int tk = gw; tk < M; tk += NGW) {
        const GAS v2u* hrow = (const GAS v2u*)((const bf16*)(F.ws + WS_H16) + (size_t)tk * DM) + lane; GAS f32x4* drow = (GAS f32x4*)(dst + (size_t)tk * DM) + lane;
#pragma unroll
        for (int j = 0; j < 4; ++j) { const v2u hw = hrow[64 * j]; f32x4 v = (f32x4){bflo(hw.x), bfhi(hw.x), bflo(hw.y), bfhi(hw.y)};
#pragma unroll
            for (int k = 0; k < 4; ++k) { const unsigned y = *((const GAS unsigned*)(YS2 + (size_t)(tk * 4 + k) * DM) + lane + 64 * j);
                const f32x2 lo = __builtin_amdgcn_cvt_pk_f32_fp8(y, false), hi = __builtin_amdgcn_cvt_pk_f32_fp8(y, true); v += (f32x4){lo[0], lo[1], hi[0], hi[1]} * 0.0625f; }
            drow[64 * j] = v; }
    }
}

struct Args { const float* in[31]; float* out; unsigned char* ws; unsigned char* hi; int ph_lo, ph_hi; };
__global__ void __launch_bounds__(NWAVES * 64, 2) mk_fwd(Args args) {
    extern __shared__ __attribute__((aligned(16))) unsigned char lds[];
    Frame F;
    F.lds = (LAS unsigned char*)lds;
    F.MISC = (volatile LAS unsigned*)(F.lds + MISC_OFF);
    F.tid = threadIdx.x; F.lane = F.tid & 63; F.wave = __builtin_amdgcn_readfirstlane(F.tid >> 6);
    F.G = gridDim.x; { const int bx = blockIdx.x; F.vcu = (F.G % 8 == 0) ? (bx % 8) * (F.G / 8) + bx / 8 : bx; }
    F.ws = args.ws; F.hi = args.hi; F.ctl = (gu32*)(args.ws + WS_CTL); F.out = args.out;
#pragma unroll
    for (int i = 0; i < 31; ++i) F.in[i] = args.in[i];
    for (int u = F.tid; u < 64; u += NWAVES * 64) F.MISC[u] = 0u;
    __syncthreads();
    XcdBarrier bar; bar.bar = (unsigned*)(F.ctl + CW_BAR); bar.x = 0; bar.st = nullptr;
    if (N_LAUNCHES != PER_PHASE) bar = xcd_barrier_post((unsigned*)(F.ctl + CW_BAR), F.MISC + 8);
#define GRID_BAR() do { if (N_LAUNCHES != PER_PHASE) xcd_barrier(bar); } while (0)
    const int lo = args.ph_lo, hi = args.ph_hi;
    unsigned long long tpA = 0, tpB = 0;
#define TP_BEGIN(k) do { if (PROBE_REP == 60 + (k)) tpA = __builtin_amdgcn_s_memrealtime(); } while (0)
#define TP_END(k) do { if (PROBE_REP == 60 + (k)) tpB = __builtin_amdgcn_s_memrealtime(); } while (0)
#define IN(k) (lo <= (k) && (k) < hi)
#define BOTH(k) (IN(k) && IN((k) + 1))
    unsigned char* ws = args.ws; unsigned char* wsh = args.hi;

    TP_BEGIN(0);
    if (PROBE_REP == 80) tpA = __builtin_amdgcn_s_memrealtime();
    if (IN(0)) { for (int rep = 0; rep < NREP(0); ++rep) { p0_prologue(F); if (BOTH(0)) GRID_BAR(); } }

    TP_END(0);
    TP_BEGIN(1);
    if (IN(1)) for (int rep = 0; rep < NREP(1); ++rep) {
        pg8::StaticOrder S; S.init(M, IN_W / 2, F.G, (int)blockIdx.x);
        { pg8::Gemm g{(const bf16*)(wsh + (WS_XN - HI)), (const bf16*)(wsh + (WS_WIN - HI)), M, IN_W / 2, DM};
          EpiInProj E{(bf16*)(ws + WS_U), (bf16*)(ws + WS_Q), (bf16*)(ws + WS_K), (bf16*)(ws + WS_V), (bf16*)(ws + WS_G1), (bf16*)(ws + WS_G2), F.in[I_BGATE], F.in[I_QG], F.in[I_KG], 0, 1.0f};
          pg8::gemm_phase<EpiInProj, pg8::StaticOrder, true>(F.lds + RING_OFF, g, S, E); }
        { pg8::Gemm g{(const bf16*)(wsh + (WS_XN8 - HI)), (const bf16*)(wsh + (WS_WIN8 - HI)), M, IN_W / 2, DM};
          EpiInProj E{(bf16*)(ws + WS_U), (bf16*)(ws + WS_Q), (bf16*)(ws + WS_K), (bf16*)(ws + WS_V), (bf16*)(ws + WS_G1), (bf16*)(ws + WS_G2), F.in[I_BGATE], F.in[I_QG], F.in[I_KG], 8, 0.0078125f};
          const Fp8Dense S8{S, (const LAS int*)(F.lds + SLOT_OFF)};
          pg8::gemm_phase<EpiInProj, Fp8Dense, true, true, true, true>(F.lds + RING_OFF, g, S8, E, 0, 0); }
        if (BOTH(1)) GRID_BAR();
    }

    if (PROBE_REP == 30 && IN(1) && IN(2)) { GRID_BAR(); GRID_BAR(); GRID_BAR(); GRID_BAR(); }
    TP_END(1);
    TP_BEGIN(2);
    if (IN(2)) {
        for (int rep = 0; rep < NREP(20); ++rep) for (int u = F.vcu; u < BATCH * SSM_G; u += F.G) { const int g = (u >> 5) * 4 + ((u & 31) >> 3), b = u & 7; s5_unit(F, b, g); }
        float lam;
        { const float a = wave_sum(F.in[I_LQ1][F.lane] * F.in[I_LK1][F.lane]), c = wave_sum(F.in[I_LQ2][F.lane] * F.in[I_LK2][F.lane]); lam = __expf(a) - __expf(c) + LAMBDA_INIT; }
        for (int rep = 0; rep < NREP(21); ++rep) for (int u = F.vcu; u < BATCH * ATT_H * 8; u += F.G) { const int bh = u >> 3, qp = u & 7; attn_unit(F, bh >> 2, bh & 3, 15 - qp, lam); attn_unit(F, bh >> 2, bh & 3, qp, lam); }
        if (BOTH(2)) GRID_BAR();
    }

    TP_END(2);
    TP_BEGIN(3);
    const bool pf3 = (F.G == M / 64) && IN(3) && IN(4) && (PROBE_REP < 0 || PROBE_REP >= 60);
    unsigned* const panel3 = (unsigned*)(F.ctl + CW_PANEL3);
    if (IN(3)) for (int rep = 0; rep < NREP(3); ++rep) {
        { pg8::Gemm g{(const bf16*)(ws + WS_YG), (const bf16*)(ws + WS_WGLU), M, 512, 512}; PanelOrder S; S.so.init(M, 512, F.G, (int)blockIdx.x); S.wflag = nullptr; S.pflag = pf3 ? panel3 : nullptr;
          EpiMix<0> E{(const bf16*)(ws + WS_YG), nullptr, (bf16*)(ws + WS_YS), F.in[I_BGLU], 512};
          pg8::gemm_phase<EpiMix<0>, PanelOrder, true>(F.lds + RING_OFF, g, S, E); }
        if ((int)blockIdx.x >= (M / 256) * 2 && rep == 0) convert_big(F, 1, BIG_SPLIT, NBIG);
        if (BOTH(3) && !pf3) GRID_BAR();
    }

    TP_END(3);
    TP_BEGIN(4);
    const bool pf = (F.G == M / 64) && IN(4) && IN(5) && IN(6) && (PROBE_REP < 0 || PROBE_REP >= 60);
    unsigned* const panel4 = (unsigned*)(F.ctl + CW_PANEL4); unsigned* const panel5 = (unsigned*)(F.ctl + CW_PANEL5);
    if (IN(4)) for (int rep = 0; rep < NREP(4); ++rep) {
        pg8::Gemm g{(const bf16*)(ws + WS_OB), (const bf16*)(ws + WS_WPS), M, DM, 512};
        ChainOrder S; S.so.init(M, DM, F.G, (int)blockIdx.x); S.A_att = (const bf16*)(ws + WS_OB); S.A_ssm = (const bf16*)(ws + WS_YS); S.pflag = pf ? panel4 : nullptr; S.wflag = pf3 ? panel3 : nullptr;
        EpiChain E{(const bf16*)(ws + WS_G1), (const bf16*)(ws + WS_G2), (bf16*)(ws + WS_MX), pf};
        pg8::gemm_phase<EpiChain, ChainOrder, true>(F.lds + RING_OFF, g, S, E);
        if (BOTH(4) && !pf) GRID_BAR();
    }

    TP_END(4);
    TP_BEGIN(5);
    if (IN(5)) for (int rep = 0; rep < NREP(5); ++rep) {
        pg8::Gemm g{(const bf16*)(ws + WS_MX), (const bf16*)(ws + WS_WOUT), M, DM, DM}; PanelOrder S; S.so.init(M, DM, F.G, (int)blockIdx.x); S.wflag = pf ? panel4 : nullptr; S.pflag = pf ? panel5 : nullptr;
        EpiOut E{F.in[I_X], (bf16*)(ws + WS_H16), ws + WS_HB, pf};
        pg8::gemm_phase<EpiOut, PanelOrder, true>(F.lds + RING_OFF, g, S, E);
        if (BOTH(5) && !pf) GRID_BAR();
    }

    TP_END(5);
    TP_BEGIN(6);
    if (IN(6)) {
        if (pf) { pg8::StaticOrder so; so.init(M, DM, F.G, (int)blockIdx.x); pg8::Unit u; so.next(0, u);
                  router_phase(F, false, 4 * u.pm + u.pn, panel5 + u.pm * PANEL_STRIDE); }
        else router_phase(F);
        if (BOTH(6)) GRID_BAR(); }

    TP_END(6);
    TP_BEGIN(7);
    if (IN(7)) for (int rep = 0; rep < NREP(7); ++rep) {
        const int nmt = moe_tables(F); LAS int* T = (LAS int*)(F.lds + MOE_LDS_OFF); unsigned* mflag = (unsigned*)(F.ctl + CW_MFLAG) + (rep ? 288 * MFLAG_STRIDE : 0);
        { pg8::Gemm g{(const bf16*)(ws + WS_HB), (const bf16*)(wsh + (WS_WUP - HI)), M, UPW, DM, UPW};
          MoeOrder<8, true> S{nmt * 8, F.G, F.vcu, T, T + 32, T + 72, (const int*)(ws + WS_ELIST), mflag, (LAS int*)(F.lds + SLOT_OFF)}; S.fill(F.tid, (const float*)(ws + WS_RS2)); __syncthreads();
          EpiUp E{ws + WS_ACT, F.in[I_BUP], (const float*)(ws + WS_RS2)};
          pg8::gemm_phase<EpiUp, MoeOrder<8, true>, true, true, true, true>(F.lds + RING_OFF, g, S, E, 0, 0); }
        { pg8::Gemm g{(const bf16*)(ws + WS_ACT), (const bf16*)(wsh + (WS_WDN - HI)), MOE_ROWS_MAX, DM, DE, DM};
          MoeOrder<4, false> S{nmt * 4, F.G, F.G - 1 - F.vcu, T, T + 32, T + 72, (const int*)(ws + WS_ELIST), mflag, (LAS int*)(F.lds + SLOT_OFF)}; S.fill(F.tid, (const float*)(ws + WS_WSLOT)); __syncthreads();
          EpiDown E{ws + WS_YS2, F.in[I_BDN], (const float*)(ws + WS_WSLOT)};
          pg8::gemm_phase<EpiDown, MoeOrder<4, false>, true, true, true, true>(F.lds + RING_OFF, g, S, E, 0, 0); }
        if (BOTH(7)) GRID_BAR();
    }

    TP_END(7);
    TP_BEGIN(9);
    if (IN(9)) { combine_phase(F, F.out); }
    if (IN(16)) router_phase(F, true);
    if (IN(19)) combine_phase(F, (float*)(ws + WS_TA));
    TP_END(9);
    if (PROBE_REP == 80) tpB = __builtin_amdgcn_s_memrealtime();
    if (PROBE_REP >= 60 && blockIdx.x == 0) { const unsigned long long t0 = __builtin_amdgcn_s_memrealtime(); while (__builtin_amdgcn_s_memrealtime() - t0 < tpB - tpA) __builtin_amdgcn_s_sleep(8); }
#undef IN
#undef BOTH
#undef GRID_BAR
}

extern "C" void kernel_launch(void* const* d_in, const int* in_sizes, int n_in, void* d_out, int out_size, void* d_ws, size_t ws_size, hipStream_t stream) {
    static int grid = 0;
    if (grid == 0) {
        if (n_in != 31 || in_sizes[0] != M * DM || out_size != M * DM || ws_size < WS_END) {
            fprintf(stderr, "kernel_launch: unexpected shapes (n_in %d, in0 %d, out %d, ws %zu < %zu); nothing launched\n", n_in, n_in > 0 ? in_sizes[0] : -1, out_size, ws_size, (size_t)WS_END); grid = -1; return; }
        int dev = 0, cus = 0;
        if (hipGetDevice(&dev) != hipSuccess || hipDeviceGetAttribute(&cus, hipDeviceAttributeMultiprocessorCount, dev) != hipSuccess) { grid = -1; return; }
        if (hipFuncSetAttribute((const void*)mk_fwd, hipFuncAttributeMaxDynamicSharedMemorySize, LDS_BYTES) != hipSuccess) { fprintf(stderr, "kernel_launch: hipFuncSetAttribute failed\n"); grid = -1; return; }
        int per_cu = 0;
        if (hipOccupancyMaxActiveBlocksPerMultiprocessor(&per_cu, (const void*)mk_fwd, NWAVES * 64, LDS_BYTES) != hipSuccess || per_cu < 1) fprintf(stderr, "kernel_launch: occupancy query reports %d\n", per_cu);
        (void)hipGetLastError();
        grid = cus;
    }
    if (grid < 0) return;
    (void)hipMemsetAsync((char*)d_ws + WS_CTL, 0, CTL_ZERO_BYTES, stream);
    Args a{};
    for (int i = 0; i < 31; ++i) a.in[i] = (const float*)d_in[i];
    a.out = (float*)d_out; a.ws = (unsigned char*)d_ws; a.hi = (unsigned char*)d_ws + ((ws_size - 256 * MiB) & ~(size_t)0xfffff);
    if (N_LAUNCHES == 1) { a.ph_lo = 0; a.ph_hi = PER_PHASE; hipLaunchKernelGGL(mk_fwd, dim3(grid), dim3(NWAVES * 64), LDS_BYTES, stream, a); }
    else for (int p = 0; p < PER_PHASE; ++p) { a.ph_lo = p; a.ph_hi = p + 1; if (PROBE_REP - 110 == p) { a.ph_lo = p + 10; a.ph_hi = p + 11; hipLaunchKernelGGL(mk_fwd, dim3(grid), dim3(NWAVES * 64), LDS_BYTES, stream, a); a.ph_lo = p; a.ph_hi = p + 1; }
        for (int rep = 0; rep < ((PROBE_REP - 100 == p) ? 2 : 1); ++rep) hipLaunchKernelGGL(mk_fwd, dim3(grid), dim3(NWAVES * 64), LDS_BYTES, stream, a); }
}
```
